# Optimizing an MI355X kernel written in HIP

```python
import numpy as np
import jax
import jax.numpy as jnp
from jax import lax

D_MODEL = 1024
BATCH = 8
SEQ = 4096
DEPTH = 4

CTX_LEN = 256
GRID_W = 64
NORM_EPS = 1e-6
CHUNK = 64

HG_HEADS = 4
HG_DK = 64
HG_DV = 64
HG_WIDTH = HG_HEADS * HG_DV
ML_HEADS = 4
ML_DK = 64
ML_DV = 64
ML_WIDTH = ML_HEADS * ML_DV
AT_HEADS = 4
AT_KV_HEADS = 2
AT_HEAD_DIM = 128
AT_WIDTH = AT_HEADS * AT_HEAD_DIM
ROPE_THETA = 10000.0
Q_BLOCK = 128

D_MIX = HG_WIDTH + ML_WIDTH + AT_WIDTH

N_EXPERTS = 32
TOP_K = 4
D_EXPERT = D_MODEL
SWIGLU_LIMIT = 7.0
SWIGLU_ALPHA = 1.702
MOE_BLOCK = 512

HG_SPLITS = (HG_HEADS * HG_DK, HG_HEADS * HG_DK, HG_HEADS * HG_DK, HG_WIDTH, HG_WIDTH)
ML_SPLITS = (ML_HEADS * ML_DK, ML_HEADS * ML_DK, ML_WIDTH, ML_WIDTH, 4 * ML_HEADS)
AT_SPLITS = (AT_WIDTH, AT_KV_HEADS * AT_HEAD_DIM, AT_KV_HEADS * AT_HEAD_DIM)
HG_IN = sum(HG_SPLITS)
ML_IN = sum(ML_SPLITS)
AT_IN = sum(AT_SPLITS)
N_IN = HG_IN + ML_IN + AT_IN

F32 = jnp.float32

kernel_name = 'hybrid_hgrn2_mlstm_gqa_moe_dit'


def split_sizes(a, sizes):
    return jnp.split(a, np.cumsum(sizes)[:-1].tolist(), axis=-1)


def rms_norm(x, g):
    xf = x.astype(F32)
    y = xf * lax.rsqrt(jnp.mean(xf * xf, axis=-1, keepdims=True) + NORM_EPS)
    return (y * g.astype(F32)).astype(x.dtype)


def to_heads(a, n_heads):
    b, t, _ = a.shape
    return a.reshape(b, t, n_heads, -1).transpose(0, 2, 1, 3)


def from_heads(a):
    b, h, t, d = a.shape
    return a.transpose(0, 2, 1, 3).reshape(b, t, h * d)


def to_chunks(a):
    b, h, t = a.shape[:3]
    return jnp.moveaxis(a.reshape(b, h, t // CHUNK, CHUNK, *a.shape[3:]), 2, 0)


def from_chunks(a):
    a = jnp.moveaxis(a, 0, 2)
    b, h, n, c = a.shape[:4]
    return a.reshape(b, h, n * c, *a.shape[4:])


def hgrn2_lower_bounds(lb_logits):
    p = jax.nn.softmax(lb_logits.astype(F32), axis=1)
    cum = jnp.cumsum(p, axis=1)
    return cum - cum[:, :1]


def hgrn2_gates(z, lb):
    z = z.astype(F32)
    log_f = jnp.logaddexp(jnp.log(lb), jnp.log1p(-lb) + jax.nn.log_sigmoid(z))
    k = (1.0 - lb) * jax.nn.sigmoid(-z)
    return log_f, k


def gla_scan(q, k, v, log_f, s0, reverse):
    if reverse:
        q, k, v, log_f = (jnp.flip(a, 2) for a in (q, k, v, log_f))
    causal = jnp.tril(jnp.ones((CHUNK, CHUNK), bool))

    def step(s, blk):
        qc, kc, vc, lf = blk
        b = jnp.cumsum(lf, axis=-2)
        diff = b[..., :, None, :] - b[..., None, :, :]
        decay = jnp.exp(jnp.where(causal[:, :, None], diff, -jnp.inf))
        scores = jnp.einsum('bhtd,bhsd,bhtsd->bhts', qc, kc, decay)
        o = (jnp.einsum('bhts,bhsv->bhtv', scores, vc)
             + jnp.einsum('bhtd,bhdv->bhtv', qc * jnp.exp(b), s))
        b_end = b[..., -1:, :]
        s_new = (jnp.exp(b_end[..., 0, :])[..., None] * s
                 + jnp.einsum('bhsd,bhsv->bhdv', kc * jnp.exp(b_end - b), vc))
        return s_new, o

    s_fin, o = lax.scan(step, s0, tuple(to_chunks(a.astype(F32)) for a in (q, k, v, log_f)))
    o = from_chunks(o)
    if reverse:
        o = jnp.flip(o, 2)
    return o, s_fin


def hgrn2_mixer(p, pc, lb, out_g, with_ctx_out):
    def prep(a):
        q, z_fwd, z_bwd, v, g = split_sizes(a, HG_SPLITS)
        return (to_heads(q, HG_HEADS), (to_heads(z_fwd, HG_HEADS), to_heads(z_bwd, HG_HEADS)),
                to_heads(v, HG_HEADS), g)

    q, z, v, g = prep(p)
    qc, zc, vc, gc = prep(pc)
    s0 = jnp.zeros((p.shape[0], HG_HEADS, HG_DK, HG_DV), F32)
    o = 0.0
    oc = 0.0
    for direction in range(2):
        rev = direction == 1
        lb_d = lb[direction].astype(F32).reshape(HG_HEADS, 1, HG_DK)
        log_f, k = hgrn2_gates(z[direction], lb_d)
        log_fc, kc = hgrn2_gates(zc[direction], lb_d)
        oc_d, s_ctx = gla_scan(qc, kc, vc, log_fc, s0, rev)
        o_d, _ = gla_scan(q, k, v, log_f, s_ctx, rev)
        o = o + o_d
        oc = oc + oc_d

    def finish(o, g):
        return (from_heads(rms_norm(o, out_g)) * jax.nn.silu(g.astype(F32))).astype(g.dtype)

    return finish(o, g), (finish(oc, gc) if with_ctx_out else None)


def mlstm_scan(q, k, v, i_pre, log_f, state, reverse):
    if reverse:
        q, k, v, i_pre, log_f = (jnp.flip(a, 2) for a in (q, k, v, i_pre, log_f))
    causal = jnp.tril(jnp.ones((CHUNK, CHUNK), bool))

    def step(carry, blk):
        c_st, n_st, m_st = carry
        qc, kc, vc, ic, fc = blk
        b = jnp.cumsum(fc, axis=-1)
        d = jnp.where(causal, b[..., :, None] - b[..., None, :] + ic[..., None, :], -jnp.inf)
        from_prev = b + m_st[..., None]
        m_t = jnp.maximum(from_prev, jnp.max(d, axis=-1))
        w = jnp.exp(d - m_t[..., None]) * jnp.einsum('bhtd,bhsd->bhts', qc, kc)
        a_prev = jnp.exp(from_prev - m_t)
        num = (jnp.einsum('bhts,bhsv->bhtv', w, vc)
               + a_prev[..., None] * jnp.einsum('bhtd,bhdv->bhtv', qc, c_st))
        den = jnp.sum(w, axis=-1) + a_prev * jnp.einsum('bhtd,bhd->bht', qc, n_st)
        h = num / jnp.maximum(jnp.abs(den), jnp.exp(-m_t))[..., None]
        m_new = m_t[..., -1]
        a_end = jnp.exp(b[..., -1] + m_st - m_new)
        w_end = jnp.exp(b[..., -1:] - b + ic - m_new[..., None])
        c_new = a_end[..., None, None] * c_st + jnp.einsum('bhs,bhsd,bhsv->bhdv', w_end, kc, vc)
        n_new = a_end[..., None] * n_st + jnp.einsum('bhs,bhsd->bhd', w_end, kc)
        return (c_new, n_new, m_new), h

    state_fin, h = lax.scan(step, state, tuple(to_chunks(a.astype(F32)) for a in (q, k, v, i_pre, log_f)))
    h = from_chunks(h)
    if reverse:
        h = jnp.flip(h, 2)
    return h, state_fin


def mlstm_mixer(p, pc, gate_bias, out_g, with_ctx_out):
    def prep(a):
        q, k, v, og, gates = split_sizes(a, ML_SPLITS)
        gates = gates.astype(F32).reshape(a.shape[0], a.shape[1], 4, ML_HEADS) + gate_bias.astype(F32)
        gates = jnp.moveaxis(gates, 1, -1)
        return (to_heads(q, ML_HEADS), to_heads(k, ML_HEADS) * (ML_DK ** -0.5), to_heads(v, ML_HEADS), og,
                gates[:, 0:2], jax.nn.log_sigmoid(gates[:, 2:4]))

    q, k, v, og, i_pre, log_f = prep(p)
    qc, kc, vc, ogc, i_prec, log_fc = prep(pc)
    b = p.shape[0]
    state0 = (jnp.zeros((b, ML_HEADS, ML_DK, ML_DV), F32), jnp.zeros((b, ML_HEADS, ML_DK), F32),
              jnp.zeros((b, ML_HEADS), F32))
    h = 0.0
    hc = 0.0
    for direction in range(2):
        rev = direction == 1
        hc_d, st_ctx = mlstm_scan(qc, kc, vc, i_prec[:, direction], log_fc[:, direction], state0, rev)
        h_d, _ = mlstm_scan(q, k, v, i_pre[:, direction], log_f[:, direction], st_ctx, rev)
        h = h + h_d
        hc = hc + hc_d

    def finish(h, og):
        return (from_heads(rms_norm(h, out_g)) * jax.nn.sigmoid(og.astype(F32))).astype(og.dtype)

    return finish(h, og), (finish(hc, ogc) if with_ctx_out else None)


def rope_tables(n, dtype):
    rows = n // GRID_W
    row = jnp.broadcast_to(jnp.arange(rows)[:, None], (rows, GRID_W)).reshape(-1).astype(F32)
    col = jnp.broadcast_to(jnp.arange(GRID_W)[None, :], (rows, GRID_W)).reshape(-1).astype(F32)
    axis_dims = AT_HEAD_DIM // 2
    inv_freq = ROPE_THETA ** (-jnp.arange(0, axis_dims, 2, dtype=F32) / axis_dims)
    ang_r = row[:, None] * inv_freq
    ang_c = col[:, None] * inv_freq
    return tuple(t.astype(dtype) for t in (jnp.cos(ang_r), jnp.sin(ang_r), jnp.cos(ang_c), jnp.sin(ang_c)))


def rotate(x, cos, sin):
    x1, x2 = jnp.split(x, 2, axis=-1)
    return jnp.concatenate([x1 * cos - x2 * sin, x2 * cos + x1 * sin], axis=-1)


def rope_2d(x, tables):
    cos_r, sin_r, cos_c, sin_c = tables
    x_row, x_col = jnp.split(x, 2, axis=-1)
    return jnp.concatenate([rotate(x_row, cos_r, sin_r), rotate(x_col, cos_c, sin_c)], axis=-1)


def gqa_attend(qb, keys, vals):
    s = jnp.einsum('bkgqd,bksd->bkgqs', qb, keys).astype(F32) * (AT_HEAD_DIM ** -0.5)
    pr = jax.nn.softmax(s, axis=-1).astype(vals.dtype)
    return jnp.einsum('bkgqs,bksd->bkgqd', pr, vals)


def attn_mixer(p, pc, q_g, k_g, rope, with_ctx_out):
    def prep(a):
        q, k, v = split_sizes(a, AT_SPLITS)
        return (rms_norm(to_heads(q, AT_HEADS), q_g), rms_norm(to_heads(k, AT_KV_HEADS), k_g),
                to_heads(v, AT_KV_HEADS))

    q, k, v = prep(p)
    qc, kc, vc = prep(pc)
    q = rope_2d(q, rope)
    k = rope_2d(k, rope)
    keys = jnp.concatenate([kc, k], axis=2)
    vals = jnp.concatenate([vc, v], axis=2)
    b, _, n, hd = q.shape
    grp = AT_HEADS // AT_KV_HEADS
    qb = jnp.moveaxis(q.reshape(b, AT_KV_HEADS, grp, n // Q_BLOCK, Q_BLOCK, hd), 3, 0)
    ob = lax.map(lambda blk: gqa_attend(blk, keys, vals), qb)
    out = from_heads(jnp.moveaxis(ob, 0, 3).reshape(b, AT_HEADS, n, hd)).astype(p.dtype)
    if not with_ctx_out:
        return out, None
    lc = qc.shape[2]
    oc = gqa_attend(qc.reshape(b, AT_KV_HEADS, grp, lc, hd), kc, vc).reshape(b, AT_HEADS, lc, hd)
    return out, from_heads(oc).astype(pc.dtype)


def moe_ffn(h, w_router, b_router, w_gu, b_gu, w_down, b_down):
    t, d = h.shape
    logits = (h @ w_router + b_router).astype(F32)
    top_v, top_i = lax.top_k(logits, TOP_K)
    gates = jax.nn.softmax(top_v, axis=-1).astype(h.dtype)
    tk = t * TOP_K
    flat_e = top_i.reshape(tk)
    flat_tok = jnp.arange(tk) // TOP_K
    flat_g = gates.reshape(tk)
    order = jnp.argsort(flat_e)
    se = flat_e[order]
    counts = jnp.bincount(flat_e, length=N_EXPERTS)
    padded = (counts + MOE_BLOCK - 1) // MOE_BLOCK * MOE_BLOCK
    pend = jnp.cumsum(padded)
    pstart = pend - padded
    cstart = jnp.cumsum(counts) - counts
    dest = pstart[se] + jnp.arange(tk) - cstart[se]
    nb = -(-tk // MOE_BLOCK) + N_EXPERTS
    tok_buf = jnp.full((nb * MOE_BLOCK,), t, jnp.int32).at[dest].set(flat_tok[order])
    gate_buf = jnp.zeros((nb * MOE_BLOCK,), h.dtype).at[dest].set(flat_g[order])
    block_e = jnp.minimum(jnp.searchsorted(pend, jnp.arange(nb) * MOE_BLOCK, side='right'), N_EXPERTS - 1)
    h_pad = jnp.concatenate([h, jnp.zeros((1, d), h.dtype)], axis=0)

    def body(out, blk):
        tok, g, e = blk
        gu = h_pad[tok] @ w_gu[e] + b_gu[e]
        gate, up = jnp.split(gu, 2, axis=-1)
        gate = jnp.minimum(gate, SWIGLU_LIMIT)
        up = jnp.clip(up, -SWIGLU_LIMIT, SWIGLU_LIMIT)
        act = (up + 1.0) * gate * jax.nn.sigmoid(SWIGLU_ALPHA * gate)
        y = (act @ w_down[e] + b_down[e]) * g[:, None]
        return out.at[tok].add(y), None

    out, _ = lax.scan(body, jnp.zeros((t + 1, d), h.dtype),
                      (tok_buf.reshape(nb, MOE_BLOCK), gate_buf.reshape(nb, MOE_BLOCK), block_e))
    return out[:t]


def modulation(cvec, w, b):
    return jnp.split(jax.nn.silu(cvec) @ w + b, 6, axis=-1)


def modulate(h, shift, scale):
    return h * (1.0 + scale) + shift


def setup_inputs(seed: int = 0) -> dict:
    key = jax.random.key(seed)
    ks = jax.random.split(key, 26)

    def nrm(k, shape, s):
        return jax.random.normal(k, shape, F32) * s

    i_bias = nrm(ks[12], (DEPTH, 2, ML_HEADS), 0.1)
    f_bias = jnp.linspace(3.0, 6.0, ML_HEADS, dtype=F32) + nrm(ks[13], (DEPTH, 2, ML_HEADS), 0.1)
    return {
        'x': nrm(ks[0], (BATCH, SEQ, D_MODEL), 1.0),
        'c': nrm(ks[1], (BATCH, D_MODEL), 1.0),
        'ctx': nrm(ks[2], (BATCH, CTX_LEN, D_MODEL), 1.0),
        'c_ctx': nrm(ks[3], (D_MODEL,), 1.0),
        'w_mod': nrm(ks[4], (DEPTH, D_MODEL, 6 * D_MODEL), 0.5 * D_MODEL ** -0.5),
        'b_mod': nrm(ks[5], (DEPTH, 6 * D_MODEL), 0.01),
        'norm1_g': 1.0 + nrm(ks[6], (DEPTH, D_MODEL), 0.01),
        'norm2_g': 1.0 + nrm(ks[7], (DEPTH, D_MODEL), 0.01),
        'w_in': nrm(ks[8], (DEPTH, D_MODEL, N_IN), D_MODEL ** -0.5),
        'w_out': nrm(ks[9], (DEPTH, D_MIX, D_MODEL), D_MIX ** -0.5),
        'hg_lb_logits': nrm(ks[10], (2, DEPTH, HG_HEADS * HG_DK), 0.5),
        'hg_norm_g': 1.0 + nrm(ks[11], (DEPTH, HG_DV), 0.01),
        'ml_gate_bias': jnp.concatenate([i_bias, f_bias], axis=1),
        'ml_norm_g': 1.0 + nrm(ks[14], (DEPTH, ML_DV), 0.01),
        'q_norm_g': 1.0 + nrm(ks[15], (DEPTH, AT_HEAD_DIM), 0.01),
        'k_norm_g': 1.0 + nrm(ks[16], (DEPTH, AT_HEAD_DIM), 0.01),
        'w_router': nrm(ks[17], (DEPTH, D_MODEL, N_EXPERTS), D_MODEL ** -0.5),
        'b_router': nrm(ks[18], (DEPTH, N_EXPERTS), 0.01),
        'w_gu': nrm(ks[19], (DEPTH, N_EXPERTS, D_MODEL, 2 * D_EXPERT), D_MODEL ** -0.5),
        'b_gu': nrm(ks[20], (DEPTH, N_EXPERTS, 2 * D_EXPERT), 0.01),
        'w_down': nrm(ks[21], (DEPTH, N_EXPERTS, D_EXPERT, D_MODEL), D_EXPERT ** -0.5),
        'b_down': nrm(ks[22], (DEPTH, N_EXPERTS, D_MODEL), 0.01),
    }


def reference(x, c, ctx, c_ctx, w_mod, b_mod, norm1_g, norm2_g, w_in, w_out,
              hg_lb_logits, hg_norm_g, ml_gate_bias, ml_norm_g, q_norm_g, k_norm_g,
              w_router, b_router, w_gu, b_gu, w_down, b_down):
    b, n, d = x.shape
    rope = rope_tables(n, x.dtype)
    hg_lb = hgrn2_lower_bounds(hg_lb_logits)
    xc = ctx
    for layer in range(DEPTH):
        last = layer == DEPTH - 1
        sh1, sc1, g1, sh2, sc2, g2 = [m[:, None, :] for m in modulation(c, w_mod[layer], b_mod[layer])]
        sh1c, sc1c, g1c, sh2c, sc2c, g2c = modulation(c_ctx, w_mod[layer], b_mod[layer])

        h = modulate(rms_norm(x, norm1_g[layer]), sh1, sc1)
        hc = modulate(rms_norm(xc, norm1_g[layer]), sh1c, sc1c)
        p_hg, p_ml, p_at = split_sizes(h @ w_in[layer], (HG_IN, ML_IN, AT_IN))
        pc_hg, pc_ml, pc_at = split_sizes(hc @ w_in[layer], (HG_IN, ML_IN, AT_IN))
        y_hg, yc_hg = hgrn2_mixer(p_hg, pc_hg, hg_lb[:, layer], hg_norm_g[layer], not last)
        y_ml, yc_ml = mlstm_mixer(p_ml, pc_ml, ml_gate_bias[layer], ml_norm_g[layer], not last)
        y_at, yc_at = attn_mixer(p_at, pc_at, q_norm_g[layer], k_norm_g[layer], rope, not last)
        x = x + g1 * (jnp.concatenate([y_hg, y_ml, y_at], axis=-1) @ w_out[layer])

        h2 = modulate(rms_norm(x, norm2_g[layer]), sh2, sc2)
        if last:
            f = moe_ffn(h2.reshape(b * n, d), w_router[layer], b_router[layer], w_gu[layer],
                        b_gu[layer], w_down[layer], b_down[layer])
            x = x + g2 * f.reshape(b, n, d)
        else:
            xc = xc + g1c * (jnp.concatenate([yc_hg, yc_ml, yc_at], axis=-1) @ w_out[layer])
            h2c = modulate(rms_norm(xc, norm2_g[layer]), sh2c, sc2c)
            tokens = jnp.concatenate([h2.reshape(b * n, d), h2c.reshape(-1, d)], axis=0)
            f = moe_ffn(tokens, w_router[layer], b_router[layer], w_gu[layer],
                        b_gu[layer], w_down[layer], b_down[layer])
            x = x + g2 * f[:b * n].reshape(b, n, d)
            xc = xc + g2c * f[b * n:].reshape(xc.shape)
    return x
```

```cpp
#include <hip/hip_runtime.h>
#include <cstdio>
#include <cstdint>
#include <cmath>

#ifndef MK_MULTI
#define MK_MULTI 0
#endif
#ifndef MOE_FP8
#define MOE_FP8 1
#endif
#ifndef OUTPROJ_FP8
#define OUTPROJ_FP8 1
#endif
#ifndef INPROJ_I8
#define INPROJ_I8 1
#endif
#ifndef GEMM_ALIGN
#define GEMM_ALIGN 1
#endif
#ifndef NEW_HG
#define NEW_HG 1
#endif
#ifndef NEW_ML
#define NEW_ML 1
#endif
#ifndef PROBE_DOUBLE
#define PROBE_DOUBLE -1
#endif

#define GAS __attribute__((address_space(1)))
#define LAS __attribute__((address_space(3)))
typedef unsigned short bf16;
typedef short bf16x8 __attribute__((ext_vector_type(8)));
typedef short s16x4 __attribute__((ext_vector_type(4)));
typedef float f32x2 __attribute__((ext_vector_type(2)));
typedef float f32x4 __attribute__((ext_vector_type(4)));
typedef float f32x16 __attribute__((ext_vector_type(16)));
typedef unsigned u32x2 __attribute__((ext_vector_type(2)));
typedef unsigned u32x4 __attribute__((ext_vector_type(4)));
typedef __bf16 bf16x2_t __attribute__((ext_vector_type(2)));
typedef int v8i __attribute__((ext_vector_type(8)));
typedef int v4i __attribute__((ext_vector_type(4)));
typedef unsigned u32x8 __attribute__((ext_vector_type(8)));

constexpr int DM = 1024, NB = 8, SEQ = 4096, CTX = 256, SB = SEQ + CTX  , NR = NB * SB  , DEPTH = 4;
constexpr int PC = 3584;
constexpr int C_ATQ = 0, C_ATK = 512, C_ATV = 768, C_HGQ = 1024, C_HGZF = 1280, C_HGZB = 1536, C_HGV = 1792, C_HGG = 2048,
              C_MLQ = 2304, C_MLK = 2560, C_MLV = 2816, C_MLOG = 3072, C_MLG = 3328;
constexpr int NIN = 3344;
constexpr int NEXP = 32, NPOS = 147456;
constexpr float EPS = 1e-6f;
constexpr int NTHR = 512, NWAVE = 8;

constexpr size_t MiB = 1u << 20;
constexpr size_t WS_CTL = 0, CTL_ZERO_BYTES = 1 * MiB;
constexpr size_t WS_MOD = 1 * MiB;
constexpr size_t WS_ROPE = 2 * MiB;
constexpr size_t WS_WRH = 2 * MiB + 65536, WS_WRL = WS_WRH + 262144;
constexpr size_t WS_WSC = 2 * MiB + 655360;
constexpr size_t WS_HSC = 2 * MiB + 720896;
constexpr size_t WS_RE = 3 * MiB, WS_RS = WS_RE + 600000, WS_RG = WS_RS + 600000, WS_POS = WS_RG + 600000;
constexpr size_t WS_CNT = WS_POS + 600000;
constexpr size_t WS_TOK = 6 * MiB, WS_GATEP = WS_TOK + 600000, WS_TILEE = WS_GATEP + 600000, WS_NRT = WS_TILEE + 8192;
constexpr size_t WS_WIN = 8 * MiB;
constexpr size_t WS_WOUT = 36 * MiB;
constexpr size_t WS_WGU = 44 * MiB;
constexpr size_t WS_WDN = 556 * MiB;
constexpr size_t WS_H = 812 * MiB;
constexpr size_t WS_P = 880 * MiB;
constexpr size_t WS_Y = 1118 * MiB;
constexpr size_t WS_XC = 1186 * MiB;
constexpr size_t WS_ACT = 1194 * MiB;
constexpr size_t WS_YM = 1482 * MiB;
constexpr size_t WS_OH = 1770 * MiB;
constexpr size_t WS_OM = 1838 * MiB;
constexpr size_t WS_UTH = 1906 * MiB, WS_SPH = 1940 * MiB, WS_UTM = 1974 * MiB, WS_SPM = 2008 * MiB;
constexpr size_t WS_DT = 2042 * MiB, WS_NU = WS_DT + 1310720, WS_NP = WS_NU + 1310720, WS_GL = WS_NP + 1310720, WS_MP = WS_GL + 131072;
constexpr size_t WS_H8 = 2046 * MiB;
constexpr size_t WS_XB = 2080 * MiB;
constexpr size_t WS_END = 2148 * MiB;
static_assert(WS_CNT + 32768 <= WS_TOK && WS_NRT + 64 <= WS_WIN, "ws map");
static_assert((size_t)NR * 4 * 4 <= 600000 && (size_t)NPOS * 4 <= 600000, "ws map");

constexpr int CW_CMAX = 16384;
constexpr int CW_BAR = 4096;

constexpr int LDS_BYTES = 147456;
constexpr int PH_LDS = 143360;
constexpr int MISC_OFF = PH_LDS;

struct Args { const float* in[22]; float* out; unsigned char* ws; int ph_lo, ph_hi; };

#define LDS_WAIT() asm volatile("s_waitcnt lgkmcnt(0)" ::: "memory")
#define VM_WAIT() asm volatile("s_waitcnt vmcnt(0)" ::: "memory")

__device__ __forceinline__ unsigned pk2(float lo, float hi) { f32x2 v = {lo, hi}; bf16x2_t b = __builtin_convertvector(v, bf16x2_t); return __builtin_bit_cast(unsigned, b); }
__device__ __forceinline__ unsigned f2bf(float f) { return pk2(f, 0.f) & 0xffffu; }
__device__ __forceinline__ float clamp8(float x) { return fminf(fmaxf(x, -448.f), 448.f); }
__device__ __forceinline__ unsigned pk_fp8x4(float a, float b, float c, float d) {
    int w = 0; w = __builtin_amdgcn_cvt_pk_fp8_f32(clamp8(a), clamp8(b), w, false); w = __builtin_amdgcn_cvt_pk_fp8_f32(clamp8(c), clamp8(d), w, true); return (unsigned)w; }
__device__ __forceinline__ unsigned fp8_1(float a) { return pk_fp8x4(a, 0.f, 0.f, 0.f) & 0xffu; }
__device__ __forceinline__ float bf2f(unsigned h) { return __uint_as_float(h << 16); }
__device__ __forceinline__ float bflo(unsigned w) { return __uint_as_float(w << 16); }
__device__ __forceinline__ float bfhi(unsigned w) { return __uint_as_float(w & 0xffff0000u); }
__device__ __forceinline__ float wave_sum(float v) {
#define WS_DPP(x, ctrl, rmask) __builtin_bit_cast(float, __builtin_amdgcn_update_dpp(0, __builtin_bit_cast(int, x), ctrl, rmask, 0xF, false))
    v += WS_DPP(v, 0xB1, 0xF);
    v += WS_DPP(v, 0x4E, 0xF);
    v += WS_DPP(v, 0x141, 0xF);
    v += WS_DPP(v, 0x140, 0xF);
    v += WS_DPP(v, 0x142, 0xA);
    v += WS_DPP(v, 0x143, 0xC);
#undef WS_DPP
    return __builtin_bit_cast(float, __builtin_amdgcn_readlane(__builtin_bit_cast(int, v), 63));
}
__device__ __forceinline__ float wave_max_nn(float v) {
#define WS_DPP(x, ctrl, rmask) __builtin_bit_cast(float, __builtin_amdgcn_update_dpp(0, __builtin_bit_cast(int, x), ctrl, rmask, 0xF, false))
    v = fmaxf(v, WS_DPP(v, 0xB1, 0xF)); v = fmaxf(v, WS_DPP(v, 0x4E, 0xF)); v = fmaxf(v, WS_DPP(v, 0x141, 0xF)); v = fmaxf(v, WS_DPP(v, 0x140, 0xF));
    v = fmaxf(v, WS_DPP(v, 0x142, 0xA)); v = fmaxf(v, WS_DPP(v, 0x143, 0xC));
#undef WS_DPP
    return __builtin_bit_cast(float, __builtin_amdgcn_readlane(__builtin_bit_cast(int, v), 63));
}
__device__ __forceinline__ unsigned pk_i8x4(float a, float b, float c, float d) {
    const int q0 = __float2int_rn(a), q1 = __float2int_rn(b), q2 = __float2int_rn(c), q3 = __float2int_rn(d);
    return (unsigned)(q0 & 0xff) | ((unsigned)(q1 & 0xff) << 8) | ((unsigned)(q2 & 0xff) << 16) | ((unsigned)q3 << 24); }
__device__ __forceinline__ float sigm(float x) { return __builtin_amdgcn_rcpf(1.f + __expf(-x)); }


constexpr int ARGS_OFF = MISC_OFF + 256, WTAB_OFF = MISC_OFF + 512;
__device__ __forceinline__ unsigned hw_slot() { return (unsigned)__builtin_amdgcn_s_getreg((5 << 11) | 4) & 63u; }
__device__ __forceinline__ int lane_id(unsigned zo) { return (int)__builtin_amdgcn_mbcnt_hi(~0u, __builtin_amdgcn_mbcnt_lo(~0u, zo)); }
__device__ __forceinline__ int otid() {
    unsigned zo = 0; asm volatile("" : "+v"(zo));
    const int wave = __builtin_amdgcn_readfirstlane(*(const LAS int*)(WTAB_OFF + hw_slot() * 4 + zo));
    int t = wave * 64 + lane_id(zo); asm volatile("" : "+v"(t)); return t;
}
__device__ __forceinline__ int obid() { int b = blockIdx.x; asm volatile("" : "+s"(b)); return b; }
__device__ __forceinline__ int ogrid() { int g = gridDim.x; asm volatile("" : "+s"(g)); return g; }
__device__ __forceinline__ const void* lds_ptr64(int byte_off, unsigned zo) {
    const u32x2 w = *(const LAS u32x2*)(byte_off + zo);
    const unsigned lo = __builtin_amdgcn_readfirstlane(w.x), hi = __builtin_amdgcn_readfirstlane(w.y);
    return (const void*)(((unsigned long long)hi << 32) | lo);
}
__device__ __forceinline__ Args fetch_args() {
    unsigned zo = 0; asm volatile("" : "+v"(zo));
    Args r;
#pragma unroll
    for (int i = 0; i < 22; ++i) r.in[i] = (const float*)lds_ptr64(ARGS_OFF + 8 * i, zo);
    r.out = (float*)lds_ptr64(ARGS_OFF + 8 * 22, zo); r.ws = (unsigned char*)lds_ptr64(ARGS_OFF + 8 * 23, zo); r.ph_lo = 0; r.ph_hi = 0;
    return r;
}
__device__ __forceinline__ void kernel_setup(const Args& a) {
    const int tid = threadIdx.x;
    LAS unsigned* M = (LAS unsigned*)MISC_OFF;
    if (tid < 64) M[tid] = 0u;
    if (tid == 0) { LAS unsigned long long* A = (LAS unsigned long long*)ARGS_OFF;
#pragma unroll
        for (int i = 0; i < 22; ++i) A[i] = (unsigned long long)a.in[i];
        A[22] = (unsigned long long)a.out; A[23] = (unsigned long long)a.ws; }
    if ((tid & 63) == 0) *(LAS int*)(WTAB_OFF + hw_slot() * 4) = tid >> 6;
    __syncthreads();
}

__device__ __forceinline__ const float* x_rd(const Args& a, bool from_input, int r) {
    const int b = r / SB, s = r - b * SB;
    if (s < CTX) return (from_input ? a.in[2] : (const float*)(a.ws + WS_XC)) + (size_t)(b * CTX + s) * DM;
    return (from_input ? a.in[0] : (const float*)a.out) + (size_t)(b * SEQ + s - CTX) * DM;
}
__device__ __forceinline__ float* x_wr(const Args& a, int r) {
    const int b = r / SB, s = r - b * SB;
    if (s < CTX) return (float*)(a.ws + WS_XC) + (size_t)(b * CTX + s) * DM;
    return a.out + (size_t)(b * SEQ + s - CTX) * DM;
}
__device__ __forceinline__ const float* modv(const Args& a, int layer, int r, int chunk) {
    const int b = r / SB, s = r - b * SB; const int j = s < CTX ? 8 : b;
    return (const float*)(a.ws + WS_MOD) + ((size_t)(layer * 9 + j) * 6 + chunk) * DM;
}

#define XB_TMO      128
#define XB_XCNT(j)  (256  + 64 * (j))
#define XB_XSUB(j)  (1280 + 64 * (j))
#define XB_XGEN(j)  (2304 + 64 * (j))
#define XB_TOP      3328
#define XB_TOPGEN   3392
#define XCD_BAR_WORDS 3456
#define XB_SPIN_CAP (1u << 18)
__device__ __forceinline__ unsigned xb_ld(unsigned* p)              { return __hip_atomic_load(p, __ATOMIC_RELAXED, __HIP_MEMORY_SCOPE_AGENT); }
__device__ __forceinline__ unsigned xb_add(unsigned* p, unsigned v) { return __hip_atomic_fetch_add(p, v, __ATOMIC_RELAXED, __HIP_MEMORY_SCOPE_AGENT); }
__device__ __forceinline__ unsigned xb_xcc_id() { return (unsigned)__builtin_amdgcn_s_getreg((3 << 11) | 20) & 0xFu; }
#define XB_SPIN(cond, bar) do { unsigned _sp = 0; while (cond) { __builtin_amdgcn_s_sleep(1); \
    if ((++_sp & 255u) == 0u) { if (xb_ld(&(bar)[XB_TMO])) break; if (_sp > XB_SPIN_CAP) { atomicAdd(&(bar)[XB_TMO], 1u); break; } } } } while (0)
struct XcdBarrier { unsigned* bar; unsigned x; volatile LAS unsigned* st; };
__device__ __forceinline__ XcdBarrier xcd_barrier_post(unsigned* bar, volatile LAS unsigned* st) {
    XcdBarrier b; b.bar = bar; b.x = xb_xcc_id(); b.st = st;
    if (otid() == 0) (void)xb_add(&bar[XB_XCNT(b.x)], 1u);
    return b;
}
__device__ __forceinline__ void xcd_barrier_complete(unsigned* bar, unsigned x, unsigned& nloc, unsigned& nx) {
    const unsigned G = gridDim.x * gridDim.y * gridDim.z;
    unsigned sum, cnt, mine, sp = 0u;
    for (;;) {
        sum = 0u; cnt = 0u; mine = 0u;
#pragma unroll
        for (unsigned j = 0; j < 16; ++j) { const unsigned c = xb_ld(&bar[XB_XCNT(j)]); sum += c; cnt += (c > 0u) ? 1u : 0u; mine = (j == x) ? c : mine; }
        if (sum == G) break;
        __builtin_amdgcn_s_sleep(1);
        if ((++sp & 255u) == 0u) { if (xb_ld(&bar[XB_TMO])) break; if (sp > XB_SPIN_CAP) { atomicAdd(&bar[XB_TMO], 1u); break; } }
    }
    nloc = mine > 0u ? mine : 1u; nx = cnt > 0u ? cnt : 1u;
}
__device__ __forceinline__ void xcd_barrier(const XcdBarrier& b) {
    asm volatile("s_waitcnt vmcnt(0)" ::: "memory");
    __syncthreads();
    if (otid() == 0) {
        unsigned* bar = b.bar;
        __builtin_amdgcn_s_waitcnt(0);
        unsigned nloc = b.st[0], nx = b.st[1];
        if (nloc == 0u) { xcd_barrier_complete(bar, b.x, nloc, nx); b.st[0] = nloc; b.st[1] = nx; }
        const unsigned old = xb_add(&bar[XB_XSUB(b.x)], 1u);
        const unsigned gen = old / nloc;
        if (old + 1u == (gen + 1u) * nloc) {
            __builtin_amdgcn_fence(__ATOMIC_RELEASE, "agent");
            asm volatile("s_waitcnt vmcnt(0)" ::: "memory");
            const unsigned og = xb_add(&bar[XB_TOP], 1u);
            const unsigned tg = og / nx;
            if (og + 1u == (tg + 1u) * nx) xb_add(&bar[XB_TOPGEN], 1u);
            else XB_SPIN(xb_ld(&bar[XB_TOPGEN]) == tg, bar);
            __builtin_amdgcn_fence(__ATOMIC_ACQUIRE, "agent");
            xb_add(&bar[XB_XGEN(b.x)], 1u);
            asm volatile("s_waitcnt vmcnt(0)" ::: "memory");
        } else {
            XB_SPIN(xb_ld(&bar[XB_XGEN(b.x)]) == gen, bar);
            __builtin_amdgcn_fence(__ATOMIC_ACQUIRE, "agent");
            asm volatile("s_waitcnt vmcnt(0)" ::: "memory");
        }
    }
    __syncthreads();
}

__device__ __forceinline__ void glds16s2(const void* sbase, unsigned voff0, unsigned voff1, unsigned lds0, unsigned lds1) {
    unsigned keep;
    asm volatile("s_mov_b32 %0, m0\n\ts_mov_b32 m0, %4\n\ts_nop 0\n\tglobal_load_lds_dwordx4 %1, %3\n\ts_mov_b32 m0, %5\n\ts_nop 0\n\tglobal_load_lds_dwordx4 %2, %3\n\ts_mov_b32 m0, %0"
                 : "=&s"(keep) : "v"(voff0), "v"(voff1), "s"(sbase), "s"(lds0), "s"(lds1) : "memory");
}

namespace pg8 {
constexpr int BM = 256, BK = 64, HALF = 128, HTB = HALF * BK * 2, STAGE_BYTES = 8 * HTB, NXCD = 8, WGM = 8, K = 1024;
__host__ __device__ __forceinline__ int lds_byte(int r, int c) { const int st = (r >> 4) * 2 + (c >> 5), rr = r & 15, cc = c & 31, ob = rr * 64 + cc * 2; return st * 1024 + (ob ^ (((ob >> 9) & 1) << 5)); }
__host__ __device__ __forceinline__ void stage_rc(int b, int& R, int& C) { const int st = b / 1024, sb = b % 1024, swz = sb ^ (((sb >> 9) & 1) << 5); R = (st >> 1) * 16 + swz / 64; C = (st & 1) * 32 + (swz % 64) / 2; }
__host__ __device__ __forceinline__ int perm32(int rho) { const int n = rho >> 4, i = rho & 15; return 8 * (i >> 2) + 4 * n + (i & 3); }

struct Unit { int pm, pn, e; const char* Bt; };

struct SchedDense {
    int nM, nN, nwg, G, c, rb; const char* Bt;
    __device__ void init(int M, int N, int G_, int c_, const bf16* Bt_) { nM = M / BM; nN = N / BM; nwg = nM * nN; G = G_; c = c_; Bt = (const char*)Bt_; rb = 2 * K; }
    __device__ __forceinline__ bool next(int i, Unit& u) const {
        const long L = (long)i * G + c; if (L >= nwg) return false;
        int wgid = (int)L; { const int q = nwg / NXCD, r = nwg % NXCD, xcd = wgid % NXCD, off = wgid / NXCD; wgid = (xcd < r ? xcd * (q + 1) : r * (q + 1) + (xcd - r) * q) + off; }
        const int nig = WGM * nN, gid = wgid / nig, fm = gid * WGM, gsz = (nM - fm) < WGM ? (nM - fm) : WGM;
        u.pm = fm + ((wgid % nig) % gsz); u.pn = (wgid % nig) / gsz; u.e = 0; u.Bt = Bt + (size_t)u.pn * BM * rb; return true;
    }
    __device__ __forceinline__ int row(const Unit& u, int local) const { return u.pm * BM + local; }
};
struct SchedMoe {
    int G, c, nct, ntot, nrt; const int* tile_e; const char* WT; const int* tok; int rb  ;
    __device__ __forceinline__ bool next(int i, Unit& u) const {
        int rt, pn;
        if ((G & 7) == 0) { const int x = c & 7, j = c >> 3, per = G >> 3, base = nrt >> 3, rem = nrt & 7;
            const int cnt = base + (x < rem ? 1 : 0), start = x * base + (x < rem ? x : rem), q = i * per + j;
            if (q >= cnt * nct) return false;
            const int rl = q / nct; pn = q - rl * nct; rt = start + rl; }
        else { const int L = i * G + c; if (L >= nrt * nct) return false; rt = L / nct; pn = L - rt * nct; }
        u.pm = rt; u.pn = pn; u.e = __builtin_amdgcn_readfirstlane(__hip_atomic_load(tile_e + rt, __ATOMIC_RELAXED, __HIP_MEMORY_SCOPE_AGENT));
        u.Bt = WT + ((size_t)u.e * ntot + (size_t)u.pn * BM) * rb; return true;
    }
    __device__ __forceinline__ int row(const Unit& u, int local) const { return tok ? tok[u.pm * BM + local] : u.pm * BM + local; }
};

template <int MODE  , class Epi, class Sched>
__device__ __forceinline__ void gemm_phase(LAS unsigned char* lds, const void* Abase, const Sched& S, const Epi& E) {
    const int tid = otid(), wid = __builtin_amdgcn_readfirstlane(tid >> 6), lane = tid & 63, wr = wid >> 2, wc = wid & 3, fr = lane & 15, fq = lane >> 4;
    constexpr bool FP8 = (MODE == 1), I8 = (MODE == 2);
    constexpr int RB = MODE ? K : 2 * K;
    constexpr int nt = RB / 128;
    int R0, C0; stage_rc(tid * 16, R0, C0);
    const unsigned voffB0 = (unsigned)((Epi::PERM ? ((R0 & ~31) + perm32(R0 & 31)) : R0) * RB + C0 * 2);
    constexpr size_t kstep = (size_t)(BK * 2);
    constexpr size_t hstep = (size_t)HALF * RB;
    const unsigned ldsw = (unsigned)wid * 1024u, ldsb = (unsigned)(size_t)lds;
    const int aoff = lds_byte(wr * 64 + fr, fq * 8), boff = lds_byte(wc * 32 + fr, fq * 8);
    const char* Ab = (const char*)Abase;
    LAS u32x4* nslot = (LAS u32x4*)(lds + STAGE_BYTES + tid * 16);
#define PG8_SA(b, h) (((b) * 2 + (h)) * HTB)
#define PG8_SB(b, h) ((4 + (b) * 2 + (h)) * HTB)
#define PG8_STAGEA(bufoff, gbase, voff) glds16s2((gbase), (voff)[0], (voff)[1], ldsb + (unsigned)(bufoff) + ldsw, ldsb + (unsigned)(bufoff) + ldsw + 8192u)
#define PG8_STAGEB(bufoff, gbase) glds16s2((gbase), voffB0, voffB0 + (unsigned)(64 * RB), ldsb + (unsigned)(bufoff) + ldsw, ldsb + (unsigned)(bufoff) + ldsw + 8192u)
#define PG8_LDA(dst, b, h) do { if constexpr (FP8) { _Pragma("unroll") for (int m = 0; m < 4; ++m) { dst##8[m].lo = *(const LAS u32x4*)(lds + PG8_SA(b, h) + aoff + m * 2048); dst##8[m].hi = *(const LAS u32x4*)(lds + PG8_SA(b, h) + aoff + m * 2048 + 1024); } } \
    else { _Pragma("unroll") for (int m = 0; m < 4; ++m) _Pragma("unroll") for (int k = 0; k < 2; ++k) dst[m][k] = *(const LAS bf16x8*)(lds + PG8_SA(b, h) + aoff + m * 2048 + k * 1024); } } while (0)
#define PG8_LDB(dst, b, h) do { if constexpr (FP8) { _Pragma("unroll") for (int n = 0; n < 2; ++n) { dst##8[n].lo = *(const LAS u32x4*)(lds + PG8_SB(b, h) + boff + n * 2048); dst##8[n].hi = *(const LAS u32x4*)(lds + PG8_SB(b, h) + boff + n * 2048 + 1024); } } \
    else { _Pragma("unroll") for (int n = 0; n < 2; ++n) _Pragma("unroll") for (int k = 0; k < 2; ++k) dst[n][k] = *(const LAS bf16x8*)(lds + PG8_SB(b, h) + boff + n * 2048 + k * 1024); } } while (0)
#define PG8_MMA(ai, bj, At, Bt) do { __builtin_amdgcn_s_setprio(1); if constexpr (FP8) { _Pragma("unroll") for (int m = 0; m < 4; ++m) _Pragma("unroll") for (int n = 0; n < 2; ++n) \
        acc[ai][bj][m][n] = __builtin_amdgcn_mfma_scale_f32_16x16x128_f8f6f4(__builtin_bit_cast(v8i, Bt##8[n]), __builtin_bit_cast(v8i, At##8[m]), acc[ai][bj][m][n], 0, 0, 0, 0x7f7f7f7f, 0, 0x7f7f7f7f); } \
        else if constexpr (I8) { _Pragma("unroll") for (int m = 0; m < 4; ++m) _Pragma("unroll") for (int n = 0; n < 2; ++n) _Pragma("unroll") for (int k = 0; k < 2; ++k) \
        acc[ai][bj][m][n] = __builtin_bit_cast(f32x4, __builtin_amdgcn_mfma_i32_16x16x64_i8(__builtin_bit_cast(v4i, Bt[n][k]), __builtin_bit_cast(v4i, At[m][k]), __builtin_bit_cast(v4i, acc[ai][bj][m][n]), 0, 0, 0)); } \
        else { _Pragma("unroll") for (int m = 0; m < 4; ++m) _Pragma("unroll") for (int n = 0; n < 2; ++n) _Pragma("unroll") for (int k = 0; k < 2; ++k) \
        acc[ai][bj][m][n] = __builtin_amdgcn_mfma_f32_16x16x32_bf16(Bt[n][k], At[m][k], acc[ai][bj][m][n], 0, 0, 0); } __builtin_amdgcn_s_setprio(0); } while (0)
#define PG8_WAIT_V(n) asm volatile("s_waitcnt vmcnt(" #n ")" ::: "memory")
#define PG8_WAIT_L(n) asm volatile("s_waitcnt lgkmcnt(" #n ")" ::: "memory")
#define PG8_BAR __builtin_amdgcn_s_barrier()
#define PG8_SCHED __builtin_amdgcn_sched_barrier(0)
#define PG8_VAOFF(u, h, i) ((unsigned)(S.row(u, (h) * HALF + R0 + 64 * (i)) * RB + C0 * 2))
    Unit cur, nxt; int ui = 0;
    if (!S.next(0, cur)) return;
    f32x4 acc[2][2][4][2];
#pragma unroll
    for (int a = 0; a < 2; ++a)
#pragma unroll
        for (int b = 0; b < 2; ++b)
#pragma unroll
            for (int m = 0; m < 4; ++m)
#pragma unroll
                for (int n = 0; n < 2; ++n) acc[a][b][m][n] = (f32x4){0.f, 0.f, 0.f, 0.f};
    bf16x8 At[4][2], B0[2][2], B1[2][2];
    u32x8 At8[4], B08[2], B18[2];
    unsigned vA[2][2];
#pragma unroll
    for (int h = 0; h < 2; ++h)
#pragma unroll
        for (int i = 0; i < 2; ++i) vA[h][i] = PG8_VAOFF(cur, h, i);
    const char* cB = cur.Bt;
    PG8_STAGEB(PG8_SB(0, 0), cB); PG8_STAGEB(PG8_SB(0, 1), cB + hstep); PG8_STAGEA(PG8_SA(0, 0), Ab, vA[0]); PG8_STAGEA(PG8_SA(0, 1), Ab, vA[1]);
    if (wr == 1) PG8_BAR;
    PG8_WAIT_V(2); PG8_BAR;
    PG8_STAGEB(PG8_SB(1, 0), cB + kstep); PG8_STAGEA(PG8_SA(1, 0), Ab + kstep, vA[0]); PG8_STAGEB(PG8_SB(1, 1), cB + hstep + kstep);
    PG8_WAIT_V(6); PG8_BAR;
    for (;;) {
        const bool has_next = S.next(ui + 1, nxt);
        if (has_next) *nslot = (u32x4){PG8_VAOFF(nxt, 0, 0), PG8_VAOFF(nxt, 0, 1), PG8_VAOFF(nxt, 1, 0), PG8_VAOFF(nxt, 1, 1)};
        const char* nB = has_next ? nxt.Bt : cB;
#pragma unroll 1
        for (int t = 0; t < nt; t += 2) {
            const bool last = (t == nt - 2);
            const char* a1 = Ab + (size_t)(t + 1) * kstep;
            const char* a2 = last ? Ab : Ab + (size_t)(t + 2) * kstep; const char* b2 = last ? nB : cB + (size_t)(t + 2) * kstep;
            const char* a3 = a2 + kstep; const char* b3 = b2 + kstep;
            PG8_LDB(B0, 0, 0); PG8_LDB(B1, 0, 1); PG8_SCHED; PG8_LDA(At, 0, 0); PG8_STAGEA(PG8_SA(1, 1), a1, vA[1]);
            if (last && has_next) { const u32x4 nv = *nslot; vA[0][0] = nv.x; vA[0][1] = nv.y; vA[1][0] = nv.z; vA[1][1] = nv.w; }
            PG8_WAIT_V(8); PG8_WAIT_L(0); PG8_BAR; PG8_MMA(0, 0, At, B0); PG8_MMA(0, 1, At, B1); PG8_BAR; PG8_SCHED;
            PG8_LDA(At, 0, 1); PG8_STAGEB(PG8_SB(0, 0), b2); PG8_STAGEB(PG8_SB(0, 1), b2 + hstep); PG8_STAGEA(PG8_SA(0, 0), a2, vA[0]);
            PG8_WAIT_V(8); PG8_WAIT_L(0); PG8_BAR; PG8_MMA(1, 0, At, B0); PG8_MMA(1, 1, At, B1); PG8_BAR; PG8_SCHED;
            PG8_LDB(B0, 1, 0); PG8_LDB(B1, 1, 1); PG8_SCHED; PG8_LDA(At, 1, 0); PG8_STAGEA(PG8_SA(0, 1), a2, vA[1]);
            PG8_WAIT_V(8); PG8_WAIT_L(0); PG8_BAR; PG8_MMA(0, 0, At, B0); PG8_MMA(0, 1, At, B1); PG8_BAR; PG8_SCHED;
            PG8_LDA(At, 1, 1); PG8_STAGEB(PG8_SB(1, 0), b3); PG8_STAGEB(PG8_SB(1, 1), b3 + hstep); PG8_STAGEA(PG8_SA(1, 0), a3, vA[0]);
            PG8_WAIT_V(8); PG8_WAIT_L(0); PG8_BAR; PG8_MMA(1, 0, At, B0); PG8_MMA(1, 1, At, B1); PG8_BAR; PG8_SCHED;
        }
        if (GEMM_ALIGN && wr == 0) PG8_BAR;
        { int fr_ = fr, fq_ = fq; asm volatile("" : "+v"(fr_), "+v"(fq_));
          E(acc, cur, wr, wc, fr_, fq_); }
        if (!has_next) break;
#pragma unroll
        for (int a = 0; a < 2; ++a)
#pragma unroll
            for (int b = 0; b < 2; ++b)
#pragma unroll
                for (int m = 0; m < 4; ++m)
#pragma unroll
                    for (int n = 0; n < 2; ++n) acc[a][b][m][n] = (f32x4){0.f, 0.f, 0.f, 0.f};
        cur = nxt; cB = nB; ++ui;
        if (GEMM_ALIGN && wr == 1) PG8_BAR;
    }
    PG8_WAIT_V(0);
    if (!GEMM_ALIGN && wr == 0) PG8_BAR;
    PG8_BAR;
#undef PG8_SA
#undef PG8_SB
#undef PG8_STAGEA
#undef PG8_STAGEB
#undef PG8_LDA
#undef PG8_LDB
#undef PG8_MMA
#undef PG8_WAIT_V
#undef PG8_WAIT_L
#undef PG8_BAR
#undef PG8_SCHED
#undef PG8_VAOFF
}

struct EpiBf16 {
    static constexpr bool PERM = true;
    bf16* O; int ldc;
    __device__ __forceinline__ void operator()(const f32x4 (&acc)[2][2][4][2], const Unit& u, int wr, int wc, int fr, int fq) const {
        const int row0 = u.pm * BM + wr * 64 + fr, col0 = u.pn * BM + wc * 32 + 8 * fq;
#pragma unroll
        for (int ai = 0; ai < 2; ++ai)
#pragma unroll
            for (int m = 0; m < 4; ++m) { bf16* rowp = O + (size_t)(row0 + ai * HALF + m * 16) * ldc + col0;
#pragma unroll
                for (int bj = 0; bj < 2; ++bj) { const f32x4 v0 = acc[ai][bj][m][0], v1 = acc[ai][bj][m][1];
                    u32x4 w; w.x = pk2(v0[0], v0[1]); w.y = pk2(v0[2], v0[3]); w.z = pk2(v1[0], v1[1]); w.w = pk2(v1[2], v1[3]);
                    *(u32x4*)(rowp + bj * HALF) = w; } }
    }
};
struct EpiI8 {
    static constexpr bool PERM = true;
    bf16* O; int ldc; const float* hs; const float* ws;
    __device__ __forceinline__ void operator()(const f32x4 (&acc)[2][2][4][2], const Unit& u, int wr, int wc, int fr, int fq) const {
        const int row0 = u.pm * BM + wr * 64 + fr, col0 = u.pn * BM + wc * 32 + 8 * fq;
        f32x4 wv[2][2];
#pragma unroll
        for (int bj = 0; bj < 2; ++bj)
#pragma unroll
            for (int n = 0; n < 2; ++n) wv[bj][n] = *(const f32x4*)(ws + col0 + bj * HALF + 4 * n);
#pragma unroll
        for (int ai = 0; ai < 2; ++ai)
#pragma unroll
            for (int m = 0; m < 4; ++m) { const int row = row0 + ai * HALF + m * 16; const float hr = hs[row]; bf16* rowp = O + (size_t)row * ldc + col0;
#pragma unroll
                for (int bj = 0; bj < 2; ++bj) { const f32x4 v0 = __builtin_convertvector(__builtin_bit_cast(v4i, acc[ai][bj][m][0]), f32x4) * hr * wv[bj][0], v1 = __builtin_convertvector(__builtin_bit_cast(v4i, acc[ai][bj][m][1]), f32x4) * hr * wv[bj][1];
                    u32x4 w; w.x = pk2(v0[0], v0[1]); w.y = pk2(v0[2], v0[3]); w.z = pk2(v1[0], v1[1]); w.w = pk2(v1[2], v1[3]);
                    *(u32x4*)(rowp + bj * HALF) = w; } }
    }
};
struct EpiResid {
    static constexpr bool PERM = true;
    const float* xin_lat; const float* xin_ctx; bf16* xb; const float* mod  ; int chunk; bool skip_ctx, first; float sc;
    __device__ __forceinline__ void operator()(const f32x4 (&acc)[2][2][4][2], const Unit& u, int wr, int wc, int fr, int fq) const {
        const int b = u.pm / 17, j = u.pm - b * 17; const bool isctx = (j == 0);
        if (isctx && skip_ctx) return;
        const float* xin = isctx ? xin_ctx + (size_t)b * CTX * DM : xin_lat + ((size_t)b * SEQ + (size_t)(j - 1) * 256) * DM;
        bf16* xt = xb + (size_t)u.pm * BM * DM;
        const float* g = mod + (size_t)((isctx ? 8 : b) * 6 + chunk) * DM;
        const int col0 = u.pn * BM + wc * 32 + 8 * fq;
        f32x4 gv[2][2];
#pragma unroll
        for (int bj = 0; bj < 2; ++bj)
#pragma unroll
            for (int n = 0; n < 2; ++n) gv[bj][n] = *(const f32x4*)(g + col0 + bj * HALF + 4 * n) * sc;
#pragma unroll
        for (int ai = 0; ai < 2; ++ai)
#pragma unroll
            for (int m = 0; m < 4; ++m) { const size_t ro = (size_t)(ai * HALF + wr * 64 + m * 16 + fr) * DM;
#pragma unroll
                for (int bj = 0; bj < 2; ++bj) { const int c = col0 + bj * HALF; f32x4 x0, x1;
                    if (first) { x0 = *(const f32x4*)(xin + ro + c); x1 = *(const f32x4*)(xin + ro + c + 4); }
                    else { const u32x4 w = *(const u32x4*)(xt + ro + c); x0 = (f32x4){bflo(w.x), bfhi(w.x), bflo(w.y), bfhi(w.y)}; x1 = (f32x4){bflo(w.z), bfhi(w.z), bflo(w.w), bfhi(w.w)}; }
                    x0 = x0 + gv[bj][0] * acc[ai][bj][m][0]; x1 = x1 + gv[bj][1] * acc[ai][bj][m][1];
                    u32x4 o; o.x = pk2(x0[0], x0[1]); o.y = pk2(x0[2], x0[3]); o.z = pk2(x1[0], x1[1]); o.w = pk2(x1[2], x1[3]);
                    *(u32x4*)(xt + ro + c) = o; } }
    }
};
struct EpiGU {
    static constexpr bool PERM = true;
    void* ACT; const float* bgu  ;
    __device__ __forceinline__ void operator()(const f32x4 (&acc)[2][2][4][2], const Unit& u, int wr, int wc, int fr, int fq) const {
        const int row0 = u.pm * BM + wr * 64 + fr, col0 = u.pn * HALF + wc * 32 + 8 * fq;
        const float* bg = bgu + (size_t)u.e * 2048 + col0;
        constexpr float SC = MOE_FP8 ? 1.f / 512.f : 1.f;
        f32x4 bgv[2], buv[2];
#pragma unroll
        for (int n = 0; n < 2; ++n) { bgv[n] = *(const f32x4*)(bg + 4 * n); buv[n] = *(const f32x4*)(bg + 1024 + 4 * n); }
#pragma unroll
        for (int ai = 0; ai < 2; ++ai)
#pragma unroll
            for (int m = 0; m < 4; ++m) { float o[8];
#pragma unroll
                for (int n = 0; n < 2; ++n)
#pragma unroll
                    for (int i = 0; i < 4; ++i) { float gt = acc[ai][0][m][n][i] * SC + bgv[n][i], up = acc[ai][1][m][n][i] * SC + buv[n][i];
                        gt = fminf(gt, 7.f); up = fminf(fmaxf(up, -7.f), 7.f);
                        o[4 * n + i] = (up + 1.f) * gt * sigm(1.702f * gt); }
                const size_t eo = (size_t)(row0 + ai * HALF + m * 16) * DM + col0;
                if constexpr (MOE_FP8) { u32x2 w; w.x = pk_fp8x4(4.f * o[0], 4.f * o[1], 4.f * o[2], 4.f * o[3]); w.y = pk_fp8x4(4.f * o[4], 4.f * o[5], 4.f * o[6], 4.f * o[7]);
                    *(u32x2*)((unsigned char*)ACT + eo) = w; }
                else { u32x4 w; w.x = pk2(o[0], o[1]); w.y = pk2(o[2], o[3]); w.z = pk2(o[4], o[5]); w.w = pk2(o[6], o[7]); *(u32x4*)((bf16*)ACT + eo) = w; } }
    }
};
struct EpiDown {
    static constexpr bool PERM = true;
    bf16* YM; const float* bdn  ; const float* gatep;
    __device__ __forceinline__ void operator()(const f32x4 (&acc)[2][2][4][2], const Unit& u, int wr, int wc, int fr, int fq) const {
        const int row0 = u.pm * BM + wr * 64 + fr, col0 = u.pn * BM + wc * 32 + 8 * fq;
        const float* bd = bdn + (size_t)u.e * 1024 + col0;
        constexpr float SC = MOE_FP8 ? 1.f / 256.f : 1.f;
        f32x4 bv[2][2];
#pragma unroll
        for (int bj = 0; bj < 2; ++bj)
#pragma unroll
            for (int n = 0; n < 2; ++n) bv[bj][n] = *(const f32x4*)(bd + bj * HALF + 4 * n);
#pragma unroll
        for (int ai = 0; ai < 2; ++ai)
#pragma unroll
            for (int m = 0; m < 4; ++m) { const int row = row0 + ai * HALF + m * 16; const float gt = gatep[row]; bf16* rowp = YM + (size_t)row * DM + col0;
#pragma unroll
                for (int bj = 0; bj < 2; ++bj) { const f32x4 v0 = (acc[ai][bj][m][0] * SC + bv[bj][0]) * gt, v1 = (acc[ai][bj][m][1] * SC + bv[bj][1]) * gt;
                    u32x4 w; w.x = pk2(v0[0], v0[1]); w.y = pk2(v0[2], v0[3]); w.z = pk2(v1[0], v1[1]); w.w = pk2(v1[2], v1[3]);
                    *(u32x4*)(rowp + bj * HALF) = w; } }
    }
};
}

namespace att {
constexpr int D = 128, NW = 8, QBLK = 32, KVBLK = 64;
constexpr float SCALE = 0.088388347648318440f;
constexpr float THR = 8.f;
constexpr int LDQ = PC, LDK = PC, LDO = DM;
constexpr size_t SHM_V = KVBLK * D * 2, SHM_K = KVBLK * D * 2, SHM_ATTN = 2 * SHM_V + 2 * SHM_K + NW * 64 * 4;
#define KSWZ(row, colB) ((row) * 256 + ((colB) ^ (((row) & 7) << 4)))
#define SBAR() __builtin_amdgcn_sched_barrier(0)
__device__ __forceinline__ int crow(int r, int hi) { return (r & 3) + 8 * (r >> 2) + 4 * hi; }
__device__ __forceinline__ unsigned cvtpk(float lo, float hi) { unsigned r; asm volatile("v_cvt_pk_bf16_f32 %0, %1, %2" : "=v"(r) : "v"(lo), "v"(hi)); return r; }
__device__ __forceinline__ bf16x8 ld8(const bf16* p) { return *reinterpret_cast<const bf16x8*>(p); }
__device__ __forceinline__ void finishSM(f32x16& p0, f32x16& p1, float& l_reg, bf16x8& pa0, bf16x8& pa1, bf16x8& pa2, bf16x8& pa3) {
  for (int r = 0; r < 16; ++r) p1[r] = __builtin_amdgcn_exp2f(p1[r]);
  float ps = 0; for (int r = 0; r < 16; ++r) ps += p0[r]; for (int r = 0; r < 16; ++r) ps += p1[r];
  { auto rr = __builtin_amdgcn_permlane32_swap(__float_as_uint(ps), __float_as_uint(ps), false, false);
    ps = __uint_as_float(rr[0]) + __uint_as_float(rr[1]); }
  l_reg += ps;
#define PK4(P, BASE, OUT) do { unsigned a0 = cvtpk(P[BASE + 0], P[BASE + 1]), a1 = cvtpk(P[BASE + 2], P[BASE + 3]);   \
    unsigned b0 = cvtpk(P[BASE + 4], P[BASE + 5]), b1 = cvtpk(P[BASE + 6], P[BASE + 7]);                              \
    auto r0 = __builtin_amdgcn_permlane32_swap(a0, b0, false, false); auto r1 = __builtin_amdgcn_permlane32_swap(a1, b1, false, false); \
    u32x4 w = {r0[0], r1[0], r0[1], r1[1]}; OUT = *reinterpret_cast<bf16x8*>(&w); } while (0)
  PK4(p0, 0, pa0); PK4(p0, 8, pa1); PK4(p1, 0, pa2); PK4(p1, 8, pa3);
#undef PK4
}
__device__ __forceinline__ void qkt(f32x16& p0, f32x16& p1, const LAS char* Ks, const bf16x8* qr, int r32, int hi, float negm) {
#pragma unroll
  for (int r = 0; r < 16; ++r) { p0[r] = negm; p1[r] = negm; }
  for (int d0 = 0; d0 < 8; ++d0) { int cb = (d0 * 16 + hi * 8) * 2;
    bf16x8 b0 = *reinterpret_cast<const LAS bf16x8*>(Ks + KSWZ(r32, cb));
    bf16x8 b1 = *reinterpret_cast<const LAS bf16x8*>(Ks + KSWZ(32 + r32, cb));
    p0 = __builtin_amdgcn_mfma_f32_32x32x16_bf16(b0, qr[d0], p0, 0, 0, 0);
    p1 = __builtin_amdgcn_mfma_f32_32x32x16_bf16(b1, qr[d0], p1, 0, 0, 0); }
}
__device__ __forceinline__ void partialSM_fix(f32x16& p0) { for (int r = 0; r < 16; ++r) p0[r] = __builtin_amdgcn_exp2f(p0[r]); }
__device__ __forceinline__ int v_st(int k, int c) { const int kk = (k & ~0xC) | ((k & 4) << 1) | ((k & 8) >> 1); return ((kk >> 3) * 4 + (c >> 5)) * 512 + ((kk & 7) * 32 + (c & 31)) * 2; }
__device__ __forceinline__ int v_rd_base(int lane) { return ((lane & 3) << 3) | (((lane >> 2) & 3) << 6) | (((lane >> 4) & 1) << 5) | (((lane >> 5) & 1) << 8); }
constexpr int v_rd_off(int d0, int ks, int half) { return d0 * 512 + ks * 4096 + half * 2048; }
template <int OFF> __device__ __forceinline__ s16x4 tr_read(int vb) {
  s16x4 r; asm volatile("ds_read_b64_tr_b16 %0, %1 offset:%2" : "=&v"(r) : "v"(vb), "i"(OFF) : "memory"); return r;
}
template <int D0> __device__ __forceinline__ void pv_one(f32x16& od, int vb, bf16x8 pa0, bf16x8 pa1, bf16x8 pa2, bf16x8 pa3) {
  const s16x4 l0 = tr_read<v_rd_off(D0, 0, 0)>(vb), h0 = tr_read<v_rd_off(D0, 0, 1)>(vb), l1 = tr_read<v_rd_off(D0, 1, 0)>(vb), h1 = tr_read<v_rd_off(D0, 1, 1)>(vb);
  const s16x4 l2 = tr_read<v_rd_off(D0, 2, 0)>(vb), h2 = tr_read<v_rd_off(D0, 2, 1)>(vb), l3 = tr_read<v_rd_off(D0, 3, 0)>(vb), h3 = tr_read<v_rd_off(D0, 3, 1)>(vb);
  asm volatile("s_waitcnt lgkmcnt(0)" ::: "memory"); SBAR();
#define PK(L, H) (bf16x8){L[0], L[1], L[2], L[3], H[0], H[1], H[2], H[3]}
  od = __builtin_amdgcn_mfma_f32_32x32x16_bf16(pa0, PK(l0, h0), od, 0, 0, 0);
  od = __builtin_amdgcn_mfma_f32_32x32x16_bf16(pa1, PK(l1, h1), od, 0, 0, 0);
  od = __builtin_amdgcn_mfma_f32_32x32x16_bf16(pa2, PK(l2, h2), od, 0, 0, 0);
  od = __builtin_amdgcn_mfma_f32_32x32x16_bf16(pa3, PK(l3, h3), od, 0, 0, 0);
#undef PK
}
__device__ __forceinline__ void pv_d0(f32x16* o, int vb, bf16x8 pa0, bf16x8 pa1, bf16x8 pa2, bf16x8 pa3) {
  pv_one<0>(o[0], vb, pa0, pa1, pa2, pa3); pv_one<1>(o[1], vb, pa0, pa1, pa2, pa3); pv_one<2>(o[2], vb, pa0, pa1, pa2, pa3); pv_one<3>(o[3], vb, pa0, pa1, pa2, pa3);
}
__device__ __forceinline__ void attn_dense_body(const bf16* __restrict__ Qb, const bf16* __restrict__ Kh, const bf16* __restrict__ Vh, bf16* __restrict__ Ob, int seq, LAS char* lds,
                                                const float* __restrict__ qg, const float* __restrict__ ropet, int t0, float negm_u, int exactmax) {
  const int tid = otid(), wid = tid >> 6, lane = tid & 63, r32 = lane & 31, hi = lane >> 5;
  LAS char* V_lds = lds; LAS char* K_lds = lds + 2 * SHM_V;
  LAS float* ws = (LAS float*)(lds + 2 * SHM_V + 2 * SHM_K) + wid * 64; LAS float* li_l = ws;
  float l_reg = 0; f32x16 o[4] = {}; bf16x8 qr[8];
  const bf16* Qw = Qb + (long)(wid * QBLK + r32) * LDQ + hi * 8;
#pragma unroll
  for (int d0 = 0; d0 < 8; ++d0) qr[d0] = ld8(Qw + d0 * 16);
  { float x[8][8]; float ss = 0.f;
#pragma unroll
    for (int d0 = 0; d0 < 8; ++d0) { const u32x4 w = __builtin_bit_cast(u32x4, qr[d0]);
#pragma unroll
      for (int p = 0; p < 4; ++p) { x[d0][2 * p] = bflo(w[p]); x[d0][2 * p + 1] = bfhi(w[p]); ss += x[d0][2 * p] * x[d0][2 * p] + x[d0][2 * p + 1] * x[d0][2 * p + 1]; } }
    { auto rr = __builtin_amdgcn_permlane32_swap(__float_as_uint(ss), __float_as_uint(ss), false, false); ss = __uint_as_float(rr[0]) + __uint_as_float(rr[1]); }
    const float rstd = __builtin_amdgcn_rsqf(ss * (1.f / 128.f) + EPS) * (SCALE * 1.4426950408889634f);
#pragma unroll
    for (int d0 = 0; d0 < 8; ++d0) { const f32x4 g0 = *(const f32x4*)(qg + 16 * d0 + 8 * hi), g1 = *(const f32x4*)(qg + 16 * d0 + 8 * hi + 4);
#pragma unroll
      for (int j = 0; j < 4; ++j) { x[d0][j] *= rstd * g0[j]; x[d0][4 + j] *= rstd * g1[j]; } }
    if (t0 >= 0) { const int t = t0 + wid * QBLK + r32;
#pragma unroll
      for (int kind = 0; kind < 2; ++kind) { const int pos = kind == 0 ? (t >> 6) : (t & 63);
#pragma unroll
        for (int e = 0; e < 2; ++e) { const float* cp = ropet + pos * 32 + 16 * e + 8 * hi;
          const f32x4 c0 = *(const f32x4*)cp, c1 = *(const f32x4*)(cp + 4), s0 = *(const f32x4*)(cp + 2048), s1 = *(const f32x4*)(cp + 2048 + 4);
#pragma unroll
          for (int j = 0; j < 8; ++j) { const float cs = j < 4 ? c0[j & 3] : c1[j & 3], sn = j < 4 ? s0[j & 3] : s1[j & 3];
            const float a1 = x[4 * kind + e][j], a2 = x[4 * kind + 2 + e][j]; x[4 * kind + e][j] = a1 * cs - a2 * sn; x[4 * kind + 2 + e][j] = a2 * cs + a1 * sn; } } } }
#pragma unroll
    for (int d0 = 0; d0 < 8; ++d0) { u32x4 w; w.x = pk2(x[d0][0], x[d0][1]); w.y = pk2(x[d0][2], x[d0][3]); w.z = pk2(x[d0][4], x[d0][5]); w.w = pk2(x[d0][6], x[d0][7]); qr[d0] = __builtin_bit_cast(bf16x8, w); } }
  const int sr = tid >> 4, sc = (tid & 15) * 8, vst0 = v_st(sr, sc), vst1 = v_st(32 + sr, sc);
  const int vb0 = (int)(unsigned)(size_t)V_lds + v_rd_base(lane);
  const unsigned goff = (unsigned)(sr * LDK + sc) * 2u;
  const char* Kb0 = (const char*)Kh; const char* Vb0 = (const char*)Vh;
  const int NT = seq / KVBLK;
  float negm = negm_u;
  if (exactmax) {
    float mrow = -3.0e38f; f32x16 p0, p1;
    for (int j = 0; j < NT; ++j) { const size_t to_ = (size_t)j * KVBLK * LDK * 2;
      const bf16x8 k0 = *(const bf16x8*)(Kb0 + to_ + goff), k1 = *(const bf16x8*)(Kb0 + to_ + (size_t)32 * LDK * 2 + goff);
      __syncthreads();
      *(LAS bf16x8*)(K_lds + KSWZ(sr, sc * 2)) = k0; *(LAS bf16x8*)(K_lds + KSWZ(32 + sr, sc * 2)) = k1;
      __syncthreads();
      qkt(p0, p1, K_lds, qr, r32, hi, 0.f);
#pragma unroll
      for (int r = 0; r < 16; ++r) mrow = fmaxf(mrow, fmaxf(p0[r], p1[r])); }
    { auto rr = __builtin_amdgcn_permlane32_swap(__float_as_uint(mrow), __float_as_uint(mrow), false, false); mrow = fmaxf(__uint_as_float(rr[0]), __uint_as_float(rr[1])); }
    negm = -mrow; __syncthreads(); }
  struct { bf16x8 vs0, vs1, ks0, ks1; } sr_[1];
#define SLOAD(i, k0) do { const size_t to_ = (size_t)(k0) * LDK * 2; \
    sr_[i].vs0 = *(const bf16x8*)(Vb0 + to_ + goff); sr_[i].vs1 = *(const bf16x8*)(Vb0 + to_ + (size_t)32 * LDK * 2 + goff); \
    sr_[i].ks0 = *(const bf16x8*)(Kb0 + to_ + goff); sr_[i].ks1 = *(const bf16x8*)(Kb0 + to_ + (size_t)32 * LDK * 2 + goff); } while (0)
#define SWRITE(b, i) do { *(LAS bf16x8*)(V_lds + (b) * SHM_V + vst0) = sr_[i].vs0;          \
    *(LAS bf16x8*)(V_lds + (b) * SHM_V + vst1) = sr_[i].vs1; int kc = sc * 2;               \
    *(LAS bf16x8*)(K_lds + (b) * SHM_K + KSWZ(sr, kc)) = sr_[i].ks0;                       \
    *(LAS bf16x8*)(K_lds + (b) * SHM_K + KSWZ(32 + sr, kc)) = sr_[i].ks1; } while (0)
#define SWAIT() asm volatile("s_waitcnt vmcnt(0)" ::: "memory")
#define PSM(P0) do { for (int r_ = 0; r_ < 16; ++r_) P0[r_] = __builtin_amdgcn_exp2f(P0[r_]); } while (0)
  f32x16 pA0, pA1, pB0, pB1; bf16x8 pa0, pa1, pa2, pa3;
  constexpr int SE = 0, SO = 0;
  SLOAD(SE, 0); asm volatile("s_waitcnt vmcnt(0)" ::: "memory"); SWRITE(0, SE); __syncthreads();
  qkt(pA0, pA1, K_lds, qr, r32, hi, negm); PSM(pA0);
  SLOAD(SO, KVBLK);
  SWAIT(); SWRITE(1, SO); if (2 < NT) SLOAD(SE, 2 * KVBLK); __syncthreads();
  for (int j = 1; j + 1 < NT; j += 2) {
    SBAR(); qkt(pB0, pB1, K_lds + SHM_K, qr, r32, hi, negm);
    finishSM(pA0, pA1, l_reg, pa0, pa1, pa2, pa3); SBAR();
    pv_d0(o, vb0, pa0, pa1, pa2, pa3); PSM(pB0);
    __syncthreads(); SWAIT(); SWRITE(0, SE); SBAR(); SLOAD(SO, (j + 2) * KVBLK); SBAR();
    __syncthreads();
    SBAR(); qkt(pA0, pA1, K_lds, qr, r32, hi, negm);
    finishSM(pB0, pB1, l_reg, pa0, pa1, pa2, pa3); SBAR();
    pv_d0(o, vb0 + (int)SHM_V, pa0, pa1, pa2, pa3); PSM(pA0);
    __syncthreads(); SWAIT(); SWRITE(1, SO); SBAR(); if (j + 3 < NT) SLOAD(SE, (j + 3) * KVBLK); SBAR();
    __syncthreads();
  }
  SBAR(); qkt(pB0, pB1, K_lds + SHM_K, qr, r32, hi, negm);
  finishSM(pA0, pA1, l_reg, pa0, pa1, pa2, pa3); SBAR();
  pv_d0(o, vb0, pa0, pa1, pa2, pa3); PSM(pB0);
  __syncthreads();
  finishSM(pB0, pB1, l_reg, pa0, pa1, pa2, pa3); SBAR();
  pv_d0(o, vb0 + (int)SHM_V, pa0, pa1, pa2, pa3);
#undef PSM
  if (hi == 0) li_l[r32] = l_reg; asm volatile("s_waitcnt lgkmcnt(0)" ::: "memory");
  float rli[16];
#pragma unroll
  for (int r = 0; r < 16; ++r) rli[r] = __builtin_amdgcn_rcpf(li_l[crow(r, hi)]);
  bf16* Ow = Ob + (long)(wid * QBLK) * LDO;
#pragma unroll
  for (int r = 0; r < 16; ++r) { int orow = crow(r, hi);
    for (int d0 = 0; d0 < 4; ++d0) { if (OUTPROJ_FP8) ((unsigned char*)Ob)[(long)(wid * QBLK + orow) * LDO + d0 * 32 + r32] = (unsigned char)fp8_1(16.f * o[d0][r] * rli[r]); else Ow[(long)orow * LDO + d0 * 32 + r32] = (bf16)f2bf(o[d0][r] * rli[r]); } }
#undef SLOAD
#undef SWRITE
#undef SWAIT
}
}

enum { PH_PRO = 0, PH_NORM1 = 1, PH_INPROJ = 2, PH_PREP = 3, PH_SCAN = 4, PH_ATTN = 5, PH_FINISH = 6, PH_OUTPROJ = 7, PH_ROUTER = 8, PH_DISPATCH = 9, PH_GU = 10, PH_DOWN = 11, PH_COMBINE = 12, NPH = 13 };

struct MapIn  { __device__ __forceinline__ int operator()(int n) const { return n < 2320 ? n + 1024 : n - 2320; } };
struct MapId  { __device__ __forceinline__ int operator()(int n) const { return n; } };
struct MapGU  { __device__ __forceinline__ int operator()(int n) const { const int bj = n >> 10, w = n & 1023; return (w >> 7) * 256 + bj * 128 + (w & 127); } };
struct TrItem { const float* W; unsigned char* WT; int N, kind  , kb, nb, m  ; unsigned* cmax; };
__device__ __forceinline__ int tr_map(int kind, int n) {
    if (kind == 0) return n < 2320 ? n + 1024 : n - 2320;
    if (kind == 2) { const int bj = n >> 10, w = n & 1023; return (w >> 7) * 256 + bj * 128 + (w & 127); }
    return n;
}
__device__ __forceinline__ void tr_load(f32x4 (&v)[16], const TrItem& t, int lane) {
    const int nq = (lane & 15) * 4, kr = lane >> 4; const bool okn = 64 * t.nb + nq < t.N;
#pragma unroll
    for (int j = 0; j < 16; ++j) v[j] = okn ? *(const f32x4*)(t.W + (size_t)(64 * t.kb + kr + 4 * j) * t.N + 64 * t.nb + nq) : (f32x4){0.f, 0.f, 0.f, 0.f};
}
__device__ __forceinline__ void tr_store(const f32x4 (&v)[16], const TrItem& t, LAS float* scr, int lane) {
    const int k0 = 64 * t.kb, n0 = 64 * t.nb, nq = (lane & 15) * 4, kr = lane >> 4;
#pragma unroll
    for (int j = 0; j < 16; ++j) { LAS float* s = scr + (kr + 4 * j) * 65 + nq; s[0] = v[j][0]; s[1] = v[j][1]; s[2] = v[j][2]; s[3] = v[j][3]; }
    LDS_WAIT(); asm volatile("" ::: "memory");
    if (INPROJ_I8 && t.kind == 0) {
        const int n = n0 + lane; float mx = 0.f;
#pragma unroll 8
        for (int k = 0; k < 64; ++k) mx = fmaxf(mx, fabsf(scr[k * 65 + lane]));
        if (n < t.N) __hip_atomic_fetch_max(t.cmax + t.m * PC + tr_map(0, n), __float_as_uint(mx), __ATOMIC_RELAXED, __HIP_MEMORY_SCOPE_AGENT);
        LDS_WAIT(); asm volatile("" ::: "memory"); return; }
    if ((MOE_FP8 && t.kind >= 2) || (OUTPROJ_FP8 && t.kind == 1)) { const int c = lane & 3;
#pragma unroll
        for (int j = 0; j < 4; ++j) { const int nl = (lane >> 2) + 16 * j, n = n0 + nl; const LAS float* s = scr + (16 * c) * 65 + nl;
            u32x4 o; o.x = pk_fp8x4(64.f * s[0 * 65], 64.f * s[1 * 65], 64.f * s[2 * 65], 64.f * s[3 * 65]); o.y = pk_fp8x4(64.f * s[4 * 65], 64.f * s[5 * 65], 64.f * s[6 * 65], 64.f * s[7 * 65]);
            o.z = pk_fp8x4(64.f * s[8 * 65], 64.f * s[9 * 65], 64.f * s[10 * 65], 64.f * s[11 * 65]); o.w = pk_fp8x4(64.f * s[12 * 65], 64.f * s[13 * 65], 64.f * s[14 * 65], 64.f * s[15 * 65]);
            if (n < t.N) *(u32x4*)(t.WT + (size_t)tr_map(t.kind, n) * 1024 + k0 + 16 * c) = o; } }
    else { const int c = lane & 7;
#pragma unroll
        for (int j = 0; j < 8; ++j) { const int nl = (lane >> 3) + 8 * j, n = n0 + nl; const LAS float* s = scr + (8 * c) * 65 + nl;
            u32x4 o; o.x = pk2(s[0 * 65], s[1 * 65]); o.y = pk2(s[2 * 65], s[3 * 65]); o.z = pk2(s[4 * 65], s[5 * 65]); o.w = pk2(s[6 * 65], s[7 * 65]);
            if (n < t.N) *(u32x4*)((bf16*)t.WT + (size_t)tr_map(t.kind, n) * 1024 + k0 + 8 * c) = o; } }
    LDS_WAIT(); asm volatile("" ::: "memory");
}
__device__ __forceinline__ void tr_load_w(f32x4 (&v)[16], const TrItem& t, int lane) {
    const int nq = (lane & 7) * 4, kr = lane >> 3;
#pragma unroll
    for (int j = 0; j < 16; ++j) v[j] = *(const f32x4*)(t.W + (size_t)(128 * t.kb + kr + 8 * j) * t.N + 32 * t.nb + nq);
}
__device__ __forceinline__ void tr_store_w(const f32x4 (&v)[16], const TrItem& t, LAS float* scr, int lane) {
    const int k0 = 128 * t.kb, n0 = 32 * t.nb, nq = (lane & 7) * 4, kr = lane >> 3;
#pragma unroll
    for (int j = 0; j < 16; ++j) { LAS float* s = scr + (kr + 8 * j) * 33 + nq; s[0] = v[j][0]; s[1] = v[j][1]; s[2] = v[j][2]; s[3] = v[j][3]; }
    LDS_WAIT(); asm volatile("" ::: "memory");
    const int c = lane & 7;
#pragma unroll
    for (int j = 0; j < 4; ++j) { const int nl = (lane >> 3) + 8 * j, n = n0 + nl; const LAS float* s = scr + (16 * c) * 33 + nl;
        u32x4 o; o.x = pk_fp8x4(64.f * s[0 * 33], 64.f * s[1 * 33], 64.f * s[2 * 33], 64.f * s[3 * 33]); o.y = pk_fp8x4(64.f * s[4 * 33], 64.f * s[5 * 33], 64.f * s[6 * 33], 64.f * s[7 * 33]);
        o.z = pk_fp8x4(64.f * s[8 * 33], 64.f * s[9 * 33], 64.f * s[10 * 33], 64.f * s[11 * 33]); o.w = pk_fp8x4(64.f * s[12 * 33], 64.f * s[13 * 33], 64.f * s[14 * 33], 64.f * s[15 * 33]);
        *(u32x4*)(t.WT + (size_t)tr_map(t.kind, n) * 1024 + k0 + 16 * c) = o; }
    LDS_WAIT(); asm volatile("" ::: "memory");
}
__device__ __forceinline__ void p_prologue(const Args& a, LAS unsigned char* lds) {
    const int tid = otid(), lane = tid & 63, wave = tid >> 6, G = ogrid(), bid = obid();
    const int gw = bid * NWAVE + wave, NGW = G * NWAVE;
    const int gt = bid * NTHR + tid, NGT = G * NTHR;
    LAS float* scr = (LAS float*)(lds + wave * 16896);
    constexpr int NNB_IN = (NIN + 63) / 64;
    constexpr int I_IN = 16 * NNB_IN, I_OUT = 16 * 16, I_GU = 16 * 32, I_DN = 16 * 16;
    constexpr int T_IN = DEPTH * I_IN, T_OUT = DEPTH * I_OUT, T_GU = DEPTH * NEXP * I_GU, T_DN = DEPTH * NEXP * I_DN;
    constexpr int NITEMS = T_IN + T_OUT + T_GU + T_DN;
    constexpr size_t WB = MOE_FP8 ? 1 : 2;
    auto decode = [&](int it) { TrItem t; int r = it;
        if (r < T_IN) { const int m = r / I_IN, q = r % I_IN; t.W = a.in[8] + (size_t)m * 1024 * NIN; t.WT = a.ws + WS_WIN + (size_t)m * PC * 1024 * 2; t.N = NIN; t.kind = 0; t.kb = q / NNB_IN; t.nb = q % NNB_IN; t.m = m; t.cmax = (unsigned*)(a.ws + WS_CTL) + CW_CMAX; return t; } r -= T_IN;
        if (r < T_OUT) { const int m = r / I_OUT, q = r % I_OUT; t.W = a.in[9] + (size_t)m * 1024 * 1024; t.WT = a.ws + WS_WOUT + (size_t)m * 1024 * 1024 * (OUTPROJ_FP8 ? 1 : 2); t.N = 1024; t.kind = 1; t.kb = q / 16; t.nb = q % 16; return t; } r -= T_OUT;
        if (r < T_GU) { const int m = r / I_GU, q = r % I_GU; t.W = a.in[18] + (size_t)m * 1024 * 2048; t.WT = a.ws + WS_WGU + (size_t)m * 2048 * 1024 * WB; t.N = 2048; t.kind = 2; if (MOE_FP8) { t.kb = q / 64; t.nb = q % 64; } else { t.kb = q / 32; t.nb = q % 32; } return t; } r -= T_GU;
        { const int m = r / I_DN, q = r % I_DN; t.W = a.in[20] + (size_t)m * 1024 * 1024; t.WT = a.ws + WS_WDN + (size_t)m * 1024 * 1024 * WB; t.N = 1024; t.kind = 3; if (MOE_FP8) { t.kb = q / 32; t.nb = q % 32; } else { t.kb = q / 16; t.nb = q % 16; } return t; } };
    if (gw < NITEMS) {
        TrItem cur = decode(gw); f32x4 vc[16]; if (MOE_FP8 && cur.kind >= 2) tr_load_w(vc, cur, lane); else tr_load(vc, cur, lane);
        for (int it = gw; it < NITEMS; it += NGW) {
            const bool more = it + NGW < NITEMS; TrItem nxt = cur; f32x4 vn[16];
            if (more) { nxt = decode(it + NGW); if (MOE_FP8 && nxt.kind >= 2) tr_load_w(vn, nxt, lane); else tr_load(vn, nxt, lane); }
            if (MOE_FP8 && cur.kind >= 2) tr_store_w(vc, cur, scr, lane); else tr_store(vc, cur, scr, lane);
            if (more) { cur = nxt;
#pragma unroll
                for (int j = 0; j < 16; ++j) vc[j] = vn[j]; }
        }
    }
    if (!INPROJ_I8) for (int i = gt; i < DEPTH * (PC - NIN) * 128; i += NGT) { const int m = i / ((PC - NIN) * 128), q = i % ((PC - NIN) * 128);
        *(u32x4*)((bf16*)(a.ws + WS_WIN) + ((size_t)m * PC + NIN) * 1024 + (size_t)q * 8) = (u32x4){0u, 0u, 0u, 0u}; }
    for (int i = gt; i < DEPTH * 32 * 1024; i += NGT) { const int l = i >> 15, e = (i >> 10) & 31, k = i & 1023;
        const float w = a.in[16][((size_t)l * 1024 + k) * 32 + e]; const unsigned h = f2bf(w); const float lo = w - bf2f(h);
        ((bf16*)(a.ws + WS_WRH))[i] = (bf16)h; ((bf16*)(a.ws + WS_WRL))[i] = (bf16)f2bf(lo); }
    for (int i = gt; i < 64 * 32; i += NGT) { const int pos = i >> 5, fi = i & 31;
        const float inv = powf(10000.f, -(float)(2 * fi) / 64.f); const float ang = (float)pos * inv;
        ((float*)(a.ws + WS_ROPE))[i] = cosf(ang); ((float*)(a.ws + WS_ROPE))[2048 + i] = sinf(ang); }
    __syncthreads();
    {
        LAS float* SL = (LAS float*)lds;
        LAS float* PT = (LAS float*)(lds + 40960);
        bool have = false;
        for (int it = bid; it < DEPTH * 96; it += G) {
            if (!have) { for (int i = tid; i < 9 * 1024; i += NTHR) { const float v = i < 8192 ? a.in[1][i] : a.in[3][i - 8192]; SL[i] = v / (1.f + expf(-v)); } have = true; __syncthreads(); }
            const int l = it / 96, n = (it % 96) * 64 + lane;
            const float* W = a.in[4] + ((size_t)l * 1024 + wave * 128) * 6144 + n;
            float acc[9];
#pragma unroll
            for (int j = 0; j < 9; ++j) acc[j] = 0.f;
#pragma unroll 8
            for (int k = 0; k < 128; ++k) { const float w = W[(size_t)k * 6144];
#pragma unroll
                for (int j = 0; j < 9; ++j) acc[j] += SL[j * 1024 + wave * 128 + k] * w; }
#pragma unroll
            for (int j = 0; j < 9; ++j) PT[(wave * 9 + j) * 64 + lane] = acc[j];
            __syncthreads();
            for (int i = tid; i < 9 * 64; i += NTHR) { const int j = i >> 6, c = i & 63; float s = 0.f;
#pragma unroll
                for (int w = 0; w < 8; ++w) s += PT[(w * 9 + j) * 64 + c];
                const int nn = (it % 96) * 64 + c;
                ((float*)(a.ws + WS_MOD))[(size_t)(l * 9 + j) * 6144 + nn] = s + a.in[5][(size_t)l * 6144 + nn]; }
            __syncthreads();
        }
    }
}

__device__ __forceinline__ void norm_mod_store(f32x4 (&v)[2][2], const float* gn, const float* sc, const float* sh, bf16* hrow, int lane) {
    float ss = 0.f;
#pragma unroll
    for (int j = 0; j < 2; ++j)
#pragma unroll
        for (int q = 0; q < 2; ++q) ss += (v[j][q][0] * v[j][q][0] + v[j][q][1] * v[j][q][1]) + (v[j][q][2] * v[j][q][2] + v[j][q][3] * v[j][q][3]);
    const float rstd = 1.f / sqrtf(wave_sum(ss) * (1.f / DM) + EPS);
#pragma unroll
    for (int j = 0; j < 2; ++j) { const int c = 8 * lane + 512 * j;
#pragma unroll
        for (int q = 0; q < 2; ++q) { const f32x4 g = *(const f32x4*)(gn + c + 4 * q), s1 = *(const f32x4*)(sc + c + 4 * q), s0 = *(const f32x4*)(sh + c + 4 * q);
            v[j][q] = v[j][q] * rstd * g * (1.f + s1) + s0; }
        if (hrow) { u32x4 w; w.x = pk2(v[j][0][0], v[j][0][1]); w.y = pk2(v[j][0][2], v[j][0][3]); w.z = pk2(v[j][1][0], v[j][1][1]); w.w = pk2(v[j][1][2], v[j][1][3]);
            *(u32x4*)(hrow + c) = w; } }
}
__device__ __forceinline__ void load_row_bf(const bf16* xr, f32x4 (&v)[2][2], int lane) {
#pragma unroll
    for (int j = 0; j < 2; ++j) { const u32x4 w = *(const u32x4*)(xr + 8 * lane + 512 * j);
        v[j][0] = (f32x4){bflo(w.x), bfhi(w.x), bflo(w.y), bfhi(w.y)}; v[j][1] = (f32x4){bflo(w.z), bfhi(w.z), bflo(w.w), bfhi(w.w)}; }
}
__device__ __forceinline__ void load_row(const float* xr, f32x4 (&v)[2][2], int lane) {
#pragma unroll
    for (int j = 0; j < 2; ++j)
#pragma unroll
        for (int q = 0; q < 2; ++q) v[j][q] = *(const f32x4*)(xr + 8 * lane + 512 * j + 4 * q);
}

__device__ __forceinline__ void p_quant_win(const Args& a) {
    const int gt = obid() * NTHR + otid(), NGT = ogrid() * NTHR;
    const unsigned* CM = (const unsigned*)(a.ws + WS_CTL) + CW_CMAX; float* WSC = (float*)(a.ws + WS_WSC); unsigned char* W8 = (unsigned char*)(a.ws + WS_WIN);
    for (int idx = gt; idx < DEPTH * 64 * PC; idx += NGT) { const int l = idx / (64 * PC), rem = idx - l * (64 * PC), kc = rem / PC, j = rem - kc * PC;
        u32x4 o = {0u, 0u, 0u, 0u}; float s = 0.f;
        if (j < NIN) { const int n = j < 1024 ? j + 2320 : j - 1024; const float cm = __uint_as_float(__hip_atomic_load(CM + l * PC + j, __ATOMIC_RELAXED, __HIP_MEMORY_SCOPE_AGENT));
            s = cm * (1.f / 127.f); const float inv = cm > 0.f ? 127.f / cm : 0.f; const float* wp = a.in[8] + ((size_t)l * 1024 + 16 * kc) * NIN + n; float w[16];
#pragma unroll
            for (int i = 0; i < 16; ++i) w[i] = wp[(size_t)i * NIN] * inv;
            o.x = pk_i8x4(w[0], w[1], w[2], w[3]); o.y = pk_i8x4(w[4], w[5], w[6], w[7]); o.z = pk_i8x4(w[8], w[9], w[10], w[11]); o.w = pk_i8x4(w[12], w[13], w[14], w[15]); }
        *(u32x4*)(W8 + ((size_t)l * PC + j) * 1024 + 16 * kc) = o;
        if (kc == 0) WSC[l * PC + j] = s; }
}
__device__ __forceinline__ void store_row_i8(const f32x4 (&v)[2][2], unsigned char* hrow, float* hs, int lane) {
    float mx = 0.f;
#pragma unroll
    for (int j = 0; j < 2; ++j)
#pragma unroll
        for (int q = 0; q < 2; ++q) mx = fmaxf(fmaxf(mx, fmaxf(fabsf(v[j][q][0]), fabsf(v[j][q][1]))), fmaxf(fabsf(v[j][q][2]), fabsf(v[j][q][3])));
    mx = fmaxf(wave_max_nn(mx), 1e-20f); const float inv = 127.f / mx;
#pragma unroll
    for (int j = 0; j < 2; ++j) { u32x2 w; w.x = pk_i8x4(v[j][0][0] * inv, v[j][0][1] * inv, v[j][0][2] * inv, v[j][0][3] * inv); w.y = pk_i8x4(v[j][1][0] * inv, v[j][1][1] * inv, v[j][1][2] * inv, v[j][1][3] * inv);
        *(u32x2*)(hrow + 8 * lane + 512 * j) = w; }
    if (lane == 0) *hs = mx * (1.f / 127.f);
}
__device__ __forceinline__ void p_norm1(const Args& a, int layer) {
    const int tid = otid(), lane = tid & 63, wave = tid >> 6; const int gw = obid() * NWAVE + wave, NGW = ogrid() * NWAVE;
    bf16* H = (bf16*)(a.ws + WS_H);
    for (int r = gw; r < NR; r += NGW) { f32x4 v[2][2]; load_row(x_rd(a, layer == 0, r), v, lane);
        norm_mod_store(v, a.in[6] + (size_t)layer * DM, modv(a, layer, r, 1), modv(a, layer, r, 0), INPROJ_I8 ? (bf16*)nullptr : H + (size_t)r * DM, lane);
        if (INPROJ_I8) store_row_i8(v, (unsigned char*)(a.ws + WS_H) + (size_t)r * DM, (float*)(a.ws + WS_HSC) + r, lane); }
}

__device__ __forceinline__ void p_prep(const Args& a, int layer, bool dry = false) {
    const int tid = otid(), lane = tid & 63, wave = tid >> 6; const int gw = obid() * NWAVE + wave, NGW = ogrid() * NWAVE;
    bf16* P = (bf16*)(a.ws + WS_P); const float* COS = (const float*)(a.ws + WS_ROPE); const float* SIN = COS + 2048;
    const int half = lane >> 5, fi = lane & 31;
    const float gq1 = a.in[14][layer * 128 + half * 64 + fi], gq2 = a.in[14][layer * 128 + half * 64 + 32 + fi];
    const float gk1 = a.in[15][layer * 128 + half * 64 + fi], gk2 = a.in[15][layer * 128 + half * 64 + 32 + fi];
    for (int r = gw; r < NR; r += NGW) { const int s = r % SB; const bool lat = s >= CTX; const int t = s - CTX;
        float cs = 1.f, sn = 0.f;
        if (lat) { const int pos = half == 0 ? (t >> 6) : (t & 63); cs = COS[pos * 32 + fi]; sn = SIN[pos * 32 + fi]; }
        bf16* pr = P + (size_t)r * PC;
#pragma unroll
        for (int hh = 4; hh < 6; ++hh) { bf16* p1 = pr + hh * 128 + half * 64 + fi;
            const float x1 = bf2f(p1[0]), x2 = bf2f(p1[32]);
            const float rstd = __builtin_amdgcn_rsqf(wave_sum(x1 * x1 + x2 * x2) * (1.f / 128.f) + EPS);
            const float y1 = x1 * rstd * gk1, y2 = x2 * rstd * gk2;
            bf16* po = dry ? (bf16*)(a.ws + WS_ACT) + (size_t)r * 1024 + hh * 128 + half * 64 + fi : p1;
            po[0] = (bf16)f2bf(y1 * cs - y2 * sn); po[32] = (bf16)f2bf(y2 * cs + y1 * sn); }
    }
}

__device__ __forceinline__ int seq_step_s(int dir, int n) { return dir == 0 ? n : (n < CTX ? CTX - 1 - n : SB + CTX - 1 - n); }
__device__ __forceinline__ void hg_seq(const Args& a, int layer, int sid, LAS unsigned char* lds) {
    const int tid = otid(), lane = tid & 63, wave = tid >> 6;
    const int dir = sid & 1, h = (sid >> 1) & 3, b = sid >> 3;
    LAS float* qs = (LAS float*)lds; LAS float* ks = qs + 2048; LAS float* fs = ks + 2048; LAS float* vs = fs + 2048; LAS float* part = vs + 2048;
    const bf16* P = (const bf16*)(a.ws + WS_P);
    float* OH = (float*)(a.ws + WS_OH) + (size_t)dir * NR * 256;
    float lb;
    { const float* lg = a.in[10] + (size_t)dir * DEPTH * 256 + h * 64 + lane;
      const float l0 = lg[0], l1 = lg[256], l2 = lg[512], l3 = lg[768]; const float mx = fmaxf(fmaxf(l0, l1), fmaxf(l2, l3));
      const float e0 = expf(l0 - mx), e1 = expf(l1 - mx), e2 = expf(l2 - mx), e3 = expf(l3 - mx);
      lb = ((layer >= 1 ? e1 : 0.f) + (layer >= 2 ? e2 : 0.f) + (layer >= 3 ? e3 : 0.f)) / (e0 + e1 + e2 + e3); }
    float S[8];
#pragma unroll
    for (int i = 0; i < 8; ++i) S[i] = 0.f;
    for (int n0 = 0; n0 < SB; n0 += 32) {
#pragma unroll
        for (int jj = 0; jj < 4; ++jj) { const int j = wave + 8 * jj; const int s = seq_step_s(dir, n0 + j);
            const bf16* pr = P + (size_t)(b * SB + s) * PC + h * 64 + lane;
            const float q = bf2f(pr[C_HGQ]), z = bf2f(pr[dir ? C_HGZB : C_HGZF]), v = bf2f(pr[C_HGV]);
            const float sg = 1.f / (1.f + expf(-z));
            qs[j * 64 + lane] = q; fs[j * 64 + lane] = lb + (1.f - lb) * sg; ks[j * 64 + lane] = (1.f - lb) * (1.f - sg); vs[j * 64 + lane] = v; }
        __syncthreads();
        for (int j = 0; j < 32; ++j) { const float v = vs[j * 64 + lane]; float p = 0.f;
#pragma unroll
            for (int i = 0; i < 8; ++i) { const int d = wave * 8 + i; S[i] = fs[j * 64 + d] * S[i] + ks[j * 64 + d] * v; p += S[i] * qs[j * 64 + d]; }
            part[(wave * 32 + j) * 64 + lane] = p; }
        __syncthreads();
#pragma unroll
        for (int jj = 0; jj < 4; ++jj) { const int j = wave + 8 * jj; float o = 0.f;
#pragma unroll
            for (int w = 0; w < 8; ++w) o += part[(w * 32 + j) * 64 + lane];
            const int s = seq_step_s(dir, n0 + j); OH[(size_t)(b * SB + s) * 256 + h * 64 + lane] = o; }
        __syncthreads();
    }
}
__device__ __forceinline__ void ml_seq(const Args& a, int layer, int sid, LAS unsigned char* lds) {
    const int tid = otid(), lane = tid & 63, wave = tid >> 6;
    const int dir = sid & 1, h = (sid >> 1) & 3, b = sid >> 3;
    LAS float* qs = (LAS float*)lds; LAS float* ks = qs + 2048; LAS float* vs = ks + 2048; LAS float* part = vs + 2048;
    LAS float* ip = part + 8 * 2048; LAS float* lf = ip + 32; LAS float* dp = lf + 32; LAS float* ms = dp + 8 * 32;
    const bf16* P = (const bf16*)(a.ws + WS_P);
    float* OM = (float*)(a.ws + WS_OM) + (size_t)dir * NR * 256;
    const float bi = a.in[12][layer * 16 + dir * 4 + h], bfg = a.in[12][layer * 16 + 8 + dir * 4 + h];
    float C[8], nn[8], m = 0.f;
#pragma unroll
    for (int i = 0; i < 8; ++i) { C[i] = 0.f; nn[i] = 0.f; }
    for (int n0 = 0; n0 < SB; n0 += 32) {
#pragma unroll
        for (int jj = 0; jj < 4; ++jj) { const int j = wave + 8 * jj; const int s = seq_step_s(dir, n0 + j);
            const bf16* pr = P + (size_t)(b * SB + s) * PC;
            qs[j * 64 + lane] = bf2f(pr[C_MLQ + h * 64 + lane]); ks[j * 64 + lane] = bf2f(pr[C_MLK + h * 64 + lane]) * 0.125f; vs[j * 64 + lane] = bf2f(pr[C_MLV + h * 64 + lane]);
            if (lane == 0) { ip[j] = bf2f(pr[C_MLG + dir * 4 + h]) + bi; const float fp = bf2f(pr[C_MLG + 8 + dir * 4 + h]) + bfg;
                lf[j] = fminf(fp, 0.f) - log1pf(expf(-fabsf(fp))); } }
        __syncthreads();
        for (int j = 0; j < 32; ++j) { const float v = vs[j * 64 + lane]; const float ipj = ip[j], lfj = lf[j];
            const float mn = fmaxf(lfj + m, ipj); const float aa = expf(lfj + m - mn), bb = expf(ipj - mn); m = mn;
            float p = 0.f, dn = 0.f;
#pragma unroll
            for (int i = 0; i < 8; ++i) { const int d = wave * 8 + i; const float kk = ks[j * 64 + d] * bb, qq = qs[j * 64 + d];
                C[i] = aa * C[i] + kk * v; nn[i] = aa * nn[i] + kk; p += C[i] * qq; dn += nn[i] * qq; }
            part[(wave * 32 + j) * 64 + lane] = p; if (lane == 0) { dp[wave * 32 + j] = dn; if (wave == 0) ms[j] = mn; } }
        __syncthreads();
#pragma unroll
        for (int jj = 0; jj < 4; ++jj) { const int j = wave + 8 * jj; float o = 0.f, dn = 0.f;
#pragma unroll
            for (int w = 0; w < 8; ++w) { o += part[(w * 32 + j) * 64 + lane]; dn += dp[w * 32 + j]; }
            const int s = seq_step_s(dir, n0 + j); OM[(size_t)(b * SB + s) * 256 + h * 64 + lane] = o / fmaxf(fabsf(dn), expf(-ms[j])); }
        __syncthreads();
    }
}
__device__ __forceinline__ void p_scan(const Args& a, int layer, LAS unsigned char* lds, int do_hg, int do_ml) {
    for (int u = obid(); u < 128; u += ogrid()) { if (u < 64) { if (do_hg) hg_seq(a, layer, u, lds); } else { if (do_ml) ml_seq(a, layer, u - 64, lds); } }
}


namespace scan {
constexpr int NCH = 68, NTASK = NB * 4 * 2 * NCH;
__device__ __forceinline__ int swz(int row, int unit) { return row * 128 + ((unit ^ ((row >> 1) & 7)) << 4); }
__device__ __forceinline__ bf16x8 frag(const LAS char* arr, int row, int unit) { return *(const LAS bf16x8*)(arr + swz(row, unit)); }
__device__ __forceinline__ void put2(LAS char* arr, int row, int col_even, float lo, float hi) { *(LAS unsigned*)(arr + swz(row, col_even >> 3) + (col_even & 7) * 2) = pk2(lo, hi); }
__device__ __forceinline__ void put1(LAS char* arr, int row, int col, float x) { *(LAS bf16*)(arr + swz(row, col >> 3) + (col & 7) * 2) = (bf16)f2bf(x); }
__device__ __forceinline__ int crow(int r, int hh) { return (r & 3) + 8 * (r >> 2) + 4 * hh; }
__device__ __forceinline__ void mm64(f32x16 (&acc)[2][2], const LAS char* A, const LAS char* B, int r32, int hh, int skip_a, int skip_b) {
#pragma unroll
    for (int st = 0; st < 4; ++st) { bf16x8 af[2], bfr[2];
#pragma unroll
        for (int i = 0; i < 2; ++i) { af[i] = frag(A, 32 * i + r32, 2 * st + hh); bfr[i] = frag(B, 32 * i + r32, 2 * st + hh); }
#pragma unroll
        for (int ai = 0; ai < 2; ++ai)
#pragma unroll
            for (int bi = 0; bi < 2; ++bi) if (!(ai == skip_a && bi == skip_b)) acc[ai][bi] = __builtin_amdgcn_mfma_f32_32x32x16_bf16(af[ai], bfr[bi], acc[ai][bi], 0, 0, 0); }
}
#define SC_PK4(P, BASE, OUT) do { unsigned a0 = pk2(P[BASE + 0], P[BASE + 1]), a1 = pk2(P[BASE + 2], P[BASE + 3]);   \
    unsigned b0 = pk2(P[BASE + 4], P[BASE + 5]), b1 = pk2(P[BASE + 6], P[BASE + 7]);                              \
    auto r0 = __builtin_amdgcn_permlane32_swap(a0, b0, false, false); auto r1 = __builtin_amdgcn_permlane32_swap(a1, b1, false, false); \
    u32x4 w = {r0[0], r1[0], r0[1], r1[1]}; OUT = __builtin_bit_cast(bf16x8, w); } while (0)
__device__ __forceinline__ float hg_lb(const Args& a, int layer, int dir, int h, int lane) {
    const float* lg = a.in[10] + (size_t)dir * DEPTH * 256 + h * 64 + lane;
    const float l0 = lg[0], l1 = lg[256], l2 = lg[512], l3 = lg[768]; const float mx = fmaxf(fmaxf(l0, l1), fmaxf(l2, l3));
    const float e0 = __expf(l0 - mx), e1 = __expf(l1 - mx), e2 = __expf(l2 - mx), e3 = __expf(l3 - mx);
    return ((layer >= 1 ? e1 : 0.f) + (layer >= 2 ? e2 : 0.f) + (layer >= 3 ? e3 : 0.f)) / (e0 + e1 + e2 + e3);
}
__device__ __forceinline__ float scan_add(float x, int lane, int dir) {
#pragma unroll
    for (int o = 1; o < 64; o <<= 1) { const float y = dir ? __shfl_down(x, o) : __shfl_up(x, o); const bool ok = dir ? (lane + o < 64) : (lane >= o); x += ok ? y : 0.f; }
    return x;
}
__device__ __forceinline__ float scan_max(float x, int lane, int dir) {
#pragma unroll
    for (int o = 1; o < 64; o <<= 1) { const float y = dir ? __shfl_down(x, o) : __shfl_up(x, o); const bool ok = dir ? (lane + o < 64) : (lane >= o); x = ok ? fmaxf(x, y) : x; }
    return x;
}
__device__ __forceinline__ float wave_max(float v) {
#pragma unroll
    for (int o = 1; o < 64; o <<= 1) v = fmaxf(v, __shfl_xor(v, o));
    return v;
}
__device__ __forceinline__ float logsig(float x) { return fminf(x, 0.f) - __logf(1.f + __expf(-fabsf(x))); }
__device__ __forceinline__ void store_ut(bf16* UT, const f32x16 (&acc)[2][2], int r32, int hh) {
#pragma unroll
    for (int vi = 0; vi < 2; ++vi)
#pragma unroll
        for (int di = 0; di < 2; ++di)
#pragma unroll
            for (int rg = 0; rg < 16; ++rg) UT[(32 * vi + crow(rg, hh)) * 64 + 32 * di + r32] = (bf16)f2bf(acc[vi][di][rg]);
}
__device__ __forceinline__ void stage_vt(LAS char* X, const bf16* Pr, int vcol, int lane) {
#pragma unroll 8
    for (int p = 0; p < 32; ++p) put2(X, lane, 2 * p, bf2f(Pr[(size_t)(2 * p) * PC + vcol + lane]), bf2f(Pr[(size_t)(2 * p + 1) * PC + vcol + lane]));
}
__device__ __forceinline__ void stage_copy(LAS char* X, const bf16* G, int ldg, int lane) {
#pragma unroll
    for (int j = 0; j < 8; ++j) { const int u = lane + 64 * j, row = u >> 3, unit = u & 7; *(LAS u32x4*)(X + swz(row, unit)) = *(const u32x4*)(G + (size_t)row * ldg + unit * 8); }
}

__device__ __forceinline__ int tile8_row(int lane, int j) { return 2 * (lane >> 3) + (j & 1) + 16 * (j >> 1); }
__device__ __forceinline__ void load_tile8(u32x4 (&vr)[8], const bf16* G, int ldg, int lane) {
#pragma unroll
    for (int j = 0; j < 8; ++j) vr[j] = *(const u32x4*)(G + (size_t)tile8_row(lane, j) * ldg + 8 * (lane & 7));
}
__device__ __forceinline__ void put_tile8_t(LAS char* X, const u32x4 (&vr)[8], int lane) {
#pragma unroll
    for (int j = 0; j < 8; j += 2) { const int t = tile8_row(lane, j);
#pragma unroll
        for (int e = 0; e < 8; ++e) { const int v = 8 * (lane & 7) + e; const unsigned w0 = vr[j][e >> 1], w1 = vr[j + 1][e >> 1];
            const unsigned pk = (e & 1) ? ((w0 >> 16) | (w1 & 0xffff0000u)) : ((w0 & 0xffffu) | (w1 << 16));
            *(LAS unsigned*)(X + swz(v, t >> 3) + (t & 7) * 2) = pk; } }
}
__device__ __forceinline__ void put_tile8(LAS char* X, const u32x4 (&vr)[8], int lane) {
#pragma unroll
    for (int j = 0; j < 8; ++j) *(LAS u32x4*)(X + swz(tile8_row(lane, j), lane & 7)) = vr[j];
}
__device__ __forceinline__ float get1(const LAS char* arr, int row, int col) { return bf2f(*(const LAS bf16*)(arr + swz(row, col >> 3) + (col & 7) * 2)); }

__device__ __forceinline__ void hgA(const Args& a, int layer, int b, int c, int h, int dir, LAS char* X, LAS char* Y, int lane) {
    const bf16* Pr = (const bf16*)(a.ws + WS_P) + (size_t)(b * SB + 64 * c) * PC;
    stage_copy(X, Pr + (dir ? C_HGZB : C_HGZF) + h * 64, PC, lane);
    u32x4 vr[8]; load_tile8(vr, Pr + C_HGV + h * 64, PC, lane);
    const float lb = hg_lb(a, layer, dir, h, lane), omlb = 1.f - lb;
    float R = 1.f;
#pragma unroll 4
    for (int p = 0; p < 32; ++p) { const int t0 = dir ? 2 * p : 63 - 2 * p, t1 = dir ? 2 * p + 1 : 62 - 2 * p;
        const float f0 = lb + omlb * sigm(get1(X, t0, lane)); const float k0 = (1.f - f0) * R; R *= f0;
        const float f1 = lb + omlb * sigm(get1(X, t1, lane)); const float k1 = (1.f - f1) * R; R *= f1;
        put2(Y, lane, dir ? t0 : t1, dir ? k0 : k1, dir ? k1 : k0); }
    put_tile8_t(X, vr, lane);
    const int tk = ((b * 4 + h) * 2 + dir) * NCH + c;
    ((float*)(a.ws + WS_DT))[(size_t)tk * 64 + lane] = R;
    f32x16 acc[2][2] = {};
    mm64(acc, X, Y, lane & 31, lane >> 5, -1, -1);
    store_ut((bf16*)(a.ws + WS_UTH) + (size_t)tk * 4096, acc, lane & 31, lane >> 5);
}
__device__ __forceinline__ void mlA(const Args& a, int layer, int b, int c, int h, int dir, LAS char* X, LAS char* Y, int lane) {
    const bf16* Pr = (const bf16*)(a.ws + WS_P) + (size_t)(b * SB + 64 * c) * PC;
    stage_copy(X, Pr + C_MLK + h * 64, PC, lane);
    u32x4 vr[8]; load_tile8(vr, Pr + C_MLV + h * 64, PC, lane);
    const float ip = bf2f(Pr[(size_t)lane * PC + C_MLG + dir * 4 + h]) + a.in[12][layer * 16 + dir * 4 + h];
    const float lf = logsig(bf2f(Pr[(size_t)lane * PC + C_MLG + 8 + dir * 4 + h]) + a.in[12][layer * 16 + 8 + dir * 4 + h]);
    const float bt = scan_add(lf, lane, dir), g = wave_sum(lf);
    const float at = g - bt + ip, l = wave_max(at), w = __expf(at - l);
    float nu = 0.f;
#pragma unroll
    for (int p = 0; p < 32; ++p) { const float w0 = __builtin_bit_cast(float, __builtin_amdgcn_readlane(__builtin_bit_cast(int, w), 2 * p)), w1 = __builtin_bit_cast(float, __builtin_amdgcn_readlane(__builtin_bit_cast(int, w), 2 * p + 1));
        const float k0 = get1(X, 2 * p, lane) * 0.125f * w0, k1 = get1(X, 2 * p + 1, lane) * 0.125f * w1;
        nu += k0 + k1; put2(Y, lane, 2 * p, k0, k1); }
    put_tile8_t(X, vr, lane);
    const int tk = ((b * 4 + h) * 2 + dir) * NCH + c;
    ((float*)(a.ws + WS_NU))[(size_t)tk * 64 + lane] = nu;
    if (lane == 0) { ((float*)(a.ws + WS_GL))[tk * 2] = g; ((float*)(a.ws + WS_GL))[tk * 2 + 1] = l; }
    f32x16 acc[2][2] = {};
    mm64(acc, X, Y, lane & 31, lane >> 5, -1, -1);
    store_ut((bf16*)(a.ws + WS_UTM) + (size_t)tk * 4096, acc, lane & 31, lane >> 5);
}
__device__ __forceinline__ void p_scanA(const Args& a, int layer, LAS unsigned char* lds, int do_hg, int do_ml) {
    const int tid = otid(), lane = tid & 63, wave = __builtin_amdgcn_readfirstlane(tid >> 6), G = ogrid(), h = wave >> 1, dir = wave & 1;
    LAS char* X = (LAS char*)lds + wave * 16384; LAS char* Y = X + 8192;
    for (int u = obid(); u < 2 * NB * NCH; u += G) { const int mixer = u / (NB * NCH), q = u % (NB * NCH), b = q / NCH, c = q % NCH;
        int ln = lane; asm volatile("" : "+v"(ln));
        if (mixer == 0) { if (do_hg) hgA(a, layer, b, c, h, dir, X, Y, ln); } else { if (do_ml) mlA(a, layer, b, c, h, dir, X, Y, ln); } }
}

__device__ __forceinline__ int chunk_of(int dir, int k) { return dir == 0 ? k : (k < 4 ? 3 - k : NCH + 3 - k); }
__device__ __forceinline__ void p_scanB(const Args& a, int do_hg, int do_ml) {
    const int tid = otid(), G = ogrid();
    for (int g = obid() * NTHR + tid; g < 128 * 1024; g += G * NTHR) {
        const int seq = g >> 10, mixer = seq >> 6, sq = seq & 63, dir = sq & 1, e4 = g & 1023, d0 = (e4 & 15) * 4;
        if (mixer == 0) { if (!do_hg) continue;
            const bf16* UT = (const bf16*)(a.ws + WS_UTH); bf16* SP = (bf16*)(a.ws + WS_SPH); const float* DT = (const float*)(a.ws + WS_DT);
            f32x4 S = {0.f, 0.f, 0.f, 0.f};
#pragma unroll 4
            for (int k = 0; k < NCH; ++k) { const size_t tk = (size_t)sq * NCH + chunk_of(dir, k);
                const u32x2 u = *(const u32x2*)(UT + tk * 4096 + e4 * 4); const f32x4 dd = *(const f32x4*)(DT + tk * 64 + d0);
                u32x2 o; o.x = pk2(S[0], S[1]); o.y = pk2(S[2], S[3]); *(u32x2*)(SP + tk * 4096 + e4 * 4) = o;
                S = S * dd + (f32x4){bflo(u.x), bfhi(u.x), bflo(u.y), bfhi(u.y)}; }
        } else { if (!do_ml) continue;
            const bf16* UT = (const bf16*)(a.ws + WS_UTM); bf16* SP = (bf16*)(a.ws + WS_SPM); const float* NU = (const float*)(a.ws + WS_NU);
            float* NP = (float*)(a.ws + WS_NP); const float* GL = (const float*)(a.ws + WS_GL); float* MP = (float*)(a.ws + WS_MP);
            f32x4 S = {0.f, 0.f, 0.f, 0.f}, n = {0.f, 0.f, 0.f, 0.f}; float m = 0.f;
#pragma unroll 4
            for (int k = 0; k < NCH; ++k) { const size_t tk = (size_t)sq * NCH + chunk_of(dir, k);
                const u32x2 u = *(const u32x2*)(UT + tk * 4096 + e4 * 4); const f32x4 nu = *(const f32x4*)(NU + tk * 64 + d0); const f32x2 gl = *(const f32x2*)(GL + tk * 2);
                u32x2 o; o.x = pk2(S[0], S[1]); o.y = pk2(S[2], S[3]); *(u32x2*)(SP + tk * 4096 + e4 * 4) = o;
                if (e4 < 16) { *(f32x4*)(NP + tk * 64 + d0) = n; if (e4 == 0) MP[tk] = m; }
                const float mn = fmaxf(gl[0] + m, gl[1]), aa = __expf(gl[0] + m - mn), bb = __expf(gl[1] - mn); m = mn;
                S = S * aa + (f32x4){bflo(u.x), bfhi(u.x), bflo(u.y), bfhi(u.y)} * bb; n = n * aa + nu * bb; }
        }
    }
}

__device__ __forceinline__ void hgC(const Args& a, int layer, int b, int c, int h, int dir, LAS char* X, LAS char* Y, int lane) {
    const int r32 = lane & 31, hh = lane >> 5;
    const bf16* Pr = (const bf16*)(a.ws + WS_P) + (size_t)(b * SB + 64 * c) * PC;
    const int tk = ((b * 4 + h) * 2 + dir) * NCH + c;
    u32x4 qr_[8], zr_[8], vr[8], sp[8];
    load_tile8(qr_, Pr + C_HGQ + h * 64, PC, lane); load_tile8(zr_, Pr + (dir ? C_HGZB : C_HGZF) + h * 64, PC, lane);
    load_tile8(vr, Pr + C_HGV + h * 64, PC, lane); load_tile8(sp, (const bf16*)(a.ws + WS_SPH) + (size_t)tk * 4096, 64, lane);
    put_tile8(X, qr_, lane); put_tile8(Y, zr_, lane);
    const float lb = hg_lb(a, layer, dir, h, lane), omlb = 1.f - lb;
    float Gp = 1.f;
#pragma unroll 4
    for (int i = 32; i < 64; ++i) { const int t = dir ? 63 - i : i; const float f = lb + omlb * sigm(get1(Y, t, lane)); Gp *= f;
        const float q = get1(X, t, lane) * Gp, k = (1.f - f) * __builtin_amdgcn_rcpf(Gp); put1(X, t, lane, q); put1(Y, t, lane, k); }
    float Hp = 1.f;
#pragma unroll 4
    for (int i = 31; i >= 0; --i) { const int t = dir ? 63 - i : i; const float f = lb + omlb * sigm(get1(Y, t, lane));
        const float q = get1(X, t, lane) * __builtin_amdgcn_rcpf(Hp), k = (1.f - f) * Hp; Hp *= f; put1(X, t, lane, q); put1(Y, t, lane, k); }
    f32x16 sc[2][2] = {};
    mm64(sc, Y, X, r32, hh, dir ? 0 : 1, dir ? 1 : 0);
    bf16x8 pa[2][4];
#pragma unroll
    for (int ti = 0; ti < 2; ++ti)
#pragma unroll
        for (int si = 0; si < 2; ++si) { const bool dead = dir ? (si == 0 && ti == 1) : (si == 1 && ti == 0);
            if (dead) { pa[ti][2 * si] = (bf16x8){0, 0, 0, 0, 0, 0, 0, 0}; pa[ti][2 * si + 1] = (bf16x8){0, 0, 0, 0, 0, 0, 0, 0}; }
            else { f32x16 p = sc[si][ti];
                if (si == ti) {
#pragma unroll
                    for (int rg = 0; rg < 16; ++rg) { const int s = crow(rg, hh); const bool ok = dir ? (s >= r32) : (s <= r32); p[rg] = ok ? p[rg] : 0.f; } }
                SC_PK4(p, 0, pa[ti][2 * si]); SC_PK4(p, 8, pa[ti][2 * si + 1]); } }
    { const float eb = Hp;
#pragma unroll 8
      for (int t = 0; t < 64; ++t) put1(Y, t, lane, get1(X, t, lane) * eb); }
    put_tile8_t(X, vr, lane);
    f32x16 o[2][2] = {};
#pragma unroll
    for (int ss = 0; ss < 4; ++ss) { bf16x8 vf[2];
#pragma unroll
        for (int vi = 0; vi < 2; ++vi) vf[vi] = frag(X, 32 * vi + r32, 2 * ss + hh);
#pragma unroll
        for (int ti = 0; ti < 2; ++ti)
#pragma unroll
            for (int vi = 0; vi < 2; ++vi) o[ti][vi] = __builtin_amdgcn_mfma_f32_32x32x16_bf16(pa[ti][ss], vf[vi], o[ti][vi], 0, 0, 0); }
    put_tile8(X, sp, lane);
    mm64(o, Y, X, r32, hh, -1, -1);
    LAS float* O = (LAS float*)X;
#pragma unroll
    for (int ti = 0; ti < 2; ++ti)
#pragma unroll
        for (int vi = 0; vi < 2; ++vi)
#pragma unroll
            for (int rg = 0; rg < 16; ++rg) O[(32 * ti + crow(rg, hh)) * 64 + 32 * vi + r32] = o[ti][vi][rg];
}
__device__ __forceinline__ void mlC(const Args& a, int layer, int b, int c, int h, int dir, LAS char* X, LAS char* Y, LAS float* T, int lane) {
    const int r32 = lane & 31, hh = lane >> 5;
    const bf16* Pr = (const bf16*)(a.ws + WS_P) + (size_t)(b * SB + 64 * c) * PC;
    const int tk = ((b * 4 + h) * 2 + dir) * NCH + c;
    LAS float* TMU = T; LAS float* TCS = T + 64; LAS float* TEM = T + 128; LAS float* TAP = T + 192;
    { const float ip = bf2f(Pr[(size_t)lane * PC + C_MLG + dir * 4 + h]) + a.in[12][layer * 16 + dir * 4 + h];
      const float lf = logsig(bf2f(Pr[(size_t)lane * PC + C_MLG + 8 + dir * 4 + h]) + a.in[12][layer * 16 + 8 + dir * 4 + h]);
      const float bt = scan_add(lf, lane, dir), cs = ip - bt, mp = ((const float*)(a.ws + WS_MP))[tk];
      const float mu = fmaxf(mp, scan_max(cs, lane, dir));
      TMU[lane] = mu; TCS[lane] = cs; TEM[lane] = __expf(-bt - mu); TAP[lane] = __expf(mp - mu); }
    u32x4 qr_[8], kr_[8], vr[8], sp[8];
    load_tile8(qr_, Pr + C_MLQ + h * 64, PC, lane); load_tile8(kr_, Pr + C_MLK + h * 64, PC, lane);
    load_tile8(vr, Pr + C_MLV + h * 64, PC, lane); load_tile8(sp, (const bf16*)(a.ws + WS_SPM) + (size_t)tk * 4096, 64, lane);
    put_tile8(X, qr_, lane); put_tile8(Y, kr_, lane);
    f32x16 sc[2][2] = {};
    mm64(sc, Y, X, r32, hh, dir ? 0 : 1, dir ? 1 : 0);
    bf16x8 pa[2][4];
#pragma unroll
    for (int ti = 0; ti < 2; ++ti) { const float mu = TMU[32 * ti + r32];
#pragma unroll
        for (int si = 0; si < 2; ++si) { const bool dead = dir ? (si == 0 && ti == 1) : (si == 1 && ti == 0);
            if (dead) { pa[ti][2 * si] = (bf16x8){0, 0, 0, 0, 0, 0, 0, 0}; pa[ti][2 * si + 1] = (bf16x8){0, 0, 0, 0, 0, 0, 0, 0}; }
            else { f32x16 p = sc[si][ti];
#pragma unroll
                for (int g4 = 0; g4 < 4; ++g4) { const f32x4 cs = *(const LAS f32x4*)(TCS + 32 * si + 8 * g4 + 4 * hh);
#pragma unroll
                    for (int i = 0; i < 4; ++i) { const int rg = 4 * g4 + i, s = crow(rg, hh); const bool ok = (si != ti) || (dir ? (s >= r32) : (s <= r32));
                        const float w = p[rg] * 0.125f * __expf(cs[i] - mu); p[rg] = ok ? w : 0.f; } }
                SC_PK4(p, 0, pa[ti][2 * si]); SC_PK4(p, 8, pa[ti][2 * si + 1]); } } }
#pragma unroll
    for (int j = 0; j < 8; ++j) { const int u = lane + 64 * j, row = u >> 3, unit = u & 7; const float ap = TAP[row];
        const u32x4 qv = *(const LAS u32x4*)(X + swz(row, unit)); u32x4 o;
        o.x = pk2(bflo(qv.x) * ap, bfhi(qv.x) * ap); o.y = pk2(bflo(qv.y) * ap, bfhi(qv.y) * ap); o.z = pk2(bflo(qv.z) * ap, bfhi(qv.z) * ap); o.w = pk2(bflo(qv.w) * ap, bfhi(qv.w) * ap);
        *(LAS u32x4*)(Y + swz(row, unit)) = o; }
    put_tile8_t(X, vr, lane);
    f32x16 o[2][2] = {}; f32x16 dn[2] = {};
    const bf16x8 ones = {0x3f80, 0x3f80, 0x3f80, 0x3f80, 0x3f80, 0x3f80, 0x3f80, 0x3f80};
#pragma unroll
    for (int ss = 0; ss < 4; ++ss) { bf16x8 vf[2];
#pragma unroll
        for (int vi = 0; vi < 2; ++vi) vf[vi] = frag(X, 32 * vi + r32, 2 * ss + hh);
#pragma unroll
        for (int ti = 0; ti < 2; ++ti) { dn[ti] = __builtin_amdgcn_mfma_f32_32x32x16_bf16(pa[ti][ss], ones, dn[ti], 0, 0, 0);
#pragma unroll
            for (int vi = 0; vi < 2; ++vi) o[ti][vi] = __builtin_amdgcn_mfma_f32_32x32x16_bf16(pa[ti][ss], vf[vi], o[ti][vi], 0, 0, 0); } }
    put_tile8(X, sp, lane);
    mm64(o, Y, X, r32, hh, -1, -1);
    { const float* NPg = (const float*)(a.ws + WS_NP) + (size_t)tk * 64;
#pragma unroll
      for (int st = 0; st < 4; ++st) { const f32x4 n0 = *(const f32x4*)(NPg + 16 * st + 8 * hh), n1 = *(const f32x4*)(NPg + 16 * st + 8 * hh + 4);
          u32x4 w; w.x = pk2(n0[0], n0[1]); w.y = pk2(n0[2], n0[3]); w.z = pk2(n1[0], n1[1]); w.w = pk2(n1[2], n1[3]); const bf16x8 nf = __builtin_bit_cast(bf16x8, w);
#pragma unroll
          for (int ti = 0; ti < 2; ++ti) dn[ti] = __builtin_amdgcn_mfma_f32_32x32x16_bf16(frag(Y, 32 * ti + r32, 2 * st + hh), nf, dn[ti], 0, 0, 0); } }
    float em[2][16];
#pragma unroll
    for (int ti = 0; ti < 2; ++ti)
#pragma unroll
        for (int g4 = 0; g4 < 4; ++g4) { const f32x4 e = *(const LAS f32x4*)(TEM + 32 * ti + 8 * g4 + 4 * hh);
#pragma unroll
            for (int i = 0; i < 4; ++i) em[ti][4 * g4 + i] = e[i]; }
    LAS float* O = (LAS float*)X;
#pragma unroll
    for (int ti = 0; ti < 2; ++ti)
#pragma unroll
        for (int rg = 0; rg < 16; ++rg) { const float rd = __builtin_amdgcn_rcpf(fmaxf(fabsf(dn[ti][rg]), em[ti][rg]));
#pragma unroll
            for (int vi = 0; vi < 2; ++vi) O[(32 * ti + crow(rg, hh)) * 64 + 32 * vi + r32] = o[ti][vi][rg] * rd; }
}
__device__ __forceinline__ void p_scanC(const Args& a, int layer, LAS unsigned char* lds, int do_hg, int do_ml) {
    const int tid = otid(), lane = tid & 63, wave = __builtin_amdgcn_readfirstlane(tid >> 6), G = ogrid(), h = wave >> 1, dir = wave & 1;
    LAS char* X = (LAS char*)lds + wave * 16384; LAS char* Y = X + 8192; LAS float* T = (LAS float*)(lds + 131072 + wave * 1024);
    const bf16* P = (const bf16*)(a.ws + WS_P); bf16* Yo = (bf16*)(a.ws + WS_Y);
    const bool lastl = layer == DEPTH - 1;
    for (int u = obid(); u < 2 * NB * NCH; u += G) { const int mixer = u / (NB * NCH), q = u % (NB * NCH), b = q / NCH, c = q % NCH;
        if (lastl && c < 4) continue;
        if (mixer == 0 ? !do_hg : !do_ml) continue;
        int ln = lane; asm volatile("" : "+v"(ln));
        if (mixer == 0) hgC(a, layer, b, c, h, dir, X, Y, ln); else mlC(a, layer, b, c, h, dir, X, Y, T, ln);
        __syncthreads();
        asm volatile("" : "+v"(ln));
        { const LAS float* Of = (const LAS float*)((LAS char*)lds + (2 * h) * 16384); const LAS float* Ob = (const LAS float*)((LAS char*)lds + (2 * h + 1) * 16384);
          const float gn = mixer == 0 ? a.in[11][layer * 64 + ln] : a.in[13][layer * 64 + ln];
          const int gcol = (mixer == 0 ? C_HGG : C_MLOG) + h * 64 + ln;
#pragma unroll 8
          for (int i = 0; i < 32; ++i) { const int t = 32 * dir + i; const size_t r = (size_t)(b * SB + 64 * c + t);
              const float ov = Of[t * 64 + ln] + Ob[t * 64 + ln]; const float y = ov * __builtin_amdgcn_rsqf(wave_sum(ov * ov) * (1.f / 64.f) + EPS) * gn;
              const float gt = bf2f(P[r * PC + gcol]); const float outv = mixer == 0 ? y * gt * sigm(gt) : y * sigm(gt);
              if (OUTPROJ_FP8) ((unsigned char*)Yo)[r * DM + mixer * 256 + h * 64 + ln] = (unsigned char)fp8_1(16.f * outv); else Yo[r * DM + mixer * 256 + h * 64 + ln] = (bf16)f2bf(outv); } }
        __syncthreads();
    }
}
#undef SC_PK4
}

__device__ __forceinline__ void p_attn(const Args& a, int layer, LAS char* ldsg) {
    asm volatile("" ::: "memory");
    const bf16* P = (const bf16*)(a.ws + WS_P); bf16* Y = (bf16*)(a.ws + WS_Y); const int G = ogrid();
    const int bid = obid(), lane = otid() & 63;
    const float* qg = a.in[14] + layer * 128; const float* kg = a.in[15] + layer * 128;
    const float mq = wave_max_nn(fmaxf(fabsf(qg[lane]), fabsf(qg[lane + 64]))), mk = wave_max_nn(fmaxf(fabsf(kg[lane]), fabsf(kg[lane + 64])));
    const float bound = 128.f * mq * mk * (att::SCALE * 1.4426950408889634f) * 1.02f;
    const bool fix = bound <= 60.f;
    const int cu = (layer != DEPTH - 1) ? (G >= 96 ? bid - 64 : bid) : -1; const bool hasc = cu >= 0 && cu < 32;
    const float* ropet = (const float*)(a.ws + WS_ROPE);
#define AT_LAT(u) const int b = (u) & 7, idx = ((u) >> 3) & 31, kvh = (u) >> 8, h = kvh * 2 + (idx >> 4), qb = idx & 15; const size_t r0 = (size_t)b * SB + CTX + (size_t)qb * 256; \
        const bf16* Qp = P + r0 * PC + C_ATQ + h * 128; const bf16* Kp = P + (size_t)b * SB * PC + C_ATK + kvh * 128; const bf16* Vp = P + (size_t)b * SB * PC + C_ATV + kvh * 128; \
        bf16* Op = (bf16*)((unsigned char*)Y + (r0 * DM + 512 + h * 128) * (OUTPROJ_FP8 ? 1 : 2));
#define AT_CTX() const int b = cu & 7, h = cu >> 3, kvh = h >> 1; const size_t r0 = (size_t)b * SB; \
        const bf16* Qp = P + r0 * PC + C_ATQ + h * 128; const bf16* Kp = P + r0 * PC + C_ATK + kvh * 128; const bf16* Vp = P + r0 * PC + C_ATV + kvh * 128; \
        bf16* Op = (bf16*)((unsigned char*)Y + (r0 * DM + 512 + h * 128) * (OUTPROJ_FP8 ? 1 : 2));
    const int ex = fix ? 0 : 1;
    for (int u = bid; u < 512; u += G) { AT_LAT(u) att::attn_dense_body(Qp, Kp, Vp, Op, SB, ldsg, qg, ropet, qb * 256, -bound, ex); __syncthreads(); }
    if (hasc) { AT_CTX() att::attn_dense_body(Qp, Kp, Vp, Op, CTX, ldsg, qg, ropet, -1, -bound, ex); __syncthreads(); }
#undef AT_LAT
#undef AT_CTX
}

__device__ __forceinline__ void p_finish(const Args& a, int layer, int do_hg, int do_ml) {
    const int tid = otid(), lane = tid & 63, wave = tid >> 6; const int gw = obid() * NWAVE + wave, NGW = ogrid() * NWAVE;
    const bf16* P = (const bf16*)(a.ws + WS_P); bf16* Y = (bf16*)(a.ws + WS_Y);
    const float* OH = (const float*)(a.ws + WS_OH); const float* OM = (const float*)(a.ws + WS_OM);
    const float gh = a.in[11][layer * 64 + lane], gm = a.in[13][layer * 64 + lane];
    for (int r = gw; r < NR; r += NGW) { if (layer == DEPTH - 1 && (r % SB) < CTX) continue;
#pragma unroll
        for (int h = 0; h < 4; ++h) {
            if (do_hg) { const float o = OH[(size_t)r * 256 + h * 64 + lane] + OH[(size_t)(NR + r) * 256 + h * 64 + lane];
              const float y = o * (1.f / sqrtf(wave_sum(o * o) * (1.f / 64.f) + EPS)) * gh; const float g = bf2f(P[(size_t)r * PC + C_HGG + h * 64 + lane]);
              Y[(size_t)r * DM + h * 64 + lane] = (bf16)f2bf(y * g * sigm(g)); }
            if (do_ml) { const float o = OM[(size_t)r * 256 + h * 64 + lane] + OM[(size_t)(NR + r) * 256 + h * 64 + lane];
              const float y = o * (1.f / sqrtf(wave_sum(o * o) * (1.f / 64.f) + EPS)) * gm; const float g = bf2f(P[(size_t)r * PC + C_MLOG + h * 64 + lane]);
              Y[(size_t)r * DM + 256 + h * 64 + lane] = (bf16)f2bf(y * sigm(g)); }
        }
    }
}

__device__ __forceinline__ void p_router(const Args& a, int layer, LAS unsigned char* lds) {
    const int tid = otid(), lane = tid & 63, wave = tid >> 6, G = ogrid(), bid = obid();
    constexpr int TP = 2064;
    LAS unsigned char* TH = lds; LAS unsigned char* TL = lds + 32 * TP;
    LAS float* PART = (LAS float*)lds;
    LAS float* LOG = (LAS float*)(lds + 64 * TP);
    LAS int* LCNT = (LAS int*)(lds + 64 * TP + 32 * 33 * 4);
    bf16* H = (bf16*)(a.ws + WS_H);
    int* RE = (int*)(a.ws + WS_RE); int* RS = (int*)(a.ws + WS_RS); float* RG = (float*)(a.ws + WS_RG);
    const bool lastl = layer == DEPTH - 1;
    const int e_l = lane & 31, hh = lane >> 5;
    bf16x8 bh[8], bl[8];
#pragma unroll
    for (int ks = 0; ks < 8; ++ks) { const size_t o = ((size_t)(layer * 32 + e_l)) * 1024 + wave * 128 + ks * 16 + hh * 8;
        bh[ks] = *(const bf16x8*)((const bf16*)(a.ws + WS_WRH) + o); bl[ks] = *(const bf16x8*)((const bf16*)(a.ws + WS_WRL) + o); }
    if (tid < 32) LCNT[tid] = 0;
    __syncthreads();
    for (int tile = bid; tile < NR / 32; tile += G) {
        const int r0 = tile * 32; if (lastl && (r0 % SB) < CTX) continue;
#pragma unroll
        for (int q = 0; q < 4; ++q) { const int row = wave * 4 + q, r = r0 + row; f32x4 v[2][2]; load_row_bf((const bf16*)(a.ws + WS_XB) + (size_t)r * DM, v, lane);
            norm_mod_store(v, a.in[7] + (size_t)layer * DM, modv(a, layer, r, 4), modv(a, layer, r, 3), MOE_FP8 ? (bf16*)nullptr : H + (size_t)r * DM, lane);
            if (MOE_FP8) {
#pragma unroll
                for (int j = 0; j < 2; ++j) { u32x2 w8; w8.x = pk_fp8x4(8.f * v[j][0][0], 8.f * v[j][0][1], 8.f * v[j][0][2], 8.f * v[j][0][3]); w8.y = pk_fp8x4(8.f * v[j][1][0], 8.f * v[j][1][1], 8.f * v[j][1][2], 8.f * v[j][1][3]);
                    *(u32x2*)((unsigned char*)(a.ws + WS_H8) + (size_t)r * DM + 8 * lane + 512 * j) = w8; } }
#pragma unroll
            for (int j = 0; j < 2; ++j) { unsigned hi[4], lo[4];
#pragma unroll
                for (int p = 0; p < 4; ++p) { const float x0 = v[j][p >> 1][(p & 1) * 2], x1 = v[j][p >> 1][(p & 1) * 2 + 1]; const unsigned w = pk2(x0, x1); hi[p] = w; lo[p] = pk2(x0 - bflo(w), x1 - bfhi(w)); }
                *(LAS u32x4*)(TH + row * TP + (8 * lane + 512 * j) * 2) = (u32x4){hi[0], hi[1], hi[2], hi[3]};
                *(LAS u32x4*)(TL + row * TP + (8 * lane + 512 * j) * 2) = (u32x4){lo[0], lo[1], lo[2], lo[3]}; } }
        __syncthreads();
        f32x16 acc = {};
#pragma unroll
        for (int ks = 0; ks < 8; ++ks) { const int off = e_l * TP + (wave * 128 + ks * 16 + hh * 8) * 2;
            const bf16x8 ah = *(const LAS bf16x8*)(TH + off), al = *(const LAS bf16x8*)(TL + off);
            acc = __builtin_amdgcn_mfma_f32_32x32x16_bf16(ah, bh[ks], acc, 0, 0, 0);
            acc = __builtin_amdgcn_mfma_f32_32x32x16_bf16(ah, bl[ks], acc, 0, 0, 0);
            acc = __builtin_amdgcn_mfma_f32_32x32x16_bf16(al, bh[ks], acc, 0, 0, 0); }
        __syncthreads();
#pragma unroll
        for (int rg = 0; rg < 16; ++rg) { const int row = (rg & 3) + 8 * (rg >> 2) + 4 * hh; PART[(wave * 32 + row) * 32 + e_l] = acc[rg]; }
        __syncthreads();
#pragma unroll
        for (int q = 0; q < 2; ++q) { const int idx = tid + 512 * q, row = idx >> 5, e = idx & 31; float s = a.in[17][layer * 32 + e];
#pragma unroll
            for (int w = 0; w < 8; ++w) s += PART[(w * 32 + row) * 32 + e];
            LOG[row * 33 + e] = s; }
        __syncthreads();
        if (tid < 32) { const int r = r0 + tid; float tv[4]; int te[4];
#pragma unroll
            for (int k = 0; k < 4; ++k) { float best = -INFINITY; int bi = 0;
                for (int e = 0; e < 32; ++e) { const float v = LOG[tid * 33 + e]; if (v > best) { best = v; bi = e; } }
                tv[k] = best; te[k] = bi; LOG[tid * 33 + bi] = -INFINITY; }
            float p[4], ps = 0.f;
#pragma unroll
            for (int k = 0; k < 4; ++k) { p[k] = expf(tv[k] - tv[0]); ps += p[k]; }
#pragma unroll
            for (int k = 0; k < 4; ++k) { RE[r * 4 + k] = te[k]; RS[r * 4 + k] = atomicAdd((int*)&LCNT[te[k]], 1); RG[r * 4 + k] = p[k] / ps; } }
        __syncthreads();
    }
    if (tid < 32) ((int*)(a.ws + WS_CNT))[bid * 32 + tid] = LCNT[tid];
}

__device__ __forceinline__ void p_dispatch(const Args& a, int layer, LAS unsigned char* lds) {
    const int tid = otid(), G = ogrid(), bid = obid();
    LAS int* tot = (LAS int*)lds; LAS int* base = tot + 32; LAS int* pst = base + 32;
    const int* CNT = (const int*)(a.ws + WS_CNT);
    const int* RE = (const int*)(a.ws + WS_RE); const int* RS = (const int*)(a.ws + WS_RS); const float* RG = (const float*)(a.ws + WS_RG);
    int* POS = (int*)(a.ws + WS_POS); int* TOK = (int*)(a.ws + WS_TOK); float* GATEP = (float*)(a.ws + WS_GATEP); int* TILEE = (int*)(a.ws + WS_TILEE);
    const bool lastl = layer == DEPTH - 1;
    { LAS int* ptot = pst + 64; LAS int* pbase = ptot + 512;
      const int e = tid & 31, part = tid >> 5; int t = 0, bs = 0;
      for (int blk = part; blk < G; blk += 16) { const int c = CNT[blk * 32 + e]; if (blk < bid) bs += c; t += c; }
      ptot[tid] = t; pbase[tid] = bs;
      __syncthreads();
      if (tid < 32) { int tt = 0, bb = 0;
#pragma unroll
          for (int p = 0; p < 16; ++p) { tt += ptot[p * 32 + tid]; bb += pbase[p * 32 + tid]; }
          tot[tid] = tt; base[tid] = bb; } }
    __syncthreads();
    if (tid == 0) { int p = 0; for (int e = 0; e < 32; ++e) { pst[e] = p; p += (tot[e] + 255) & ~255; } pst[32] = p; }
    __syncthreads();
    for (int tile = bid; tile < NR / 32; tile += G) { const int r0 = tile * 32; if (lastl && (r0 % SB) < CTX) continue;
        if (tid < 128) { const int i = r0 * 4 + tid; const int e = RE[i]; const int pos = pst[e] + base[e] + RS[i]; TOK[pos] = r0 + (tid >> 2); GATEP[pos] = RG[i]; POS[i] = pos; } }
    for (int e = bid; e < 32; e += G) {
        for (int p = pst[e] + tot[e] + tid; p < pst[e + 1]; p += NTHR) { TOK[p] = 0; GATEP[p] = 0.f; }
        for (int rt = pst[e] / 256 + tid; rt < pst[e + 1] / 256; rt += NTHR) TILEE[rt] = e; }
    if (bid == 0 && tid == 0) *(int*)(a.ws + WS_NRT) = pst[32] / 256;
}

__device__ __forceinline__ void p_combine(const Args& a, int layer, bool dry = false) {
    const int tid = otid(), lane = tid & 63, wave = tid >> 6; const int gw = obid() * NWAVE + wave, NGW = ogrid() * NWAVE;
    const bf16* YM = (const bf16*)(a.ws + WS_YM); const int* POS = (const int*)(a.ws + WS_POS); bf16* H = (bf16*)(a.ws + WS_H);
    const bool lastl = layer == DEPTH - 1;
    for (int r = gw; r < NR; r += NGW) { if (lastl && (r % SB) < CTX) continue;
        const float* g2 = modv(a, layer, r, 5); bf16* xb = (bf16*)(a.ws + WS_XB) + (size_t)r * DM;
        float* xo = dry ? (float*)(a.ws + WS_ACT) + (size_t)r * DM : a.out + ((size_t)(r / SB) * SEQ + (r % SB) - CTX) * DM;
        bf16* xbo = dry ? (bf16*)(a.ws + WS_ACT) + (size_t)r * DM : xb; bf16* hw = dry ? (bf16*)(a.ws + WS_ACT + 160 * MiB) + (size_t)r * DM : H + (size_t)r * DM;
        int pos[4];
#pragma unroll
        for (int k = 0; k < 4; ++k) pos[k] = POS[r * 4 + k];
        f32x4 v[2][2]; load_row_bf(xb, v, lane);
#pragma unroll
        for (int j = 0; j < 2; ++j) { const int c = 8 * lane + 512 * j; float f[8];
#pragma unroll
            for (int i = 0; i < 8; ++i) f[i] = 0.f;
#pragma unroll
            for (int k = 0; k < 4; ++k) { const u32x4 y = *(const u32x4*)(YM + (size_t)pos[k] * DM + c);
                f[0] += bflo(y.x); f[1] += bfhi(y.x); f[2] += bflo(y.y); f[3] += bfhi(y.y); f[4] += bflo(y.z); f[5] += bfhi(y.z); f[6] += bflo(y.w); f[7] += bfhi(y.w); }
#pragma unroll
            for (int q = 0; q < 2; ++q) { const f32x4 g = *(const f32x4*)(g2 + c + 4 * q);
                v[j][q] = v[j][q] + g * (f32x4){f[4 * q], f[4 * q + 1], f[4 * q + 2], f[4 * q + 3]};
                if (lastl) *(f32x4*)(xo + c + 4 * q) = v[j][q]; }
            if (!lastl) { u32x4 w; w.x = pk2(v[j][0][0], v[j][0][1]); w.y = pk2(v[j][0][2], v[j][0][3]); w.z = pk2(v[j][1][0], v[j][1][1]); w.w = pk2(v[j][1][2], v[j][1][3]); *(u32x4*)(xbo + c) = w; } }
        if (!lastl) { norm_mod_store(v, a.in[6] + (size_t)(layer + 1) * DM, modv(a, layer + 1, r, 1), modv(a, layer + 1, r, 0), INPROJ_I8 ? (bf16*)nullptr : hw, lane);
            if (INPROJ_I8) store_row_i8(v, dry ? (unsigned char*)(a.ws + WS_ACT + 160 * MiB) + (size_t)r * DM : (unsigned char*)(a.ws + WS_H) + (size_t)r * DM, dry ? (float*)(a.ws + WS_ACT + 240 * MiB) + r : (float*)(a.ws + WS_HSC) + r, lane); }
    }
}

template <int PH>
__device__ __forceinline__ void run_phase(int layer, unsigned char* ldsg) {
    const Args a = fetch_args();
    LAS unsigned char* lds = (LAS unsigned char*)ldsg;
    const int G = ogrid(), bid = obid();
    if constexpr (PH == PH_PRO) p_prologue(a, lds);
    if constexpr (PH == PH_NORM1) { if (INPROJ_I8) p_quant_win(a); p_norm1(a, layer); }
    if constexpr (PH == PH_INPROJ) {
        if constexpr (INPROJ_I8) { pg8::SchedDense S; S.init(NR, PC, G, bid, nullptr); S.Bt = (const char*)(a.ws + WS_WIN) + (size_t)layer * PC * 1024; S.rb = 1024;
            pg8::EpiI8 E{(bf16*)(a.ws + WS_P), PC, (const float*)(a.ws + WS_HSC), (const float*)(a.ws + WS_WSC) + (size_t)layer * PC}; pg8::gemm_phase<2>(lds, (const void*)(a.ws + WS_H), S, E); }
        else { pg8::SchedDense S; S.init(NR, PC, G, bid, (const bf16*)(a.ws + WS_WIN) + (size_t)layer * PC * 1024);
            pg8::EpiBf16 E{(bf16*)(a.ws + WS_P), PC}; pg8::gemm_phase<0>(lds, (const bf16*)(a.ws + WS_H), S, E); } }
    if constexpr (PH == PH_PREP) { if (PROBE_DOUBLE == 96) p_prep(a, layer, true); p_prep(a, layer); if (NEW_HG || NEW_ML) scan::p_scanA(a, layer, lds, NEW_HG, NEW_ML); if (PROBE_DOUBLE == 20) scan::p_scanA(a, layer, lds, NEW_HG, NEW_ML); }
    if constexpr (PH == PH_SCAN) { if (!NEW_HG || !NEW_ML) p_scan(a, layer, lds, !NEW_HG, !NEW_ML); if (NEW_HG || NEW_ML) scan::p_scanB(a, NEW_HG, NEW_ML); if (PROBE_DOUBLE == 21) scan::p_scanB(a, NEW_HG, NEW_ML); }
    if constexpr (PH == PH_ATTN) { if (NEW_HG || NEW_ML) scan::p_scanC(a, layer, lds, NEW_HG, NEW_ML); if (PROBE_DOUBLE == 22) scan::p_scanC(a, layer, lds, NEW_HG, NEW_ML); p_attn(a, layer, (LAS char*)lds); }
    if constexpr (PH == PH_FINISH) { if (!NEW_HG || !NEW_ML) p_finish(a, layer, !NEW_HG, !NEW_ML); }
    if constexpr (PH == PH_OUTPROJ) { pg8::SchedDense S; S.init(NR, DM, G, bid, nullptr); S.rb = OUTPROJ_FP8 ? 1024 : 2048; S.Bt = (const char*)(a.ws + WS_WOUT) + (size_t)layer * 1024 * S.rb;
        pg8::EpiResid E{a.in[0], a.in[2], (bf16*)(a.ws + WS_XB), (const float*)(a.ws + WS_MOD) + (size_t)layer * 9 * 6144, 2, layer == DEPTH - 1, layer == 0, OUTPROJ_FP8 ? 1.f / 1024.f : 1.f};
        pg8::gemm_phase<OUTPROJ_FP8 ? 1 : 0>(lds, (const void*)(a.ws + WS_Y), S, E); }
    if constexpr (PH == PH_ROUTER) p_router(a, layer, lds);
    if constexpr (PH == PH_DISPATCH) p_dispatch(a, layer, lds);
    if constexpr (PH == PH_GU) { constexpr int RBW = MOE_FP8 ? 1024 : 2048;
        pg8::SchedMoe S{G, bid, 8, 2048, __builtin_amdgcn_readfirstlane(__hip_atomic_load((const int*)(a.ws + WS_NRT), __ATOMIC_RELAXED, __HIP_MEMORY_SCOPE_AGENT)), (const int*)(a.ws + WS_TILEE),
                        (const char*)(a.ws + WS_WGU) + (size_t)layer * 32 * 2048 * RBW, (const int*)(a.ws + WS_TOK), RBW};
        pg8::EpiGU E{(void*)(a.ws + WS_ACT), a.in[19] + (size_t)layer * 32 * 2048};
        pg8::gemm_phase<MOE_FP8>(lds, MOE_FP8 ? (const void*)(a.ws + WS_H8) : (const void*)(a.ws + WS_H), S, E); }
    if constexpr (PH == PH_DOWN) { constexpr int RBW = MOE_FP8 ? 1024 : 2048;
        pg8::SchedMoe S{G, bid, 4, 1024, __builtin_amdgcn_readfirstlane(__hip_atomic_load((const int*)(a.ws + WS_NRT), __ATOMIC_RELAXED, __HIP_MEMORY_SCOPE_AGENT)), (const int*)(a.ws + WS_TILEE),
                        (const char*)(a.ws + WS_WDN) + (size_t)layer * 32 * 1024 * RBW, nullptr, RBW};
        pg8::EpiDown E{(bf16*)(a.ws + WS_YM), a.in[21] + (size_t)layer * 32 * 1024, (const float*)(a.ws + WS_GATEP)}; pg8::gemm_phase<MOE_FP8>(lds, (const void*)(a.ws + WS_ACT), S, E); }
    if constexpr (PH == PH_COMBINE) { if (PROBE_DOUBLE == 97) p_combine(a, layer, true); p_combine(a, layer); }
}

template <int PH>
__global__ void __launch_bounds__(NTHR, 2) k_phase(Args a, int layer) {
    extern __shared__ __attribute__((aligned(16))) unsigned char lds[];
    kernel_setup(a);
    run_phase<PH>(layer, lds);
}


__global__ void __launch_bounds__(NTHR, 2) k_mega(Args a) {
    extern __shared__ __attribute__((aligned(16))) unsigned char lds[];
    kernel_setup(a);
    const XcdBarrier bar = xcd_barrier_post((unsigned*)(a.ws + WS_CTL) + CW_BAR, (volatile LAS unsigned*)(MISC_OFF + 32));
#define GRID_BAR() do { for (int rep_ = 0; rep_ < (PROBE_DOUBLE == 99 ? 2 : 1); ++rep_) { const Args b_ = fetch_args(); XcdBarrier bb; bb.bar = (unsigned*)(b_.ws + WS_CTL) + CW_BAR; bb.x = xb_xcc_id(); bb.st = (volatile LAS unsigned*)(MISC_OFF + 32); xcd_barrier(bb); } } while (0)
    run_phase<PH_PRO>(0, lds); GRID_BAR();
    if (PROBE_DOUBLE == PH_PRO) { run_phase<PH_PRO>(0, lds); GRID_BAR(); }
    run_phase<PH_NORM1>(0, lds); GRID_BAR();
#define RUNP(PH, l) do { run_phase<PH>(l, lds); if (PROBE_DOUBLE == PH) { GRID_BAR(); run_phase<PH>(l, lds); } } while (0)
#define LAYER_BODY(l) do { \
        RUNP(PH_INPROJ, l); GRID_BAR(); \
        run_phase<PH_PREP>(l, lds); GRID_BAR(); \
        RUNP(PH_SCAN, l); GRID_BAR(); \
        RUNP(PH_ATTN, l); GRID_BAR(); \
        if (!NEW_HG || !NEW_ML) { RUNP(PH_FINISH, l); GRID_BAR(); } \
        run_phase<PH_OUTPROJ>(l, lds); GRID_BAR(); \
        if (PROBE_DOUBLE == 98 && (l) == 0) { run_phase<PH_OUTPROJ>(l, lds); GRID_BAR(); } \
        RUNP(PH_ROUTER, l); GRID_BAR(); \
        RUNP(PH_DISPATCH, l); GRID_BAR(); \
        RUNP(PH_GU, l); GRID_BAR(); \
        RUNP(PH_DOWN, l); GRID_BAR(); \
        run_phase<PH_COMBINE>(l, lds); \
        if ((l) + 1 < DEPTH) GRID_BAR(); \
    } while (0)
    LAYER_BODY(0); LAYER_BODY(1); LAYER_BODY(2); LAYER_BODY(3);
#undef LAYER_BODY
#undef RUNP
#undef GRID_BAR
}

template <int PH> static void launch_phase(const Args& a, int layer, int grid, hipStream_t stream) {
    static bool attr = false;
    if (!attr) { (void)hipFuncSetAttribute((const void*)k_phase<PH>, hipFuncAttributeMaxDynamicSharedMemorySize, LDS_BYTES); attr = true; }
    hipLaunchKernelGGL(k_phase<PH>, dim3(grid), dim3(NTHR), LDS_BYTES, stream, a, layer);
}

extern "C" void kernel_launch(void* const* d_in, const int* in_sizes, int n_in, void* d_out, int out_size, void* d_ws, size_t ws_size, hipStream_t stream) {
    static int grid = 0;
    if (grid == 0) {
        if (n_in != 22 || out_size != NB * SEQ * DM || ws_size < WS_END) { fprintf(stderr, "kernel_launch: unexpected shapes (n_in %d, out %d, ws %zu < %zu)\n", n_in, out_size, ws_size, (size_t)WS_END); grid = -1; return; }
        int dev = 0, cus = 0;
        if (hipGetDevice(&dev) != hipSuccess || hipDeviceGetAttribute(&cus, hipDeviceAttributeMultiprocessorCount, dev) != hipSuccess) { grid = -1; return; }
        grid = cus;
    }
    if (grid < 0) return;
    (void)hipMemsetAsync((char*)d_ws + WS_CTL, 0, CTL_ZERO_BYTES, stream);
    Args a{};
    for (int i = 0; i < 22; ++i) a.in[i] = (const float*)d_in[i];
    a.out = (float*)d_out; a.ws = (unsigned char*)d_ws; a.ph_lo = 0; a.ph_hi = 0;
#if MK_MULTI
    launch_phase<PH_PRO>(a, 0, grid, stream);
    launch_phase<PH_NORM1>(a, 0, grid, stream);
    for (int l = 0; l < DEPTH; ++l) {
        launch_phase<PH_INPROJ>(a, l, grid, stream);
        launch_phase<PH_PREP>(a, l, grid, stream);
        launch_phase<PH_SCAN>(a, l, grid, stream);
        launch_phase<PH_ATTN>(a, l, grid, stream);
        launch_phase<PH_FINISH>(a, l, grid, stream);
        launch_phase<PH_OUTPROJ>(a, l, grid, stream);
        launch_phase<PH_ROUTER>(a, l, grid, stream);
        launch_phase<PH_DISPATCH>(a, l, grid, stream);
        launch_phase<PH_GU>(a, l, grid, stream);
        launch_phase<PH_DOWN>(a, l, grid, stream);
        launch_phase<PH_COMBINE>(a, l, grid, stream);
    }
#else
    static bool attr = false;
    if (!attr) { (void)hipFuncSetAttribute((const void*)k_mega, hipFuncAttributeMaxDynamicSharedMemorySize, LDS_BYTES); attr = true; }
    hipLaunchKernelGGL(k_mega, dim3(grid), dim3(NTHR), LDS_BYTES, stream, a);
#endif
}
```

```cpp
#include <hip/hip_runtime.h>
#include <cstdio>
#include <cstdint>
#include <cmath>

#ifndef MK_MULTI
#define MK_MULTI 0
#endif
#ifndef MOE_FP8
#define MOE_FP8 1
#endif
#ifndef OUTPROJ_FP8
#define OUTPROJ_FP8 1
#endif
#ifndef INPROJ_I8
#define INPROJ_I8 1
#endif
#ifndef GEMM_ALIGN
#define GEMM_ALIGN 1
#endif
#ifndef NEW_HG
#define NEW_HG 1
#endif
#ifndef NEW_ML
#define NEW_ML 1
#endif
#ifndef PROBE_DOUBLE
#define PROBE_DOUBLE -1
#endif

#define GAS __attribute__((address_space(1)))
#define LAS __attribute__((address_space(3)))
typedef unsigned short bf16;
typedef short bf16x8 __attribute__((ext_vector_type(8)));
typedef short s16x4 __attribute__((ext_vector_type(4)));
typedef float f32x2 __attribute__((ext_vector_type(2)));
typedef float f32x4 __attribute__((ext_vector_type(4)));
typedef float f32x16 __attribute__((ext_vector_type(16)));
typedef unsigned u32x2 __attribute__((ext_vector_type(2)));
typedef unsigned u32x4 __attribute__((ext_vector_type(4)));
typedef __bf16 bf16x2_t __attribute__((ext_vector_type(2)));
typedef int v8i __attribute__((ext_vector_type(8)));
typedef int v4i __attribute__((ext_vector_type(4)));
typedef unsigned u32x8 __attribute__((ext_vector_type(8)));

constexpr int DM = 1024, NB = 8, SEQ = 4096, CTX = 256, SB = SEQ + CTX  , NR = NB * SB  , DEPTH = 4;
constexpr int PC = 3584;
constexpr int C_ATQ = 0, C_ATK = 512, C_ATV = 768, C_HGQ = 1024, C_HGZF = 1280, C_HGZB = 1536, C_HGV = 1792, C_HGG = 2048,
              C_MLQ = 2304, C_MLK = 2560, C_MLV = 2816, C_MLOG = 3072, C_MLG = 3328;
constexpr int NIN = 3344;
constexpr int NEXP = 32, NPOS = 147456;
constexpr float EPS = 1e-6f;
constexpr int NTHR = 512, NWAVE = 8;

constexpr size_t MiB = 1u << 20;
constexpr size_t WS_CTL = 0, CTL_ZERO_BYTES = 1 * MiB;
constexpr size_t WS_MOD = 1 * MiB;
constexpr size_t WS_ROPE = 2 * MiB;
constexpr size_t WS_WRH = 2 * MiB + 65536, WS_WRL = WS_WRH + 262144;
constexpr size_t WS_WSC = 2 * MiB + 655360;
constexpr size_t WS_HSC = 2 * MiB + 720896;
constexpr size_t WS_RE = 3 * MiB, WS_RS = WS_RE + 600000, WS_RG = WS_RS + 600000, WS_POS = WS_RG + 600000;
constexpr size_t WS_CNT = WS_POS + 600000;
constexpr size_t WS_TOK = 6 * MiB, WS_GATEP = WS_TOK + 600000, WS_TILEE = WS_GATEP + 600000, WS_NRT = WS_TILEE + 8192;
constexpr size_t WS_WIN = 8 * MiB;
constexpr size_t WS_WOUT = 36 * MiB;
constexpr size_t WS_WGU = 44 * MiB;
constexpr size_t WS_WDN = 556 * MiB;
constexpr size_t WS_H = 812 * MiB;
constexpr size_t WS_P = 880 * MiB;
constexpr size_t WS_Y = 1118 * MiB;
constexpr size_t WS_XC = 1186 * MiB;
constexpr size_t WS_ACT = 1194 * MiB;
constexpr size_t WS_YM = 1482 * MiB;
constexpr size_t WS_OH = 1770 * MiB;
constexpr size_t WS_OM = 1838 * MiB;
constexpr size_t WS_UTH = 1906 * MiB, WS_SPH = 1940 * MiB, WS_UTM = 1974 * MiB, WS_SPM = 2008 * MiB;
constexpr size_t WS_DT = 2042 * MiB, WS_NU = WS_DT + 1310720, WS_NP = WS_NU + 1310720, WS_GL = WS_NP + 1310720, WS_MP = WS_GL + 131072;
constexpr size_t WS_H8 = 2046 * MiB;
constexpr size_t WS_XB = 2080 * MiB;
constexpr size_t WS_END = 2148 * MiB;
static_assert(WS_CNT + 32768 <= WS_TOK && WS_NRT + 64 <= WS_WIN, "ws map");
static_assert((size_t)NR * 4 * 4 <= 600000 && (size_t)NPOS * 4 <= 600000, "ws map");

constexpr int CW_CMAX = 16384;
constexpr int CW_BAR = 4096;

constexpr int LDS_BYTES = 147456;
constexpr int PH_LDS = 143360;
constexpr int MISC_OFF = PH_LDS;

struct Args { const float* in[22]; float* out; unsigned char* ws; int ph_lo, ph_hi; };

#define LDS_WAIT() asm volatile("s_waitcnt lgkmcnt(0)" ::: "memory")
#define VM_WAIT() asm volatile("s_waitcnt vmcnt(0)" ::: "memory")

__device__ __forceinline__ unsigned pk2(float lo, float hi) { f32x2 v = {lo, hi}; bf16x2_t b = __builtin_convertvector(v, bf16x2_t); return __builtin_bit_cast(unsigned, b); }
__device__ __forceinline__ unsigned f2bf(float f) { return pk2(f, 0.f) & 0xffffu; }
__device__ __forceinline__ float clamp8(float x) { return fminf(fmaxf(x, -448.f), 448.f); }
__device__ __forceinline__ unsigned pk_fp8x4(float a, float b, float c, float d) {
    int w = 0; w = __builtin_amdgcn_cvt_pk_fp8_f32(clamp8(a), clamp8(b), w, false); w = __builtin_amdgcn_cvt_pk_fp8_f32(clamp8(c), clamp8(d), w, true); return (unsigned)w; }
__device__ __forceinline__ unsigned fp8_1(float a) { return pk_fp8x4(a, 0.f, 0.f, 0.f) & 0xffu; }
__device__ __forceinline__ float bf2f(unsigned h) { return __uint_as_float(h << 16); }
__device__ __forceinline__ float bflo(unsigned w) { return __uint_as_float(w << 16); }
__device__ __forceinline__ float bfhi(unsigned w) { return __uint_as_float(w & 0xffff0000u); }
__device__ __forceinline__ float wave_sum(float v) {
#define WS_DPP(x, ctrl, rmask) __builtin_bit_cast(float, __builtin_amdgcn_update_dpp(0, __builtin_bit_cast(int, x), ctrl, rmask, 0xF, false))
    v += WS_DPP(v, 0xB1, 0xF);
    v += WS_DPP(v, 0x4E, 0xF);
    v += WS_DPP(v, 0x141, 0xF);
    v += WS_DPP(v, 0x140, 0xF);
    v += WS_DPP(v, 0x142, 0xA);
    v += WS_DPP(v, 0x143, 0xC);
#undef WS_DPP
    return __builtin_bit_cast(float, __builtin_amdgcn_readlane(__builtin_bit_cast(int, v), 63));
}
__device__ __forceinline__ float wave_max_nn(float v) {
#define WS_DPP(x, ctrl, rmask) __builtin_bit_cast(float, __builtin_amdgcn_update_dpp(0, __builtin_bit_cast(int, x), ctrl, rmask, 0xF, false))
    v = fmaxf(v, WS_DPP(v, 0xB1, 0xF)); v = fmaxf(v, WS_DPP(v, 0x4E, 0xF)); v = fmaxf(v, WS_DPP(v, 0x141, 0xF)); v = fmaxf(v, WS_DPP(v, 0x140, 0xF));
    v = fmaxf(v, WS_DPP(v, 0x142, 0xA)); v = fmaxf(v, WS_DPP(v, 0x143, 0xC));
#undef WS_DPP
    return __builtin_bit_cast(float, __builtin_amdgcn_readlane(__builtin_bit_cast(int, v), 63));
}
__device__ __forceinline__ unsigned pk_i8x4(float a, float b, float c, float d) {
    const int q0 = __float2int_rn(a), q1 = __float2int_rn(b), q2 = __float2int_rn(c), q3 = __float2int_rn(d);
    return (unsigned)(q0 & 0xff) | ((unsigned)(q1 & 0xff) << 8) | ((unsigned)(q2 & 0xff) << 16) | ((unsigned)q3 << 24); }
__device__ __forceinline__ float sigm(float x) { return __builtin_amdgcn_rcpf(1.f + __expf(-x)); }


constexpr int ARGS_OFF = MISC_OFF + 256, WTAB_OFF = MISC_OFF + 512;
__device__ __forceinline__ unsigned hw_slot() { return (unsigned)__builtin_amdgcn_s_getreg((5 << 11) | 4) & 63u; }
__device__ __forceinline__ int lane_id(unsigned zo) { return (int)__builtin_amdgcn_mbcnt_hi(~0u, __builtin_amdgcn_mbcnt_lo(~0u, zo)); }
__device__ __forceinline__ int otid() {
    unsigned zo = 0; asm volatile("" : "+v"(zo));
    const int wave = __builtin_amdgcn_readfirstlane(*(const LAS int*)(WTAB_OFF + hw_slot() * 4 + zo));
    int t = wave * 64 + lane_id(zo); asm volatile("" : "+v"(t)); return t;
}
__device__ __forceinline__ int obid() { int b = blockIdx.x; asm volatile("" : "+s"(b)); return b; }
__device__ __forceinline__ int ogrid() { int g = gridDim.x; asm volatile("" : "+s"(g)); return g; }
__device__ __forceinline__ const void* lds_ptr64(int byte_off, unsigned zo) {
    const u32x2 w = *(const LAS u32x2*)(byte_off + zo);
    const unsigned lo = __builtin_amdgcn_readfirstlane(w.x), hi = __builtin_amdgcn_readfirstlane(w.y);
    return (const void*)(((unsigned long long)hi << 32) | lo);
}
__device__ __forceinline__ Args fetch_args() {
    unsigned zo = 0; asm volatile("" : "+v"(zo));
    Args r;
#pragma unroll
    for (int i = 0; i < 22; ++i) r.in[i] = (const float*)lds_ptr64(ARGS_OFF + 8 * i, zo);
    r.out = (float*)lds_ptr64(ARGS_OFF + 8 * 22, zo); r.ws = (unsigned char*)lds_ptr64(ARGS_OFF + 8 * 23, zo); r.ph_lo = 0; r.ph_hi = 0;
    return r;
}
__device__ __forceinline__ void kernel_setup(const Args& a) {
    const int tid = threadIdx.x;
    LAS unsigned* M = (LAS unsigned*)MISC_OFF;
    if (tid < 64) M[tid] = 0u;
    if (tid == 0) { LAS unsigned long long* A = (LAS unsigned long long*)ARGS_OFF;
#pragma unroll
        for (int i = 0; i < 22; ++i) A[i] = (unsigned long long)a.in[i];
        A[22] = (unsigned long long)a.out; A[23] = (unsigned long long)a.ws; }
    if ((tid & 63) == 0) *(LAS int*)(WTAB_OFF + hw_slot() * 4) = tid >> 6;
    __syncthreads();
}

__device__ __forceinline__ const float* x_rd(const Args& a, bool from_input, int r) {
    const int b = r / SB, s = r - b * SB;
    if (s < CTX) return (from_input ? a.in[2] : (const float*)(a.ws + WS_XC)) + (size_t)(b * CTX + s) * DM;
    return (from_input ? a.in[0] : (const float*)a.out) + (size_t)(b * SEQ + s - CTX) * DM;
}
__device__ __forceinline__ float* x_wr(const Args& a, int r) {
    const int b = r / SB, s = r - b * SB;
    if (s < CTX) return (float*)(a.ws + WS_XC) + (size_t)(b * CTX + s) * DM;
    return a.out + (size_t)(b * SEQ + s - CTX) * DM;
}
__device__ __forceinline__ const float* modv(const Args& a, int layer, int r, int chunk) {
    const int b = r / SB, s = r - b * SB; const int j = s < CTX ? 8 : b;
    return (const float*)(a.ws + WS_MOD) + ((size_t)(layer * 9 + j) * 6 + chunk) * DM;
}

#define XB_TMO      128
#define XB_XCNT(j)  (256  + 64 * (j))
#define XB_XSUB(j)  (1280 + 64 * (j))
#define XB_XGEN(j)  (2304 + 64 * (j))
#define XB_TOP      3328
#define XB_TOPGEN   3392
#define XCD_BAR_WORDS 3456
#define XB_SPIN_CAP (1u << 18)
__device__ __forceinline__ unsigned xb_ld(unsigned* p)              { return __hip_atomic_load(p, __ATOMIC_RELAXED, __HIP_MEMORY_SCOPE_AGENT); }
__device__ __forceinline__ unsigned xb_add(unsigned* p, unsigned v) { return __hip_atomic_fetch_add(p, v, __ATOMIC_RELAXED, __HIP_MEMORY_SCOPE_AGENT); }
__device__ __forceinline__ unsigned xb_xcc_id() { return (unsigned)__builtin_amdgcn_s_getreg((3 << 11) | 20) & 0xFu; }
#define XB_SPIN(cond, bar) do { unsigned _sp = 0; while (cond) { __builtin_amdgcn_s_sleep(1); \
    if ((++_sp & 255u) == 0u) { if (xb_ld(&(bar)[XB_TMO])) break; if (_sp > XB_SPIN_CAP) { atomicAdd(&(bar)[XB_TMO], 1u); break; } } } } while (0)
struct XcdBarrier { unsigned* bar; unsigned x; volatile LAS unsigned* st; };
__device__ __forceinline__ XcdBarrier xcd_barrier_post(unsigned* bar, volatile LAS unsigned* st) {
    XcdBarrier b; b.bar = bar; b.x = xb_xcc_id(); b.st = st;
    if (otid() == 0) (void)xb_add(&bar[XB_XCNT(b.x)], 1u);
    return b;
}
__device__ __forceinline__ void xcd_barrier_complete(unsigned* bar, unsigned x, unsigned& nloc, unsigned& nx) {
    const unsigned G = gridDim.x * gridDim.y * gridDim.z;
    unsigned sum, cnt, mine, sp = 0u;
    for (;;) {
        sum = 0u; cnt = 0u; mine = 0u;
#pragma unroll
        for (unsigned j = 0; j < 16; ++j) { const unsigned c = xb_ld(&bar[XB_XCNT(j)]); sum += c; cnt += (c > 0u) ? 1u : 0u; mine = (j == x) ? c : mine; }
        if (sum == G) break;
        __builtin_amdgcn_s_sleep(1);
        if ((++sp & 255u) == 0u) { if (xb_ld(&bar[XB_TMO])) break; if (sp > XB_SPIN_CAP) { atomicAdd(&bar[XB_TMO], 1u); break; } }
    }
    nloc = mine > 0u ? mine : 1u; nx = cnt > 0u ? cnt : 1u;
}
__device__ __forceinline__ void xcd_barrier(const XcdBarrier& b) {
    asm volatile("s_waitcnt vmcnt(0)" ::: "memory");
    __syncthreads();
    if (otid() == 0) {
        unsigned* bar = b.bar;
        __builtin_amdgcn_s_waitcnt(0);
        unsigned nloc = b.st[0], nx = b.st[1];
        if (nloc == 0u) { xcd_barrier_complete(bar, b.x, nloc, nx); b.st[0] = nloc; b.st[1] = nx; }
        const unsigned old = xb_add(&bar[XB_XSUB(b.x)], 1u);
        const unsigned gen = old / nloc;
        if (old + 1u == (gen + 1u) * nloc) {
            __builtin_amdgcn_fence(__ATOMIC_RELEASE, "agent");
            asm volatile("s_waitcnt vmcnt(0)" ::: "memory");
            const unsigned og = xb_add(&bar[XB_TOP], 1u);
            const unsigned tg = og / nx;
            if (og + 1u == (tg + 1u) * nx) xb_add(&bar[XB_TOPGEN], 1u);
            else XB_SPIN(xb_ld(&bar[XB_TOPGEN]) == tg, bar);
            __builtin_amdgcn_fence(__ATOMIC_ACQUIRE, "agent");
            xb_add(&bar[XB_XGEN(b.x)], 1u);
            asm volatile("s_waitcnt vmcnt(0)" ::: "memory");
        } else {
            XB_SPIN(xb_ld(&bar[XB_XGEN(b.x)]) == gen, bar);
            __builtin_amdgcn_fence(__ATOMIC_ACQUIRE, "agent");
            asm volatile("s_waitcnt vmcnt(0)" ::: "memory");
        }
    }
    __syncthreads();
}

__device__ __forceinline__ void glds16s2(const void* sbase, unsigned voff0, unsigned voff1, unsigned lds0, unsigned lds1) {
    unsigned keep;
    asm volatile("s_mov_b32 %0, m0\n\ts_mov_b32 m0, %4\n\ts_nop 0\n\tglobal_load_lds_dwordx4 %1, %3\n\ts_mov_b32 m0, %5\n\ts_nop 0\n\tglobal_load_lds_dwordx4 %2, %3\n\ts_mov_b32 m0, %0"
                 : "=&s"(keep) : "v"(voff0), "v"(voff1), "s"(sbase), "s"(lds0), "s"(lds1) : "memory");
}

__device__ __forceinline__ void glds16s1(const void* sbase, unsigned voff, unsigned lds0) {
    unsigned keep;
    asm volatile("s_mov_b32 %0, m0\n\ts_mov_b32 m0, %3\n\ts_nop 0\n\tglobal_load_lds_dwordx4 %1, %2\n\ts_mov_b32 m0, %0" : "=&s"(keep) : "v"(voff), "s"(sbase), "s"(lds0) : "memory");
}
struct AuxSrc { const void* base; unsigned off; };

namespace pg8 {
constexpr int BM = 256, BK = 64, HALF = 128, HTB = HALF * BK * 2, STAGE_BYTES = 8 * HTB, NXCD = 8, WGM = 8, K = 1024;
__host__ __device__ __forceinline__ int lds_byte(int r, int c) { const int st = (r >> 4) * 2 + (c >> 5), rr = r & 15, cc = c & 31, ob = rr * 64 + cc * 2; return st * 1024 + (ob ^ (((ob >> 9) & 1) << 5)); }
__host__ __device__ __forceinline__ void stage_rc(int b, int& R, int& C) { const int st = b / 1024, sb = b % 1024, swz = sb ^ (((sb >> 9) & 1) << 5); R = (st >> 1) * 16 + swz / 64; C = (st & 1) * 32 + (swz % 64) / 2; }
__host__ __device__ __forceinline__ int perm32(int rho) { const int n = rho >> 4, i = rho & 15; return 8 * (i >> 2) + 4 * n + (i & 3); }

struct Unit { int pm, pn, e; const char* Bt; };

struct SchedDense {
    int nM, nN, nwg, G, c, rb; const char* Bt;
    __device__ void init(int M, int N, int G_, int c_, const bf16* Bt_) { nM = M / BM; nN = N / BM; nwg = nM * nN; G = G_; c = c_; Bt = (const char*)Bt_; rb = 2 * K; }
    __device__ __forceinline__ bool next(int i, Unit& u) const {
        const long L = (long)i * G + c; if (L >= nwg) return false;
        int wgid = (int)L; { const int q = nwg / NXCD, r = nwg % NXCD, xcd = wgid % NXCD, off = wgid / NXCD; wgid = (xcd < r ? xcd * (q + 1) : r * (q + 1) + (xcd - r) * q) + off; }
        const int nig = WGM * nN, gid = wgid / nig, fm = gid * WGM, gsz = (nM - fm) < WGM ? (nM - fm) : WGM;
        u.pm = fm + ((wgid % nig) % gsz); u.pn = (wgid % nig) / gsz; u.e = 0; u.Bt = Bt + (size_t)u.pn * BM * rb; return true;
    }
    __device__ __forceinline__ int row(const Unit& u, int local) const { return u.pm * BM + local; }
};
struct SchedMoe {
    int G, c, nct, ntot, nrt; const int* tile_e; const char* WT; const int* tok; int rb  ;
    __device__ __forceinline__ bool next(int i, Unit& u) const {
        int rt, pn;
        if ((G & 7) == 0) { const int x = c & 7, j = c >> 3, per = G >> 3, base = nrt >> 3, rem = nrt & 7;
            const int cnt = base + (x < rem ? 1 : 0), start = x * base + (x < rem ? x : rem), q = i * per + j;
            if (q >= cnt * nct) return false;
            const int rl = q / nct; pn = q - rl * nct; rt = start + rl; }
        else { const int L = i * G + c; if (L >= nrt * nct) return false; rt = L / nct; pn = L - rt * nct; }
        u.pm = rt; u.pn = pn; u.e = __builtin_amdgcn_readfirstlane(__hip_atomic_load(tile_e + rt, __ATOMIC_RELAXED, __HIP_MEMORY_SCOPE_AGENT));
        u.Bt = WT + ((size_t)u.e * ntot + (size_t)u.pn * BM) * rb; return true;
    }
    __device__ __forceinline__ int row(const Unit& u, int local) const { return tok ? tok[u.pm * BM + local] : u.pm * BM + local; }
};

template <int MODE  , class Epi, class Sched>
__device__ __forceinline__ void gemm_phase(LAS unsigned char* lds, const void* Abase, const Sched& S, const Epi& E) {
    const int tid = otid(), wid = __builtin_amdgcn_readfirstlane(tid >> 6), lane = tid & 63, wr = wid >> 2, wc = wid & 3, fr = lane & 15, fq = lane >> 4;
    constexpr bool FP8 = (MODE == 1), I8 = (MODE == 2);
    constexpr int RB = MODE ? K : 2 * K;
    constexpr int nt = RB / 128;
    int R0, C0; stage_rc(tid * 16, R0, C0);
    const unsigned voffB0 = (unsigned)((Epi::PERM ? ((R0 & ~31) + perm32(R0 & 31)) : R0) * RB + C0 * 2);
    constexpr size_t kstep = (size_t)(BK * 2);
    constexpr size_t hstep = (size_t)HALF * RB;
    const unsigned ldsw = (unsigned)wid * 1024u, ldsb = (unsigned)(size_t)lds;
    const int aoff = lds_byte(wr * 64 + fr, fq * 8), boff = lds_byte(wc * 32 + fr, fq * 8);
    const char* Ab = (const char*)Abase;
    LAS u32x4* nslot = (LAS u32x4*)(lds + STAGE_BYTES + tid * 16);
    constexpr int AUX_OFF = STAGE_BYTES + 8192;
#define PG8_AUX(u, idx) do { if (wid < 2) { const AuxSrc s_ = E.aux(wid, u, lane); if (s_.base) glds16s1(s_.base, s_.off, ldsb + (unsigned)(AUX_OFF + ((idx) & 1) * 2048 + wid * 1024)); } } while (0)
#define PG8_SA(b, h) (((b) * 2 + (h)) * HTB)
#define PG8_SB(b, h) ((4 + (b) * 2 + (h)) * HTB)
#define PG8_STAGEA(bufoff, gbase, voff) glds16s2((gbase), (voff)[0], (voff)[1], ldsb + (unsigned)(bufoff) + ldsw, ldsb + (unsigned)(bufoff) + ldsw + 8192u)
#define PG8_STAGEB(bufoff, gbase) glds16s2((gbase), voffB0, voffB0 + (unsigned)(64 * RB), ldsb + (unsigned)(bufoff) + ldsw, ldsb + (unsigned)(bufoff) + ldsw + 8192u)
#define PG8_LDA(dst, b, h) do { if constexpr (FP8) { _Pragma("unroll") for (int m = 0; m < 4; ++m) { dst##8[m].lo = *(const LAS u32x4*)(lds + PG8_SA(b, h) + aoff + m * 2048); dst##8[m].hi = *(const LAS u32x4*)(lds + PG8_SA(b, h) + aoff + m * 2048 + 1024); } } \
    else { _Pragma("unroll") for (int m = 0; m < 4; ++m) _Pragma("unroll") for (int k = 0; k < 2; ++k) dst[m][k] = *(const LAS bf16x8*)(lds + PG8_SA(b, h) + aoff + m * 2048 + k * 1024); } } while (0)
#define PG8_LDB(dst, b, h) do { if constexpr (FP8) { _Pragma("unroll") for (int n = 0; n < 2; ++n) { dst##8[n].lo = *(const LAS u32x4*)(lds + PG8_SB(b, h) + boff + n * 2048); dst##8[n].hi = *(const LAS u32x4*)(lds + PG8_SB(b, h) + boff + n * 2048 + 1024); } } \
    else { _Pragma("unroll") for (int n = 0; n < 2; ++n) _Pragma("unroll") for (int k = 0; k < 2; ++k) dst[n][k] = *(const LAS bf16x8*)(lds + PG8_SB(b, h) + boff + n * 2048 + k * 1024); } } while (0)
#define PG8_MMA(ai, bj, At, Bt) do { __builtin_amdgcn_s_setprio(1); if constexpr (FP8) { _Pragma("unroll") for (int m = 0; m < 4; ++m) _Pragma("unroll") for (int n = 0; n < 2; ++n) \
        acc[ai][bj][m][n] = __builtin_amdgcn_mfma_scale_f32_16x16x128_f8f6f4(__builtin_bit_cast(v8i, Bt##8[n]), __builtin_bit_cast(v8i, At##8[m]), acc[ai][bj][m][n], 0, 0, 0, 0x7f7f7f7f, 0, 0x7f7f7f7f); } \
        else if constexpr (I8) { _Pragma("unroll") for (int m = 0; m < 4; ++m) _Pragma("unroll") for (int n = 0; n < 2; ++n) _Pragma("unroll") for (int k = 0; k < 2; ++k) \
        acc[ai][bj][m][n] = __builtin_bit_cast(f32x4, __builtin_amdgcn_mfma_i32_16x16x64_i8(__builtin_bit_cast(v4i, Bt[n][k]), __builtin_bit_cast(v4i, At[m][k]), __builtin_bit_cast(v4i, acc[ai][bj][m][n]), 0, 0, 0)); } \
        else { _Pragma("unroll") for (int m = 0; m < 4; ++m) _Pragma("unroll") for (int n = 0; n < 2; ++n) _Pragma("unroll") for (int k = 0; k < 2; ++k) \
        acc[ai][bj][m][n] = __builtin_amdgcn_mfma_f32_16x16x32_bf16(Bt[n][k], At[m][k], acc[ai][bj][m][n], 0, 0, 0); } __builtin_amdgcn_s_setprio(0); } while (0)
#define PG8_WAIT_V(n) asm volatile("s_waitcnt vmcnt(" #n ")" ::: "memory")
#define PG8_WAIT_L(n) asm volatile("s_waitcnt lgkmcnt(" #n ")" ::: "memory")
#define PG8_BAR __builtin_amdgcn_s_barrier()
#define PG8_SCHED __builtin_amdgcn_sched_barrier(0)
#define PG8_VAOFF(u, h, i) ((unsigned)(S.row(u, (h) * HALF + R0 + 64 * (i)) * RB + C0 * 2))
    Unit cur, nxt; int ui = 0;
    if (!S.next(0, cur)) return;
    f32x4 acc[2][2][4][2];
#pragma unroll
    for (int a = 0; a < 2; ++a)
#pragma unroll
        for (int b = 0; b < 2; ++b)
#pragma unroll
            for (int m = 0; m < 4; ++m)
#pragma unroll
                for (int n = 0; n < 2; ++n) acc[a][b][m][n] = (f32x4){0.f, 0.f, 0.f, 0.f};
    bf16x8 At[4][2], B0[2][2], B1[2][2];
    u32x8 At8[4], B08[2], B18[2];
    unsigned vA[2][2];
#pragma unroll
    for (int h = 0; h < 2; ++h)
#pragma unroll
        for (int i = 0; i < 2; ++i) vA[h][i] = PG8_VAOFF(cur, h, i);
    const char* cB = cur.Bt;
    PG8_AUX(cur, 0);
    PG8_STAGEB(PG8_SB(0, 0), cB); PG8_STAGEB(PG8_SB(0, 1), cB + hstep); PG8_STAGEA(PG8_SA(0, 0), Ab, vA[0]); PG8_STAGEA(PG8_SA(0, 1), Ab, vA[1]);
    if (wr == 1) PG8_BAR;
    PG8_WAIT_V(2); PG8_BAR;
    PG8_STAGEB(PG8_SB(1, 0), cB + kstep); PG8_STAGEA(PG8_SA(1, 0), Ab + kstep, vA[0]); PG8_STAGEB(PG8_SB(1, 1), cB + hstep + kstep);
    PG8_WAIT_V(6); PG8_BAR;
    for (;;) {
        const bool has_next = S.next(ui + 1, nxt);
        if (has_next) *nslot = (u32x4){PG8_VAOFF(nxt, 0, 0), PG8_VAOFF(nxt, 0, 1), PG8_VAOFF(nxt, 1, 0), PG8_VAOFF(nxt, 1, 1)};
        const char* nB = has_next ? nxt.Bt : cB;
#pragma unroll 1
        for (int t = 0; t < nt; t += 2) {
            const bool last = (t == nt - 2);
            const char* a1 = Ab + (size_t)(t + 1) * kstep;
            const char* a2 = last ? Ab : Ab + (size_t)(t + 2) * kstep; const char* b2 = last ? nB : cB + (size_t)(t + 2) * kstep;
            const char* a3 = a2 + kstep; const char* b3 = b2 + kstep;
            PG8_LDB(B0, 0, 0); PG8_LDB(B1, 0, 1); PG8_SCHED; PG8_LDA(At, 0, 0); PG8_STAGEA(PG8_SA(1, 1), a1, vA[1]);
            if (last && has_next) { const u32x4 nv = *nslot; vA[0][0] = nv.x; vA[0][1] = nv.y; vA[1][0] = nv.z; vA[1][1] = nv.w; }
            PG8_WAIT_V(8); PG8_WAIT_L(0); PG8_BAR; PG8_MMA(0, 0, At, B0); PG8_MMA(0, 1, At, B1); PG8_BAR; PG8_SCHED;
            PG8_LDA(At, 0, 1); PG8_STAGEB(PG8_SB(0, 0), b2); PG8_STAGEB(PG8_SB(0, 1), b2 + hstep); PG8_STAGEA(PG8_SA(0, 0), a2, vA[0]);
            PG8_WAIT_V(8); PG8_WAIT_L(0); PG8_BAR; PG8_MMA(1, 0, At, B0); PG8_MMA(1, 1, At, B1); PG8_BAR; PG8_SCHED;
            PG8_LDB(B0, 1, 0); PG8_LDB(B1, 1, 1); PG8_SCHED; PG8_LDA(At, 1, 0); PG8_STAGEA(PG8_SA(0, 1), a2, vA[1]);
            PG8_WAIT_V(8); PG8_WAIT_L(0); PG8_BAR; PG8_MMA(0, 0, At, B0); PG8_MMA(0, 1, At, B1); PG8_BAR; PG8_SCHED;
            PG8_LDA(At, 1, 1); PG8_STAGEB(PG8_SB(1, 0), b3); PG8_STAGEB(PG8_SB(1, 1), b3 + hstep); PG8_STAGEA(PG8_SA(1, 0), a3, vA[0]);
            PG8_WAIT_V(8); PG8_WAIT_L(0); PG8_BAR; PG8_MMA(1, 0, At, B0); PG8_MMA(1, 1, At, B1); PG8_BAR; PG8_SCHED;
        }
        if (GEMM_ALIGN && wr == 0) PG8_BAR;
        { int fr_ = fr, fq_ = fq; asm volatile("" : "+v"(fr_), "+v"(fq_));
          E(acc, cur, wr, wc, fr_, fq_, (const LAS float*)(lds + AUX_OFF + (ui & 1) * 2048), (const LAS float*)(lds + AUX_OFF + (ui & 1) * 2048 + 1024)); }
        if (!has_next) break;
#pragma unroll
        for (int a = 0; a < 2; ++a)
#pragma unroll
            for (int b = 0; b < 2; ++b)
#pragma unroll
                for (int m = 0; m < 4; ++m)
#pragma unroll
                    for (int n = 0; n < 2; ++n) acc[a][b][m][n] = (f32x4){0.f, 0.f, 0.f, 0.f};
        cur = nxt; cB = nB; ++ui;
        PG8_AUX(cur, ui);
        if (GEMM_ALIGN && wr == 1) PG8_BAR;
    }
    PG8_WAIT_V(0);
    if (!GEMM_ALIGN && wr == 0) PG8_BAR;
    PG8_BAR;
#undef PG8_SA
#undef PG8_SB
#undef PG8_STAGEA
#undef PG8_STAGEB
#undef PG8_LDA
#undef PG8_LDB
#undef PG8_MMA
#undef PG8_WAIT_V
#undef PG8_WAIT_L
#undef PG8_BAR
#undef PG8_SCHED
#undef PG8_VAOFF
#undef PG8_AUX
}

struct EpiBf16 {
    static constexpr bool PERM = true;
    bf16* O; int ldc;
    __device__ __forceinline__ AuxSrc aux(int, const Unit&, int) const { return AuxSrc{nullptr, 0u}; }
    __device__ __forceinline__ void operator()(const f32x4 (&acc)[2][2][4][2], const Unit& u, int wr, int wc, int fr, int fq, const LAS float*, const LAS float*) const {
        const int row0 = u.pm * BM + wr * 64 + fr, col0 = u.pn * BM + wc * 32 + 8 * fq;
#pragma unroll
        for (int ai = 0; ai < 2; ++ai)
#pragma unroll
            for (int m = 0; m < 4; ++m) { bf16* rowp = O + (size_t)(row0 + ai * HALF + m * 16) * ldc + col0;
#pragma unroll
                for (int bj = 0; bj < 2; ++bj) { const f32x4 v0 = acc[ai][bj][m][0], v1 = acc[ai][bj][m][1];
                    u32x4 w; w.x = pk2(v0[0], v0[1]); w.y = pk2(v0[2], v0[3]); w.z = pk2(v1[0], v1[1]); w.w = pk2(v1[2], v1[3]);
                    *(u32x4*)(rowp + bj * HALF) = w; } }
    }
};
struct EpiI8 {
    static constexpr bool PERM = true;
    bf16* O; int ldc; const float* hs; const float* ws;
    __device__ __forceinline__ AuxSrc aux(int which, const Unit& u, int lane) const { return which == 0 ? AuxSrc{ws + u.pn * BM, (unsigned)lane * 16u} : AuxSrc{hs + u.pm * BM, (unsigned)lane * 16u}; }
    __device__ __forceinline__ void operator()(const f32x4 (&acc)[2][2][4][2], const Unit& u, int wr, int wc, int fr, int fq, const LAS float* a0, const LAS float* a1) const {
        const int row0 = u.pm * BM + wr * 64 + fr, col0 = u.pn * BM + wc * 32 + 8 * fq;
        f32x4 wv[2][2];
#pragma unroll
        for (int bj = 0; bj < 2; ++bj)
#pragma unroll
            for (int n = 0; n < 2; ++n) wv[bj][n] = *(const LAS f32x4*)(a0 + wc * 32 + 8 * fq + bj * HALF + 4 * n);
#pragma unroll
        for (int ai = 0; ai < 2; ++ai)
#pragma unroll
            for (int m = 0; m < 4; ++m) { const int row = row0 + ai * HALF + m * 16; const float hr = a1[wr * 64 + fr + ai * HALF + m * 16]; bf16* rowp = O + (size_t)row * ldc + col0;
#pragma unroll
                for (int bj = 0; bj < 2; ++bj) { const f32x4 v0 = __builtin_convertvector(__builtin_bit_cast(v4i, acc[ai][bj][m][0]), f32x4) * hr * wv[bj][0], v1 = __builtin_convertvector(__builtin_bit_cast(v4i, acc[ai][bj][m][1]), f32x4) * hr * wv[bj][1];
                    u32x4 w; w.x = pk2(v0[0], v0[1]); w.y = pk2(v0[2], v0[3]); w.z = pk2(v1[0], v1[1]); w.w = pk2(v1[2], v1[3]);
                    *(u32x4*)(rowp + bj * HALF) = w; } }
    }
};
struct EpiResid {
    static constexpr bool PERM = true;
    const float* xin_lat; const float* xin_ctx; bf16* xb; const float* mod  ; int chunk; bool skip_ctx, first; float sc;
    __device__ __forceinline__ AuxSrc aux(int which, const Unit& u, int lane) const { const int b = u.pm / 17, j = u.pm - b * 17;
        return which == 0 ? AuxSrc{mod + (size_t)((j == 0 ? 8 : b) * 6 + chunk) * DM + u.pn * BM, (unsigned)lane * 16u} : AuxSrc{nullptr, 0u}; }
    __device__ __forceinline__ void operator()(const f32x4 (&acc)[2][2][4][2], const Unit& u, int wr, int wc, int fr, int fq, const LAS float* a0, const LAS float*) const {
        const int b = u.pm / 17, j = u.pm - b * 17; const bool isctx = (j == 0);
        if (isctx && skip_ctx) return;
        const float* xin = isctx ? xin_ctx + (size_t)b * CTX * DM : xin_lat + ((size_t)b * SEQ + (size_t)(j - 1) * 256) * DM;
        bf16* xt = xb + (size_t)u.pm * BM * DM;
        const int col0 = u.pn * BM + wc * 32 + 8 * fq;
        f32x4 gv[2][2];
#pragma unroll
        for (int bj = 0; bj < 2; ++bj)
#pragma unroll
            for (int n = 0; n < 2; ++n) gv[bj][n] = *(const LAS f32x4*)(a0 + wc * 32 + 8 * fq + bj * HALF + 4 * n) * sc;
#pragma unroll
        for (int ai = 0; ai < 2; ++ai)
#pragma unroll
            for (int m = 0; m < 4; ++m) { const size_t ro = (size_t)(ai * HALF + wr * 64 + m * 16 + fr) * DM;
#pragma unroll
                for (int bj = 0; bj < 2; ++bj) { const int c = col0 + bj * HALF; f32x4 x0, x1;
                    if (first) { x0 = *(const f32x4*)(xin + ro + c); x1 = *(const f32x4*)(xin + ro + c + 4); }
                    else { const u32x4 w = *(const u32x4*)(xt + ro + c); x0 = (f32x4){bflo(w.x), bfhi(w.x), bflo(w.y), bfhi(w.y)}; x1 = (f32x4){bflo(w.z), bfhi(w.z), bflo(w.w), bfhi(w.w)}; }
                    x0 = x0 + gv[bj][0] * acc[ai][bj][m][0]; x1 = x1 + gv[bj][1] * acc[ai][bj][m][1];
                    u32x4 o; o.x = pk2(x0[0], x0[1]); o.y = pk2(x0[2], x0[3]); o.z = pk2(x1[0], x1[1]); o.w = pk2(x1[2], x1[3]);
                    *(u32x4*)(xt + ro + c) = o; } }
    }
};
struct EpiGU {
    static constexpr bool PERM = true;
    void* ACT; const float* bgu  ;
    __device__ __forceinline__ AuxSrc aux(int which, const Unit& u, int lane) const {
        return which == 0 ? AuxSrc{bgu + (size_t)u.e * 2048 + u.pn * HALF, lane < 32 ? (unsigned)lane * 16u : 4096u + (unsigned)(lane - 32) * 16u} : AuxSrc{nullptr, 0u}; }
    __device__ __forceinline__ void operator()(const f32x4 (&acc)[2][2][4][2], const Unit& u, int wr, int wc, int fr, int fq, const LAS float* a0, const LAS float*) const {
        const int row0 = u.pm * BM + wr * 64 + fr, col0 = u.pn * HALF + wc * 32 + 8 * fq;
        constexpr float SC = MOE_FP8 ? 1.f / 512.f : 1.f;
        f32x4 bgv[2], buv[2];
#pragma unroll
        for (int n = 0; n < 2; ++n) { bgv[n] = *(const LAS f32x4*)(a0 + wc * 32 + 8 * fq + 4 * n); buv[n] = *(const LAS f32x4*)(a0 + HALF + wc * 32 + 8 * fq + 4 * n); }
#pragma unroll
        for (int ai = 0; ai < 2; ++ai)
#pragma unroll
            for (int m = 0; m < 4; ++m) { float o[8];
#pragma unroll
                for (int n = 0; n < 2; ++n)
#pragma unroll
                    for (int i = 0; i < 4; ++i) { float gt = acc[ai][0][m][n][i] * SC + bgv[n][i], up = acc[ai][1][m][n][i] * SC + buv[n][i];
                        gt = fminf(gt, 7.f); up = fminf(fmaxf(up, -7.f), 7.f);
                        o[4 * n + i] = (up + 1.f) * gt * sigm(1.702f * gt); }
                const size_t eo = (size_t)(row0 + ai * HALF + m * 16) * DM + col0;
                if constexpr (MOE_FP8) { u32x2 w; w.x = pk_fp8x4(4.f * o[0], 4.f * o[1], 4.f * o[2], 4.f * o[3]); w.y = pk_fp8x4(4.f * o[4], 4.f * o[5], 4.f * o[6], 4.f * o[7]);
                    *(u32x2*)((unsigned char*)ACT + eo) = w; }
                else { u32x4 w; w.x = pk2(o[0], o[1]); w.y = pk2(o[2], o[3]); w.z = pk2(o[4], o[5]); w.w = pk2(o[6], o[7]); *(u32x4*)((bf16*)ACT + eo) = w; } }
    }
};
struct EpiDown {
    static constexpr bool PERM = true;
    bf16* YM; const float* bdn  ; const float* gatep;
    __device__ __forceinline__ AuxSrc aux(int which, const Unit& u, int lane) const {
        return which == 0 ? AuxSrc{bdn + (size_t)u.e * 1024 + u.pn * BM, (unsigned)lane * 16u} : AuxSrc{gatep + (size_t)u.pm * BM, (unsigned)lane * 16u}; }
    __device__ __forceinline__ void operator()(const f32x4 (&acc)[2][2][4][2], const Unit& u, int wr, int wc, int fr, int fq, const LAS float* a0, const LAS float* a1) const {
        const int row0 = u.pm * BM + wr * 64 + fr, col0 = u.pn * BM + wc * 32 + 8 * fq;
        constexpr float SC = MOE_FP8 ? 1.f / 256.f : 1.f;
        f32x4 bv[2][2];
#pragma unroll
        for (int bj = 0; bj < 2; ++bj)
#pragma unroll
            for (int n = 0; n < 2; ++n) bv[bj][n] = *(const LAS f32x4*)(a0 + wc * 32 + 8 * fq + bj * HALF + 4 * n);
#pragma unroll
        for (int ai = 0; ai < 2; ++ai)
#pragma unroll
            for (int m = 0; m < 4; ++m) { const int row = row0 + ai * HALF + m * 16; const float gt = a1[wr * 64 + fr + ai * HALF + m * 16]; bf16* rowp = YM + (size_t)row * DM + col0;
#pragma unroll
                for (int bj = 0; bj < 2; ++bj) { const f32x4 v0 = (acc[ai][bj][m][0] * SC + bv[bj][0]) * gt, v1 = (acc[ai][bj][m][1] * SC + bv[bj][1]) * gt;
                    u32x4 w; w.x = pk2(v0[0], v0[1]); w.y = pk2(v0[2], v0[3]); w.z = pk2(v1[0], v1[1]); w.w = pk2(v1[2], v1[3]);
                    *(u32x4*)(rowp + bj * HALF) = w; } }
    }
};
}

namespace att {
constexpr int D = 128, NW = 8, QBLK = 32, KVBLK = 64;
constexpr float SCALE = 0.088388347648318440f;
constexpr float THR = 8.f;
constexpr int LDQ = PC, LDK = PC, LDO = DM;
constexpr size_t SHM_V = KVBLK * D * 2, SHM_K = KVBLK * D * 2, SHM_ATTN = 2 * SHM_V + 2 * SHM_K + NW * 64 * 4;
#define KSWZ(row, colB) ((row) * 256 + ((colB) ^ (((row) & 7) << 4)))
#define SBAR() __builtin_amdgcn_sched_barrier(0)
__device__ __forceinline__ int crow(int r, int hi) { return (r & 3) + 8 * (r >> 2) + 4 * hi; }
__device__ __forceinline__ unsigned cvtpk(float lo, float hi) { unsigned r; asm volatile("v_cvt_pk_bf16_f32 %0, %1, %2" : "=v"(r) : "v"(lo), "v"(hi)); return r; }
__device__ __forceinline__ bf16x8 ld8(const bf16* p) { return *reinterpret_cast<const bf16x8*>(p); }
__device__ __forceinline__ void finishSM(f32x16& p0, f32x16& p1, float& l_reg, bf16x8& pa0, bf16x8& pa1, bf16x8& pa2, bf16x8& pa3) {
  for (int r = 0; r < 16; ++r) p1[r] = __builtin_amdgcn_exp2f(p1[r]);
  float ps = 0; for (int r = 0; r < 16; ++r) ps += p0[r]; for (int r = 0; r < 16; ++r) ps += p1[r];
  { auto rr = __builtin_amdgcn_permlane32_swap(__float_as_uint(ps), __float_as_uint(ps), false, false);
    ps = __uint_as_float(rr[0]) + __uint_as_float(rr[1]); }
  l_reg += ps;
#define PK4(P, BASE, OUT) do { unsigned a0 = cvtpk(P[BASE + 0], P[BASE + 1]), a1 = cvtpk(P[BASE + 2], P[BASE + 3]);   \
    unsigned b0 = cvtpk(P[BASE + 4], P[BASE + 5]), b1 = cvtpk(P[BASE + 6], P[BASE + 7]);                              \
    auto r0 = __builtin_amdgcn_permlane32_swap(a0, b0, false, false); auto r1 = __builtin_amdgcn_permlane32_swap(a1, b1, false, false); \
    u32x4 w = {r0[0], r1[0], r0[1], r1[1]}; OUT = *reinterpret_cast<bf16x8*>(&w); } while (0)
  PK4(p0, 0, pa0); PK4(p0, 8, pa1); PK4(p1, 0, pa2); PK4(p1, 8, pa3);
#undef PK4
}
__device__ __forceinline__ void qkt(f32x16& p0, f32x16& p1, const LAS char* Ks, const bf16x8* qr, int r32, int hi, float negm) {
#pragma unroll
  for (int r = 0; r < 16; ++r) { p0[r] = negm; p1[r] = negm; }
  for (int d0 = 0; d0 < 8; ++d0) { int cb = (d0 * 16 + hi * 8) * 2;
    bf16x8 b0 = *reinterpret_cast<const LAS bf16x8*>(Ks + KSWZ(r32, cb));
    bf16x8 b1 = *reinterpret_cast<const LAS bf16x8*>(Ks + KSWZ(32 + r32, cb));
    p0 = __builtin_amdgcn_mfma_f32_32x32x16_bf16(b0, qr[d0], p0, 0, 0, 0);
    p1 = __builtin_amdgcn_mfma_f32_32x32x16_bf16(b1, qr[d0], p1, 0, 0, 0); }
}
__device__ __forceinline__ void partialSM_fix(f32x16& p0) { for (int r = 0; r < 16; ++r) p0[r] = __builtin_amdgcn_exp2f(p0[r]); }
__device__ __forceinline__ int v_st(int k, int c) { const int kk = (k & ~0xC) | ((k & 4) << 1) | ((k & 8) >> 1); return ((kk >> 3) * 4 + (c >> 5)) * 512 + ((kk & 7) * 32 + (c & 31)) * 2; }
__device__ __forceinline__ int v_rd_base(int lane) { return ((lane & 3) << 3) | (((lane >> 2) & 3) << 6) | (((lane >> 4) & 1) << 5) | (((lane >> 5) & 1) << 8); }
constexpr int v_rd_off(int d0, int ks, int half) { return d0 * 512 + ks * 4096 + half * 2048; }
template <int OFF> __device__ __forceinline__ s16x4 tr_read(int vb) {
  s16x4 r; asm volatile("ds_read_b64_tr_b16 %0, %1 offset:%2" : "=&v"(r) : "v"(vb), "i"(OFF) : "memory"); return r;
}
template <int D0> __device__ __forceinline__ void pv_one(f32x16& od, int vb, bf16x8 pa0, bf16x8 pa1, bf16x8 pa2, bf16x8 pa3) {
  const s16x4 l0 = tr_read<v_rd_off(D0, 0, 0)>(vb), h0 = tr_read<v_rd_off(D0, 0, 1)>(vb), l1 = tr_read<v_rd_off(D0, 1, 0)>(vb), h1 = tr_read<v_rd_off(D0, 1, 1)>(vb);
  const s16x4 l2 = tr_read<v_rd_off(D0, 2, 0)>(vb), h2 = tr_read<v_rd_off(D0, 2, 1)>(vb), l3 = tr_read<v_rd_off(D0, 3, 0)>(vb), h3 = tr_read<v_rd_off(D0, 3, 1)>(vb);
  asm volatile("s_waitcnt lgkmcnt(0)" ::: "memory"); SBAR();
#define PK(L, H) (bf16x8){L[0], L[1], L[2], L[3], H[0], H[1], H[2], H[3]}
  od = __builtin_amdgcn_mfma_f32_32x32x16_bf16(pa0, PK(l0, h0), od, 0, 0, 0);
  od = __builtin_amdgcn_mfma_f32_32x32x16_bf16(pa1, PK(l1, h1), od, 0, 0, 0);
  od = __builtin_amdgcn_mfma_f32_32x32x16_bf16(pa2, PK(l2, h2), od, 0, 0, 0);
  od = __builtin_amdgcn_mfma_f32_32x32x16_bf16(pa3, PK(l3, h3), od, 0, 0, 0);
#undef PK
}
__device__ __forceinline__ void pv_d0(f32x16* o, int vb, bf16x8 pa0, bf16x8 pa1, bf16x8 pa2, bf16x8 pa3) {
  pv_one<0>(o[0], vb, pa0, pa1, pa2, pa3); pv_one<1>(o[1], vb, pa0, pa1, pa2, pa3); pv_one<2>(o[2], vb, pa0, pa1, pa2, pa3); pv_one<3>(o[3], vb, pa0, pa1, pa2, pa3);
}
__device__ __forceinline__ void attn_dense_body(const bf16* __restrict__ Qb, const bf16* __restrict__ Kh, const bf16* __restrict__ Vh, bf16* __restrict__ Ob, int seq, LAS char* lds,
                                                const float* __restrict__ qg, const float* __restrict__ ropet, int t0, float negm_u, int exactmax) {
  const int tid = otid(), wid = tid >> 6, lane = tid & 63, r32 = lane & 31, hi = lane >> 5;
  LAS char* V_lds = lds; LAS char* K_lds = lds + 2 * SHM_V;
  LAS float* ws = (LAS float*)(lds + 2 * SHM_V + 2 * SHM_K) + wid * 64; LAS float* li_l = ws;
  float l_reg = 0; f32x16 o[4] = {}; bf16x8 qr[8];
  const bf16* Qw = Qb + (long)(wid * QBLK + r32) * LDQ + hi * 8;
#pragma unroll
  for (int d0 = 0; d0 < 8; ++d0) qr[d0] = ld8(Qw + d0 * 16);
  { float x[8][8]; float ss = 0.f;
#pragma unroll
    for (int d0 = 0; d0 < 8; ++d0) { const u32x4 w = __builtin_bit_cast(u32x4, qr[d0]);
#pragma unroll
      for (int p = 0; p < 4; ++p) { x[d0][2 * p] = bflo(w[p]); x[d0][2 * p + 1] = bfhi(w[p]); ss += x[d0][2 * p] * x[d0][2 * p] + x[d0][2 * p + 1] * x[d0][2 * p + 1]; } }
    { auto rr = __builtin_amdgcn_permlane32_swap(__float_as_uint(ss), __float_as_uint(ss), false, false); ss = __uint_as_float(rr[0]) + __uint_as_float(rr[1]); }
    const float rstd = __builtin_amdgcn_rsqf(ss * (1.f / 128.f) + EPS) * (SCALE * 1.4426950408889634f);
#pragma unroll
    for (int d0 = 0; d0 < 8; ++d0) { const f32x4 g0 = *(const f32x4*)(qg + 16 * d0 + 8 * hi), g1 = *(const f32x4*)(qg + 16 * d0 + 8 * hi + 4);
#pragma unroll
      for (int j = 0; j < 4; ++j) { x[d0][j] *= rstd * g0[j]; x[d0][4 + j] *= rstd * g1[j]; } }
    if (t0 >= 0) { const int t = t0 + wid * QBLK + r32;
#pragma unroll
      for (int kind = 0; kind < 2; ++kind) { const int pos = kind == 0 ? (t >> 6) : (t & 63);
#pragma unroll
        for (int e = 0; e < 2; ++e) { const float* cp = ropet + pos * 32 + 16 * e + 8 * hi;
          const f32x4 c0 = *(const f32x4*)cp, c1 = *(const f32x4*)(cp + 4), s0 = *(const f32x4*)(cp + 2048), s1 = *(const f32x4*)(cp + 2048 + 4);
#pragma unroll
          for (int j = 0; j < 8; ++j) { const float cs = j < 4 ? c0[j & 3] : c1[j & 3], sn = j < 4 ? s0[j & 3] : s1[j & 3];
            const float a1 = x[4 * kind + e][j], a2 = x[4 * kind + 2 + e][j]; x[4 * kind + e][j] = a1 * cs - a2 * sn; x[4 * kind + 2 + e][j] = a2 * cs + a1 * sn; } } } }
#pragma unroll
    for (int d0 = 0; d0 < 8; ++d0) { u32x4 w; w.x = pk2(x[d0][0], x[d0][1]); w.y = pk2(x[d0][2], x[d0][3]); w.z = pk2(x[d0][4], x[d0][5]); w.w = pk2(x[d0][6], x[d0][7]); qr[d0] = __builtin_bit_cast(bf16x8, w); } }
  const int sr = tid >> 4, sc = (tid & 15) * 8, vst0 = v_st(sr, sc), vst1 = v_st(32 + sr, sc);
  const int vb0 = (int)(unsigned)(size_t)V_lds + v_rd_base(lane);
  const unsigned goff = (unsigned)(sr * LDK + sc) * 2u;
  const char* Kb0 = (const char*)Kh; const char* Vb0 = (const char*)Vh;
  const int NT = seq / KVBLK;
  float negm = negm_u;
  if (exactmax) {
    float mrow = -3.0e38f; f32x16 p0, p1;
    for (int j = 0; j < NT; ++j) { const size_t to_ = (size_t)j * KVBLK * LDK * 2;
      const bf16x8 k0 = *(const bf16x8*)(Kb0 + to_ + goff), k1 = *(const bf16x8*)(Kb0 + to_ + (size_t)32 * LDK * 2 + goff);
      __syncthreads();
      *(LAS bf16x8*)(K_lds + KSWZ(sr, sc * 2)) = k0; *(LAS bf16x8*)(K_lds + KSWZ(32 + sr, sc * 2)) = k1;
      __syncthreads();
      qkt(p0, p1, K_lds, qr, r32, hi, 0.f);
#pragma unroll
      for (int r = 0; r < 16; ++r) mrow = fmaxf(mrow, fmaxf(p0[r], p1[r])); }
    { auto rr = __builtin_amdgcn_permlane32_swap(__float_as_uint(mrow), __float_as_uint(mrow), false, false); mrow = fmaxf(__uint_as_float(rr[0]), __uint_as_float(rr[1])); }
    negm = -mrow; __syncthreads(); }
  struct { bf16x8 vs0, vs1, ks0, ks1; } sr_[1];
#define SLOAD(i, k0) do { const size_t to_ = (size_t)(k0) * LDK * 2; \
    sr_[i].vs0 = *(const bf16x8*)(Vb0 + to_ + goff); sr_[i].vs1 = *(const bf16x8*)(Vb0 + to_ + (size_t)32 * LDK * 2 + goff); \
    sr_[i].ks0 = *(const bf16x8*)(Kb0 + to_ + goff); sr_[i].ks1 = *(const bf16x8*)(Kb0 + to_ + (size_t)32 * LDK * 2 + goff); } while (0)
#define SWRITE(b, i) do { *(LAS bf16x8*)(V_lds + (b) * SHM_V + vst0) = sr_[i].vs0;          \
    *(LAS bf16x8*)(V_lds + (b) * SHM_V + vst1) = sr_[i].vs1; int kc = sc * 2;               \
    *(LAS bf16x8*)(K_lds + (b) * SHM_K + KSWZ(sr, kc)) = sr_[i].ks0;                       \
    *(LAS bf16x8*)(K_lds + (b) * SHM_K + KSWZ(32 + sr, kc)) = sr_[i].ks1; } while (0)
#define SWAIT() asm volatile("s_waitcnt vmcnt(0)" ::: "memory")
#define PSM(P0) do { for (int r_ = 0; r_ < 16; ++r_) P0[r_] = __builtin_amdgcn_exp2f(P0[r_]); } while (0)
  f32x16 pA0, pA1, pB0, pB1; bf16x8 pa0, pa1, pa2, pa3;
  constexpr int SE = 0, SO = 0;
  SLOAD(SE, 0); asm volatile("s_waitcnt vmcnt(0)" ::: "memory"); SWRITE(0, SE); __syncthreads();
  qkt(pA0, pA1, K_lds, qr, r32, hi, negm); PSM(pA0);
  SLOAD(SO, KVBLK);
  SWAIT(); SWRITE(1, SO); if (2 < NT) SLOAD(SE, 2 * KVBLK); __syncthreads();
  for (int j = 1; j + 1 < NT; j += 2) {
    SBAR(); qkt(pB0, pB1, K_lds + SHM_K, qr, r32, hi, negm);
    finishSM(pA0, pA1, l_reg, pa0, pa1, pa2, pa3); SBAR();
    pv_d0(o, vb0, pa0, pa1, pa2, pa3); PSM(pB0);
    __syncthreads(); SWAIT(); SWRITE(0, SE); SBAR(); SLOAD(SO, (j + 2) * KVBLK); SBAR();
    __syncthreads();
    SBAR(); qkt(pA0, pA1, K_lds, qr, r32, hi, negm);
    finishSM(pB0, pB1, l_reg, pa0, pa1, pa2, pa3); SBAR();
    pv_d0(o, vb0 + (int)SHM_V, pa0, pa1, pa2, pa3); PSM(pA0);
    __syncthreads(); SWAIT(); SWRITE(1, SO); SBAR(); if (j + 3 < NT) SLOAD(SE, (j + 3) * KVBLK); SBAR();
    __syncthreads();
  }
  SBAR(); qkt(pB0, pB1, K_lds + SHM_K, qr, r32, hi, negm);
  finishSM(pA0, pA1, l_reg, pa0, pa1, pa2, pa3); SBAR();
  pv_d0(o, vb0, pa0, pa1, pa2, pa3); PSM(pB0);
  __syncthreads();
  finishSM(pB0, pB1, l_reg, pa0, pa1, pa2, pa3); SBAR();
  pv_d0(o, vb0 + (int)SHM_V, pa0, pa1, pa2, pa3);
#undef PSM
  if (hi == 0) li_l[r32] = l_reg; asm volatile("s_waitcnt lgkmcnt(0)" ::: "memory");
  float rli[16];
#pragma unroll
  for (int r = 0; r < 16; ++r) rli[r] = __builtin_amdgcn_rcpf(li_l[crow(r, hi)]);
  bf16* Ow = Ob + (long)(wid * QBLK) * LDO;
#pragma unroll
  for (int r = 0; r < 16; ++r) { int orow = crow(r, hi);
    for (int d0 = 0; d0 < 4; ++d0) { if (OUTPROJ_FP8) ((unsigned char*)Ob)[(long)(wid * QBLK + orow) * LDO + d0 * 32 + r32] = (unsigned char)fp8_1(16.f * o[d0][r] * rli[r]); else Ow[(long)orow * LDO + d0 * 32 + r32] = (bf16)f2bf(o[d0][r] * rli[r]); } }
#undef SLOAD
#undef SWRITE
#undef SWAIT
}
}

enum { PH_PRO = 0, PH_NORM1 = 1, PH_INPROJ = 2, PH_PREP = 3, PH_SCAN = 4, PH_ATTN = 5, PH_FINISH = 6, PH_OUTPROJ = 7, PH_ROUTER = 8, PH_DISPATCH = 9, PH_GU = 10, PH_DOWN = 11, PH_COMBINE = 12, NPH = 13 };

struct MapIn  { __device__ __forceinline__ int operator()(int n) const { return n < 2320 ? n + 1024 : n - 2320; } };
struct MapId  { __device__ __forceinline__ int operator()(int n) const { return n; } };
struct MapGU  { __device__ __forceinline__ int operator()(int n) const { const int bj = n >> 10, w = n & 1023; return (w >> 7) * 256 + bj * 128 + (w & 127); } };
struct TrItem { const float* W; unsigned char* WT; int N, kind  , kb, nb, m  ; unsigned* cmax; };
__device__ __forceinline__ int tr_map(int kind, int n) {
    if (kind == 0) return n < 2320 ? n + 1024 : n - 2320;
    if (kind == 2) { const int bj = n >> 10, w = n & 1023; return (w >> 7) * 256 + bj * 128 + (w & 127); }
    return n;
}
__device__ __forceinline__ void tr_load(f32x4 (&v)[16], const TrItem& t, int lane) {
    const int nq = (lane & 15) * 4, kr = lane >> 4; const bool okn = 64 * t.nb + nq < t.N;
#pragma unroll
    for (int j = 0; j < 16; ++j) v[j] = okn ? *(const f32x4*)(t.W + (size_t)(64 * t.kb + kr + 4 * j) * t.N + 64 * t.nb + nq) : (f32x4){0.f, 0.f, 0.f, 0.f};
}
__device__ __forceinline__ void tr_store(const f32x4 (&v)[16], const TrItem& t, LAS float* scr, int lane) {
    const int k0 = 64 * t.kb, n0 = 64 * t.nb, nq = (lane & 15) * 4, kr = lane >> 4;
#pragma unroll
    for (int j = 0; j < 16; ++j) { LAS float* s = scr + (kr + 4 * j) * 65 + nq; s[0] = v[j][0]; s[1] = v[j][1]; s[2] = v[j][2]; s[3] = v[j][3]; }
    LDS_WAIT(); asm volatile("" ::: "memory");
    if (INPROJ_I8 && t.kind == 0) {
        const int n = n0 + lane; float mx = 0.f;
#pragma unroll 8
        for (int k = 0; k < 64; ++k) mx = fmaxf(mx, fabsf(scr[k * 65 + lane]));
        if (n < t.N) __hip_atomic_fetch_max(t.cmax + t.m * PC + tr_map(0, n), __float_as_uint(mx), __ATOMIC_RELAXED, __HIP_MEMORY_SCOPE_AGENT);
        LDS_WAIT(); asm volatile("" ::: "memory"); return; }
    if ((MOE_FP8 && t.kind >= 2) || (OUTPROJ_FP8 && t.kind == 1)) { const int c = lane & 3;
#pragma unroll
        for (int j = 0; j < 4; ++j) { const int nl = (lane >> 2) + 16 * j, n = n0 + nl; const LAS float* s = scr + (16 * c) * 65 + nl;
            u32x4 o; o.x = pk_fp8x4(64.f * s[0 * 65], 64.f * s[1 * 65], 64.f * s[2 * 65], 64.f * s[3 * 65]); o.y = pk_fp8x4(64.f * s[4 * 65], 64.f * s[5 * 65], 64.f * s[6 * 65], 64.f * s[7 * 65]);
            o.z = pk_fp8x4(64.f * s[8 * 65], 64.f * s[9 * 65], 64.f * s[10 * 65], 64.f * s[11 * 65]); o.w = pk_fp8x4(64.f * s[12 * 65], 64.f * s[13 * 65], 64.f * s[14 * 65], 64.f * s[15 * 65]);
            if (n < t.N) *(u32x4*)(t.WT + (size_t)tr_map(t.kind, n) * 1024 + k0 + 16 * c) = o; } }
    else { const int c = lane & 7;
#pragma unroll
        for (int j = 0; j < 8; ++j) { const int nl = (lane >> 3) + 8 * j, n = n0 + nl; const LAS float* s = scr + (8 * c) * 65 + nl;
            u32x4 o; o.x = pk2(s[0 * 65], s[1 * 65]); o.y = pk2(s[2 * 65], s[3 * 65]); o.z = pk2(s[4 * 65], s[5 * 65]); o.w = pk2(s[6 * 65], s[7 * 65]);
            if (n < t.N) *(u32x4*)((bf16*)t.WT + (size_t)tr_map(t.kind, n) * 1024 + k0 + 8 * c) = o; } }
    LDS_WAIT(); asm volatile("" ::: "memory");
}
__device__ __forceinline__ void tr_load_w(f32x4 (&v)[16], const TrItem& t, int lane) {
    const int nq = (lane & 7) * 4, kr = lane >> 3;
#pragma unroll
    for (int j = 0; j < 16; ++j) v[j] = *(const f32x4*)(t.W + (size_t)(128 * t.kb + kr + 8 * j) * t.N + 32 * t.nb + nq);
}
__device__ __forceinline__ void tr_store_w(const f32x4 (&v)[16], const TrItem& t, LAS float* scr, int lane) {
    const int k0 = 128 * t.kb, n0 = 32 * t.nb, nq = (lane & 7) * 4, kr = lane >> 3;
#pragma unroll
    for (int j = 0; j < 16; ++j) { LAS float* s = scr + (kr + 8 * j) * 33 + nq; s[0] = v[j][0]; s[1] = v[j][1]; s[2] = v[j][2]; s[3] = v[j][3]; }
    LDS_WAIT(); asm volatile("" ::: "memory");
    const int c = lane & 7;
#pragma unroll
    for (int j = 0; j < 4; ++j) { const int nl = (lane >> 3) + 8 * j, n = n0 + nl; const LAS float* s = scr + (16 * c) * 33 + nl;
        u32x4 o; o.x = pk_fp8x4(64.f * s[0 * 33], 64.f * s[1 * 33], 64.f * s[2 * 33], 64.f * s[3 * 33]); o.y = pk_fp8x4(64.f * s[4 * 33], 64.f * s[5 * 33], 64.f * s[6 * 33], 64.f * s[7 * 33]);
        o.z = pk_fp8x4(64.f * s[8 * 33], 64.f * s[9 * 33], 64.f * s[10 * 33], 64.f * s[11 * 33]); o.w = pk_fp8x4(64.f * s[12 * 33], 64.f * s[13 * 33], 64.f * s[14 * 33], 64.f * s[15 * 33]);
        *(u32x4*)(t.WT + (size_t)tr_map(t.kind, n) * 1024 + k0 + 16 * c) = o; }
    LDS_WAIT(); asm volatile("" ::: "memory");
}
__device__ __forceinline__ void p_prologue(const Args& a, LAS unsigned char* lds) {
    const int tid = otid(), lane = tid & 63, wave = tid >> 6, G = ogrid(), bid = obid();
    const int gw = bid * NWAVE + wave, NGW = G * NWAVE;
    const int gt = bid * NTHR + tid, NGT = G * NTHR;
    LAS float* scr = (LAS float*)(lds + wave * 16896);
    constexpr int NNB_IN = (NIN + 63) / 64;
    constexpr int I_IN = 16 * NNB_IN, I_OUT = 16 * 16, I_GU = 16 * 32, I_DN = 16 * 16;
    constexpr int T_IN = DEPTH * I_IN, T_OUT = DEPTH * I_OUT, T_GU = DEPTH * NEXP * I_GU, T_DN = DEPTH * NEXP * I_DN;
    constexpr int NITEMS = T_IN + T_OUT + T_GU + T_DN;
    constexpr size_t WB = MOE_FP8 ? 1 : 2;
    auto decode = [&](int it) { TrItem t; int r = it;
        if (r < T_IN) { const int m = r / I_IN, q = r % I_IN; t.W = a.in[8] + (size_t)m * 1024 * NIN; t.WT = a.ws + WS_WIN + (size_t)m * PC * 1024 * 2; t.N = NIN; t.kind = 0; t.kb = q / NNB_IN; t.nb = q % NNB_IN; t.m = m; t.cmax = (unsigned*)(a.ws + WS_CTL) + CW_CMAX; return t; } r -= T_IN;
        if (r < T_OUT) { const int m = r / I_OUT, q = r % I_OUT; t.W = a.in[9] + (size_t)m * 1024 * 1024; t.WT = a.ws + WS_WOUT + (size_t)m * 1024 * 1024 * (OUTPROJ_FP8 ? 1 : 2); t.N = 1024; t.kind = 1; t.kb = q / 16; t.nb = q % 16; return t; } r -= T_OUT;
        if (r < T_GU) { const int m = r / I_GU, q = r % I_GU; t.W = a.in[18] + (size_t)m * 1024 * 2048; t.WT = a.ws + WS_WGU + (size_t)m * 2048 * 1024 * WB; t.N = 2048; t.kind = 2; if (MOE_FP8) { t.kb = q / 64; t.nb = q % 64; } else { t.kb = q / 32; t.nb = q % 32; } return t; } r -= T_GU;
        { const int m = r / I_DN, q = r % I_DN; t.W = a.in[20] + (size_t)m * 1024 * 1024; t.WT = a.ws + WS_WDN + (size_t)m * 1024 * 1024 * WB; t.N = 1024; t.kind = 3; if (MOE_FP8) { t.kb = q / 32; t.nb = q % 32; } else { t.kb = q / 16; t.nb = q % 16; } return t; } };
    if (gw < NITEMS) {
        TrItem cur = decode(gw); f32x4 vc[16]; if (MOE_FP8 && cur.kind >= 2) tr_load_w(vc, cur, lane); else tr_load(vc, cur, lane);
        for (int it = gw; it < NITEMS; it += NGW) {
            const bool more = it + NGW < NITEMS; TrItem nxt = cur; f32x4 vn[16];
            if (more) { nxt = decode(it + NGW); if (MOE_FP8 && nxt.kind >= 2) tr_load_w(vn, nxt, lane); else tr_load(vn, nxt, lane); }
            if (MOE_FP8 && cur.kind >= 2) tr_store_w(vc, cur, scr, lane); else tr_store(vc, cur, scr, lane);
            if (more) { cur = nxt;
#pragma unroll
                for (int j = 0; j < 16; ++j) vc[j] = vn[j]; }
        }
    }
    if (!INPROJ_I8) for (int i = gt; i < DEPTH * (PC - NIN) * 128; i += NGT) { const int m = i / ((PC - NIN) * 128), q = i % ((PC - NIN) * 128);
        *(u32x4*)((bf16*)(a.ws + WS_WIN) + ((size_t)m * PC + NIN) * 1024 + (size_t)q * 8) = (u32x4){0u, 0u, 0u, 0u}; }
    for (int i = gt; i < DEPTH * 32 * 1024; i += NGT) { const int l = i >> 15, e = (i >> 10) & 31, k = i & 1023;
        const float w = a.in[16][((size_t)l * 1024 + k) * 32 + e]; const unsigned h = f2bf(w); const float lo = w - bf2f(h);
        ((bf16*)(a.ws + WS_WRH))[i] = (bf16)h; ((bf16*)(a.ws + WS_WRL))[i] = (bf16)f2bf(lo); }
    for (int i = gt; i < 64 * 32; i += NGT) { const int pos = i >> 5, fi = i & 31;
        const float inv = powf(10000.f, -(float)(2 * fi) / 64.f); const float ang = (float)pos * inv;
        ((float*)(a.ws + WS_ROPE))[i] = cosf(ang); ((float*)(a.ws + WS_ROPE))[2048 + i] = sinf(ang); }
    __syncthreads();
    {
        LAS float* SL = (LAS float*)lds;
        LAS float* PT = (LAS float*)(lds + 40960);
        bool have = false;
        for (int it = bid; it < DEPTH * 96; it += G) {
            if (!have) { for (int i = tid; i < 9 * 1024; i += NTHR) { const float v = i < 8192 ? a.in[1][i] : a.in[3][i - 8192]; SL[i] = v / (1.f + expf(-v)); } have = true; __syncthreads(); }
            const int l = it / 96, n = (it % 96) * 64 + lane;
            const float* W = a.in[4] + ((size_t)l * 1024 + wave * 128) * 6144 + n;
            float acc[9];
#pragma unroll
            for (int j = 0; j < 9; ++j) acc[j] = 0.f;
#pragma unroll 8
            for (int k = 0; k < 128; ++k) { const float w = W[(size_t)k * 6144];
#pragma unroll
                for (int j = 0; j < 9; ++j) acc[j] += SL[j * 1024 + wave * 128 + k] * w; }
#pragma unroll
            for (int j = 0; j < 9; ++j) PT[(wave * 9 + j) * 64 + lane] = acc[j];
            __syncthreads();
            for (int i = tid; i < 9 * 64; i += NTHR) { const int j = i >> 6, c = i & 63; float s = 0.f;
#pragma unroll
                for (int w = 0; w < 8; ++w) s += PT[(w * 9 + j) * 64 + c];
                const int nn = (it % 96) * 64 + c;
                ((float*)(a.ws + WS_MOD))[(size_t)(l * 9 + j) * 6144 + nn] = s + a.in[5][(size_t)l * 6144 + nn]; }
            __syncthreads();
        }
    }
}

__device__ __forceinline__ void norm_mod_store(f32x4 (&v)[2][2], const float* gn, const float* sc, const float* sh, bf16* hrow, int lane) {
    float ss = 0.f;
#pragma unroll
    for (int j = 0; j < 2; ++j)
#pragma unroll
        for (int q = 0; q < 2; ++q) ss += (v[j][q][0] * v[j][q][0] + v[j][q][1] * v[j][q][1]) + (v[j][q][2] * v[j][q][2] + v[j][q][3] * v[j][q][3]);
    const float rstd = 1.f / sqrtf(wave_sum(ss) * (1.f / DM) + EPS);
#pragma unroll
    for (int j = 0; j < 2; ++j) { const int c = 8 * lane + 512 * j;
#pragma unroll
        for (int q = 0; q < 2; ++q) { const f32x4 g = *(const f32x4*)(gn + c + 4 * q), s1 = *(const f32x4*)(sc + c + 4 * q), s0 = *(const f32x4*)(sh + c + 4 * q);
            v[j][q] = v[j][q] * rstd * g * (1.f + s1) + s0; }
        if (hrow) { u32x4 w; w.x = pk2(v[j][0][0], v[j][0][1]); w.y = pk2(v[j][0][2], v[j][0][3]); w.z = pk2(v[j][1][0], v[j][1][1]); w.w = pk2(v[j][1][2], v[j][1][3]);
            *(u32x4*)(hrow + c) = w; } }
}
__device__ __forceinline__ void load_row_bf(const bf16* xr, f32x4 (&v)[2][2], int lane) {
#pragma unroll
    for (int j = 0; j < 2; ++j) { const u32x4 w = *(const u32x4*)(xr + 8 * lane + 512 * j);
        v[j][0] = (f32x4){bflo(w.x), bfhi(w.x), bflo(w.y), bfhi(w.y)}; v[j][1] = (f32x4){bflo(w.z), bfhi(w.z), bflo(w.w), bfhi(w.w)}; }
}
__device__ __forceinline__ void load_row(const float* xr, f32x4 (&v)[2][2], int lane) {
#pragma unroll
    for (int j = 0; j < 2; ++j)
#pragma unroll
        for (int q = 0; q < 2; ++q) v[j][q] = *(const f32x4*)(xr + 8 * lane + 512 * j + 4 * q);
}

__device__ __forceinline__ void p_quant_win(const Args& a) {
    const int gt = obid() * NTHR + otid(), NGT = ogrid() * NTHR;
    const unsigned* CM = (const unsigned*)(a.ws + WS_CTL) + CW_CMAX; float* WSC = (float*)(a.ws + WS_WSC); unsigned char* W8 = (unsigned char*)(a.ws + WS_WIN);
    for (int idx = gt; idx < DEPTH * 64 * PC; idx += NGT) { const int l = idx / (64 * PC), rem = idx - l * (64 * PC), kc = rem / PC, j = rem - kc * PC;
        u32x4 o = {0u, 0u, 0u, 0u}; float s = 0.f;
        if (j < NIN) { const int n = j < 1024 ? j + 2320 : j - 1024; const float cm = __uint_as_float(__hip_atomic_load(CM + l * PC + j, __ATOMIC_RELAXED, __HIP_MEMORY_SCOPE_AGENT));
            s = cm * (1.f / 127.f); const float inv = cm > 0.f ? 127.f / cm : 0.f; const float* wp = a.in[8] + ((size_t)l * 1024 + 16 * kc) * NIN + n; float w[16];
#pragma unroll
            for (int i = 0; i < 16; ++i) w[i] = wp[(size_t)i * NIN] * inv;
            o.x = pk_i8x4(w[0], w[1], w[2], w[3]); o.y = pk_i8x4(w[4], w[5], w[6], w[7]); o.z = pk_i8x4(w[8], w[9], w[10], w[11]); o.w = pk_i8x4(w[12], w[13], w[14], w[15]); }
        *(u32x4*)(W8 + ((size_t)l * PC + j) * 1024 + 16 * kc) = o;
        if (kc == 0) WSC[l * PC + j] = s; }
}
__device__ __forceinline__ void store_row_i8(const f32x4 (&v)[2][2], unsigned char* hrow, float* hs, int lane) {
    float mx = 0.f;
#pragma unroll
    for (int j = 0; j < 2; ++j)
#pragma unroll
        for (int q = 0; q < 2; ++q) mx = fmaxf(fmaxf(mx, fmaxf(fabsf(v[j][q][0]), fabsf(v[j][q][1]))), fmaxf(fabsf(v[j][q][2]), fabsf(v[j][q][3])));
    mx = fmaxf(wave_max_nn(mx), 1e-20f); const float inv = 127.f / mx;
#pragma unroll
    for (int j = 0; j < 2; ++j) { u32x2 w; w.x = pk_i8x4(v[j][0][0] * inv, v[j][0][1] * inv, v[j][0][2] * inv, v[j][0][3] * inv); w.y = pk_i8x4(v[j][1][0] * inv, v[j][1][1] * inv, v[j][1][2] * inv, v[j][1][3] * inv);
        *(u32x2*)(hrow + 8 * lane + 512 * j) = w; }
    if (lane == 0) *hs = mx * (1.f / 127.f);
}
__device__ __forceinline__ void p_norm1(const Args& a, int layer) {
    const int tid = otid(), lane = tid & 63, wave = tid >> 6; const int gw = obid() * NWAVE + wave, NGW = ogrid() * NWAVE;
    bf16* H = (bf16*)(a.ws + WS_H);
    for (int r = gw; r < NR; r += NGW) { f32x4 v[2][2]; load_row(x_rd(a, layer == 0, r), v, lane);
        norm_mod_store(v, a.in[6] + (size_t)layer * DM, modv(a, layer, r, 1), modv(a, layer, r, 0), INPROJ_I8 ? (bf16*)nullptr : H + (size_t)r * DM, lane);
        if (INPROJ_I8) store_row_i8(v, (unsigned char*)(a.ws + WS_H) + (size_t)r * DM, (float*)(a.ws + WS_HSC) + r, lane); }
}

__device__ __forceinline__ void p_prep(const Args& a, int layer, bool dry = false) {
    const int tid = otid(), lane = tid & 63, wave = tid >> 6; const int gw = obid() * NWAVE + wave, NGW = ogrid() * NWAVE;
    bf16* P = (bf16*)(a.ws + WS_P); const float* COS = (const float*)(a.ws + WS_ROPE); const float* SIN = COS + 2048;
    const int half = lane >> 5, fi = lane & 31;
    const float gq1 = a.in[14][layer * 128 + half * 64 + fi], gq2 = a.in[14][layer * 128 + half * 64 + 32 + fi];
    const float gk1 = a.in[15][layer * 128 + half * 64 + fi], gk2 = a.in[15][layer * 128 + half * 64 + 32 + fi];
    for (int r = gw; r < NR; r += NGW) { const int s = r % SB; const bool lat = s >= CTX; const int t = s - CTX;
        float cs = 1.f, sn = 0.f;
        if (lat) { const int pos = half == 0 ? (t >> 6) : (t & 63); cs = COS[pos * 32 + fi]; sn = SIN[pos * 32 + fi]; }
        bf16* pr = P + (size_t)r * PC;
#pragma unroll
        for (int hh = 4; hh < 6; ++hh) { bf16* p1 = pr + hh * 128 + half * 64 + fi;
            const float x1 = bf2f(p1[0]), x2 = bf2f(p1[32]);
            const float rstd = __builtin_amdgcn_rsqf(wave_sum(x1 * x1 + x2 * x2) * (1.f / 128.f) + EPS);
            const float y1 = x1 * rstd * gk1, y2 = x2 * rstd * gk2;
            bf16* po = dry ? (bf16*)(a.ws + WS_ACT) + (size_t)r * 1024 + hh * 128 + half * 64 + fi : p1;
            po[0] = (bf16)f2bf(y1 * cs - y2 * sn); po[32] = (bf16)f2bf(y2 * cs + y1 * sn); }
    }
}

__device__ __forceinline__ int seq_step_s(int dir, int n) { return dir == 0 ? n : (n < CTX ? CTX - 1 - n : SB + CTX - 1 - n); }
__device__ __forceinline__ void hg_seq(const Args& a, int layer, int sid, LAS unsigned char* lds) {
    const int tid = otid(), lane = tid & 63, wave = tid >> 6;
    const int dir = sid & 1, h = (sid >> 1) & 3, b = sid >> 3;
    LAS float* qs = (LAS float*)lds; LAS float* ks = qs + 2048; LAS float* fs = ks + 2048; LAS float* vs = fs + 2048; LAS float* part = vs + 2048;
    const bf16* P = (const bf16*)(a.ws + WS_P);
    float* OH = (float*)(a.ws + WS_OH) + (size_t)dir * NR * 256;
    float lb;
    { const float* lg = a.in[10] + (size_t)dir * DEPTH * 256 + h * 64 + lane;
      const float l0 = lg[0], l1 = lg[256], l2 = lg[512], l3 = lg[768]; const float mx = fmaxf(fmaxf(l0, l1), fmaxf(l2, l3));
      const float e0 = expf(l0 - mx), e1 = expf(l1 - mx), e2 = expf(l2 - mx), e3 = expf(l3 - mx);
      lb = ((layer >= 1 ? e1 : 0.f) + (layer >= 2 ? e2 : 0.f) + (layer >= 3 ? e3 : 0.f)) / (e0 + e1 + e2 + e3); }
    float S[8];
#pragma unroll
    for (int i = 0; i < 8; ++i) S[i] = 0.f;
    for (int n0 = 0; n0 < SB; n0 += 32) {
#pragma unroll
        for (int jj = 0; jj < 4; ++jj) { const int j = wave + 8 * jj; const int s = seq_step_s(dir, n0 + j);
            const bf16* pr = P + (size_t)(b * SB + s) * PC + h * 64 + lane;
            const float q = bf2f(pr[C_HGQ]), z = bf2f(pr[dir ? C_HGZB : C_HGZF]), v = bf2f(pr[C_HGV]);
            const float sg = 1.f / (1.f + expf(-z));
            qs[j * 64 + lane] = q; fs[j * 64 + lane] = lb + (1.f - lb) * sg; ks[j * 64 + lane] = (1.f - lb) * (1.f - sg); vs[j * 64 + lane] = v; }
        __syncthreads();
        for (int j = 0; j < 32; ++j) { const float v = vs[j * 64 + lane]; float p = 0.f;
#pragma unroll
            for (int i = 0; i < 8; ++i) { const int d = wave * 8 + i; S[i] = fs[j * 64 + d] * S[i] + ks[j * 64 + d] * v; p += S[i] * qs[j * 64 + d]; }
            part[(wave * 32 + j) * 64 + lane] = p; }
        __syncthreads();
#pragma unroll
        for (int jj = 0; jj < 4; ++jj) { const int j = wave + 8 * jj; float o = 0.f;
#pragma unroll
            for (int w = 0; w < 8; ++w) o += part[(w * 32 + j) * 64 + lane];
            const int s = seq_step_s(dir, n0 + j); OH[(size_t)(b * SB + s) * 256 + h * 64 + lane] = o; }
        __syncthreads();
    }
}
__device__ __forceinline__ void ml_seq(const Args& a, int layer, int sid, LAS unsigned char* lds) {
    const int tid = otid(), lane = tid & 63, wave = tid >> 6;
    const int dir = sid & 1, h = (sid >> 1) & 3, b = sid >> 3;
    LAS float* qs = (LAS float*)lds; LAS float* ks = qs + 2048; LAS float* vs = ks + 2048; LAS float* part = vs + 2048;
    LAS float* ip = part + 8 * 2048; LAS float* lf = ip + 32; LAS float* dp = lf + 32; LAS float* ms = dp + 8 * 32;
    const bf16* P = (const bf16*)(a.ws + WS_P);
    float* OM = (float*)(a.ws + WS_OM) + (size_t)dir * NR * 256;
    const float bi = a.in[12][layer * 16 + dir * 4 + h], bfg = a.in[12][layer * 16 + 8 + dir * 4 + h];
    float C[8], nn[8], m = 0.f;
#pragma unroll
    for (int i = 0; i < 8; ++i) { C[i] = 0.f; nn[i] = 0.f; }
    for (int n0 = 0; n0 < SB; n0 += 32) {
#pragma unroll
        for (int jj = 0; jj < 4; ++jj) { const int j = wave + 8 * jj; const int s = seq_step_s(dir, n0 + j);
            const bf16* pr = P + (size_t)(b * SB + s) * PC;
            qs[j * 64 + lane] = bf2f(pr[C_MLQ + h * 64 + lane]); ks[j * 64 + lane] = bf2f(pr[C_MLK + h * 64 + lane]) * 0.125f; vs[j * 64 + lane] = bf2f(pr[C_MLV + h * 64 + lane]);
            if (lane == 0) { ip[j] = bf2f(pr[C_MLG + dir * 4 + h]) + bi; const float fp = bf2f(pr[C_MLG + 8 + dir * 4 + h]) + bfg;
                lf[j] = fminf(fp, 0.f) - log1pf(expf(-fabsf(fp))); } }
        __syncthreads();
        for (int j = 0; j < 32; ++j) { const float v = vs[j * 64 + lane]; const float ipj = ip[j], lfj = lf[j];
            const float mn = fmaxf(lfj + m, ipj); const float aa = expf(lfj + m - mn), bb = expf(ipj - mn); m = mn;
            float p = 0.f, dn = 0.f;
#pragma unroll
            for (int i = 0; i < 8; ++i) { const int d = wave * 8 + i; const float kk = ks[j * 64 + d] * bb, qq = qs[j * 64 + d];
                C[i] = aa * C[i] + kk * v; nn[i] = aa * nn[i] + kk; p += C[i] * qq; dn += nn[i] * qq; }
            part[(wave * 32 + j) * 64 + lane] = p; if (lane == 0) { dp[wave * 32 + j] = dn; if (wave == 0) ms[j] = mn; } }
        __syncthreads();
#pragma unroll
        for (int jj = 0; jj < 4; ++jj) { const int j = wave + 8 * jj; float o = 0.f, dn = 0.f;
#pragma unroll
            for (int w = 0; w < 8; ++w) { o += part[(w * 32 + j) * 64 + lane]; dn += dp[w * 32 + j]; }
            const int s = seq_step_s(dir, n0 + j); OM[(size_t)(b * SB + s) * 256 + h * 64 + lane] = o / fmaxf(fabsf(dn), expf(-ms[j])); }
        __syncthreads();
    }
}
__device__ __forceinline__ void p_scan(const Args& a, int layer, LAS unsigned char* lds, int do_hg, int do_ml) {
    for (int u = obid(); u < 128; u += ogrid()) { if (u < 64) { if (do_hg) hg_seq(a, layer, u, lds); } else { if (do_ml) ml_seq(a, layer, u - 64, lds); } }
}


namespace scan {
constexpr int NCH = 68, NTASK = NB * 4 * 2 * NCH;
__device__ __forceinline__ int swz(int row, int unit) { return row * 128 + ((unit ^ ((row >> 1) & 7)) << 4); }
__device__ __forceinline__ bf16x8 frag(const LAS char* arr, int row, int unit) { return *(const LAS bf16x8*)(arr + swz(row, unit)); }
__device__ __forceinline__ void put2(LAS char* arr, int row, int col_even, float lo, float hi) { *(LAS unsigned*)(arr + swz(row, col_even >> 3) + (col_even & 7) * 2) = pk2(lo, hi); }
__device__ __forceinline__ void put1(LAS char* arr, int row, int col, float x) { *(LAS bf16*)(arr + swz(row, col >> 3) + (col & 7) * 2) = (bf16)f2bf(x); }
__device__ __forceinline__ int crow(int r, int hh) { return (r & 3) + 8 * (r >> 2) + 4 * hh; }
__device__ __forceinline__ void mm64(f32x16 (&acc)[2][2], const LAS char* A, const LAS char* B, int r32, int hh, int skip_a, int skip_b) {
#pragma unroll
    for (int st = 0; st < 4; ++st) { bf16x8 af[2], bfr[2];
#pragma unroll
        for (int i = 0; i < 2; ++i) { af[i] = frag(A, 32 * i + r32, 2 * st + hh); bfr[i] = frag(B, 32 * i + r32, 2 * st + hh); }
#pragma unroll
        for (int ai = 0; ai < 2; ++ai)
#pragma unroll
            for (int bi = 0; bi < 2; ++bi) if (!(ai == skip_a && bi == skip_b)) acc[ai][bi] = __builtin_amdgcn_mfma_f32_32x32x16_bf16(af[ai], bfr[bi], acc[ai][bi], 0, 0, 0); }
}
#define SC_PK4(P, BASE, OUT) do { unsigned a0 = pk2(P[BASE + 0], P[BASE + 1]), a1 = pk2(P[BASE + 2], P[BASE + 3]);   \
    unsigned b0 = pk2(P[BASE + 4], P[BASE + 5]), b1 = pk2(P[BASE + 6], P[BASE + 7]);                              \
    auto r0 = __builtin_amdgcn_permlane32_swap(a0, b0, false, false); auto r1 = __builtin_amdgcn_permlane32_swap(a1, b1, false, false); \
    u32x4 w = {r0[0], r1[0], r0[1], r1[1]}; OUT = __builtin_bit_cast(bf16x8, w); } while (0)
__device__ __forceinline__ float hg_lb(const Args& a, int layer, int dir, int h, int lane) {
    const float* lg = a.in[10] + (size_t)dir * DEPTH * 256 + h * 64 + lane;
    const float l0 = lg[0], l1 = lg[256], l2 = lg[512], l3 = lg[768]; const float mx = fmaxf(fmaxf(l0, l1), fmaxf(l2, l3));
    const float e0 = __expf(l0 - mx), e1 = __expf(l1 - mx), e2 = __expf(l2 - mx), e3 = __expf(l3 - mx);
    return ((layer >= 1 ? e1 : 0.f) + (layer >= 2 ? e2 : 0.f) + (layer >= 3 ? e3 : 0.f)) / (e0 + e1 + e2 + e3);
}
__device__ __forceinline__ float scan_add(float x, int lane, int dir) {
#pragma unroll
    for (int o = 1; o < 64; o <<= 1) { const float y = dir ? __shfl_down(x, o) : __shfl_up(x, o); const bool ok = dir ? (lane + o < 64) : (lane >= o); x += ok ? y : 0.f; }
    return x;
}
__device__ __forceinline__ float scan_max(float x, int lane, int dir) {
#pragma unroll
    for (int o = 1; o < 64; o <<= 1) { const float y = dir ? __shfl_down(x, o) : __shfl_up(x, o); const bool ok = dir ? (lane + o < 64) : (lane >= o); x = ok ? fmaxf(x, y) : x; }
    return x;
}
__device__ __forceinline__ float wave_max(float v) {
#pragma unroll
    for (int o = 1; o < 64; o <<= 1) v = fmaxf(v, __shfl_xor(v, o));
    return v;
}
__device__ __forceinline__ float logsig(float x) { return fminf(x, 0.f) - __logf(1.f + __expf(-fabsf(x))); }
__device__ __forceinline__ void store_ut(bf16* UT, const f32x16 (&acc)[2][2], int r32, int hh) {
#pragma unroll
    for (int vi = 0; vi < 2; ++vi)
#pragma unroll
        for (int di = 0; di < 2; ++di)
#pragma unroll
            for (int rg = 0; rg < 16; ++rg) UT[(32 * vi + crow(rg, hh)) * 64 + 32 * di + r32] = (bf16)f2bf(acc[vi][di][rg]);
}
__device__ __forceinline__ void stage_vt(LAS char* X, const bf16* Pr, int vcol, int lane) {
#pragma unroll 8
    for (int p = 0; p < 32; ++p) put2(X, lane, 2 * p, bf2f(Pr[(size_t)(2 * p) * PC + vcol + lane]), bf2f(Pr[(size_t)(2 * p + 1) * PC + vcol + lane]));
}
__device__ __forceinline__ void stage_copy(LAS char* X, const bf16* G, int ldg, int lane) {
#pragma unroll
    for (int j = 0; j < 8; ++j) { const int u = lane + 64 * j, row = u >> 3, unit = u & 7; *(LAS u32x4*)(X + swz(row, unit)) = *(const u32x4*)(G + (size_t)row * ldg + unit * 8); }
}

__device__ __forceinline__ int tile8_row(int lane, int j) { return 2 * (lane >> 3) + (j & 1) + 16 * (j >> 1); }
__device__ __forceinline__ void load_tile8(u32x4 (&vr)[8], const bf16* G, int ldg, int lane) {
#pragma unroll
    for (int j = 0; j < 8; ++j) vr[j] = *(const u32x4*)(G + (size_t)tile8_row(lane, j) * ldg + 8 * (lane & 7));
}
__device__ __forceinline__ void put_tile8_t(LAS char* X, const u32x4 (&vr)[8], int lane) {
#pragma unroll
    for (int j = 0; j < 8; j += 2) { const int t = tile8_row(lane, j);
#pragma unroll
        for (int e = 0; e < 8; ++e) { const int v = 8 * (lane & 7) + e; const unsigned w0 = vr[j][e >> 1], w1 = vr[j + 1][e >> 1];
            const unsigned pk = (e & 1) ? ((w0 >> 16) | (w1 & 0xffff0000u)) : ((w0 & 0xffffu) | (w1 << 16));
            *(LAS unsigned*)(X + swz(v, t >> 3) + (t & 7) * 2) = pk; } }
}
__device__ __forceinline__ void put_tile8(LAS char* X, const u32x4 (&vr)[8], int lane) {
#pragma unroll
    for (int j = 0; j < 8; ++j) *(LAS u32x4*)(X + swz(tile8_row(lane, j), lane & 7)) = vr[j];
}
__device__ __forceinline__ float get1(const LAS char* arr, int row, int col) { return bf2f(*(const LAS bf16*)(arr + swz(row, col >> 3) + (col & 7) * 2)); }

__device__ __forceinline__ void hgA(const Args& a, int layer, int b, int c, int h, int dir, LAS char* X, LAS char* Y, int lane) {
    const bf16* Pr = (const bf16*)(a.ws + WS_P) + (size_t)(b * SB + 64 * c) * PC;
    stage_copy(X, Pr + (dir ? C_HGZB : C_HGZF) + h * 64, PC, lane);
    u32x4 vr[8]; load_tile8(vr, Pr + C_HGV + h * 64, PC, lane);
    const float lb = hg_lb(a, layer, dir, h, lane), omlb = 1.f - lb;
    float R = 1.f;
#pragma unroll 4
    for (int p = 0; p < 32; ++p) { const int t0 = dir ? 2 * p : 63 - 2 * p, t1 = dir ? 2 * p + 1 : 62 - 2 * p;
        const float f0 = lb + omlb * sigm(get1(X, t0, lane)); const float k0 = (1.f - f0) * R; R *= f0;
        const float f1 = lb + omlb * sigm(get1(X, t1, lane)); const float k1 = (1.f - f1) * R; R *= f1;
        put2(Y, lane, dir ? t0 : t1, dir ? k0 : k1, dir ? k1 : k0); }
    put_tile8_t(X, vr, lane);
    const int tk = ((b * 4 + h) * 2 + dir) * NCH + c;
    ((float*)(a.ws + WS_DT))[(size_t)tk * 64 + lane] = R;
    f32x16 acc[2][2] = {};
    mm64(acc, X, Y, lane & 31, lane >> 5, -1, -1);
    store_ut((bf16*)(a.ws + WS_UTH) + (size_t)tk * 4096, acc, lane & 31, lane >> 5);
}
__device__ __forceinline__ void mlA(const Args& a, int layer, int b, int c, int h, int dir, LAS char* X, LAS char* Y, int lane) {
    const bf16* Pr = (const bf16*)(a.ws + WS_P) + (size_t)(b * SB + 64 * c) * PC;
    stage_copy(X, Pr + C_MLK + h * 64, PC, lane);
    u32x4 vr[8]; load_tile8(vr, Pr + C_MLV + h * 64, PC, lane);
    const float ip = bf2f(Pr[(size_t)lane * PC + C_MLG + dir * 4 + h]) + a.in[12][layer * 16 + dir * 4 + h];
    const float lf = logsig(bf2f(Pr[(size_t)lane * PC + C_MLG + 8 + dir * 4 + h]) + a.in[12][layer * 16 + 8 + dir * 4 + h]);
    const float bt = scan_add(lf, lane, dir), g = wave_sum(lf);
    const float at = g - bt + ip, l = wave_max(at), w = __expf(at - l);
    float nu = 0.f;
#pragma unroll
    for (int p = 0; p < 32; ++p) { const float w0 = __builtin_bit_cast(float, __builtin_amdgcn_readlane(__builtin_bit_cast(int, w), 2 * p)), w1 = __builtin_bit_cast(float, __builtin_amdgcn_readlane(__builtin_bit_cast(int, w), 2 * p + 1));
        const float k0 = get1(X, 2 * p, lane) * 0.125f * w0, k1 = get1(X, 2 * p + 1, lane) * 0.125f * w1;
        nu += k0 + k1; put2(Y, lane, 2 * p, k0, k1); }
    put_tile8_t(X, vr, lane);
    const int tk = ((b * 4 + h) * 2 + dir) * NCH + c;
    ((float*)(a.ws + WS_NU))[(size_t)tk * 64 + lane] = nu;
    if (lane == 0) { ((float*)(a.ws + WS_GL))[tk * 2] = g; ((float*)(a.ws + WS_GL))[tk * 2 + 1] = l; }
    f32x16 acc[2][2] = {};
    mm64(acc, X, Y, lane & 31, lane >> 5, -1, -1);
    store_ut((bf16*)(a.ws + WS_UTM) + (size_t)tk * 4096, acc, lane & 31, lane >> 5);
}
__device__ __forceinline__ void p_scanA(const Args& a, int layer, LAS unsigned char* lds, int do_hg, int do_ml) {
    const int tid = otid(), lane = tid & 63, wave = __builtin_amdgcn_readfirstlane(tid >> 6), G = ogrid(), h = wave >> 1, dir = wave & 1;
    LAS char* X = (LAS char*)lds + wave * 16384; LAS char* Y = X + 8192;
    for (int u = obid(); u < 2 * NB * NCH; u += G) { const int mixer = u / (NB * NCH), q = u % (NB * NCH), b = q / NCH, c = q % NCH;
        int ln = lane; asm volatile("" : "+v"(ln));
        if (mixer == 0) { if (do_hg) hgA(a, layer, b, c, h, dir, X, Y, ln); } else { if (do_ml) mlA(a, layer, b, c, h, dir, X, Y, ln); } }
}

__device__ __forceinline__ int chunk_of(int dir, int k) { return dir == 0 ? k : (k < 4 ? 3 - k : NCH + 3 - k); }
__device__ __forceinline__ void p_scanB(const Args& a, int do_hg, int do_ml) {
    const int tid = otid(), G = ogrid();
    for (int g = obid() * NTHR + tid; g < 128 * 1024; g += G * NTHR) {
        const int seq = g >> 10, mixer = seq >> 6, sq = seq & 63, dir = sq & 1, e4 = g & 1023, d0 = (e4 & 15) * 4;
        if (mixer == 0) { if (!do_hg) continue;
            const bf16* UT = (const bf16*)(a.ws + WS_UTH); bf16* SP = (bf16*)(a.ws + WS_SPH); const float* DT = (const float*)(a.ws + WS_DT);
            f32x4 S = {0.f, 0.f, 0.f, 0.f};
#pragma unroll 4
            for (int k = 0; k < NCH; ++k) { const size_t tk = (size_t)sq * NCH + chunk_of(dir, k);
                const u32x2 u = *(const u32x2*)(UT + tk * 4096 + e4 * 4); const f32x4 dd = *(const f32x4*)(DT + tk * 64 + d0);
                u32x2 o; o.x = pk2(S[0], S[1]); o.y = pk2(S[2], S[3]); *(u32x2*)(SP + tk * 4096 + e4 * 4) = o;
                S = S * dd + (f32x4){bflo(u.x), bfhi(u.x), bflo(u.y), bfhi(u.y)}; }
        } else { if (!do_ml) continue;
            const bf16* UT = (const bf16*)(a.ws + WS_UTM); bf16* SP = (bf16*)(a.ws + WS_SPM); const float* NU = (const float*)(a.ws + WS_NU);
            float* NP = (float*)(a.ws + WS_NP); const float* GL = (const float*)(a.ws + WS_GL); float* MP = (float*)(a.ws + WS_MP);
            f32x4 S = {0.f, 0.f, 0.f, 0.f}, n = {0.f, 0.f, 0.f, 0.f}; float m = 0.f;
#pragma unroll 4
            for (int k = 0; k < NCH; ++k) { const size_t tk = (size_t)sq * NCH + chunk_of(dir, k);
                const u32x2 u = *(const u32x2*)(UT + tk * 4096 + e4 * 4); const f32x4 nu = *(const f32x4*)(NU + tk * 64 + d0); const f32x2 gl = *(const f32x2*)(GL + tk * 2);
                u32x2 o; o.x = pk2(S[0], S[1]); o.y = pk2(S[2], S[3]); *(u32x2*)(SP + tk * 4096 + e4 * 4) = o;
                if (e4 < 16) { *(f32x4*)(NP + tk * 64 + d0) = n; if (e4 == 0) MP[tk] = m; }
                const float mn = fmaxf(gl[0] + m, gl[1]), aa = __expf(gl[0] + m - mn), bb = __expf(gl[1] - mn); m = mn;
                S = S * aa + (f32x4){bflo(u.x), bfhi(u.x), bflo(u.y), bfhi(u.y)} * bb; n = n * aa + nu * bb; }
        }
    }
}

__device__ __forceinline__ void hgC(const Args& a, int layer, int b, int c, int h, int dir, LAS char* X, LAS char* Y, int lane) {
    const int r32 = lane & 31, hh = lane >> 5;
    const bf16* Pr = (const bf16*)(a.ws + WS_P) + (size_t)(b * SB + 64 * c) * PC;
    const int tk = ((b * 4 + h) * 2 + dir) * NCH + c;
    u32x4 qr_[8], zr_[8], vr[8], sp[8];
    load_tile8(qr_, Pr + C_HGQ + h * 64, PC, lane); load_tile8(zr_, Pr + (dir ? C_HGZB : C_HGZF) + h * 64, PC, lane);
    load_tile8(vr, Pr + C_HGV + h * 64, PC, lane); load_tile8(sp, (const bf16*)(a.ws + WS_SPH) + (size_t)tk * 4096, 64, lane);
    put_tile8(X, qr_, lane); put_tile8(Y, zr_, lane);
    const float lb = hg_lb(a, layer, dir, h, lane), omlb = 1.f - lb;
    float Gp = 1.f;
#pragma unroll 4
    for (int i = 32; i < 64; ++i) { const int t = dir ? 63 - i : i; const float f = lb + omlb * sigm(get1(Y, t, lane)); Gp *= f;
        const float q = get1(X, t, lane) * Gp, k = (1.f - f) * __builtin_amdgcn_rcpf(Gp); put1(X, t, lane, q); put1(Y, t, lane, k); }
    float Hp = 1.f;
#pragma unroll 4
    for (int i = 31; i >= 0; --i) { const int t = dir ? 63 - i : i; const float f = lb + omlb * sigm(get1(Y, t, lane));
        const float q = get1(X, t, lane) * __builtin_amdgcn_rcpf(Hp), k = (1.f - f) * Hp; Hp *= f; put1(X, t, lane, q); put1(Y, t, lane, k); }
    f32x16 sc[2][2] = {};
    mm64(sc, Y, X, r32, hh, dir ? 0 : 1, dir ? 1 : 0);
    bf16x8 pa[2][4];
#pragma unroll
    for (int ti = 0; ti < 2; ++ti)
#pragma unroll
        for (int si = 0; si < 2; ++si) { const bool dead = dir ? (si == 0 && ti == 1) : (si == 1 && ti == 0);
            if (dead) { pa[ti][2 * si] = (bf16x8){0, 0, 0, 0, 0, 0, 0, 0}; pa[ti][2 * si + 1] = (bf16x8){0, 0, 0, 0, 0, 0, 0, 0}; }
            else { f32x16 p = sc[si][ti];
                if (si == ti) {
#pragma unroll
                    for (int rg = 0; rg < 16; ++rg) { const int s = crow(rg, hh); const bool ok = dir ? (s >= r32) : (s <= r32); p[rg] = ok ? p[rg] : 0.f; } }
                SC_PK4(p, 0, pa[ti][2 * si]); SC_PK4(p, 8, pa[ti][2 * si + 1]); } }
    { const float eb = Hp;
#pragma unroll 8
      for (int t = 0; t < 64; ++t) put1(Y, t, lane, get1(X, t, lane) * eb); }
    put_tile8_t(X, vr, lane);
    f32x16 o[2][2] = {};
#pragma unroll
    for (int ss = 0; ss < 4; ++ss) { bf16x8 vf[2];
#pragma unroll
        for (int vi = 0; vi < 2; ++vi) vf[vi] = frag(X, 32 * vi + r32, 2 * ss + hh);
#pragma unroll
        for (int ti = 0; ti < 2; ++ti)
#pragma unroll
            for (int vi = 0; vi < 2; ++vi) o[ti][vi] = __builtin_amdgcn_mfma_f32_32x32x16_bf16(pa[ti][ss], vf[vi], o[ti][vi], 0, 0, 0); }
    put_tile8(X, sp, lane);
    mm64(o, Y, X, r32, hh, -1, -1);
    LAS float* O = (LAS float*)X;
#pragma unroll
    for (int ti = 0; ti < 2; ++ti)
#pragma unroll
        for (int vi = 0; vi < 2; ++vi)
#pragma unroll
            for (int rg = 0; rg < 16; ++rg) O[(32 * ti + crow(rg, hh)) * 64 + 32 * vi + r32] = o[ti][vi][rg];
}
__device__ __forceinline__ void mlC(const Args& a, int layer, int b, int c, int h, int dir, LAS char* X, LAS char* Y, LAS float* T, int lane) {
    const int r32 = lane & 31, hh = lane >> 5;
    const bf16* Pr = (const bf16*)(a.ws + WS_P) + (size_t)(b * SB + 64 * c) * PC;
    const int tk = ((b * 4 + h) * 2 + dir) * NCH + c;
    LAS float* TMU = T; LAS float* TCS = T + 64; LAS float* TEM = T + 128; LAS float* TAP = T + 192;
    { const float ip = bf2f(Pr[(size_t)lane * PC + C_MLG + dir * 4 + h]) + a.in[12][layer * 16 + dir * 4 + h];
      const float lf = logsig(bf2f(Pr[(size_t)lane * PC + C_MLG + 8 + dir * 4 + h]) + a.in[12][layer * 16 + 8 + dir * 4 + h]);
      const float bt = scan_add(lf, lane, dir), cs = ip - bt, mp = ((const float*)(a.ws + WS_MP))[tk];
      const float mu = fmaxf(mp, scan_max(cs, lane, dir));
      TMU[lane] = mu; TCS[lane] = cs; TEM[lane] = __expf(-bt - mu); TAP[lane] = __expf(mp - mu); }
    u32x4 qr_[8], kr_[8], vr[8], sp[8];
    load_tile8(qr_, Pr + C_MLQ + h * 64, PC, lane); load_tile8(kr_, Pr + C_MLK + h * 64, PC, lane);
    load_tile8(vr, Pr + C_MLV + h * 64, PC, lane); load_tile8(sp, (const bf16*)(a.ws + WS_SPM) + (size_t)tk * 4096, 64, lane);
    put_tile8(X, qr_, lane); put_tile8(Y, kr_, lane);
    f32x16 sc[2][2] = {};
    mm64(sc, Y, X, r32, hh, dir ? 0 : 1, dir ? 1 : 0);
    bf16x8 pa[2][4];
#pragma unroll
    for (int ti = 0; ti < 2; ++ti) { const float mu = TMU[32 * ti + r32];
#pragma unroll
        for (int si = 0; si < 2; ++si) { const bool dead = dir ? (si == 0 && ti == 1) : (si == 1 && ti == 0);
            if (dead) { pa[ti][2 * si] = (bf16x8){0, 0, 0, 0, 0, 0, 0, 0}; pa[ti][2 * si + 1] = (bf16x8){0, 0, 0, 0, 0, 0, 0, 0}; }
            else { f32x16 p = sc[si][ti];
#pragma unroll
                for (int g4 = 0; g4 < 4; ++g4) { const f32x4 cs = *(const LAS f32x4*)(TCS + 32 * si + 8 * g4 + 4 * hh);
#pragma unroll
                    for (int i = 0; i < 4; ++i) { const int rg = 4 * g4 + i, s = crow(rg, hh); const bool ok = (si != ti) || (dir ? (s >= r32) : (s <= r32));
                        const float w = p[rg] * 0.125f * __expf(cs[i] - mu); p[rg] = ok ? w : 0.f; } }
                SC_PK4(p, 0, pa[ti][2 * si]); SC_PK4(p, 8, pa[ti][2 * si + 1]); } } }
#pragma unroll
    for (int j = 0; j < 8; ++j) { const int u = lane + 64 * j, row = u >> 3, unit = u & 7; const float ap = TAP[row];
        const u32x4 qv = *(const LAS u32x4*)(X + swz(row, unit)); u32x4 o;
        o.x = pk2(bflo(qv.x) * ap, bfhi(qv.x) * ap); o.y = pk2(bflo(qv.y) * ap, bfhi(qv.y) * ap); o.z = pk2(bflo(qv.z) * ap, bfhi(qv.z) * ap); o.w = pk2(bflo(qv.w) * ap, bfhi(qv.w) * ap);
        *(LAS u32x4*)(Y + swz(row, unit)) = o; }
    put_tile8_t(X, vr, lane);
    f32x16 o[2][2] = {}; f32x16 dn[2] = {};
    const bf16x8 ones = {0x3f80, 0x3f80, 0x3f80, 0x3f80, 0x3f80, 0x3f80, 0x3f80, 0x3f80};
#pragma unroll
    for (int ss = 0; ss < 4; ++ss) { bf16x8 vf[2];
#pragma unroll
        for (int vi = 0; vi < 2; ++vi) vf[vi] = frag(X, 32 * vi + r32, 2 * ss + hh);
#pragma unroll
        for (int ti = 0; ti < 2; ++ti) { dn[ti] = __builtin_amdgcn_mfma_f32_32x32x16_bf16(pa[ti][ss], ones, dn[ti], 0, 0, 0);
#pragma unroll
            for (int vi = 0; vi < 2; ++vi) o[ti][vi] = __builtin_amdgcn_mfma_f32_32x32x16_bf16(pa[ti][ss], vf[vi], o[ti][vi], 0, 0, 0); } }
    put_tile8(X, sp, lane);
    mm64(o, Y, X, r32, hh, -1, -1);
    { const float* NPg = (const float*)(a.ws + WS_NP) + (size_t)tk * 64;
#pragma unroll
      for (int st = 0; st < 4; ++st) { const f32x4 n0 = *(const f32x4*)(NPg + 16 * st + 8 * hh), n1 = *(const f32x4*)(NPg + 16 * st + 8 * hh + 4);
          u32x4 w; w.x = pk2(n0[0], n0[1]); w.y = pk2(n0[2], n0[3]); w.z = pk2(n1[0], n1[1]); w.w = pk2(n1[2], n1[3]); const bf16x8 nf = __builtin_bit_cast(bf16x8, w);
#pragma unroll
          for (int ti = 0; ti < 2; ++ti) dn[ti] = __builtin_amdgcn_mfma_f32_32x32x16_bf16(frag(Y, 32 * ti + r32, 2 * st + hh), nf, dn[ti], 0, 0, 0); } }
    float em[2][16];
#pragma unroll
    for (int ti = 0; ti < 2; ++ti)
#pragma unroll
        for (int g4 = 0; g4 < 4; ++g4) { const f32x4 e = *(const LAS f32x4*)(TEM + 32 * ti + 8 * g4 + 4 * hh);
#pragma unroll
            for (int i = 0; i < 4; ++i) em[ti][4 * g4 + i] = e[i]; }
    LAS float* O = (LAS float*)X;
#pragma unroll
    for (int ti = 0; ti < 2; ++ti)
#pragma unroll
        for (int rg = 0; rg < 16; ++rg) { const float rd = __builtin_amdgcn_rcpf(fmaxf(fabsf(dn[ti][rg]), em[ti][rg]));
#pragma unroll
            for (int vi = 0; vi < 2; ++vi) O[(32 * ti + crow(rg, hh)) * 64 + 32 * vi + r32] = o[ti][vi][rg] * rd; }
}
__device__ __forceinline__ void p_scanC(const Args& a, int layer, LAS unsigned char* lds, int do_hg, int do_ml) {
    const int tid = otid(), lane = tid & 63, wave = __builtin_amdgcn_readfirstlane(tid >> 6), G = ogrid(), h = wave >> 1, dir = wave & 1;
    LAS char* X = (LAS char*)lds + wave * 16384; LAS char* Y = X + 8192; LAS float* T = (LAS float*)(lds + 131072 + wave * 1024);
    const bf16* P = (const bf16*)(a.ws + WS_P); bf16* Yo = (bf16*)(a.ws + WS_Y);
    const bool lastl = layer == DEPTH - 1;
    for (int u = obid(); u < 2 * NB * NCH; u += G) { const int mixer = u / (NB * NCH), q = u % (NB * NCH), b = q / NCH, c = q % NCH;
        if (lastl && c < 4) continue;
        if (mixer == 0 ? !do_hg : !do_ml) continue;
        int ln = lane; asm volatile("" : "+v"(ln));
        if (mixer == 0) hgC(a, layer, b, c, h, dir, X, Y, ln); else mlC(a, layer, b, c, h, dir, X, Y, T, ln);
        __syncthreads();
        asm volatile("" : "+v"(ln));
        { const LAS float* Of = (const LAS float*)((LAS char*)lds + (2 * h) * 16384); const LAS float* Ob = (const LAS float*)((LAS char*)lds + (2 * h + 1) * 16384);
          const float gn = mixer == 0 ? a.in[11][layer * 64 + ln] : a.in[13][layer * 64 + ln];
          const int gcol = (mixer == 0 ? C_HGG : C_MLOG) + h * 64 + ln;
#pragma unroll 8
          for (int i = 0; i < 32; ++i) { const int t = 32 * dir + i; const size_t r = (size_t)(b * SB + 64 * c + t);
              const float ov = Of[t * 64 + ln] + Ob[t * 64 + ln]; const float y = ov * __builtin_amdgcn_rsqf(wave_sum(ov * ov) * (1.f / 64.f) + EPS) * gn;
              const float gt = bf2f(P[r * PC + gcol]); const float outv = mixer == 0 ? y * gt * sigm(gt) : y * sigm(gt);
              if (OUTPROJ_FP8) ((unsigned char*)Yo)[r * DM + mixer * 256 + h * 64 + ln] = (unsigned char)fp8_1(16.f * outv); else Yo[r * DM + mixer * 256 + h * 64 + ln] = (bf16)f2bf(outv); } }
        __syncthreads();
    }
}
#undef SC_PK4
}

__device__ __forceinline__ void p_attn(const Args& a, int layer, LAS char* ldsg) {
    asm volatile("" ::: "memory");
    const bf16* P = (const bf16*)(a.ws + WS_P); bf16* Y = (bf16*)(a.ws + WS_Y); const int G = ogrid();
    const int bid = obid(), lane = otid() & 63;
    const float* qg = a.in[14] + layer * 128; const float* kg = a.in[15] + layer * 128;
    const float mq = wave_max_nn(fmaxf(fabsf(qg[lane]), fabsf(qg[lane + 64]))), mk = wave_max_nn(fmaxf(fabsf(kg[lane]), fabsf(kg[lane + 64])));
    const float bound = 128.f * mq * mk * (att::SCALE * 1.4426950408889634f) * 1.02f;
    const bool fix = bound <= 60.f;
    const int cu = (layer != DEPTH - 1) ? (G >= 96 ? bid - 64 : bid) : -1; const bool hasc = cu >= 0 && cu < 32;
    const float* ropet = (const float*)(a.ws + WS_ROPE);
#define AT_LAT(u) const int b = (u) & 7, idx = ((u) >> 3) & 31, kvh = (u) >> 8, h = kvh * 2 + (idx >> 4), qb = idx & 15; const size_t r0 = (size_t)b * SB + CTX + (size_t)qb * 256; \
        const bf16* Qp = P + r0 * PC + C_ATQ + h * 128; const bf16* Kp = P + (size_t)b * SB * PC + C_ATK + kvh * 128; const bf16* Vp = P + (size_t)b * SB * PC + C_ATV + kvh * 128; \
        bf16* Op = (bf16*)((unsigned char*)Y + (r0 * DM + 512 + h * 128) * (OUTPROJ_FP8 ? 1 : 2));
#define AT_CTX() const int b = cu & 7, h = cu >> 3, kvh = h >> 1; const size_t r0 = (size_t)b * SB; \
        const bf16* Qp = P + r0 * PC + C_ATQ + h * 128; const bf16* Kp = P + r0 * PC + C_ATK + kvh * 128; const bf16* Vp = P + r0 * PC + C_ATV + kvh * 128; \
        bf16* Op = (bf16*)((unsigned char*)Y + (r0 * DM + 512 + h * 128) * (OUTPROJ_FP8 ? 1 : 2));
    const int ex = fix ? 0 : 1;
    for (int u = bid; u < 512; u += G) { AT_LAT(u) att::attn_dense_body(Qp, Kp, Vp, Op, SB, ldsg, qg, ropet, qb * 256, -bound, ex); __syncthreads(); }
    if (hasc) { AT_CTX() att::attn_dense_body(Qp, Kp, Vp, Op, CTX, ldsg, qg, ropet, -1, -bound, ex); __syncthreads(); }
#undef AT_LAT
#undef AT_CTX
}

__device__ __forceinline__ void p_finish(const Args& a, int layer, int do_hg, int do_ml) {
    const int tid = otid(), lane = tid & 63, wave = tid >> 6; const int gw = obid() * NWAVE + wave, NGW = ogrid() * NWAVE;
    const bf16* P = (const bf16*)(a.ws + WS_P); bf16* Y = (bf16*)(a.ws + WS_Y);
    const float* OH = (const float*)(a.ws + WS_OH); const float* OM = (const float*)(a.ws + WS_OM);
    const float gh = a.in[11][layer * 64 + lane], gm = a.in[13][layer * 64 + lane];
    for (int r = gw; r < NR; r += NGW) { if (layer == DEPTH - 1 && (r % SB) < CTX) continue;
#pragma unroll
        for (int h = 0; h < 4; ++h) {
            if (do_hg) { const float o = OH[(size_t)r * 256 + h * 64 + lane] + OH[(size_t)(NR + r) * 256 + h * 64 + lane];
              const float y = o * (1.f / sqrtf(wave_sum(o * o) * (1.f / 64.f) + EPS)) * gh; const float g = bf2f(P[(size_t)r * PC + C_HGG + h * 64 + lane]);
              Y[(size_t)r * DM + h * 64 + lane] = (bf16)f2bf(y * g * sigm(g)); }
            if (do_ml) { const float o = OM[(size_t)r * 256 + h * 64 + lane] + OM[(size_t)(NR + r) * 256 + h * 64 + lane];
              const float y = o * (1.f / sqrtf(wave_sum(o * o) * (1.f / 64.f) + EPS)) * gm; const float g = bf2f(P[(size_t)r * PC + C_MLOG + h * 64 + lane]);
              Y[(size_t)r * DM + 256 + h * 64 + lane] = (bf16)f2bf(y * sigm(g)); }
        }
    }
}

__device__ __forceinline__ void p_router(const Args& a, int layer, LAS unsigned char* lds) {
    const int tid = otid(), lane = tid & 63, wave = tid >> 6, G = ogrid(), bid = obid();
    constexpr int TP = 2064;
    LAS unsigned char* TH = lds; LAS unsigned char* TL = lds + 32 * TP;
    LAS float* PART = (LAS float*)lds;
    LAS float* LOG = (LAS float*)(lds + 64 * TP);
    LAS int* LCNT = (LAS int*)(lds + 64 * TP + 32 * 33 * 4);
    bf16* H = (bf16*)(a.ws + WS_H);
    int* RE = (int*)(a.ws + WS_RE); int* RS = (int*)(a.ws + WS_RS); float* RG = (float*)(a.ws + WS_RG);
    const bool lastl = layer == DEPTH - 1;
    const int e_l = lane & 31, hh = lane >> 5;
    bf16x8 bh[8], bl[8];
#pragma unroll
    for (int ks = 0; ks < 8; ++ks) { const size_t o = ((size_t)(layer * 32 + e_l)) * 1024 + wave * 128 + ks * 16 + hh * 8;
        bh[ks] = *(const bf16x8*)((const bf16*)(a.ws + WS_WRH) + o); bl[ks] = *(const bf16x8*)((const bf16*)(a.ws + WS_WRL) + o); }
    if (tid < 32) LCNT[tid] = 0;
    __syncthreads();
    for (int tile = bid; tile < NR / 32; tile += G) {
        const int r0 = tile * 32; if (lastl && (r0 % SB) < CTX) continue;
#pragma unroll
        for (int q = 0; q < 4; ++q) { const int row = wave * 4 + q, r = r0 + row; f32x4 v[2][2]; load_row_bf((const bf16*)(a.ws + WS_XB) + (size_t)r * DM, v, lane);
            norm_mod_store(v, a.in[7] + (size_t)layer * DM, modv(a, layer, r, 4), modv(a, layer, r, 3), MOE_FP8 ? (bf16*)nullptr : H + (size_t)r * DM, lane);
            if (MOE_FP8) {
#pragma unroll
                for (int j = 0; j < 2; ++j) { u32x2 w8; w8.x = pk_fp8x4(8.f * v[j][0][0], 8.f * v[j][0][1], 8.f * v[j][0][2], 8.f * v[j][0][3]); w8.y = pk_fp8x4(8.f * v[j][1][0], 8.f * v[j][1][1], 8.f * v[j][1][2], 8.f * v[j][1][3]);
                    *(u32x2*)((unsigned char*)(a.ws + WS_H8) + (size_t)r * DM + 8 * lane + 512 * j) = w8; } }
#pragma unroll
            for (int j = 0; j < 2; ++j) { unsigned hi[4], lo[4];
#pragma unroll
                for (int p = 0; p < 4; ++p) { const float x0 = v[j][p >> 1][(p & 1) * 2], x1 = v[j][p >> 1][(p & 1) * 2 + 1]; const unsigned w = pk2(x0, x1); hi[p] = w; lo[p] = pk2(x0 - bflo(w), x1 - bfhi(w)); }
                *(LAS u32x4*)(TH + row * TP + (8 * lane + 512 * j) * 2) = (u32x4){hi[0], hi[1], hi[2], hi[3]};
                *(LAS u32x4*)(TL + row * TP + (8 * lane + 512 * j) * 2) = (u32x4){lo[0], lo[1], lo[2], lo[3]}; } }
        __syncthreads();
        f32x16 acc = {};
#pragma unroll
        for (int ks = 0; ks < 8; ++ks) { const int off = e_l * TP + (wave * 128 + ks * 16 + hh * 8) * 2;
            const bf16x8 ah = *(const LAS bf16x8*)(TH + off), al = *(const LAS bf16x8*)(TL + off);
            acc = __builtin_amdgcn_mfma_f32_32x32x16_bf16(ah, bh[ks], acc, 0, 0, 0);
            acc = __builtin_amdgcn_mfma_f32_32x32x16_bf16(ah, bl[ks], acc, 0, 0, 0);
            acc = __builtin_amdgcn_mfma_f32_32x32x16_bf16(al, bh[ks], acc, 0, 0, 0); }
        __syncthreads();
#pragma unroll
        for (int rg = 0; rg < 16; ++rg) { const int row = (rg & 3) + 8 * (rg >> 2) + 4 * hh; PART[(wave * 32 + row) * 32 + e_l] = acc[rg]; }
        __syncthreads();
#pragma unroll
        for (int q = 0; q < 2; ++q) { const int idx = tid + 512 * q, row = idx >> 5, e = idx & 31; float s = a.in[17][layer * 32 + e];
#pragma unroll
            for (int w = 0; w < 8; ++w) s += PART[(w * 32 + row) * 32 + e];
            LOG[row * 33 + e] = s; }
        __syncthreads();
        if (tid < 32) { const int r = r0 + tid; float tv[4]; int te[4];
#pragma unroll
            for (int k = 0; k < 4; ++k) { float best = -INFINITY; int bi = 0;
                for (int e = 0; e < 32; ++e) { const float v = LOG[tid * 33 + e]; if (v > best) { best = v; bi = e; } }
                tv[k] = best; te[k] = bi; LOG[tid * 33 + bi] = -INFINITY; }
            float p[4], ps = 0.f;
#pragma unroll
            for (int k = 0; k < 4; ++k) { p[k] = expf(tv[k] - tv[0]); ps += p[k]; }
#pragma unroll
            for (int k = 0; k < 4; ++k) { RE[r * 4 + k] = te[k]; RS[r * 4 + k] = atomicAdd((int*)&LCNT[te[k]], 1); RG[r * 4 + k] = p[k] / ps; } }
        __syncthreads();
    }
    if (tid < 32) ((int*)(a.ws + WS_CNT))[bid * 32 + tid] = LCNT[tid];
}

__device__ __forceinline__ void p_dispatch(const Args& a, int layer, LAS unsigned char* lds) {
    const int tid = otid(), G = ogrid(), bid = obid();
    LAS int* tot = (LAS int*)lds; LAS int* base = tot + 32; LAS int* pst = base + 32;
    const int* CNT = (const int*)(a.ws + WS_CNT);
    const int* RE = (const int*)(a.ws + WS_RE); const int* RS = (const int*)(a.ws + WS_RS); const float* RG = (const float*)(a.ws + WS_RG);
    int* POS = (int*)(a.ws + WS_POS); int* TOK = (int*)(a.ws + WS_TOK); float* GATEP = (float*)(a.ws + WS_GATEP); int* TILEE = (int*)(a.ws + WS_TILEE);
    const bool lastl = layer == DEPTH - 1;
    { LAS int* ptot = pst + 64; LAS int* pbase = ptot + 512;
      const int e = tid & 31, part = tid >> 5; int t = 0, bs = 0;
      for (int blk = part; blk < G; blk += 16) { const int c = CNT[blk * 32 + e]; if (blk < bid) bs += c; t += c; }
      ptot[tid] = t; pbase[tid] = bs;
      __syncthreads();
      if (tid < 32) { int tt = 0, bb = 0;
#pragma unroll
          for (int p = 0; p < 16; ++p) { tt += ptot[p * 32 + tid]; bb += pbase[p * 32 + tid]; }
          tot[tid] = tt; base[tid] = bb; } }
    __syncthreads();
    if (tid == 0) { int p = 0; for (int e = 0; e < 32; ++e) { pst[e] = p; p += (tot[e] + 255) & ~255; } pst[32] = p; }
    __syncthreads();
    for (int tile = bid; tile < NR / 32; tile += G) { const int r0 = tile * 32; if (lastl && (r0 % SB) < CTX) continue;
        if (tid < 128) { const int i = r0 * 4 + tid; const int e = RE[i]; const int pos = pst[e] + base[e] + RS[i]; TOK[pos] = r0 + (tid >> 2); GATEP[pos] = RG[i]; POS[i] = pos; } }
    for (int e = bid; e < 32; e += G) {
        for (int p = pst[e] + tot[e] + tid; p < pst[e + 1]; p += NTHR) { TOK[p] = 0; GATEP[p] = 0.f; }
        for (int rt = pst[e] / 256 + tid; rt < pst[e + 1] / 256; rt += NTHR) TILEE[rt] = e; }
    if (bid == 0 && tid == 0) *(int*)(a.ws + WS_NRT) = pst[32] / 256;
}

__device__ __forceinline__ void p_combine(const Args& a, int layer, bool dry = false) {
    const int tid = otid(), lane = tid & 63, wave = tid >> 6; const int gw = obid() * NWAVE + wave, NGW = ogrid() * NWAVE;
    const bf16* YM = (const bf16*)(a.ws + WS_YM); const int* POS = (const int*)(a.ws + WS_POS); bf16* H = (bf16*)(a.ws + WS_H);
    const bool lastl = layer == DEPTH - 1;
    for (int r = gw; r < NR; r += NGW) { if (lastl && (r % SB) < CTX) continue;
        const float* g2 = modv(a, layer, r, 5); bf16* xb = (bf16*)(a.ws + WS_XB) + (size_t)r * DM;
        float* xo = dry ? (float*)(a.ws + WS_ACT) + (size_t)r * DM : a.out + ((size_t)(r / SB) * SEQ + (r % SB) - CTX) * DM;
        bf16* xbo = dry ? (bf16*)(a.ws + WS_ACT) + (size_t)r * DM : xb; bf16* hw = dry ? (bf16*)(a.ws + WS_ACT + 160 * MiB) + (size_t)r * DM : H + (size_t)r * DM;
        int pos[4];
#pragma unroll
        for (int k = 0; k < 4; ++k) pos[k] = POS[r * 4 + k];
        f32x4 v[2][2]; load_row_bf(xb, v, lane);
#pragma unroll
        for (int j = 0; j < 2; ++j) { const int c = 8 * lane + 512 * j; float f[8];
#pragma unroll
            for (int i = 0; i < 8; ++i) f[i] = 0.f;
#pragma unroll
            for (int k = 0; k < 4; ++k) { const u32x4 y = *(const u32x4*)(YM + (size_t)pos[k] * DM + c);
                f[0] += bflo(y.x); f[1] += bfhi(y.x); f[2] += bflo(y.y); f[3] += bfhi(y.y); f[4] += bflo(y.z); f[5] += bfhi(y.z); f[6] += bflo(y.w); f[7] += bfhi(y.w); }
#pragma unroll
            for (int q = 0; q < 2; ++q) { const f32x4 g = *(const f32x4*)(g2 + c + 4 * q);
                v[j][q] = v[j][q] + g * (f32x4){f[4 * q], f[4 * q + 1], f[4 * q + 2], f[4 * q + 3]};
                if (lastl) *(f32x4*)(xo + c + 4 * q) = v[j][q]; }
            if (!lastl) { u32x4 w; w.x = pk2(v[j][0][0], v[j][0][1]); w.y = pk2(v[j][0][2], v[j][0][3]); w.z = pk2(v[j][1][0], v[j][1][1]); w.w = pk2(v[j][1][2], v[j][1][3]); *(u32x4*)(xbo + c) = w; } }
        if (!lastl) { norm_mod_store(v, a.in[6] + (size_t)(layer + 1) * DM, modv(a, layer + 1, r, 1), modv(a, layer + 1, r, 0), INPROJ_I8 ? (bf16*)nullptr : hw, lane);
            if (INPROJ_I8) store_row_i8(v, dry ? (unsigned char*)(a.ws + WS_ACT + 160 * MiB) + (size_t)r * DM : (unsigned char*)(a.ws + WS_H) + (size_t)r * DM, dry ? (float*)(a.ws + WS_ACT + 240 * MiB) + r : (float*)(a.ws + WS_HSC) + r, lane); }
    }
}

template <int PH>
__device__ __forceinline__ void run_phase(int layer, unsigned char* ldsg) {
    const Args a = fetch_args();
    LAS unsigned char* lds = (LAS unsigned char*)ldsg;
    const int G = ogrid(), bid = obid();
    if constexpr (PH == PH_PRO) p_prologue(a, lds);
    if constexpr (PH == PH_NORM1) { if (INPROJ_I8) p_quant_win(a); p_norm1(a, layer); }
    if constexpr (PH == PH_INPROJ) {
        if constexpr (INPROJ_I8) { pg8::SchedDense S; S.init(NR, PC, G, bid, nullptr); S.Bt = (const char*)(a.ws + WS_WIN) + (size_t)layer * PC * 1024; S.rb = 1024;
            pg8::EpiI8 E{(bf16*)(a.ws + WS_P), PC, (const float*)(a.ws + WS_HSC), (const float*)(a.ws + WS_WSC) + (size_t)layer * PC}; pg8::gemm_phase<2>(lds, (const void*)(a.ws + WS_H), S, E); }
        else { pg8::SchedDense S; S.init(NR, PC, G, bid, (const bf16*)(a.ws + WS_WIN) + (size_t)layer * PC * 1024);
            pg8::EpiBf16 E{(bf16*)(a.ws + WS_P), PC}; pg8::gemm_phase<0>(lds, (const bf16*)(a.ws + WS_H), S, E); } }
    if constexpr (PH == PH_PREP) { if (PROBE_DOUBLE == 96) p_prep(a, layer, true); p_prep(a, layer); if (NEW_HG || NEW_ML) scan::p_scanA(a, layer, lds, NEW_HG, NEW_ML); if (PROBE_DOUBLE == 20) scan::p_scanA(a, layer, lds, NEW_HG, NEW_ML); }
    if constexpr (PH == PH_SCAN) { if (!NEW_HG || !NEW_ML) p_scan(a, layer, lds, !NEW_HG, !NEW_ML); if (NEW_HG || NEW_ML) scan::p_scanB(a, NEW_HG, NEW_ML); if (PROBE_DOUBLE == 21) scan::p_scanB(a, NEW_HG, NEW_ML); }
    if constexpr (PH == PH_ATTN) { if (NEW_HG || NEW_ML) scan::p_scanC(a, layer, lds, NEW_HG, NEW_ML); if (PROBE_DOUBLE == 22) scan::p_scanC(a, layer, lds, NEW_HG, NEW_ML); p_attn(a, layer, (LAS char*)lds); }
    if constexpr (PH == PH_FINISH) { if (!NEW_HG || !NEW_ML) p_finish(a, layer, !NEW_HG, !NEW_ML); }
    if constexpr (PH == PH_OUTPROJ) { pg8::SchedDense S; S.init(NR, DM, G, bid, nullptr); S.rb = OUTPROJ_FP8 ? 1024 : 2048; S.Bt = (const char*)(a.ws + WS_WOUT) + (size_t)layer * 1024 * S.rb;
        pg8::EpiResid E{a.in[0], a.in[2], (bf16*)(a.ws + WS_XB), (const float*)(a.ws + WS_MOD) + (size_t)layer * 9 * 6144, 2, layer == DEPTH - 1, layer == 0, OUTPROJ_FP8 ? 1.f / 1024.f : 1.f};
        pg8::gemm_phase<OUTPROJ_FP8 ? 1 : 0>(lds, (const void*)(a.ws + WS_Y), S, E); }
    if constexpr (PH == PH_ROUTER) p_router(a, layer, lds);
    if constexpr (PH == PH_DISPATCH) p_dispatch(a, layer, lds);
    if constexpr (PH == PH_GU) { constexpr int RBW = MOE_FP8 ? 1024 : 2048;
        pg8::SchedMoe S{G, bid, 8, 2048, __builtin_amdgcn_readfirstlane(__hip_atomic_load((const int*)(a.ws + WS_NRT), __ATOMIC_RELAXED, __HIP_MEMORY_SCOPE_AGENT)), (const int*)(a.ws + WS_TILEE),
                        (const char*)(a.ws + WS_WGU) + (size_t)layer * 32 * 2048 * RBW, (const int*)(a.ws + WS_TOK), RBW};
        pg8::EpiGU E{(void*)(a.ws + WS_ACT), a.in[19] + (size_t)layer * 32 * 2048};
        pg8::gemm_phase<MOE_FP8>(lds, MOE_FP8 ? (const void*)(a.ws + WS_H8) : (const void*)(a.ws + WS_H), S, E); }
    if constexpr (PH == PH_DOWN) { constexpr int RBW = MOE_FP8 ? 1024 : 2048;
        pg8::SchedMoe S{G, bid, 4, 1024, __builtin_amdgcn_readfirstlane(__hip_atomic_load((const int*)(a.ws + WS_NRT), __ATOMIC_RELAXED, __HIP_MEMORY_SCOPE_AGENT)), (const int*)(a.ws + WS_TILEE),
                        (const char*)(a.ws + WS_WDN) + (size_t)layer * 32 * 1024 * RBW, nullptr, RBW};
        pg8::EpiDown E{(bf16*)(a.ws + WS_YM), a.in[21] + (size_t)layer * 32 * 1024, (const float*)(a.ws + WS_GATEP)}; pg8::gemm_phase<MOE_FP8>(lds, (const void*)(a.ws + WS_ACT), S, E); }
    if constexpr (PH == PH_COMBINE) { if (PROBE_DOUBLE == 97) p_combine(a, layer, true); p_combine(a, layer); }
}

template <int PH>
__global__ void __launch_bounds__(NTHR, 2) k_phase(Args a, int layer) {
    extern __shared__ __attribute__((aligned(16))) unsigned char lds[];
    kernel_setup(a);
    run_phase<PH>(layer, lds);
}


__global__ void __launch_bounds__(NTHR, 2) k_mega(Args a) {
    extern __shared__ __attribute__((aligned(16))) unsigned char lds[];
    kernel_setup(a);
    const XcdBarrier bar = xcd_barrier_post((unsigned*)(a.ws + WS_CTL) + CW_BAR, (volatile LAS unsigned*)(MISC_OFF + 32));
#define GRID_BAR() do { for (int rep_ = 0; rep_ < (PROBE_DOUBLE == 99 ? 2 : 1); ++rep_) { const Args b_ = fetch_args(); XcdBarrier bb; bb.bar = (unsigned*)(b_.ws + WS_CTL) + CW_BAR; bb.x = xb_xcc_id(); bb.st = (volatile LAS unsigned*)(MISC_OFF + 32); xcd_barrier(bb); } } while (0)
    run_phase<PH_PRO>(0, lds); GRID_BAR();
    if (PROBE_DOUBLE == PH_PRO) { run_phase<PH_PRO>(0, lds); GRID_BAR(); }
    run_phase<PH_NORM1>(0, lds); GRID_BAR();
#define RUNP(PH, l) do { run_phase<PH>(l, lds); if (PROBE_DOUBLE == PH) { GRID_BAR(); run_phase<PH>(l, lds); } } while (0)
#define LAYER_BODY(l) do { \
        RUNP(PH_INPROJ, l); GRID_BAR(); \
        run_phase<PH_PREP>(l, lds); GRID_BAR(); \
        RUNP(PH_SCAN, l); GRID_BAR(); \
        RUNP(PH_ATTN, l); GRID_BAR(); \
        if (!NEW_HG || !NEW_ML) { RUNP(PH_FINISH, l); GRID_BAR(); } \
        run_phase<PH_OUTPROJ>(l, lds); GRID_BAR(); \
        if (PROBE_DOUBLE == 98 && (l) == 0) { run_phase<PH_OUTPROJ>(l, lds); GRID_BAR(); } \
        RUNP(PH_ROUTER, l); GRID_BAR(); \
        RUNP(PH_DISPATCH, l); GRID_BAR(); \
        RUNP(PH_GU, l); GRID_BAR(); \
        RUNP(PH_DOWN, l); GRID_BAR(); \
        run_phase<PH_COMBINE>(l, lds); \
        if ((l) + 1 < DEPTH) GRID_BAR(); \
    } while (0)
    LAYER_BODY(0); LAYER_BODY(1); LAYER_BODY(2); LAYER_BODY(3);
#undef LAYER_BODY
#undef RUNP
#undef GRID_BAR
}

template <int PH> static void launch_phase(const Args& a, int layer, int grid, hipStream_t stream) {
    static bool attr = false;
    if (!attr) { (void)hipFuncSetAttribute((const void*)k_phase<PH>, hipFuncAttributeMaxDynamicSharedMemorySize, LDS_BYTES); attr = true; }
    hipLaunchKernelGGL(k_phase<PH>, dim3(grid), dim3(NTHR), LDS_BYTES, stream, a, layer);
}

extern "C" void kernel_launch(void* const* d_in, const int* in_sizes, int n_in, void* d_out, int out_size, void* d_ws, size_t ws_size, hipStream_t stream) {
    static int grid = 0;
    if (grid == 0) {
        if (n_in != 22 || out_size != NB * SEQ * DM || ws_size < WS_END) { fprintf(stderr, "kernel_launch: unexpected shapes (n_in %d, out %d, ws %zu < %zu)\n", n_in, out_size, ws_size, (size_t)WS_END); grid = -1; return; }
        int dev = 0, cus = 0;
        if (hipGetDevice(&dev) != hipSuccess || hipDeviceGetAttribute(&cus, hipDeviceAttributeMultiprocessorCount, dev) != hipSuccess) { grid = -1; return; }
        grid = cus;
    }
    if (grid < 0) return;
    (void)hipMemsetAsync((char*)d_ws + WS_CTL, 0, CTL_ZERO_BYTES, stream);
    Args a{};
    for (int i = 0; i < 22; ++i) a.in[i] = (const float*)d_in[i];
    a.out = (float*)d_out; a.ws = (unsigned char*)d_ws; a.ph_lo = 0; a.ph_hi = 0;
#if MK_MULTI
    launch_phase<PH_PRO>(a, 0, grid, stream);
    launch_phase<PH_NORM1>(a, 0, grid, stream);
    for (int l = 0; l < DEPTH; ++l) {
        launch_phase<PH_INPROJ>(a, l, grid, stream);
        launch_phase<PH_PREP>(a, l, grid, stream);
        launch_phase<PH_SCAN>(a, l, grid, stream);
        launch_phase<PH_ATTN>(a, l, grid, stream);
        launch_phase<PH_FINISH>(a, l, grid, stream);
        launch_phase<PH_OUTPROJ>(a, l, grid, stream);
        launch_phase<PH_ROUTER>(a, l, grid, stream);
        launch_phase<PH_DISPATCH>(a, l, grid, stream);
        launch_phase<PH_GU>(a, l, grid, stream);
        launch_phase<PH_DOWN>(a, l, grid, stream);
        launch_phase<PH_COMBINE>(a, l, grid, stream);
    }
#else
    static bool attr = false;
    if (!attr) { (void)hipFuncSetAttribute((const void*)k_mega, hipFuncAttributeMaxDynamicSharedMemorySize, LDS_BYTES); attr = true; }
    hipLaunchKernelGGL(k_mega, dim3(grid), dim3(NTHR), LDS_BYTES, stream, a);
#endif
}
```

```cpp
#include <hip/hip_runtime.h>
#include <cstdio>
#include <cstdint>
#include <cmath>

#ifndef MK_MULTI
#define MK_MULTI 0
#endif
#ifndef MOE_FP8
#define MOE_FP8 1
#endif
#ifndef OUTPROJ_FP8
#define OUTPROJ_FP8 1
#endif
#ifndef INPROJ_I8
#define INPROJ_I8 1
#endif
#ifndef GEMM_ALIGN
#define GEMM_ALIGN 1
#endif
#ifndef NEW_HG
#define NEW_HG 1
#endif
#ifndef NEW_ML
#define NEW_ML 1
#endif
#ifndef PROBE_DOUBLE
#define PROBE_DOUBLE -1
#endif

#define GAS __attribute__((address_space(1)))
#define LAS __attribute__((address_space(3)))
typedef unsigned short bf16;
typedef short bf16x8 __attribute__((ext_vector_type(8)));
typedef short s16x4 __attribute__((ext_vector_type(4)));
typedef float f32x2 __attribute__((ext_vector_type(2)));
typedef float f32x4 __attribute__((ext_vector_type(4)));
typedef float f32x16 __attribute__((ext_vector_type(16)));
typedef unsigned u32x2 __attribute__((ext_vector_type(2)));
typedef unsigned u32x4 __attribute__((ext_vector_type(4)));
typedef __bf16 bf16x2_t __attribute__((ext_vector_type(2)));
typedef int v8i __attribute__((ext_vector_type(8)));
typedef int v4i __attribute__((ext_vector_type(4)));
typedef unsigned u32x8 __attribute__((ext_vector_type(8)));

constexpr int DM = 1024, NB = 8, SEQ = 4096, CTX = 256, SB = SEQ + CTX  , NR = NB * SB  , DEPTH = 4;
constexpr int PC = 3584;
constexpr int C_ATQ = 0, C_ATK = 512, C_ATV = 768, C_HGQ = 1024, C_HGZF = 1280, C_HGZB = 1536, C_HGV = 1792, C_HGG = 2048,
              C_MLQ = 2304, C_MLK = 2560, C_MLV = 2816, C_MLOG = 3072, C_MLG = 3328;
constexpr int NIN = 3344;
constexpr int NEXP = 32, NPOS = 147456;
constexpr float EPS = 1e-6f;
constexpr int NTHR = 512, NWAVE = 8;

constexpr size_t MiB = 1u << 20;
constexpr size_t WS_CTL = 0, CTL_ZERO_BYTES = 1 * MiB;
constexpr size_t WS_MOD = 1 * MiB;
constexpr size_t WS_ROPE = 2 * MiB;
constexpr size_t WS_WRH = 2 * MiB + 65536, WS_WRL = WS_WRH + 262144;
constexpr size_t WS_WSC = 2 * MiB + 655360;
constexpr size_t WS_HSC = 2 * MiB + 720896;
constexpr size_t WS_RE = 3 * MiB, WS_RS = WS_RE + 600000, WS_RG = WS_RS + 600000, WS_POS = WS_RG + 600000;
constexpr size_t WS_CNT = WS_POS + 600000;
constexpr size_t WS_TOK = 6 * MiB, WS_GATEP = WS_TOK + 600000, WS_TILEE = WS_GATEP + 600000, WS_NRT = WS_TILEE + 8192;
constexpr size_t WS_WIN = 8 * MiB;
constexpr size_t WS_WOUT = 36 * MiB;
constexpr size_t WS_WGU = 44 * MiB;
constexpr size_t WS_WDN = 556 * MiB;
constexpr size_t WS_H = 812 * MiB;
constexpr size_t WS_P = 880 * MiB;
constexpr size_t WS_Y = 1118 * MiB;
constexpr size_t WS_XC = 1186 * MiB;
constexpr size_t WS_ACT = 1194 * MiB;
constexpr size_t WS_YM = 1482 * MiB;
constexpr size_t WS_OH = 1770 * MiB;
constexpr size_t WS_OM = 1838 * MiB;
constexpr size_t WS_UTH = 1906 * MiB, WS_SPH = 1940 * MiB, WS_UTM = 1974 * MiB, WS_SPM = 2008 * MiB;
constexpr size_t WS_DT = 2042 * MiB, WS_NU = WS_DT + 1310720, WS_NP = WS_NU + 1310720, WS_GL = WS_NP + 1310720, WS_MP = WS_GL + 131072;
constexpr size_t WS_H8 = 2046 * MiB;
constexpr size_t WS_XB = 2080 * MiB;
constexpr size_t WS_END = 2148 * MiB;
static_assert(WS_CNT + 32768 <= WS_TOK && WS_NRT + 64 <= WS_WIN, "ws map");
static_assert((size_t)NR * 4 * 4 <= 600000 && (size_t)NPOS * 4 <= 600000, "ws map");

constexpr int CW_CMAX = 16384;
constexpr int CW_BAR = 4096;

constexpr int LDS_BYTES = 147456;
constexpr int PH_LDS = 143360;
constexpr int MISC_OFF = PH_LDS;

struct Args { const float* in[22]; float* out; unsigned char* ws; int ph_lo, ph_hi; };

#define LDS_WAIT() asm volatile("s_waitcnt lgkmcnt(0)" ::: "memory")
#define VM_WAIT() asm volatile("s_waitcnt vmcnt(0)" ::: "memory")

__device__ __forceinline__ unsigned pk2(float lo, float hi) { f32x2 v = {lo, hi}; bf16x2_t b = __builtin_convertvector(v, bf16x2_t); return __builtin_bit_cast(unsigned, b); }
__device__ __forceinline__ unsigned f2bf(float f) { return pk2(f, 0.f) & 0xffffu; }
__device__ __forceinline__ float clamp8(float x) { return fminf(fmaxf(x, -448.f), 448.f); }
__device__ __forceinline__ unsigned pk_fp8x4(float a, float b, float c, float d) {
    int w = 0; w = __builtin_amdgcn_cvt_pk_fp8_f32(clamp8(a), clamp8(b), w, false); w = __builtin_amdgcn_cvt_pk_fp8_f32(clamp8(c), clamp8(d), w, true); return (unsigned)w; }
__device__ __forceinline__ unsigned fp8_1(float a) { return pk_fp8x4(a, 0.f, 0.f, 0.f) & 0xffu; }
__device__ __forceinline__ float bf2f(unsigned h) { return __uint_as_float(h << 16); }
__device__ __forceinline__ float bflo(unsigned w) { return __uint_as_float(w << 16); }
__device__ __forceinline__ float bfhi(unsigned w) { return __uint_as_float(w & 0xffff0000u); }
__device__ __forceinline__ float wave_sum(float v) {
#define WS_DPP(x, ctrl, rmask) __builtin_bit_cast(float, __builtin_amdgcn_update_dpp(0, __builtin_bit_cast(int, x), ctrl, rmask, 0xF, false))
    v += WS_DPP(v, 0xB1, 0xF);
    v += WS_DPP(v, 0x4E, 0xF);
    v += WS_DPP(v, 0x141, 0xF);
    v += WS_DPP(v, 0x140, 0xF);
    v += WS_DPP(v, 0x142, 0xA);
    v += WS_DPP(v, 0x143, 0xC);
#undef WS_DPP
    return __builtin_bit_cast(float, __builtin_amdgcn_readlane(__builtin_bit_cast(int, v), 63));
}
__device__ __forceinline__ float wave_max_nn(float v) {
#define WS_DPP(x, ctrl, rmask) __builtin_bit_cast(float, __builtin_amdgcn_update_dpp(0, __builtin_bit_cast(int, x), ctrl, rmask, 0xF, false))
    v = fmaxf(v, WS_DPP(v, 0xB1, 0xF)); v = fmaxf(v, WS_DPP(v, 0x4E, 0xF)); v = fmaxf(v, WS_DPP(v, 0x141, 0xF)); v = fmaxf(v, WS_DPP(v, 0x140, 0xF));
    v = fmaxf(v, WS_DPP(v, 0x142, 0xA)); v = fmaxf(v, WS_DPP(v, 0x143, 0xC));
#undef WS_DPP
    return __builtin_bit_cast(float, __builtin_amdgcn_readlane(__builtin_bit_cast(int, v), 63));
}
__device__ __forceinline__ unsigned pk_i8x4(float a, float b, float c, float d) {
    const int q0 = __float2int_rn(a), q1 = __float2int_rn(b), q2 = __float2int_rn(c), q3 = __float2int_rn(d);
    return (unsigned)(q0 & 0xff) | ((unsigned)(q1 & 0xff) << 8) | ((unsigned)(q2 & 0xff) << 16) | ((unsigned)q3 << 24); }
__device__ __forceinline__ float sigm(float x) { return __builtin_amdgcn_rcpf(1.f + __expf(-x)); }


constexpr int ARGS_OFF = MISC_OFF + 256, WTAB_OFF = MISC_OFF + 512;
__device__ __forceinline__ unsigned hw_slot() { return (unsigned)__builtin_amdgcn_s_getreg((5 << 11) | 4) & 63u; }
__device__ __forceinline__ int lane_id(unsigned zo) { return (int)__builtin_amdgcn_mbcnt_hi(~0u, __builtin_amdgcn_mbcnt_lo(~0u, zo)); }
__device__ __forceinline__ int otid() {
    unsigned zo = 0; asm volatile("" : "+v"(zo));
    const int wave = __builtin_amdgcn_readfirstlane(*(const LAS int*)(WTAB_OFF + hw_slot() * 4 + zo));
    int t = wave * 64 + lane_id(zo); asm volatile("" : "+v"(t)); return t;
}
__device__ __forceinline__ int obid() { int b = blockIdx.x; asm volatile("" : "+s"(b)); return b; }
__device__ __forceinline__ int ogrid() { int g = gridDim.x; asm volatile("" : "+s"(g)); return g; }
__device__ __forceinline__ const void* lds_ptr64(int byte_off, unsigned zo) {
    const u32x2 w = *(const LAS u32x2*)(byte_off + zo);
    const unsigned lo = __builtin_amdgcn_readfirstlane(w.x), hi = __builtin_amdgcn_readfirstlane(w.y);
    return (const void*)(const GAS void*)(((unsigned long long)hi << 32) | lo);
}
__device__ __forceinline__ Args fetch_args() {
    unsigned zo = 0; asm volatile("" : "+v"(zo));
    Args r;
#pragma unroll
    for (int i = 0; i < 22; ++i) r.in[i] = (const float*)lds_ptr64(ARGS_OFF + 8 * i, zo);
    r.out = (float*)lds_ptr64(ARGS_OFF + 8 * 22, zo); r.ws = (unsigned char*)lds_ptr64(ARGS_OFF + 8 * 23, zo); r.ph_lo = 0; r.ph_hi = 0;
    return r;
}
__device__ __forceinline__ void kernel_setup(const Args& a) {
    const int tid = threadIdx.x;
    LAS unsigned* M = (LAS unsigned*)MISC_OFF;
    if (tid < 64) M[tid] = 0u;
    if (tid == 0) { LAS unsigned long long* A = (LAS unsigned long long*)ARGS_OFF;
#pragma unroll
        for (int i = 0; i < 22; ++i) A[i] = (unsigned long long)a.in[i];
        A[22] = (unsigned long long)a.out; A[23] = (unsigned long long)a.ws; }
    if ((tid & 63) == 0) *(LAS int*)(WTAB_OFF + hw_slot() * 4) = tid >> 6;
    __syncthreads();
}

__device__ __forceinline__ const float* x_rd(const Args& a, bool from_input, int r) {
    const int b = r / SB, s = r - b * SB;
    if (s < CTX) return (from_input ? a.in[2] : (const float*)(a.ws + WS_XC)) + (size_t)(b * CTX + s) * DM;
    return (from_input ? a.in[0] : (const float*)a.out) + (size_t)(b * SEQ + s - CTX) * DM;
}
__device__ __forceinline__ float* x_wr(const Args& a, int r) {
    const int b = r / SB, s = r - b * SB;
    if (s < CTX) return (float*)(a.ws + WS_XC) + (size_t)(b * CTX + s) * DM;
    return a.out + (size_t)(b * SEQ + s - CTX) * DM;
}
__device__ __forceinline__ const float* modv(const Args& a, int layer, int r, int chunk) {
    const int b = r / SB, s = r - b * SB; const int j = s < CTX ? 8 : b;
    return (const float*)(a.ws + WS_MOD) + ((size_t)(layer * 9 + j) * 6 + chunk) * DM;
}

#define XB_TMO      128
#define XB_XCNT(j)  (256  + 64 * (j))
#define XB_XSUB(j)  (1280 + 64 * (j))
#define XB_XGEN(j)  (2304 + 64 * (j))
#define XB_TOP      3328
#define XB_TOPGEN   3392
#define XCD_BAR_WORDS 3456
#define XB_SPIN_CAP (1u << 18)
__device__ __forceinline__ unsigned xb_ld(unsigned* p)              { return __hip_atomic_load(p, __ATOMIC_RELAXED, __HIP_MEMORY_SCOPE_AGENT); }
__device__ __forceinline__ unsigned xb_add(unsigned* p, unsigned v) { return __hip_atomic_fetch_add(p, v, __ATOMIC_RELAXED, __HIP_MEMORY_SCOPE_AGENT); }
__device__ __forceinline__ unsigned xb_xcc_id() { return (unsigned)__builtin_amdgcn_s_getreg((3 << 11) | 20) & 0xFu; }
#define XB_SPIN(cond, bar) do { unsigned _sp = 0; while (cond) { __builtin_amdgcn_s_sleep(1); \
    if ((++_sp & 255u) == 0u) { if (xb_ld(&(bar)[XB_TMO])) break; if (_sp > XB_SPIN_CAP) { atomicAdd(&(bar)[XB_TMO], 1u); break; } } } } while (0)
struct XcdBarrier { unsigned* bar; unsigned x; volatile LAS unsigned* st; };
__device__ __forceinline__ XcdBarrier xcd_barrier_post(unsigned* bar, volatile LAS unsigned* st) {
    XcdBarrier b; b.bar = bar; b.x = xb_xcc_id(); b.st = st;
    if (otid() == 0) (void)xb_add(&bar[XB_XCNT(b.x)], 1u);
    return b;
}
__device__ __forceinline__ void xcd_barrier_complete(unsigned* bar, unsigned x, unsigned& nloc, unsigned& nx) {
    const unsigned G = gridDim.x * gridDim.y * gridDim.z;
    unsigned sum, cnt, mine, sp = 0u;
    for (;;) {
        sum = 0u; cnt = 0u; mine = 0u;
#pragma unroll
        for (unsigned j = 0; j < 16; ++j) { const unsigned c = xb_ld(&bar[XB_XCNT(j)]); sum += c; cnt += (c > 0u) ? 1u : 0u; mine = (j == x) ? c : mine; }
        if (sum == G) break;
        __builtin_amdgcn_s_sleep(1);
        if ((++sp & 255u) == 0u) { if (xb_ld(&bar[XB_TMO])) break; if (sp > XB_SPIN_CAP) { atomicAdd(&bar[XB_TMO], 1u); break; } }
    }
    nloc = mine > 0u ? mine : 1u; nx = cnt > 0u ? cnt : 1u;
}
__device__ __forceinline__ void xcd_barrier(const XcdBarrier& b) {
    asm volatile("s_waitcnt vmcnt(0)" ::: "memory");
    __syncthreads();
    if (otid() == 0) {
        unsigned* bar = b.bar;
        __builtin_amdgcn_s_waitcnt(0);
        unsigned nloc = b.st[0], nx = b.st[1];
        if (nloc == 0u) { xcd_barrier_complete(bar, b.x, nloc, nx); b.st[0] = nloc; b.st[1] = nx; }
        const unsigned old = xb_add(&bar[XB_XSUB(b.x)], 1u);
        const unsigned gen = old / nloc;
        if (old + 1u == (gen + 1u) * nloc) {
            __builtin_amdgcn_fence(__ATOMIC_RELEASE, "agent");
            asm volatile("s_waitcnt vmcnt(0)" ::: "memory");
            const unsigned og = xb_add(&bar[XB_TOP], 1u);
            const unsigned tg = og / nx;
            if (og + 1u == (tg + 1u) * nx) xb_add(&bar[XB_TOPGEN], 1u);
            else XB_SPIN(xb_ld(&bar[XB_TOPGEN]) == tg, bar);
            __builtin_amdgcn_fence(__ATOMIC_ACQUIRE, "agent");
            xb_add(&bar[XB_XGEN(b.x)], 1u);
            asm volatile("s_waitcnt vmcnt(0)" ::: "memory");
        } else {
            XB_SPIN(xb_ld(&bar[XB_XGEN(b.x)]) == gen, bar);
            __builtin_amdgcn_fence(__ATOMIC_ACQUIRE, "agent");
            asm volatile("s_waitcnt vmcnt(0)" ::: "memory");
        }
    }
    __syncthreads();
}

__device__ __forceinline__ void glds16s2(const void* sbase, unsigned voff0, unsigned voff1, unsigned lds0, unsigned lds1) {
    unsigned keep;
    asm volatile("s_mov_b32 %0, m0\n\ts_mov_b32 m0, %4\n\ts_nop 0\n\tglobal_load_lds_dwordx4 %1, %3\n\ts_mov_b32 m0, %5\n\ts_nop 0\n\tglobal_load_lds_dwordx4 %2, %3\n\ts_mov_b32 m0, %0"
                 : "=&s"(keep) : "v"(voff0), "v"(voff1), "s"(sbase), "s"(lds0), "s"(lds1) : "memory");
}

__device__ __forceinline__ void glds16s1(const void* sbase, unsigned voff, unsigned lds0) {
    unsigned keep;
    asm volatile("s_mov_b32 %0, m0\n\ts_mov_b32 m0, %3\n\ts_nop 0\n\tglobal_load_lds_dwordx4 %1, %2\n\ts_mov_b32 m0, %0" : "=&s"(keep) : "v"(voff), "s"(sbase), "s"(lds0) : "memory");
}
struct AuxSrc { const void* base; unsigned off; };

namespace pg8 {
constexpr int BM = 256, BK = 64, HALF = 128, HTB = HALF * BK * 2, STAGE_BYTES = 8 * HTB, NXCD = 8, WGM = 8, K = 1024;
__host__ __device__ __forceinline__ int lds_byte(int r, int c) { const int st = (r >> 4) * 2 + (c >> 5), rr = r & 15, cc = c & 31, ob = rr * 64 + cc * 2; return st * 1024 + (ob ^ (((ob >> 9) & 1) << 5)); }
__host__ __device__ __forceinline__ void stage_rc(int b, int& R, int& C) { const int st = b / 1024, sb = b % 1024, swz = sb ^ (((sb >> 9) & 1) << 5); R = (st >> 1) * 16 + swz / 64; C = (st & 1) * 32 + (swz % 64) / 2; }
__host__ __device__ __forceinline__ int perm32(int rho) { const int n = rho >> 4, i = rho & 15; return 8 * (i >> 2) + 4 * n + (i & 3); }

struct Unit { int pm, pn, e; const char* Bt; };

struct SchedDense {
    int nM, nN, nwg, G, c, rb; const char* Bt;
    __device__ void init(int M, int N, int G_, int c_, const bf16* Bt_) { nM = M / BM; nN = N / BM; nwg = nM * nN; G = G_; c = c_; Bt = (const char*)Bt_; rb = 2 * K; }
    __device__ __forceinline__ bool next(int i, Unit& u) const {
        const long L = (long)i * G + c; if (L >= nwg) return false;
        int wgid = (int)L; { const int q = nwg / NXCD, r = nwg % NXCD, xcd = wgid % NXCD, off = wgid / NXCD; wgid = (xcd < r ? xcd * (q + 1) : r * (q + 1) + (xcd - r) * q) + off; }
        const int nig = WGM * nN, gid = wgid / nig, fm = gid * WGM, gsz = (nM - fm) < WGM ? (nM - fm) : WGM;
        u.pm = fm + ((wgid % nig) % gsz); u.pn = (wgid % nig) / gsz; u.e = 0; u.Bt = Bt + (size_t)u.pn * BM * rb; return true;
    }
    __device__ __forceinline__ int row(const Unit& u, int local) const { return u.pm * BM + local; }
};
struct SchedMoe {
    int G, c, nct, ntot, nrt; const int* tile_e; const char* WT; const int* tok; int rb  ;
    __device__ __forceinline__ bool next(int i, Unit& u) const {
        int rt, pn;
        if ((G & 7) == 0) { const int x = c & 7, j = c >> 3, per = G >> 3, base = nrt >> 3, rem = nrt & 7;
            const int cnt = base + (x < rem ? 1 : 0), start = x * base + (x < rem ? x : rem), q = i * per + j;
            if (q >= cnt * nct) return false;
            const int rl = q / nct; pn = q - rl * nct; rt = start + rl; }
        else { const int L = i * G + c; if (L >= nrt * nct) return false; rt = L / nct; pn = L - rt * nct; }
        u.pm = rt; u.pn = pn; u.e = __builtin_amdgcn_readfirstlane(__hip_atomic_load(tile_e + rt, __ATOMIC_RELAXED, __HIP_MEMORY_SCOPE_AGENT));
        u.Bt = WT + ((size_t)u.e * ntot + (size_t)u.pn * BM) * rb; return true;
    }
    __device__ __forceinline__ int row(const Unit& u, int local) const { return tok ? tok[u.pm * BM + local] : u.pm * BM + local; }
};

template <int MODE  , class Epi, class Sched>
__device__ __forceinline__ void gemm_phase(LAS unsigned char* lds, const void* Abase, const Sched& S, const Epi& E) {
    const int tid = otid(), wid = __builtin_amdgcn_readfirstlane(tid >> 6), lane = tid & 63, wr = wid >> 2, wc = wid & 3, fr = lane & 15, fq = lane >> 4;
    constexpr bool FP8 = (MODE == 1), I8 = (MODE == 2);
    constexpr int RB = MODE ? K : 2 * K;
    constexpr int nt = RB / 128;
    int R0, C0; stage_rc(tid * 16, R0, C0);
    const unsigned voffB0 = (unsigned)((Epi::PERM ? ((R0 & ~31) + perm32(R0 & 31)) : R0) * RB + C0 * 2);
    constexpr size_t kstep = (size_t)(BK * 2);
    constexpr size_t hstep = (size_t)HALF * RB;
    const unsigned ldsw = (unsigned)wid * 1024u, ldsb = (unsigned)(size_t)lds;
    const int aoff = lds_byte(wr * 64 + fr, fq * 8), boff = lds_byte(wc * 32 + fr, fq * 8);
    const char* Ab = (const char*)Abase;
    LAS u32x4* nslot = (LAS u32x4*)(lds + STAGE_BYTES + tid * 16);
    constexpr int AUX_OFF = STAGE_BYTES + 8192;
#define PG8_AUX(u, idx) do { if (wid < 2) { const AuxSrc s_ = E.aux(wid, u, lane); if (s_.base) glds16s1(s_.base, s_.off, ldsb + (unsigned)(AUX_OFF + ((idx) & 1) * 2048 + wid * 1024)); } } while (0)
#define PG8_SA(b, h) (((b) * 2 + (h)) * HTB)
#define PG8_SB(b, h) ((4 + (b) * 2 + (h)) * HTB)
#define PG8_STAGEA(bufoff, gbase, voff) glds16s2((gbase), (voff)[0], (voff)[1], ldsb + (unsigned)(bufoff) + ldsw, ldsb + (unsigned)(bufoff) + ldsw + 8192u)
#define PG8_STAGEB(bufoff, gbase) glds16s2((gbase), voffB0, voffB0 + (unsigned)(64 * RB), ldsb + (unsigned)(bufoff) + ldsw, ldsb + (unsigned)(bufoff) + ldsw + 8192u)
#define PG8_LDA(dst, b, h) do { if constexpr (FP8) { _Pragma("unroll") for (int m = 0; m < 4; ++m) { dst##8[m].lo = *(const LAS u32x4*)(lds + PG8_SA(b, h) + aoff + m * 2048); dst##8[m].hi = *(const LAS u32x4*)(lds + PG8_SA(b, h) + aoff + m * 2048 + 1024); } } \
    else { _Pragma("unroll") for (int m = 0; m < 4; ++m) _Pragma("unroll") for (int k = 0; k < 2; ++k) dst[m][k] = *(const LAS bf16x8*)(lds + PG8_SA(b, h) + aoff + m * 2048 + k * 1024); } } while (0)
#define PG8_LDB(dst, b, h) do { if constexpr (FP8) { _Pragma("unroll") for (int n = 0; n < 2; ++n) { dst##8[n].lo = *(const LAS u32x4*)(lds + PG8_SB(b, h) + boff + n * 2048); dst##8[n].hi = *(const LAS u32x4*)(lds + PG8_SB(b, h) + boff + n * 2048 + 1024); } } \
    else { _Pragma("unroll") for (int n = 0; n < 2; ++n) _Pragma("unroll") for (int k = 0; k < 2; ++k) dst[n][k] = *(const LAS bf16x8*)(lds + PG8_SB(b, h) + boff + n * 2048 + k * 1024); } } while (0)
#define PG8_MMA(ai, bj, At, Bt) do { __builtin_amdgcn_s_setprio(1); if constexpr (FP8) { _Pragma("unroll") for (int m = 0; m < 4; ++m) _Pragma("unroll") for (int n = 0; n < 2; ++n) \
        acc[ai][bj][m][n] = __builtin_amdgcn_mfma_scale_f32_16x16x128_f8f6f4(__builtin_bit_cast(v8i, Bt##8[n]), __builtin_bit_cast(v8i, At##8[m]), acc[ai][bj][m][n], 0, 0, 0, 0x7f7f7f7f, 0, 0x7f7f7f7f); } \
        else if constexpr (I8) { _Pragma("unroll") for (int m = 0; m < 4; ++m) _Pragma("unroll") for (int n = 0; n < 2; ++n) _Pragma("unroll") for (int k = 0; k < 2; ++k) \
        acc[ai][bj][m][n] = __builtin_bit_cast(f32x4, __builtin_amdgcn_mfma_i32_16x16x64_i8(__builtin_bit_cast(v4i, Bt[n][k]), __builtin_bit_cast(v4i, At[m][k]), __builtin_bit_cast(v4i, acc[ai][bj][m][n]), 0, 0, 0)); } \
        else { _Pragma("unroll") for (int m = 0; m < 4; ++m) _Pragma("unroll") for (int n = 0; n < 2; ++n) _Pragma("unroll") for (int k = 0; k < 2; ++k) \
        acc[ai][bj][m][n] = __builtin_amdgcn_mfma_f32_16x16x32_bf16(Bt[n][k], At[m][k], acc[ai][bj][m][n], 0, 0, 0); } __builtin_amdgcn_s_setprio(0); } while (0)
#define PG8_WAIT_V(n) asm volatile("s_waitcnt vmcnt(" #n ")" ::: "memory")
#define PG8_WAIT_L(n) asm volatile("s_waitcnt lgkmcnt(" #n ")" ::: "memory")
#define PG8_BAR __builtin_amdgcn_s_barrier()
#define PG8_SCHED __builtin_amdgcn_sched_barrier(0)
#define PG8_VAOFF(u, h, i) ((unsigned)(S.row(u, (h) * HALF + R0 + 64 * (i)) * RB + C0 * 2))
    Unit cur, nxt; int ui = 0;
    if (!S.next(0, cur)) return;
    f32x4 acc[2][2][4][2];
#pragma unroll
    for (int a = 0; a < 2; ++a)
#pragma unroll
        for (int b = 0; b < 2; ++b)
#pragma unroll
            for (int m = 0; m < 4; ++m)
#pragma unroll
                for (int n = 0; n < 2; ++n) acc[a][b][m][n] = (f32x4){0.f, 0.f, 0.f, 0.f};
    bf16x8 At[4][2], B0[2][2], B1[2][2];
    u32x8 At8[4], B08[2], B18[2];
    unsigned vA[2][2];
#pragma unroll
    for (int h = 0; h < 2; ++h)
#pragma unroll
        for (int i = 0; i < 2; ++i) vA[h][i] = PG8_VAOFF(cur, h, i);
    const char* cB = cur.Bt;
    PG8_AUX(cur, 0);
    PG8_STAGEB(PG8_SB(0, 0), cB); PG8_STAGEB(PG8_SB(0, 1), cB + hstep); PG8_STAGEA(PG8_SA(0, 0), Ab, vA[0]); PG8_STAGEA(PG8_SA(0, 1), Ab, vA[1]);
    if (wr == 1) PG8_BAR;
    PG8_WAIT_V(2); PG8_BAR;
    PG8_STAGEB(PG8_SB(1, 0), cB + kstep); PG8_STAGEA(PG8_SA(1, 0), Ab + kstep, vA[0]); PG8_STAGEB(PG8_SB(1, 1), cB + hstep + kstep);
    PG8_WAIT_V(6); PG8_BAR;
    for (;;) {
        const bool has_next = S.next(ui + 1, nxt);
        if (has_next) *nslot = (u32x4){PG8_VAOFF(nxt, 0, 0), PG8_VAOFF(nxt, 0, 1), PG8_VAOFF(nxt, 1, 0), PG8_VAOFF(nxt, 1, 1)};
        const char* nB = has_next ? nxt.Bt : cB;
#pragma unroll 1
        for (int t = 0; t < nt; t += 2) {
            const bool last = (t == nt - 2);
            const char* a1 = Ab + (size_t)(t + 1) * kstep;
            const char* a2 = last ? Ab : Ab + (size_t)(t + 2) * kstep; const char* b2 = last ? nB : cB + (size_t)(t + 2) * kstep;
            const char* a3 = a2 + kstep; const char* b3 = b2 + kstep;
            PG8_LDB(B0, 0, 0); PG8_LDB(B1, 0, 1); PG8_SCHED; PG8_LDA(At, 0, 0); PG8_STAGEA(PG8_SA(1, 1), a1, vA[1]);
            if (last && has_next) { const u32x4 nv = *nslot; vA[0][0] = nv.x; vA[0][1] = nv.y; vA[1][0] = nv.z; vA[1][1] = nv.w; }
            PG8_WAIT_V(8); PG8_WAIT_L(0); PG8_BAR; PG8_MMA(0, 0, At, B0); PG8_MMA(0, 1, At, B1); PG8_BAR; PG8_SCHED;
            PG8_LDA(At, 0, 1); PG8_STAGEB(PG8_SB(0, 0), b2); PG8_STAGEB(PG8_SB(0, 1), b2 + hstep); PG8_STAGEA(PG8_SA(0, 0), a2, vA[0]);
            PG8_WAIT_V(8); PG8_WAIT_L(0); PG8_BAR; PG8_MMA(1, 0, At, B0); PG8_MMA(1, 1, At, B1); PG8_BAR; PG8_SCHED;
            PG8_LDB(B0, 1, 0); PG8_LDB(B1, 1, 1); PG8_SCHED; PG8_LDA(At, 1, 0); PG8_STAGEA(PG8_SA(0, 1), a2, vA[1]);
            PG8_WAIT_V(8); PG8_WAIT_L(0); PG8_BAR; PG8_MMA(0, 0, At, B0); PG8_MMA(0, 1, At, B1); PG8_BAR; PG8_SCHED;
            PG8_LDA(At, 1, 1); PG8_STAGEB(PG8_SB(1, 0), b3); PG8_STAGEB(PG8_SB(1, 1), b3 + hstep); PG8_STAGEA(PG8_SA(1, 0), a3, vA[0]);
            PG8_WAIT_V(8); PG8_WAIT_L(0); PG8_BAR; PG8_MMA(1, 0, At, B0); PG8_MMA(1, 1, At, B1); PG8_BAR; PG8_SCHED;
        }
        if (GEMM_ALIGN && wr == 0) PG8_BAR;
        { int fr_ = fr, fq_ = fq; asm volatile("" : "+v"(fr_), "+v"(fq_));
          E(acc, cur, wr, wc, fr_, fq_, (const LAS float*)(lds + AUX_OFF + (ui & 1) * 2048), (const LAS float*)(lds + AUX_OFF + (ui & 1) * 2048 + 1024)); }
        if (!has_next) break;
#pragma unroll
        for (int a = 0; a < 2; ++a)
#pragma unroll
            for (int b = 0; b < 2; ++b)
#pragma unroll
                for (int m = 0; m < 4; ++m)
#pragma unroll
                    for (int n = 0; n < 2; ++n) acc[a][b][m][n] = (f32x4){0.f, 0.f, 0.f, 0.f};
        cur = nxt; cB = nB; ++ui;
        PG8_AUX(cur, ui);
        if (GEMM_ALIGN && wr == 1) PG8_BAR;
    }
    PG8_WAIT_V(0);
    if (!GEMM_ALIGN && wr == 0) PG8_BAR;
    PG8_BAR;
#undef PG8_SA
#undef PG8_SB
#undef PG8_STAGEA
#undef PG8_STAGEB
#undef PG8_LDA
#undef PG8_LDB
#undef PG8_MMA
#undef PG8_WAIT_V
#undef PG8_WAIT_L
#undef PG8_BAR
#undef PG8_SCHED
#undef PG8_VAOFF
#undef PG8_AUX
}

struct EpiBf16 {
    static constexpr bool PERM = true;
    bf16* O; int ldc;
    __device__ __forceinline__ AuxSrc aux(int, const Unit&, int) const { return AuxSrc{nullptr, 0u}; }
    __device__ __forceinline__ void operator()(const f32x4 (&acc)[2][2][4][2], const Unit& u, int wr, int wc, int fr, int fq, const LAS float*, const LAS float*) const {
        const int row0 = u.pm * BM + wr * 64 + fr, col0 = u.pn * BM + wc * 32 + 8 * fq;
#pragma unroll
        for (int ai = 0; ai < 2; ++ai)
#pragma unroll
            for (int m = 0; m < 4; ++m) { bf16* rowp = O + (size_t)(row0 + ai * HALF + m * 16) * ldc + col0;
#pragma unroll
                for (int bj = 0; bj < 2; ++bj) { const f32x4 v0 = acc[ai][bj][m][0], v1 = acc[ai][bj][m][1];
                    u32x4 w; w.x = pk2(v0[0], v0[1]); w.y = pk2(v0[2], v0[3]); w.z = pk2(v1[0], v1[1]); w.w = pk2(v1[2], v1[3]);
                    *(u32x4*)(rowp + bj * HALF) = w; } }
    }
};
struct EpiI8 {
    static constexpr bool PERM = true;
    bf16* O; int ldc; const float* hs; const float* ws;
    __device__ __forceinline__ AuxSrc aux(int which, const Unit& u, int lane) const { return which == 0 ? AuxSrc{ws + u.pn * BM, (unsigned)lane * 16u} : AuxSrc{hs + u.pm * BM, (unsigned)lane * 16u}; }
    __device__ __forceinline__ void operator()(const f32x4 (&acc)[2][2][4][2], const Unit& u, int wr, int wc, int fr, int fq, const LAS float* a0, const LAS float* a1) const {
        const int row0 = u.pm * BM + wr * 64 + fr, col0 = u.pn * BM + wc * 32 + 8 * fq;
        f32x4 wv[2][2];
#pragma unroll
        for (int bj = 0; bj < 2; ++bj)
#pragma unroll
            for (int n = 0; n < 2; ++n) wv[bj][n] = *(const LAS f32x4*)(a0 + wc * 32 + 8 * fq + bj * HALF + 4 * n);
#pragma unroll
        for (int ai = 0; ai < 2; ++ai)
#pragma unroll
            for (int m = 0; m < 4; ++m) { const int row = row0 + ai * HALF + m * 16; const float hr = a1[wr * 64 + fr + ai * HALF + m * 16]; bf16* rowp = O + (size_t)row * ldc + col0;
#pragma unroll
                for (int bj = 0; bj < 2; ++bj) { const f32x4 v0 = __builtin_convertvector(__builtin_bit_cast(v4i, acc[ai][bj][m][0]), f32x4) * hr * wv[bj][0], v1 = __builtin_convertvector(__builtin_bit_cast(v4i, acc[ai][bj][m][1]), f32x4) * hr * wv[bj][1];
                    u32x4 w; w.x = pk2(v0[0], v0[1]); w.y = pk2(v0[2], v0[3]); w.z = pk2(v1[0], v1[1]); w.w = pk2(v1[2], v1[3]);
                    *(u32x4*)(rowp + bj * HALF) = w; } }
    }
};
struct EpiResid {
    static constexpr bool PERM = true;
    const float* xin_lat; const float* xin_ctx; bf16* xb; const float* mod  ; int chunk; bool skip_ctx, first; float sc;
    __device__ __forceinline__ AuxSrc aux(int which, const Unit& u, int lane) const { const int b = u.pm / 17, j = u.pm - b * 17;
        return which == 0 ? AuxSrc{mod + (size_t)((j == 0 ? 8 : b) * 6 + chunk) * DM + u.pn * BM, (unsigned)lane * 16u} : AuxSrc{nullptr, 0u}; }
    __device__ __forceinline__ void operator()(const f32x4 (&acc)[2][2][4][2], const Unit& u, int wr, int wc, int fr, int fq, const LAS float* a0, const LAS float*) const {
        const int b = u.pm / 17, j = u.pm - b * 17; const bool isctx = (j == 0);
        if (isctx && skip_ctx) return;
        const float* xin = isctx ? xin_ctx + (size_t)b * CTX * DM : xin_lat + ((size_t)b * SEQ + (size_t)(j - 1) * 256) * DM;
        bf16* xt = xb + (size_t)u.pm * BM * DM;
        const int col0 = u.pn * BM + wc * 32 + 8 * fq;
        f32x4 gv[2][2];
#pragma unroll
        for (int bj = 0; bj < 2; ++bj)
#pragma unroll
            for (int n = 0; n < 2; ++n) gv[bj][n] = *(const LAS f32x4*)(a0 + wc * 32 + 8 * fq + bj * HALF + 4 * n) * sc;
#pragma unroll
        for (int ai = 0; ai < 2; ++ai)
#pragma unroll
            for (int m = 0; m < 4; ++m) { const size_t ro = (size_t)(ai * HALF + wr * 64 + m * 16 + fr) * DM;
#pragma unroll
                for (int bj = 0; bj < 2; ++bj) { const int c = col0 + bj * HALF; f32x4 x0, x1;
                    if (first) { x0 = *(const f32x4*)(xin + ro + c); x1 = *(const f32x4*)(xin + ro + c + 4); }
                    else { const u32x4 w = *(const u32x4*)(xt + ro + c); x0 = (f32x4){bflo(w.x), bfhi(w.x), bflo(w.y), bfhi(w.y)}; x1 = (f32x4){bflo(w.z), bfhi(w.z), bflo(w.w), bfhi(w.w)}; }
                    x0 = x0 + gv[bj][0] * acc[ai][bj][m][0]; x1 = x1 + gv[bj][1] * acc[ai][bj][m][1];
                    u32x4 o; o.x = pk2(x0[0], x0[1]); o.y = pk2(x0[2], x0[3]); o.z = pk2(x1[0], x1[1]); o.w = pk2(x1[2], x1[3]);
                    *(u32x4*)(xt + ro + c) = o; } }
    }
};
struct EpiGU {
    static constexpr bool PERM = true;
    void* ACT; const float* bgu  ;
    __device__ __forceinline__ AuxSrc aux(int which, const Unit& u, int lane) const {
        return which == 0 ? AuxSrc{bgu + (size_t)u.e * 2048 + u.pn * HALF, lane < 32 ? (unsigned)lane * 16u : 4096u + (unsigned)(lane - 32) * 16u} : AuxSrc{nullptr, 0u}; }
    __device__ __forceinline__ void operator()(const f32x4 (&acc)[2][2][4][2], const Unit& u, int wr, int wc, int fr, int fq, const LAS float* a0, const LAS float*) const {
        const int row0 = u.pm * BM + wr * 64 + fr, col0 = u.pn * HALF + wc * 32 + 8 * fq;
        constexpr float SC = MOE_FP8 ? 1.f / 512.f : 1.f;
        f32x4 bgv[2], buv[2];
#pragma unroll
        for (int n = 0; n < 2; ++n) { bgv[n] = *(const LAS f32x4*)(a0 + wc * 32 + 8 * fq + 4 * n); buv[n] = *(const LAS f32x4*)(a0 + HALF + wc * 32 + 8 * fq + 4 * n); }
#pragma unroll
        for (int ai = 0; ai < 2; ++ai)
#pragma unroll
            for (int m = 0; m < 4; ++m) { float o[8];
#pragma unroll
                for (int n = 0; n < 2; ++n)
#pragma unroll
                    for (int i = 0; i < 4; ++i) { float gt = acc[ai][0][m][n][i] * SC + bgv[n][i], up = acc[ai][1][m][n][i] * SC + buv[n][i];
                        gt = fminf(gt, 7.f); up = fminf(fmaxf(up, -7.f), 7.f);
                        o[4 * n + i] = (up + 1.f) * gt * sigm(1.702f * gt); }
                const size_t eo = (size_t)(row0 + ai * HALF + m * 16) * DM + col0;
                if constexpr (MOE_FP8) { u32x2 w; w.x = pk_fp8x4(4.f * o[0], 4.f * o[1], 4.f * o[2], 4.f * o[3]); w.y = pk_fp8x4(4.f * o[4], 4.f * o[5], 4.f * o[6], 4.f * o[7]);
                    *(u32x2*)((unsigned char*)ACT + eo) = w; }
                else { u32x4 w; w.x = pk2(o[0], o[1]); w.y = pk2(o[2], o[3]); w.z = pk2(o[4], o[5]); w.w = pk2(o[6], o[7]); *(u32x4*)((bf16*)ACT + eo) = w; } }
    }
};
struct EpiDown {
    static constexpr bool PERM = true;
    bf16* YM; const float* bdn  ; const float* gatep;
    __device__ __forceinline__ AuxSrc aux(int which, const Unit& u, int lane) const {
        return which == 0 ? AuxSrc{bdn + (size_t)u.e * 1024 + u.pn * BM, (unsigned)lane * 16u} : AuxSrc{gatep + (size_t)u.pm * BM, (unsigned)lane * 16u}; }
    __device__ __forceinline__ void operator()(const f32x4 (&acc)[2][2][4][2], const Unit& u, int wr, int wc, int fr, int fq, const LAS float* a0, const LAS float* a1) const {
        const int row0 = u.pm * BM + wr * 64 + fr, col0 = u.pn * BM + wc * 32 + 8 * fq;
        constexpr float SC = MOE_FP8 ? 1.f / 256.f : 1.f;
        f32x4 bv[2][2];
#pragma unroll
        for (int bj = 0; bj < 2; ++bj)
#pragma unroll
            for (int n = 0; n < 2; ++n) bv[bj][n] = *(const LAS f32x4*)(a0 + wc * 32 + 8 * fq + bj * HALF + 4 * n);
#pragma unroll
        for (int ai = 0; ai < 2; ++ai)
#pragma unroll
            for (int m = 0; m < 4; ++m) { const int row = row0 + ai * HALF + m * 16; const float gt = a1[wr * 64 + fr + ai * HALF + m * 16]; bf16* rowp = YM + (size_t)row * DM + col0;
#pragma unroll
                for (int bj = 0; bj < 2; ++bj) { const f32x4 v0 = (acc[ai][bj][m][0] * SC + bv[bj][0]) * gt, v1 = (acc[ai][bj][m][1] * SC + bv[bj][1]) * gt;
                    u32x4 w; w.x = pk2(v0[0], v0[1]); w.y = pk2(v0[2], v0[3]); w.z = pk2(v1[0], v1[1]); w.w = pk2(v1[2], v1[3]);
                    *(u32x4*)(rowp + bj * HALF) = w; } }
    }
};
}

namespace att {
constexpr int D = 128, NW = 8, QBLK = 32, KVBLK = 64;
constexpr float SCALE = 0.088388347648318440f;
constexpr float THR = 8.f;
constexpr int LDQ = PC, LDK = PC, LDO = DM;
constexpr size_t SHM_V = KVBLK * D * 2, SHM_K = KVBLK * D * 2, SHM_ATTN = 2 * SHM_V + 2 * SHM_K + NW * 64 * 4;
#define KSWZ(row, colB) ((row) * 256 + ((colB) ^ (((row) & 7) << 4)))
#define SBAR() __builtin_amdgcn_sched_barrier(0)
__device__ __forceinline__ int crow(int r, int hi) { return (r & 3) + 8 * (r >> 2) + 4 * hi; }
__device__ __forceinline__ unsigned cvtpk(float lo, float hi) { unsigned r; asm volatile("v_cvt_pk_bf16_f32 %0, %1, %2" : "=v"(r) : "v"(lo), "v"(hi)); return r; }
__device__ __forceinline__ bf16x8 ld8(const bf16* p) { return *reinterpret_cast<const bf16x8*>(p); }
__device__ __forceinline__ void finishSM(f32x16& p0, f32x16& p1, float& l_reg, bf16x8& pa0, bf16x8& pa1, bf16x8& pa2, bf16x8& pa3) {
  for (int r = 0; r < 16; ++r) p1[r] = __builtin_amdgcn_exp2f(p1[r]);
  float ps = 0; for (int r = 0; r < 16; ++r) ps += p0[r]; for (int r = 0; r < 16; ++r) ps += p1[r];
  { auto rr = __builtin_amdgcn_permlane32_swap(__float_as_uint(ps), __float_as_uint(ps), false, false);
    ps = __uint_as_float(rr[0]) + __uint_as_float(rr[1]); }
  l_reg += ps;
#define PK4(P, BASE, OUT) do { unsigned a0 = cvtpk(P[BASE + 0], P[BASE + 1]), a1 = cvtpk(P[BASE + 2], P[BASE + 3]);   \
    unsigned b0 = cvtpk(P[BASE + 4], P[BASE + 5]), b1 = cvtpk(P[BASE + 6], P[BASE + 7]);                              \
    auto r0 = __builtin_amdgcn_permlane32_swap(a0, b0, false, false); auto r1 = __builtin_amdgcn_permlane32_swap(a1, b1, false, false); \
    u32x4 w = {r0[0], r1[0], r0[1], r1[1]}; OUT = *reinterpret_cast<bf16x8*>(&w); } while (0)
  PK4(p0, 0, pa0); PK4(p0, 8, pa1); PK4(p1, 0, pa2); PK4(p1, 8, pa3);
#undef PK4
}
__device__ __forceinline__ void qkt(f32x16& p0, f32x16& p1, const LAS char* Ks, const bf16x8* qr, int r32, int hi, float negm) {
#pragma unroll
  for (int r = 0; r < 16; ++r) { p0[r] = negm; p1[r] = negm; }
  for (int d0 = 0; d0 < 8; ++d0) { int cb = (d0 * 16 + hi * 8) * 2;
    bf16x8 b0 = *reinterpret_cast<const LAS bf16x8*>(Ks + KSWZ(r32, cb));
    bf16x8 b1 = *reinterpret_cast<const LAS bf16x8*>(Ks + KSWZ(32 + r32, cb));
    p0 = __builtin_amdgcn_mfma_f32_32x32x16_bf16(b0, qr[d0], p0, 0, 0, 0);
    p1 = __builtin_amdgcn_mfma_f32_32x32x16_bf16(b1, qr[d0], p1, 0, 0, 0); }
}
__device__ __forceinline__ void partialSM_fix(f32x16& p0) { for (int r = 0; r < 16; ++r) p0[r] = __builtin_amdgcn_exp2f(p0[r]); }
__device__ __forceinline__ int v_st(int k, int c) { const int kk = (k & ~0xC) | ((k & 4) << 1) | ((k & 8) >> 1); return ((kk >> 3) * 4 + (c >> 5)) * 512 + ((kk & 7) * 32 + (c & 31)) * 2; }
__device__ __forceinline__ int v_rd_base(int lane) { return ((lane & 3) << 3) | (((lane >> 2) & 3) << 6) | (((lane >> 4) & 1) << 5) | (((lane >> 5) & 1) << 8); }
constexpr int v_rd_off(int d0, int ks, int half) { return d0 * 512 + ks * 4096 + half * 2048; }
template <int OFF> __device__ __forceinline__ s16x4 tr_read(int vb) {
  s16x4 r; asm volatile("ds_read_b64_tr_b16 %0, %1 offset:%2" : "=&v"(r) : "v"(vb), "i"(OFF) : "memory"); return r;
}
template <int D0> __device__ __forceinline__ void pv_one(f32x16& od, int vb, bf16x8 pa0, bf16x8 pa1, bf16x8 pa2, bf16x8 pa3) {
  const s16x4 l0 = tr_read<v_rd_off(D0, 0, 0)>(vb), h0 = tr_read<v_rd_off(D0, 0, 1)>(vb), l1 = tr_read<v_rd_off(D0, 1, 0)>(vb), h1 = tr_read<v_rd_off(D0, 1, 1)>(vb);
  const s16x4 l2 = tr_read<v_rd_off(D0, 2, 0)>(vb), h2 = tr_read<v_rd_off(D0, 2, 1)>(vb), l3 = tr_read<v_rd_off(D0, 3, 0)>(vb), h3 = tr_read<v_rd_off(D0, 3, 1)>(vb);
  asm volatile("s_waitcnt lgkmcnt(0)" ::: "memory"); SBAR();
#define PK(L, H) (bf16x8){L[0], L[1], L[2], L[3], H[0], H[1], H[2], H[3]}
  od = __builtin_amdgcn_mfma_f32_32x32x16_bf16(pa0, PK(l0, h0), od, 0, 0, 0);
  od = __builtin_amdgcn_mfma_f32_32x32x16_bf16(pa1, PK(l1, h1), od, 0, 0, 0);
  od = __builtin_amdgcn_mfma_f32_32x32x16_bf16(pa2, PK(l2, h2), od, 0, 0, 0);
  od = __builtin_amdgcn_mfma_f32_32x32x16_bf16(pa3, PK(l3, h3), od, 0, 0, 0);
#undef PK
}
__device__ __forceinline__ void pv_d0(f32x16* o, int vb, bf16x8 pa0, bf16x8 pa1, bf16x8 pa2, bf16x8 pa3) {
  pv_one<0>(o[0], vb, pa0, pa1, pa2, pa3); pv_one<1>(o[1], vb, pa0, pa1, pa2, pa3); pv_one<2>(o[2], vb, pa0, pa1, pa2, pa3); pv_one<3>(o[3], vb, pa0, pa1, pa2, pa3);
}
__device__ __forceinline__ void attn_dense_body(const bf16* __restrict__ Qb, const bf16* __restrict__ Kh, const bf16* __restrict__ Vh, bf16* __restrict__ Ob, int seq, LAS char* lds,
                                                const float* __restrict__ qg, const float* __restrict__ ropet, int t0, float negm_u, int exactmax) {
  const int tid = otid(), wid = tid >> 6, lane = tid & 63, r32 = lane & 31, hi = lane >> 5;
  LAS char* V_lds = lds; LAS char* K_lds = lds + 2 * SHM_V;
  LAS float* ws = (LAS float*)(lds + 2 * SHM_V + 2 * SHM_K) + wid * 64; LAS float* li_l = ws;
  float l_reg = 0; f32x16 o[4] = {}; bf16x8 qr[8];
  const bf16* Qw = Qb + (long)(wid * QBLK + r32) * LDQ + hi * 8;
#pragma unroll
  for (int d0 = 0; d0 < 8; ++d0) qr[d0] = ld8(Qw + d0 * 16);
  { float x[8][8]; float ss = 0.f;
#pragma unroll
    for (int d0 = 0; d0 < 8; ++d0) { const u32x4 w = __builtin_bit_cast(u32x4, qr[d0]);
#pragma unroll
      for (int p = 0; p < 4; ++p) { x[d0][2 * p] = bflo(w[p]); x[d0][2 * p + 1] = bfhi(w[p]); ss += x[d0][2 * p] * x[d0][2 * p] + x[d0][2 * p + 1] * x[d0][2 * p + 1]; } }
    { auto rr = __builtin_amdgcn_permlane32_swap(__float_as_uint(ss), __float_as_uint(ss), false, false); ss = __uint_as_float(rr[0]) + __uint_as_float(rr[1]); }
    const float rstd = __builtin_amdgcn_rsqf(ss * (1.f / 128.f) + EPS) * (SCALE * 1.4426950408889634f);
#pragma unroll
    for (int d0 = 0; d0 < 8; ++d0) { const f32x4 g0 = *(const f32x4*)(qg + 16 * d0 + 8 * hi), g1 = *(const f32x4*)(qg + 16 * d0 + 8 * hi + 4);
#pragma unroll
      for (int j = 0; j < 4; ++j) { x[d0][j] *= rstd * g0[j]; x[d0][4 + j] *= rstd * g1[j]; } }
    if (t0 >= 0) { const int t = t0 + wid * QBLK + r32;
#pragma unroll
      for (int kind = 0; kind < 2; ++kind) { const int pos = kind == 0 ? (t >> 6) : (t & 63);
#pragma unroll
        for (int e = 0; e < 2; ++e) { const float* cp = ropet + pos * 32 + 16 * e + 8 * hi;
          const f32x4 c0 = *(const f32x4*)cp, c1 = *(const f32x4*)(cp + 4), s0 = *(const f32x4*)(cp + 2048), s1 = *(const f32x4*)(cp + 2048 + 4);
#pragma unroll
          for (int j = 0; j < 8; ++j) { const float cs = j < 4 ? c0[j & 3] : c1[j & 3], sn = j < 4 ? s0[j & 3] : s1[j & 3];
            const float a1 = x[4 * kind + e][j], a2 = x[4 * kind + 2 + e][j]; x[4 * kind + e][j] = a1 * cs - a2 * sn; x[4 * kind + 2 + e][j] = a2 * cs + a1 * sn; } } } }
#pragma unroll
    for (int d0 = 0; d0 < 8; ++d0) { u32x4 w; w.x = pk2(x[d0][0], x[d0][1]); w.y = pk2(x[d0][2], x[d0][3]); w.z = pk2(x[d0][4], x[d0][5]); w.w = pk2(x[d0][6], x[d0][7]); qr[d0] = __builtin_bit_cast(bf16x8, w); } }
  const int sr = tid >> 4, sc = (tid & 15) * 8, vst0 = v_st(sr, sc), vst1 = v_st(32 + sr, sc);
  const int vb0 = (int)(unsigned)(size_t)V_lds + v_rd_base(lane);
  const unsigned goff = (unsigned)(sr * LDK + sc) * 2u;
  const char* Kb0 = (const char*)Kh; const char* Vb0 = (const char*)Vh;
  const int NT = seq / KVBLK;
  float negm = negm_u;
  if (exactmax) {
    float mrow = -3.0e38f; f32x16 p0, p1;
    for (int j = 0; j < NT; ++j) { const size_t to_ = (size_t)j * KVBLK * LDK * 2;
      const bf16x8 k0 = *(const bf16x8*)(Kb0 + to_ + goff), k1 = *(const bf16x8*)(Kb0 + to_ + (size_t)32 * LDK * 2 + goff);
      __syncthreads();
      *(LAS bf16x8*)(K_lds + KSWZ(sr, sc * 2)) = k0; *(LAS bf16x8*)(K_lds + KSWZ(32 + sr, sc * 2)) = k1;
      __syncthreads();
      qkt(p0, p1, K_lds, qr, r32, hi, 0.f);
#pragma unroll
      for (int r = 0; r < 16; ++r) mrow = fmaxf(mrow, fmaxf(p0[r], p1[r])); }
    { auto rr = __builtin_amdgcn_permlane32_swap(__float_as_uint(mrow), __float_as_uint(mrow), false, false); mrow = fmaxf(__uint_as_float(rr[0]), __uint_as_float(rr[1])); }
    negm = -mrow; __syncthreads(); }
  struct { bf16x8 vs0, vs1, ks0, ks1; } sr_[1];
#define SLOAD(i, k0) do { const size_t to_ = (size_t)(k0) * LDK * 2; \
    sr_[i].vs0 = *(const bf16x8*)(Vb0 + to_ + goff); sr_[i].vs1 = *(const bf16x8*)(Vb0 + to_ + (size_t)32 * LDK * 2 + goff); \
    sr_[i].ks0 = *(const bf16x8*)(Kb0 + to_ + goff); sr_[i].ks1 = *(const bf16x8*)(Kb0 + to_ + (size_t)32 * LDK * 2 + goff); } while (0)
#define SWRITE(b, i) do { *(LAS bf16x8*)(V_lds + (b) * SHM_V + vst0) = sr_[i].vs0;          \
    *(LAS bf16x8*)(V_lds + (b) * SHM_V + vst1) = sr_[i].vs1; int kc = sc * 2;               \
    *(LAS bf16x8*)(K_lds + (b) * SHM_K + KSWZ(sr, kc)) = sr_[i].ks0;                       \
    *(LAS bf16x8*)(K_lds + (b) * SHM_K + KSWZ(32 + sr, kc)) = sr_[i].ks1; } while (0)
#define SWAIT() asm volatile("s_waitcnt vmcnt(0)" ::: "memory")
#define PSM(P0) do { for (int r_ = 0; r_ < 16; ++r_) P0[r_] = __builtin_amdgcn_exp2f(P0[r_]); } while (0)
  f32x16 pA0, pA1, pB0, pB1; bf16x8 pa0, pa1, pa2, pa3;
  constexpr int SE = 0, SO = 0;
  SLOAD(SE, 0); asm volatile("s_waitcnt vmcnt(0)" ::: "memory"); SWRITE(0, SE); __syncthreads();
  qkt(pA0, pA1, K_lds, qr, r32, hi, negm); PSM(pA0);
  SLOAD(SO, KVBLK);
  SWAIT(); SWRITE(1, SO); if (2 < NT) SLOAD(SE, 2 * KVBLK); __syncthreads();
  for (int j = 1; j + 1 < NT; j += 2) {
    SBAR(); qkt(pB0, pB1, K_lds + SHM_K, qr, r32, hi, negm);
    finishSM(pA0, pA1, l_reg, pa0, pa1, pa2, pa3); SBAR();
    pv_d0(o, vb0, pa0, pa1, pa2, pa3); PSM(pB0);
    __syncthreads(); SWAIT(); SWRITE(0, SE); SBAR(); SLOAD(SO, (j + 2) * KVBLK); SBAR();
    __syncthreads();
    SBAR(); qkt(pA0, pA1, K_lds, qr, r32, hi, negm);
    finishSM(pB0, pB1, l_reg, pa0, pa1, pa2, pa3); SBAR();
    pv_d0(o, vb0 + (int)SHM_V, pa0, pa1, pa2, pa3); PSM(pA0);
    __syncthreads(); SWAIT(); SWRITE(1, SO); SBAR(); if (j + 3 < NT) SLOAD(SE, (j + 3) * KVBLK); SBAR();
    __syncthreads();
  }
  SBAR(); qkt(pB0, pB1, K_lds + SHM_K, qr, r32, hi, negm);
  finishSM(pA0, pA1, l_reg, pa0, pa1, pa2, pa3); SBAR();
  pv_d0(o, vb0, pa0, pa1, pa2, pa3); PSM(pB0);
  __syncthreads();
  finishSM(pB0, pB1, l_reg, pa0, pa1, pa2, pa3); SBAR();
  pv_d0(o, vb0 + (int)SHM_V, pa0, pa1, pa2, pa3);
#undef PSM
  if (hi == 0) li_l[r32] = l_reg; asm volatile("s_waitcnt lgkmcnt(0)" ::: "memory");
  float rli[16];
#pragma unroll
  for (int r = 0; r < 16; ++r) rli[r] = __builtin_amdgcn_rcpf(li_l[crow(r, hi)]);
  bf16* Ow = Ob + (long)(wid * QBLK) * LDO;
#pragma unroll
  for (int r = 0; r < 16; ++r) { int orow = crow(r, hi);
    for (int d0 = 0; d0 < 4; ++d0) { if (OUTPROJ_FP8) ((unsigned char*)Ob)[(long)(wid * QBLK + orow) * LDO + d0 * 32 + r32] = (unsigned char)fp8_1(16.f * o[d0][r] * rli[r]); else Ow[(long)orow * LDO + d0 * 32 + r32] = (bf16)f2bf(o[d0][r] * rli[r]); } }
#undef SLOAD
#undef SWRITE
#undef SWAIT
}
}

enum { PH_PRO = 0, PH_NORM1 = 1, PH_INPROJ = 2, PH_PREP = 3, PH_SCAN = 4, PH_ATTN = 5, PH_FINISH = 6, PH_OUTPROJ = 7, PH_ROUTER = 8, PH_DISPATCH = 9, PH_GU = 10, PH_DOWN = 11, PH_COMBINE = 12, NPH = 13 };

struct MapIn  { __device__ __forceinline__ int operator()(int n) const { return n < 2320 ? n + 1024 : n - 2320; } };
struct MapId  { __device__ __forceinline__ int operator()(int n) const { return n; } };
struct MapGU  { __device__ __forceinline__ int operator()(int n) const { const int bj = n >> 10, w = n & 1023; return (w >> 7) * 256 + bj * 128 + (w & 127); } };
struct TrItem { const float* W; unsigned char* WT; int N, kind  , kb, nb, m  ; unsigned* cmax; };
__device__ __forceinline__ int tr_map(int kind, int n) {
    if (kind == 0) return n < 2320 ? n + 1024 : n - 2320;
    if (kind == 2) { const int bj = n >> 10, w = n & 1023; return (w >> 7) * 256 + bj * 128 + (w & 127); }
    return n;
}
__device__ __forceinline__ void tr_load(f32x4 (&v)[16], const TrItem& t, int lane) {
    const int nq = (lane & 15) * 4, kr = lane >> 4; const bool okn = 64 * t.nb + nq < t.N;
#pragma unroll
    for (int j = 0; j < 16; ++j) v[j] = okn ? *(const f32x4*)(t.W + (size_t)(64 * t.kb + kr + 4 * j) * t.N + 64 * t.nb + nq) : (f32x4){0.f, 0.f, 0.f, 0.f};
}
__device__ __forceinline__ void tr_store(const f32x4 (&v)[16], const TrItem& t, LAS float* scr, int lane) {
    const int k0 = 64 * t.kb, n0 = 64 * t.nb, nq = (lane & 15) * 4, kr = lane >> 4;
#pragma unroll
    for (int j = 0; j < 16; ++j) { LAS float* s = scr + (kr + 4 * j) * 65 + nq; s[0] = v[j][0]; s[1] = v[j][1]; s[2] = v[j][2]; s[3] = v[j][3]; }
    LDS_WAIT(); asm volatile("" ::: "memory");
    if (INPROJ_I8 && t.kind == 0) {
        const int n = n0 + lane; float mx = 0.f;
#pragma unroll 8
        for (int k = 0; k < 64; ++k) mx = fmaxf(mx, fabsf(scr[k * 65 + lane]));
        if (n < t.N) __hip_atomic_fetch_max(t.cmax + t.m * PC + tr_map(0, n), __float_as_uint(mx), __ATOMIC_RELAXED, __HIP_MEMORY_SCOPE_AGENT);
        LDS_WAIT(); asm volatile("" ::: "memory"); return; }
    if ((MOE_FP8 && t.kind >= 2) || (OUTPROJ_FP8 && t.kind == 1)) { const int c = lane & 3;
#pragma unroll
        for (int j = 0; j < 4; ++j) { const int nl = (lane >> 2) + 16 * j, n = n0 + nl; const LAS float* s = scr + (16 * c) * 65 + nl;
            u32x4 o; o.x = pk_fp8x4(64.f * s[0 * 65], 64.f * s[1 * 65], 64.f * s[2 * 65], 64.f * s[3 * 65]); o.y = pk_fp8x4(64.f * s[4 * 65], 64.f * s[5 * 65], 64.f * s[6 * 65], 64.f * s[7 * 65]);
            o.z = pk_fp8x4(64.f * s[8 * 65], 64.f * s[9 * 65], 64.f * s[10 * 65], 64.f * s[11 * 65]); o.w = pk_fp8x4(64.f * s[12 * 65], 64.f * s[13 * 65], 64.f * s[14 * 65], 64.f * s[15 * 65]);
            if (n < t.N) *(u32x4*)(t.WT + (size_t)tr_map(t.kind, n) * 1024 + k0 + 16 * c) = o; } }
    else { const int c = lane & 7;
#pragma unroll
        for (int j = 0; j < 8; ++j) { const int nl = (lane >> 3) + 8 * j, n = n0 + nl; const LAS float* s = scr + (8 * c) * 65 + nl;
            u32x4 o; o.x = pk2(s[0 * 65], s[1 * 65]); o.y = pk2(s[2 * 65], s[3 * 65]); o.z = pk2(s[4 * 65], s[5 * 65]); o.w = pk2(s[6 * 65], s[7 * 65]);
            if (n < t.N) *(u32x4*)((bf16*)t.WT + (size_t)tr_map(t.kind, n) * 1024 + k0 + 8 * c) = o; } }
    LDS_WAIT(); asm volatile("" ::: "memory");
}
__device__ __forceinline__ void tr_load_w(f32x4 (&v)[16], const TrItem& t, int lane) {
    const int nq = (lane & 7) * 4, kr = lane >> 3;
#pragma unroll
    for (int j = 0; j < 16; ++j) v[j] = *(const f32x4*)(t.W + (size_t)(128 * t.kb + kr + 8 * j) * t.N + 32 * t.nb + nq);
}
__device__ __forceinline__ void tr_store_w(const f32x4 (&v)[16], const TrItem& t, LAS float* scr, int lane) {
    const int k0 = 128 * t.kb, n0 = 32 * t.nb, nq = (lane & 7) * 4, kr = lane >> 3;
#pragma unroll
    for (int j = 0; j < 16; ++j) { LAS float* s = scr + (kr + 8 * j) * 33 + nq; s[0] = v[j][0]; s[1] = v[j][1]; s[2] = v[j][2]; s[3] = v[j][3]; }
    LDS_WAIT(); asm volatile("" ::: "memory");
    const int c = lane & 7;
#pragma unroll
    for (int j = 0; j < 4; ++j) { const int nl = (lane >> 3) + 8 * j, n = n0 + nl; const LAS float* s = scr + (16 * c) * 33 + nl;
        u32x4 o; o.x = pk_fp8x4(64.f * s[0 * 33], 64.f * s[1 * 33], 64.f * s[2 * 33], 64.f * s[3 * 33]); o.y = pk_fp8x4(64.f * s[4 * 33], 64.f * s[5 * 33], 64.f * s[6 * 33], 64.f * s[7 * 33]);
        o.z = pk_fp8x4(64.f * s[8 * 33], 64.f * s[9 * 33], 64.f * s[10 * 33], 64.f * s[11 * 33]); o.w = pk_fp8x4(64.f * s[12 * 33], 64.f * s[13 * 33], 64.f * s[14 * 33], 64.f * s[15 * 33]);
        *(u32x4*)(t.WT + (size_t)tr_map(t.kind, n) * 1024 + k0 + 16 * c) = o; }
    LDS_WAIT(); asm volatile("" ::: "memory");
}
__device__ __forceinline__ void p_prologue(const Args& a, LAS unsigned char* lds) {
    const int tid = otid(), lane = tid & 63, wave = tid >> 6, G = ogrid(), bid = obid();
    const int gw = bid * NWAVE + wave, NGW = G * NWAVE;
    const int gt = bid * NTHR + tid, NGT = G * NTHR;
    LAS float* scr = (LAS float*)(lds + wave * 16896);
    constexpr int NNB_IN = (NIN + 63) / 64;
    constexpr int I_IN = 16 * NNB_IN, I_OUT = 16 * 16, I_GU = 16 * 32, I_DN = 16 * 16;
    constexpr int T_IN = DEPTH * I_IN, T_OUT = DEPTH * I_OUT, T_GU = DEPTH * NEXP * I_GU, T_DN = DEPTH * NEXP * I_DN;
    constexpr int NITEMS = T_IN + T_OUT + T_GU + T_DN;
    constexpr size_t WB = MOE_FP8 ? 1 : 2;
    auto decode = [&](int it) { TrItem t; int r = it;
        if (r < T_IN) { const int m = r / I_IN, q = r % I_IN; t.W = a.in[8] + (size_t)m * 1024 * NIN; t.WT = a.ws + WS_WIN + (size_t)m * PC * 1024 * 2; t.N = NIN; t.kind = 0; t.kb = q / NNB_IN; t.nb = q % NNB_IN; t.m = m; t.cmax = (unsigned*)(a.ws + WS_CTL) + CW_CMAX; return t; } r -= T_IN;
        if (r < T_OUT) { const int m = r / I_OUT, q = r % I_OUT; t.W = a.in[9] + (size_t)m * 1024 * 1024; t.WT = a.ws + WS_WOUT + (size_t)m * 1024 * 1024 * (OUTPROJ_FP8 ? 1 : 2); t.N = 1024; t.kind = 1; t.kb = q / 16; t.nb = q % 16; return t; } r -= T_OUT;
        if (r < T_GU) { const int m = r / I_GU, q = r % I_GU; t.W = a.in[18] + (size_t)m * 1024 * 2048; t.WT = a.ws + WS_WGU + (size_t)m * 2048 * 1024 * WB; t.N = 2048; t.kind = 2; if (MOE_FP8) { t.kb = q / 64; t.nb = q % 64; } else { t.kb = q / 32; t.nb = q % 32; } return t; } r -= T_GU;
        { const int m = r / I_DN, q = r % I_DN; t.W = a.in[20] + (size_t)m * 1024 * 1024; t.WT = a.ws + WS_WDN + (size_t)m * 1024 * 1024 * WB; t.N = 1024; t.kind = 3; if (MOE_FP8) { t.kb = q / 32; t.nb = q % 32; } else { t.kb = q / 16; t.nb = q % 16; } return t; } };
    if (gw < NITEMS) {
        TrItem cur = decode(gw); f32x4 vc[16]; if (MOE_FP8 && cur.kind >= 2) tr_load_w(vc, cur, lane); else tr_load(vc, cur, lane);
        for (int it = gw; it < NITEMS; it += NGW) {
            const bool more = it + NGW < NITEMS; TrItem nxt = cur; f32x4 vn[16];
            if (more) { nxt = decode(it + NGW); if (MOE_FP8 && nxt.kind >= 2) tr_load_w(vn, nxt, lane); else tr_load(vn, nxt, lane); }
            if (MOE_FP8 && cur.kind >= 2) tr_store_w(vc, cur, scr, lane); else tr_store(vc, cur, scr, lane);
            if (more) { cur = nxt;
#pragma unroll
                for (int j = 0; j < 16; ++j) vc[j] = vn[j]; }
        }
    }
    if (!INPROJ_I8) for (int i = gt; i < DEPTH * (PC - NIN) * 128; i += NGT) { const int m = i / ((PC - NIN) * 128), q = i % ((PC - NIN) * 128);
        *(u32x4*)((bf16*)(a.ws + WS_WIN) + ((size_t)m * PC + NIN) * 1024 + (size_t)q * 8) = (u32x4){0u, 0u, 0u, 0u}; }
    for (int i = gt; i < DEPTH * 32 * 1024; i += NGT) { const int l = i >> 15, e = (i >> 10) & 31, k = i & 1023;
        const float w = a.in[16][((size_t)l * 1024 + k) * 32 + e]; const unsigned h = f2bf(w); const float lo = w - bf2f(h);
        ((bf16*)(a.ws + WS_WRH))[i] = (bf16)h; ((bf16*)(a.ws + WS_WRL))[i] = (bf16)f2bf(lo); }
    for (int i = gt; i < 64 * 32; i += NGT) { const int pos = i >> 5, fi = i & 31;
        const float inv = powf(10000.f, -(float)(2 * fi) / 64.f); const float ang = (float)pos * inv;
        ((float*)(a.ws + WS_ROPE))[i] = cosf(ang); ((float*)(a.ws + WS_ROPE))[2048 + i] = sinf(ang); }
    __syncthreads();
    {
        LAS float* SL = (LAS float*)lds;
        LAS float* PT = (LAS float*)(lds + 40960);
        bool have = false;
        for (int it = bid; it < DEPTH * 96; it += G) {
            if (!have) { for (int i = tid; i < 9 * 1024; i += NTHR) { const float v = i < 8192 ? a.in[1][i] : a.in[3][i - 8192]; SL[i] = v / (1.f + expf(-v)); } have = true; __syncthreads(); }
            const int l = it / 96, n = (it % 96) * 64 + lane;
            const float* W = a.in[4] + ((size_t)l * 1024 + wave * 128) * 6144 + n;
            float acc[9];
#pragma unroll
            for (int j = 0; j < 9; ++j) acc[j] = 0.f;
#pragma unroll 8
            for (int k = 0; k < 128; ++k) { const float w = W[(size_t)k * 6144];
#pragma unroll
                for (int j = 0; j < 9; ++j) acc[j] += SL[j * 1024 + wave * 128 + k] * w; }
#pragma unroll
            for (int j = 0; j < 9; ++j) PT[(wave * 9 + j) * 64 + lane] = acc[j];
            __syncthreads();
            for (int i = tid; i < 9 * 64; i += NTHR) { const int j = i >> 6, c = i & 63; float s = 0.f;
#pragma unroll
                for (int w = 0; w < 8; ++w) s += PT[(w * 9 + j) * 64 + c];
                const int nn = (it % 96) * 64 + c;
                ((float*)(a.ws + WS_MOD))[(size_t)(l * 9 + j) * 6144 + nn] = s + a.in[5][(size_t)l * 6144 + nn]; }
            __syncthreads();
        }
    }
}

__device__ __forceinline__ void norm_mod_store(f32x4 (&v)[2][2], const float* gn, const float* sc, const float* sh, bf16* hrow, int lane) {
    float ss = 0.f;
#pragma unroll
    for (int j = 0; j < 2; ++j)
#pragma unroll
        for (int q = 0; q < 2; ++q) ss += (v[j][q][0] * v[j][q][0] + v[j][q][1] * v[j][q][1]) + (v[j][q][2] * v[j][q][2] + v[j][q][3] * v[j][q][3]);
    const float rstd = 1.f / sqrtf(wave_sum(ss) * (1.f / DM) + EPS);
#pragma unroll
    for (int j = 0; j < 2; ++j) { const int c = 8 * lane + 512 * j;
#pragma unroll
        for (int q = 0; q < 2; ++q) { const f32x4 g = *(const f32x4*)(gn + c + 4 * q), s1 = *(const f32x4*)(sc + c + 4 * q), s0 = *(const f32x4*)(sh + c + 4 * q);
            v[j][q] = v[j][q] * rstd * g * (1.f + s1) + s0; }
        if (hrow) { u32x4 w; w.x = pk2(v[j][0][0], v[j][0][1]); w.y = pk2(v[j][0][2], v[j][0][3]); w.z = pk2(v[j][1][0], v[j][1][1]); w.w = pk2(v[j][1][2], v[j][1][3]);
            *(u32x4*)(hrow + c) = w; } }
}
__device__ __forceinline__ void load_row_bf(const bf16* xr, f32x4 (&v)[2][2], int lane) {
#pragma unroll
    for (int j = 0; j < 2; ++j) { const u32x4 w = *(const u32x4*)(xr + 8 * lane + 512 * j);
        v[j][0] = (f32x4){bflo(w.x), bfhi(w.x), bflo(w.y), bfhi(w.y)}; v[j][1] = (f32x4){bflo(w.z), bfhi(w.z), bflo(w.w), bfhi(w.w)}; }
}
__device__ __forceinline__ void load_row(const float* xr, f32x4 (&v)[2][2], int lane) {
#pragma unroll
    for (int j = 0; j < 2; ++j)
#pragma unroll
        for (int q = 0; q < 2; ++q) v[j][q] = *(const f32x4*)(xr + 8 * lane + 512 * j + 4 * q);
}

__device__ __forceinline__ void p_quant_win(const Args& a) {
    const int gt = obid() * NTHR + otid(), NGT = ogrid() * NTHR;
    const unsigned* CM = (const unsigned*)(a.ws + WS_CTL) + CW_CMAX; float* WSC = (float*)(a.ws + WS_WSC); unsigned char* W8 = (unsigned char*)(a.ws + WS_WIN);
    for (int idx = gt; idx < DEPTH * 64 * PC; idx += NGT) { const int l = idx / (64 * PC), rem = idx - l * (64 * PC), kc = rem / PC, j = rem - kc * PC;
        u32x4 o = {0u, 0u, 0u, 0u}; float s = 0.f;
        if (j < NIN) { const int n = j < 1024 ? j + 2320 : j - 1024; const float cm = __uint_as_float(__hip_atomic_load(CM + l * PC + j, __ATOMIC_RELAXED, __HIP_MEMORY_SCOPE_AGENT));
            s = cm * (1.f / 127.f); const float inv = cm > 0.f ? 127.f / cm : 0.f; const float* wp = a.in[8] + ((size_t)l * 1024 + 16 * kc) * NIN + n; float w[16];
#pragma unroll
            for (int i = 0; i < 16; ++i) w[i] = wp[(size_t)i * NIN] * inv;
            o.x = pk_i8x4(w[0], w[1], w[2], w[3]); o.y = pk_i8x4(w[4], w[5], w[6], w[7]); o.z = pk_i8x4(w[8], w[9], w[10], w[11]); o.w = pk_i8x4(w[12], w[13], w[14], w[15]); }
        *(u32x4*)(W8 + ((size_t)l * PC + j) * 1024 + 16 * kc) = o;
        if (kc == 0) WSC[l * PC + j] = s; }
}
__device__ __forceinline__ void store_row_i8(const f32x4 (&v)[2][2], unsigned char* hrow, float* hs, int lane) {
    float mx = 0.f;
#pragma unroll
    for (int j = 0; j < 2; ++j)
#pragma unroll
        for (int q = 0; q < 2; ++q) mx = fmaxf(fmaxf(mx, fmaxf(fabsf(v[j][q][0]), fabsf(v[j][q][1]))), fmaxf(fabsf(v[j][q][2]), fabsf(v[j][q][3])));
    mx = fmaxf(wave_max_nn(mx), 1e-20f); const float inv = 127.f / mx;
#pragma unroll
    for (int j = 0; j < 2; ++j) { u32x2 w; w.x = pk_i8x4(v[j][0][0] * inv, v[j][0][1] * inv, v[j][0][2] * inv, v[j][0][3] * inv); w.y = pk_i8x4(v[j][1][0] * inv, v[j][1][1] * inv, v[j][1][2] * inv, v[j][1][3] * inv);
        *(u32x2*)(hrow + 8 * lane + 512 * j) = w; }
    if (lane == 0) *hs = mx * (1.f / 127.f);
}
__device__ __forceinline__ void p_norm1(const Args& a, int layer) {
    const int tid = otid(), lane = tid & 63, wave = tid >> 6; const int gw = obid() * NWAVE + wave, NGW = ogrid() * NWAVE;
    bf16* H = (bf16*)(a.ws + WS_H);
    for (int r = gw; r < NR; r += NGW) { f32x4 v[2][2]; load_row(x_rd(a, layer == 0, r), v, lane);
        norm_mod_store(v, a.in[6] + (size_t)layer * DM, modv(a, layer, r, 1), modv(a, layer, r, 0), INPROJ_I8 ? (bf16*)nullptr : H + (size_t)r * DM, lane);
        if (INPROJ_I8) store_row_i8(v, (unsigned char*)(a.ws + WS_H) + (size_t)r * DM, (float*)(a.ws + WS_HSC) + r, lane); }
}

__device__ __forceinline__ void p_prep(const Args& a, int layer, bool dry = false) {
    const int tid = otid(), lane = tid & 63, wave = tid >> 6; const int gw = obid() * NWAVE + wave, NGW = ogrid() * NWAVE;
    bf16* P = (bf16*)(a.ws + WS_P); const float* COS = (const float*)(a.ws + WS_ROPE); const float* SIN = COS + 2048;
    const int half = lane >> 5, fi = lane & 31;
    const float gq1 = a.in[14][layer * 128 + half * 64 + fi], gq2 = a.in[14][layer * 128 + half * 64 + 32 + fi];
    const float gk1 = a.in[15][layer * 128 + half * 64 + fi], gk2 = a.in[15][layer * 128 + half * 64 + 32 + fi];
    for (int r = gw; r < NR; r += NGW) { const int s = r % SB; const bool lat = s >= CTX; const int t = s - CTX;
        float cs = 1.f, sn = 0.f;
        if (lat) { const int pos = half == 0 ? (t >> 6) : (t & 63); cs = COS[pos * 32 + fi]; sn = SIN[pos * 32 + fi]; }
        bf16* pr = P + (size_t)r * PC;
#pragma unroll
        for (int hh = 4; hh < 6; ++hh) { bf16* p1 = pr + hh * 128 + half * 64 + fi;
            const float x1 = bf2f(p1[0]), x2 = bf2f(p1[32]);
            const float rstd = __builtin_amdgcn_rsqf(wave_sum(x1 * x1 + x2 * x2) * (1.f / 128.f) + EPS);
            const float y1 = x1 * rstd * gk1, y2 = x2 * rstd * gk2;
            bf16* po = dry ? (bf16*)(a.ws + WS_ACT) + (size_t)r * 1024 + hh * 128 + half * 64 + fi : p1;
            po[0] = (bf16)f2bf(y1 * cs - y2 * sn); po[32] = (bf16)f2bf(y2 * cs + y1 * sn); }
    }
}

__device__ __forceinline__ int seq_step_s(int dir, int n) { return dir == 0 ? n : (n < CTX ? CTX - 1 - n : SB + CTX - 1 - n); }
__device__ __forceinline__ void hg_seq(const Args& a, int layer, int sid, LAS unsigned char* lds) {
    const int tid = otid(), lane = tid & 63, wave = tid >> 6;
    const int dir = sid & 1, h = (sid >> 1) & 3, b = sid >> 3;
    LAS float* qs = (LAS float*)lds; LAS float* ks = qs + 2048; LAS float* fs = ks + 2048; LAS float* vs = fs + 2048; LAS float* part = vs + 2048;
    const bf16* P = (const bf16*)(a.ws + WS_P);
    float* OH = (float*)(a.ws + WS_OH) + (size_t)dir * NR * 256;
    float lb;
    { const float* lg = a.in[10] + (size_t)dir * DEPTH * 256 + h * 64 + lane;
      const float l0 = lg[0], l1 = lg[256], l2 = lg[512], l3 = lg[768]; const float mx = fmaxf(fmaxf(l0, l1), fmaxf(l2, l3));
      const float e0 = expf(l0 - mx), e1 = expf(l1 - mx), e2 = expf(l2 - mx), e3 = expf(l3 - mx);
      lb = ((layer >= 1 ? e1 : 0.f) + (layer >= 2 ? e2 : 0.f) + (layer >= 3 ? e3 : 0.f)) / (e0 + e1 + e2 + e3); }
    float S[8];
#pragma unroll
    for (int i = 0; i < 8; ++i) S[i] = 0.f;
    for (int n0 = 0; n0 < SB; n0 += 32) {
#pragma unroll
        for (int jj = 0; jj < 4; ++jj) { const int j = wave + 8 * jj; const int s = seq_step_s(dir, n0 + j);
            const bf16* pr = P + (size_t)(b * SB + s) * PC + h * 64 + lane;
            const float q = bf2f(pr[C_HGQ]), z = bf2f(pr[dir ? C_HGZB : C_HGZF]), v = bf2f(pr[C_HGV]);
            const float sg = 1.f / (1.f + expf(-z));
            qs[j * 64 + lane] = q; fs[j * 64 + lane] = lb + (1.f - lb) * sg; ks[j * 64 + lane] = (1.f - lb) * (1.f - sg); vs[j * 64 + lane] = v; }
        __syncthreads();
        for (int j = 0; j < 32; ++j) { const float v = vs[j * 64 + lane]; float p = 0.f;
#pragma unroll
            for (int i = 0; i < 8; ++i) { const int d = wave * 8 + i; S[i] = fs[j * 64 + d] * S[i] + ks[j * 64 + d] * v; p += S[i] * qs[j * 64 + d]; }
            part[(wave * 32 + j) * 64 + lane] = p; }
        __syncthreads();
#pragma unroll
        for (int jj = 0; jj < 4; ++jj) { const int j = wave + 8 * jj; float o = 0.f;
#pragma unroll
            for (int w = 0; w < 8; ++w) o += part[(w * 32 + j) * 64 + lane];
            const int s = seq_step_s(dir, n0 + j); OH[(size_t)(b * SB + s) * 256 + h * 64 + lane] = o; }
        __syncthreads();
    }
}
__device__ __forceinline__ void ml_seq(const Args& a, int layer, int sid, LAS unsigned char* lds) {
    const int tid = otid(), lane = tid & 63, wave = tid >> 6;
    const int dir = sid & 1, h = (sid >> 1) & 3, b = sid >> 3;
    LAS float* qs = (LAS float*)lds; LAS float* ks = qs + 2048; LAS float* vs = ks + 2048; LAS float* part = vs + 2048;
    LAS float* ip = part + 8 * 2048; LAS float* lf = ip + 32; LAS float* dp = lf + 32; LAS float* ms = dp + 8 * 32;
    const bf16* P = (const bf16*)(a.ws + WS_P);
    float* OM = (float*)(a.ws + WS_OM) + (size_t)dir * NR * 256;
    const float bi = a.in[12][layer * 16 + dir * 4 + h], bfg = a.in[12][layer * 16 + 8 + dir * 4 + h];
    float C[8], nn[8], m = 0.f;
#pragma unroll
    for (int i = 0; i < 8; ++i) { C[i] = 0.f; nn[i] = 0.f; }
    for (int n0 = 0; n0 < SB; n0 += 32) {
#pragma unroll
        for (int jj = 0; jj < 4; ++jj) { const int j = wave + 8 * jj; const int s = seq_step_s(dir, n0 + j);
            const bf16* pr = P + (size_t)(b * SB + s) * PC;
            qs[j * 64 + lane] = bf2f(pr[C_MLQ + h * 64 + lane]); ks[j * 64 + lane] = bf2f(pr[C_MLK + h * 64 + lane]) * 0.125f; vs[j * 64 + lane] = bf2f(pr[C_MLV + h * 64 + lane]);
            if (lane == 0) { ip[j] = bf2f(pr[C_MLG + dir * 4 + h]) + bi; const float fp = bf2f(pr[C_MLG + 8 + dir * 4 + h]) + bfg;
                lf[j] = fminf(fp, 0.f) - log1pf(expf(-fabsf(fp))); } }
        __syncthreads();
        for (int j = 0; j < 32; ++j) { const float v = vs[j * 64 + lane]; const float ipj = ip[j], lfj = lf[j];
            const float mn = fmaxf(lfj + m, ipj); const float aa = expf(lfj + m - mn), bb = expf(ipj - mn); m = mn;
            float p = 0.f, dn = 0.f;
#pragma unroll
            for (int i = 0; i < 8; ++i) { const int d = wave * 8 + i; const float kk = ks[j * 64 + d] * bb, qq = qs[j * 64 + d];
                C[i] = aa * C[i] + kk * v; nn[i] = aa * nn[i] + kk; p += C[i] * qq; dn += nn[i] * qq; }
            part[(wave * 32 + j) * 64 + lane] = p; if (lane == 0) { dp[wave * 32 + j] = dn; if (wave == 0) ms[j] = mn; } }
        __syncthreads();
#pragma unroll
        for (int jj = 0; jj < 4; ++jj) { const int j = wave + 8 * jj; float o = 0.f, dn = 0.f;
#pragma unroll
            for (int w = 0; w < 8; ++w) { o += part[(w * 32 + j) * 64 + lane]; dn += dp[w * 32 + j]; }
            const int s = seq_step_s(dir, n0 + j); OM[(size_t)(b * SB + s) * 256 + h * 64 + lane] = o / fmaxf(fabsf(dn), expf(-ms[j])); }
        __syncthreads();
    }
}
__device__ __forceinline__ void p_scan(const Args& a, int layer, LAS unsigned char* lds, int do_hg, int do_ml) {
    for (int u = obid(); u < 128; u += ogrid()) { if (u < 64) { if (do_hg) hg_seq(a, layer, u, lds); } else { if (do_ml) ml_seq(a, layer, u - 64, lds); } }
}


namespace scan {
constexpr int NCH = 68, NTASK = NB * 4 * 2 * NCH;
__device__ __forceinline__ int swz(int row, int unit) { return row * 128 + ((unit ^ ((row >> 1) & 7)) << 4); }
__device__ __forceinline__ bf16x8 frag(const LAS char* arr, int row, int unit) { return *(const LAS bf16x8*)(arr + swz(row, unit)); }
__device__ __forceinline__ void put2(LAS char* arr, int row, int col_even, float lo, float hi) { *(LAS unsigned*)(arr + swz(row, col_even >> 3) + (col_even & 7) * 2) = pk2(lo, hi); }
__device__ __forceinline__ void put1(LAS char* arr, int row, int col, float x) { *(LAS bf16*)(arr + swz(row, col >> 3) + (col & 7) * 2) = (bf16)f2bf(x); }
__device__ __forceinline__ int crow(int r, int hh) { return (r & 3) + 8 * (r >> 2) + 4 * hh; }
__device__ __forceinline__ void mm64(f32x16 (&acc)[2][2], const LAS char* A, const LAS char* B, int r32, int hh, int skip_a, int skip_b) {
#pragma unroll
    for (int st = 0; st < 4; ++st) { bf16x8 af[2], bfr[2];
#pragma unroll
        for (int i = 0; i < 2; ++i) { af[i] = frag(A, 32 * i + r32, 2 * st + hh); bfr[i] = frag(B, 32 * i + r32, 2 * st + hh); }
#pragma unroll
        for (int ai = 0; ai < 2; ++ai)
#pragma unroll
            for (int bi = 0; bi < 2; ++bi) if (!(ai == skip_a && bi == skip_b)) acc[ai][bi] = __builtin_amdgcn_mfma_f32_32x32x16_bf16(af[ai], bfr[bi], acc[ai][bi], 0, 0, 0); }
}
#define SC_PK4(P, BASE, OUT) do { unsigned a0 = pk2(P[BASE + 0], P[BASE + 1]), a1 = pk2(P[BASE + 2], P[BASE + 3]);   \
    unsigned b0 = pk2(P[BASE + 4], P[BASE + 5]), b1 = pk2(P[BASE + 6], P[BASE + 7]);                              \
    auto r0 = __builtin_amdgcn_permlane32_swap(a0, b0, false, false); auto r1 = __builtin_amdgcn_permlane32_swap(a1, b1, false, false); \
    u32x4 w = {r0[0], r1[0], r0[1], r1[1]}; OUT = __builtin_bit_cast(bf16x8, w); } while (0)
__device__ __forceinline__ float hg_lb(const Args& a, int layer, int dir, int h, int lane) {
    const float* lg = a.in[10] + (size_t)dir * DEPTH * 256 + h * 64 + lane;
    const float l0 = lg[0], l1 = lg[256], l2 = lg[512], l3 = lg[768]; const float mx = fmaxf(fmaxf(l0, l1), fmaxf(l2, l3));
    const float e0 = __expf(l0 - mx), e1 = __expf(l1 - mx), e2 = __expf(l2 - mx), e3 = __expf(l3 - mx);
    return ((layer >= 1 ? e1 : 0.f) + (layer >= 2 ? e2 : 0.f) + (layer >= 3 ? e3 : 0.f)) / (e0 + e1 + e2 + e3);
}
__device__ __forceinline__ float scan_add(float x, int lane, int dir) {
#pragma unroll
    for (int o = 1; o < 64; o <<= 1) { const float y = dir ? __shfl_down(x, o) : __shfl_up(x, o); const bool ok = dir ? (lane + o < 64) : (lane >= o); x += ok ? y : 0.f; }
    return x;
}
__device__ __forceinline__ float scan_max(float x, int lane, int dir) {
#pragma unroll
    for (int o = 1; o < 64; o <<= 1) { const float y = dir ? __shfl_down(x, o) : __shfl_up(x, o); const bool ok = dir ? (lane + o < 64) : (lane >= o); x = ok ? fmaxf(x, y) : x; }
    return x;
}
__device__ __forceinline__ float wave_max(float v) {
#pragma unroll
    for (int o = 1; o < 64; o <<= 1) v = fmaxf(v, __shfl_xor(v, o));
    return v;
}
__device__ __forceinline__ float logsig(float x) { return fminf(x, 0.f) - __logf(1.f + __expf(-fabsf(x))); }
__device__ __forceinline__ void store_ut(bf16* UT, const f32x16 (&acc)[2][2], int r32, int hh) {
#pragma unroll
    for (int vi = 0; vi < 2; ++vi)
#pragma unroll
        for (int di = 0; di < 2; ++di)
#pragma unroll
            for (int rg = 0; rg < 16; ++rg) UT[(32 * vi + crow(rg, hh)) * 64 + 32 * di + r32] = (bf16)f2bf(acc[vi][di][rg]);
}
__device__ __forceinline__ void stage_vt(LAS char* X, const bf16* Pr, int vcol, int lane) {
#pragma unroll 8
    for (int p = 0; p < 32; ++p) put2(X, lane, 2 * p, bf2f(Pr[(size_t)(2 * p) * PC + vcol + lane]), bf2f(Pr[(size_t)(2 * p + 1) * PC + vcol + lane]));
}
__device__ __forceinline__ void stage_copy(LAS char* X, const bf16* G, int ldg, int lane) {
#pragma unroll
    for (int j = 0; j < 8; ++j) { const int u = lane + 64 * j, row = u >> 3, unit = u & 7; *(LAS u32x4*)(X + swz(row, unit)) = *(const u32x4*)(G + (size_t)row * ldg + unit * 8); }
}

__device__ __forceinline__ int tile8_row(int lane, int j) { return 2 * (lane >> 3) + (j & 1) + 16 * (j >> 1); }
__device__ __forceinline__ void load_tile8(u32x4 (&vr)[8], const bf16* G, int ldg, int lane) {
#pragma unroll
    for (int j = 0; j < 8; ++j) vr[j] = *(const u32x4*)(G + (size_t)tile8_row(lane, j) * ldg + 8 * (lane & 7));
}
__device__ __forceinline__ void put_tile8_t(LAS char* X, const u32x4 (&vr)[8], int lane) {
#pragma unroll
    for (int j = 0; j < 8; j += 2) { const int t = tile8_row(lane, j);
#pragma unroll
        for (int e = 0; e < 8; ++e) { const int v = 8 * (lane & 7) + e; const unsigned w0 = vr[j][e >> 1], w1 = vr[j + 1][e >> 1];
            const unsigned pk = (e & 1) ? ((w0 >> 16) | (w1 & 0xffff0000u)) : ((w0 & 0xffffu) | (w1 << 16));
            *(LAS unsigned*)(X + swz(v, t >> 3) + (t & 7) * 2) = pk; } }
}
__device__ __forceinline__ void put_tile8(LAS char* X, const u32x4 (&vr)[8], int lane) {
#pragma unroll
    for (int j = 0; j < 8; ++j) *(LAS u32x4*)(X + swz(tile8_row(lane, j), lane & 7)) = vr[j];
}
__device__ __forceinline__ float get1(const LAS char* arr, int row, int col) { return bf2f(*(const LAS bf16*)(arr + swz(row, col >> 3) + (col & 7) * 2)); }

__device__ __forceinline__ void hgA(const Args& a, int layer, int b, int c, int h, int dir, LAS char* X, LAS char* Y, int lane) {
    const bf16* Pr = (const bf16*)(a.ws + WS_P) + (size_t)(b * SB + 64 * c) * PC;
    stage_copy(X, Pr + (dir ? C_HGZB : C_HGZF) + h * 64, PC, lane);
    u32x4 vr[8]; load_tile8(vr, Pr + C_HGV + h * 64, PC, lane);
    const float lb = hg_lb(a, layer, dir, h, lane), omlb = 1.f - lb;
    float R = 1.f;
#pragma unroll 4
    for (int p = 0; p < 32; ++p) { const int t0 = dir ? 2 * p : 63 - 2 * p, t1 = dir ? 2 * p + 1 : 62 - 2 * p;
        const float f0 = lb + omlb * sigm(get1(X, t0, lane)); const float k0 = (1.f - f0) * R; R *= f0;
        const float f1 = lb + omlb * sigm(get1(X, t1, lane)); const float k1 = (1.f - f1) * R; R *= f1;
        put2(Y, lane, dir ? t0 : t1, dir ? k0 : k1, dir ? k1 : k0); }
    put_tile8_t(X, vr, lane);
    const int tk = ((b * 4 + h) * 2 + dir) * NCH + c;
    ((float*)(a.ws + WS_DT))[(size_t)tk * 64 + lane] = R;
    f32x16 acc[2][2] = {};
    mm64(acc, X, Y, lane & 31, lane >> 5, -1, -1);
    store_ut((bf16*)(a.ws + WS_UTH) + (size_t)tk * 4096, acc, lane & 31, lane >> 5);
}
__device__ __forceinline__ void mlA(const Args& a, int layer, int b, int c, int h, int dir, LAS char* X, LAS char* Y, int lane) {
    const bf16* Pr = (const bf16*)(a.ws + WS_P) + (size_t)(b * SB + 64 * c) * PC;
    stage_copy(X, Pr + C_MLK + h * 64, PC, lane);
    u32x4 vr[8]; load_tile8(vr, Pr + C_MLV + h * 64, PC, lane);
    const float ip = bf2f(Pr[(size_t)lane * PC + C_MLG + dir * 4 + h]) + a.in[12][layer * 16 + dir * 4 + h];
    const float lf = logsig(bf2f(Pr[(size_t)lane * PC + C_MLG + 8 + dir * 4 + h]) + a.in[12][layer * 16 + 8 + dir * 4 + h]);
    const float bt = scan_add(lf, lane, dir), g = wave_sum(lf);
    const float at = g - bt + ip, l = wave_max(at), w = __expf(at - l);
    float nu = 0.f;
#pragma unroll
    for (int p = 0; p < 32; ++p) { const float w0 = __builtin_bit_cast(float, __builtin_amdgcn_readlane(__builtin_bit_cast(int, w), 2 * p)), w1 = __builtin_bit_cast(float, __builtin_amdgcn_readlane(__builtin_bit_cast(int, w), 2 * p + 1));
        const float k0 = get1(X, 2 * p, lane) * 0.125f * w0, k1 = get1(X, 2 * p + 1, lane) * 0.125f * w1;
        nu += k0 + k1; put2(Y, lane, 2 * p, k0, k1); }
    put_tile8_t(X, vr, lane);
    const int tk = ((b * 4 + h) * 2 + dir) * NCH + c;
    ((float*)(a.ws + WS_NU))[(size_t)tk * 64 + lane] = nu;
    if (lane == 0) { ((float*)(a.ws + WS_GL))[tk * 2] = g; ((float*)(a.ws + WS_GL))[tk * 2 + 1] = l; }
    f32x16 acc[2][2] = {};
    mm64(acc, X, Y, lane & 31, lane >> 5, -1, -1);
    store_ut((bf16*)(a.ws + WS_UTM) + (size_t)tk * 4096, acc, lane & 31, lane >> 5);
}
__device__ __forceinline__ void p_scanA(const Args& a, int layer, LAS unsigned char* lds, int do_hg, int do_ml) {
    const int tid = otid(), lane = tid & 63, wave = __builtin_amdgcn_readfirstlane(tid >> 6), G = ogrid(), h = wave >> 1, dir = wave & 1;
    LAS char* X = (LAS char*)lds + wave * 16384; LAS char* Y = X + 8192;
    for (int u = obid(); u < 2 * NB * NCH; u += G) { const int mixer = u / (NB * NCH), q = u % (NB * NCH), b = q / NCH, c = q % NCH;
        int ln = lane; asm volatile("" : "+v"(ln));
        if (mixer == 0) { if (do_hg) hgA(a, layer, b, c, h, dir, X, Y, ln); } else { if (do_ml) mlA(a, layer, b, c, h, dir, X, Y, ln); } }
}

__device__ __forceinline__ int chunk_of(int dir, int k) { return dir == 0 ? k : (k < 4 ? 3 - k : NCH + 3 - k); }
__device__ __forceinline__ void p_scanB(const Args& a, int do_hg, int do_ml) {
    const int tid = otid(), G = ogrid();
    for (int g = obid() * NTHR + tid; g < 128 * 1024; g += G * NTHR) {
        const int seq = g >> 10, mixer = seq >> 6, sq = seq & 63, dir = sq & 1, e4 = g & 1023, d0 = (e4 & 15) * 4;
        if (mixer == 0) { if (!do_hg) continue;
            const bf16* UT = (const bf16*)(a.ws + WS_UTH); bf16* SP = (bf16*)(a.ws + WS_SPH); const float* DT = (const float*)(a.ws + WS_DT);
            f32x4 S = {0.f, 0.f, 0.f, 0.f};
#pragma unroll 4
            for (int k = 0; k < NCH; ++k) { const size_t tk = (size_t)sq * NCH + chunk_of(dir, k);
                const u32x2 u = *(const u32x2*)(UT + tk * 4096 + e4 * 4); const f32x4 dd = *(const f32x4*)(DT + tk * 64 + d0);
                u32x2 o; o.x = pk2(S[0], S[1]); o.y = pk2(S[2], S[3]); *(u32x2*)(SP + tk * 4096 + e4 * 4) = o;
                S = S * dd + (f32x4){bflo(u.x), bfhi(u.x), bflo(u.y), bfhi(u.y)}; }
        } else { if (!do_ml) continue;
            const bf16* UT = (const bf16*)(a.ws + WS_UTM); bf16* SP = (bf16*)(a.ws + WS_SPM); const float* NU = (const float*)(a.ws + WS_NU);
            float* NP = (float*)(a.ws + WS_NP); const float* GL = (const float*)(a.ws + WS_GL); float* MP = (float*)(a.ws + WS_MP);
            f32x4 S = {0.f, 0.f, 0.f, 0.f}, n = {0.f, 0.f, 0.f, 0.f}; float m = 0.f;
#pragma unroll 4
            for (int k = 0; k < NCH; ++k) { const size_t tk = (size_t)sq * NCH + chunk_of(dir, k);
                const u32x2 u = *(const u32x2*)(UT + tk * 4096 + e4 * 4); const f32x4 nu = *(const f32x4*)(NU + tk * 64 + d0); const f32x2 gl = *(const f32x2*)(GL + tk * 2);
                u32x2 o; o.x = pk2(S[0], S[1]); o.y = pk2(S[2], S[3]); *(u32x2*)(SP + tk * 4096 + e4 * 4) = o;
                if (e4 < 16) { *(f32x4*)(NP + tk * 64 + d0) = n; if (e4 == 0) MP[tk] = m; }
                const float mn = fmaxf(gl[0] + m, gl[1]), aa = __expf(gl[0] + m - mn), bb = __expf(gl[1] - mn); m = mn;
                S = S * aa + (f32x4){bflo(u.x), bfhi(u.x), bflo(u.y), bfhi(u.y)} * bb; n = n * aa + nu * bb; }
        }
    }
}

__device__ __forceinline__ void hgC(const Args& a, int layer, int b, int c, int h, int dir, LAS char* X, LAS char* Y, int lane) {
    const int r32 = lane & 31, hh = lane >> 5;
    const bf16* Pr = (const bf16*)(a.ws + WS_P) + (size_t)(b * SB + 64 * c) * PC;
    const int tk = ((b * 4 + h) * 2 + dir) * NCH + c;
    u32x4 qr_[8], zr_[8], vr[8], sp[8];
    load_tile8(qr_, Pr + C_HGQ + h * 64, PC, lane); load_tile8(zr_, Pr + (dir ? C_HGZB : C_HGZF) + h * 64, PC, lane);
    load_tile8(vr, Pr + C_HGV + h * 64, PC, lane); load_tile8(sp, (const bf16*)(a.ws + WS_SPH) + (size_t)tk * 4096, 64, lane);
    put_tile8(X, qr_, lane); put_tile8(Y, zr_, lane);
    const float lb = hg_lb(a, layer, dir, h, lane), omlb = 1.f - lb;
    float Gp = 1.f;
#pragma unroll 4
    for (int i = 32; i < 64; ++i) { const int t = dir ? 63 - i : i; const float f = lb + omlb * sigm(get1(Y, t, lane)); Gp *= f;
        const float q = get1(X, t, lane) * Gp, k = (1.f - f) * __builtin_amdgcn_rcpf(Gp); put1(X, t, lane, q); put1(Y, t, lane, k); }
    float Hp = 1.f;
#pragma unroll 4
    for (int i = 31; i >= 0; --i) { const int t = dir ? 63 - i : i; const float f = lb + omlb * sigm(get1(Y, t, lane));
        const float q = get1(X, t, lane) * __builtin_amdgcn_rcpf(Hp), k = (1.f - f) * Hp; Hp *= f; put1(X, t, lane, q); put1(Y, t, lane, k); }
    f32x16 sc[2][2] = {};
    mm64(sc, Y, X, r32, hh, dir ? 0 : 1, dir ? 1 : 0);
    bf16x8 pa[2][4];
#pragma unroll
    for (int ti = 0; ti < 2; ++ti)
#pragma unroll
        for (int si = 0; si < 2; ++si) { const bool dead = dir ? (si == 0 && ti == 1) : (si == 1 && ti == 0);
            if (dead) { pa[ti][2 * si] = (bf16x8){0, 0, 0, 0, 0, 0, 0, 0}; pa[ti][2 * si + 1] = (bf16x8){0, 0, 0, 0, 0, 0, 0, 0}; }
            else { f32x16 p = sc[si][ti];
                if (si == ti) {
#pragma unroll
                    for (int rg = 0; rg < 16; ++rg) { const int s = crow(rg, hh); const bool ok = dir ? (s >= r32) : (s <= r32); p[rg] = ok ? p[rg] : 0.f; } }
                SC_PK4(p, 0, pa[ti][2 * si]); SC_PK4(p, 8, pa[ti][2 * si + 1]); } }
    { const float eb = Hp;
#pragma unroll 8
      for (int t = 0; t < 64; ++t) put1(Y, t, lane, get1(X, t, lane) * eb); }
    put_tile8_t(X, vr, lane);
    f32x16 o[2][2] = {};
#pragma unroll
    for (int ss = 0; ss < 4; ++ss) { bf16x8 vf[2];
#pragma unroll
        for (int vi = 0; vi < 2; ++vi) vf[vi] = frag(X, 32 * vi + r32, 2 * ss + hh);
#pragma unroll
        for (int ti = 0; ti < 2; ++ti)
#pragma unroll
            for (int vi = 0; vi < 2; ++vi) o[ti][vi] = __builtin_amdgcn_mfma_f32_32x32x16_bf16(pa[ti][ss], vf[vi], o[ti][vi], 0, 0, 0); }
    put_tile8(X, sp, lane);
    mm64(o, Y, X, r32, hh, -1, -1);
    LAS float* O = (LAS float*)X;
#pragma unroll
    for (int ti = 0; ti < 2; ++ti)
#pragma unroll
        for (int vi = 0; vi < 2; ++vi)
#pragma unroll
            for (int rg = 0; rg < 16; ++rg) O[(32 * ti + crow(rg, hh)) * 64 + 32 * vi + r32] = o[ti][vi][rg];
}
__device__ __forceinline__ void mlC(const Args& a, int layer, int b, int c, int h, int dir, LAS char* X, LAS char* Y, LAS float* T, int lane) {
    const int r32 = lane & 31, hh = lane >> 5;
    const bf16* Pr = (const bf16*)(a.ws + WS_P) + (size_t)(b * SB + 64 * c) * PC;
    const int tk = ((b * 4 + h) * 2 + dir) * NCH + c;
    LAS float* TMU = T; LAS float* TCS = T + 64; LAS float* TEM = T + 128; LAS float* TAP = T + 192;
    { const float ip = bf2f(Pr[(size_t)lane * PC + C_MLG + dir * 4 + h]) + a.in[12][layer * 16 + dir * 4 + h];
      const float lf = logsig(bf2f(Pr[(size_t)lane * PC + C_MLG + 8 + dir * 4 + h]) + a.in[12][layer * 16 + 8 + dir * 4 + h]);
      const float bt = scan_add(lf, lane, dir), cs = ip - bt, mp = ((const float*)(a.ws + WS_MP))[tk];
      const float mu = fmaxf(mp, scan_max(cs, lane, dir));
      TMU[lane] = mu; TCS[lane] = cs; TEM[lane] = __expf(-bt - mu); TAP[lane] = __expf(mp - mu); }
    u32x4 qr_[8], kr_[8], vr[8], sp[8];
    load_tile8(qr_, Pr + C_MLQ + h * 64, PC, lane); load_tile8(kr_, Pr + C_MLK + h * 64, PC, lane);
    load_tile8(vr, Pr + C_MLV + h * 64, PC, lane); load_tile8(sp, (const bf16*)(a.ws + WS_SPM) + (size_t)tk * 4096, 64, lane);
    put_tile8(X, qr_, lane); put_tile8(Y, kr_, lane);
    f32x16 sc[2][2] = {};
    mm64(sc, Y, X, r32, hh, dir ? 0 : 1, dir ? 1 : 0);
    bf16x8 pa[2][4];
#pragma unroll
    for (int ti = 0; ti < 2; ++ti) { const float mu = TMU[32 * ti + r32];
#pragma unroll
        for (int si = 0; si < 2; ++si) { const bool dead = dir ? (si == 0 && ti == 1) : (si == 1 && ti == 0);
            if (dead) { pa[ti][2 * si] = (bf16x8){0, 0, 0, 0, 0, 0, 0, 0}; pa[ti][2 * si + 1] = (bf16x8){0, 0, 0, 0, 0, 0, 0, 0}; }
            else { f32x16 p = sc[si][ti];
#pragma unroll
                for (int g4 = 0; g4 < 4; ++g4) { const f32x4 cs = *(const LAS f32x4*)(TCS + 32 * si + 8 * g4 + 4 * hh);
#pragma unroll
                    for (int i = 0; i < 4; ++i) { const int rg = 4 * g4 + i, s = crow(rg, hh); const bool ok = (si != ti) || (dir ? (s >= r32) : (s <= r32));
                        const float w = p[rg] * 0.125f * __expf(cs[i] - mu); p[rg] = ok ? w : 0.f; } }
                SC_PK4(p, 0, pa[ti][2 * si]); SC_PK4(p, 8, pa[ti][2 * si + 1]); } } }
#pragma unroll
    for (int j = 0; j < 8; ++j) { const int u = lane + 64 * j, row = u >> 3, unit = u & 7; const float ap = TAP[row];
        const u32x4 qv = *(const LAS u32x4*)(X + swz(row, unit)); u32x4 o;
        o.x = pk2(bflo(qv.x) * ap, bfhi(qv.x) * ap); o.y = pk2(bflo(qv.y) * ap, bfhi(qv.y) * ap); o.z = pk2(bflo(qv.z) * ap, bfhi(qv.z) * ap); o.w = pk2(bflo(qv.w) * ap, bfhi(qv.w) * ap);
        *(LAS u32x4*)(Y + swz(row, unit)) = o; }
    put_tile8_t(X, vr, lane);
    f32x16 o[2][2] = {}; f32x16 dn[2] = {};
    const bf16x8 ones = {0x3f80, 0x3f80, 0x3f80, 0x3f80, 0x3f80, 0x3f80, 0x3f80, 0x3f80};
#pragma unroll
    for (int ss = 0; ss < 4; ++ss) { bf16x8 vf[2];
#pragma unroll
        for (int vi = 0; vi < 2; ++vi) vf[vi] = frag(X, 32 * vi + r32, 2 * ss + hh);
#pragma unroll
        for (int ti = 0; ti < 2; ++ti) { dn[ti] = __builtin_amdgcn_mfma_f32_32x32x16_bf16(pa[ti][ss], ones, dn[ti], 0, 0, 0);
#pragma unroll
            for (int vi = 0; vi < 2; ++vi) o[ti][vi] = __builtin_amdgcn_mfma_f32_32x32x16_bf16(pa[ti][ss], vf[vi], o[ti][vi], 0, 0, 0); } }
    put_tile8(X, sp, lane);
    mm64(o, Y, X, r32, hh, -1, -1);
    { const float* NPg = (const float*)(a.ws + WS_NP) + (size_t)tk * 64;
#pragma unroll
      for (int st = 0; st < 4; ++st) { const f32x4 n0 = *(const f32x4*)(NPg + 16 * st + 8 * hh), n1 = *(const f32x4*)(NPg + 16 * st + 8 * hh + 4);
          u32x4 w; w.x = pk2(n0[0], n0[1]); w.y = pk2(n0[2], n0[3]); w.z = pk2(n1[0], n1[1]); w.w = pk2(n1[2], n1[3]); const bf16x8 nf = __builtin_bit_cast(bf16x8, w);
#pragma unroll
          for (int ti = 0; ti < 2; ++ti) dn[ti] = __builtin_amdgcn_mfma_f32_32x32x16_bf16(frag(Y, 32 * ti + r32, 2 * st + hh), nf, dn[ti], 0, 0, 0); } }
    float em[2][16];
#pragma unroll
    for (int ti = 0; ti < 2; ++ti)
#pragma unroll
        for (int g4 = 0; g4 < 4; ++g4) { const f32x4 e = *(const LAS f32x4*)(TEM + 32 * ti + 8 * g4 + 4 * hh);
#pragma unroll
            for (int i = 0; i < 4; ++i) em[ti][4 * g4 + i] = e[i]; }
    LAS float* O = (LAS float*)X;
#pragma unroll
    for (int ti = 0; ti < 2; ++ti)
#pragma unroll
        for (int rg = 0; rg < 16; ++rg) { const float rd = __builtin_amdgcn_rcpf(fmaxf(fabsf(dn[ti][rg]), em[ti][rg]));
#pragma unroll
            for (int vi = 0; vi < 2; ++vi) O[(32 * ti + crow(rg, hh)) * 64 + 32 * vi + r32] = o[ti][vi][rg] * rd; }
}
__device__ __forceinline__ void p_scanC(const Args& a, int layer, LAS unsigned char* lds, int do_hg, int do_ml) {
    const int tid = otid(), lane = tid & 63, wave = __builtin_amdgcn_readfirstlane(tid >> 6), G = ogrid(), h = wave >> 1, dir = wave & 1;
    LAS char* X = (LAS char*)lds + wave * 16384; LAS char* Y = X + 8192; LAS float* T = (LAS float*)(lds + 131072 + wave * 1024);
    const bf16* P = (const bf16*)(a.ws + WS_P); bf16* Yo = (bf16*)(a.ws + WS_Y);
    const bool lastl = layer == DEPTH - 1;
    for (int u = obid(); u < 2 * NB * NCH; u += G) { const int mixer = u / (NB * NCH), q = u % (NB * NCH), b = q / NCH, c = q % NCH;
        if (lastl && c < 4) continue;
        if (mixer == 0 ? !do_hg : !do_ml) continue;
        int ln = lane; asm volatile("" : "+v"(ln));
        if (mixer == 0) hgC(a, layer, b, c, h, dir, X, Y, ln); else mlC(a, layer, b, c, h, dir, X, Y, T, ln);
        __syncthreads();
        asm volatile("" : "+v"(ln));
        { const LAS float* Of = (const LAS float*)((LAS char*)lds + (2 * h) * 16384); const LAS float* Ob = (const LAS float*)((LAS char*)lds + (2 * h + 1) * 16384);
          const float gn = mixer == 0 ? a.in[11][layer * 64 + ln] : a.in[13][layer * 64 + ln];
          const int gcol = (mixer == 0 ? C_HGG : C_MLOG) + h * 64 + ln;
#pragma unroll 8
          for (int i = 0; i < 32; ++i) { const int t = 32 * dir + i; const size_t r = (size_t)(b * SB + 64 * c + t);
              const float ov = Of[t * 64 + ln] + Ob[t * 64 + ln]; const float y = ov * __builtin_amdgcn_rsqf(wave_sum(ov * ov) * (1.f / 64.f) + EPS) * gn;
              const float gt = bf2f(P[r * PC + gcol]); const float outv = mixer == 0 ? y * gt * sigm(gt) : y * sigm(gt);
              if (OUTPROJ_FP8) ((unsigned char*)Yo)[r * DM + mixer * 256 + h * 64 + ln] = (unsigned char)fp8_1(16.f * outv); else Yo[r * DM + mixer * 256 + h * 64 + ln] = (bf16)f2bf(outv); } }
        __syncthreads();
    }
}
#undef SC_PK4
}

__device__ __forceinline__ void p_attn(const Args& a, int layer, LAS char* ldsg) {
    asm volatile("" ::: "memory");
    const bf16* P = (const bf16*)(a.ws + WS_P); bf16* Y = (bf16*)(a.ws + WS_Y); const int G = ogrid();
    const int bid = obid(), lane = otid() & 63;
    const float* qg = a.in[14] + layer * 128; const float* kg = a.in[15] + layer * 128;
    const float mq = wave_max_nn(fmaxf(fabsf(qg[lane]), fabsf(qg[lane + 64]))), mk = wave_max_nn(fmaxf(fabsf(kg[lane]), fabsf(kg[lane + 64])));
    const float bound = 128.f * mq * mk * (att::SCALE * 1.4426950408889634f) * 1.02f;
    const bool fix = bound <= 60.f;
    const int cu = (layer != DEPTH - 1) ? (G >= 96 ? bid - 64 : bid) : -1; const bool hasc = cu >= 0 && cu < 32;
    const float* ropet = (const float*)(a.ws + WS_ROPE);
#define AT_LAT(u) const int b = (u) & 7, idx = ((u) >> 3) & 31, kvh = (u) >> 8, h = kvh * 2 + (idx >> 4), qb = idx & 15; const size_t r0 = (size_t)b * SB + CTX + (size_t)qb * 256; \
        const bf16* Qp = P + r0 * PC + C_ATQ + h * 128; const bf16* Kp = P + (size_t)b * SB * PC + C_ATK + kvh * 128; const bf16* Vp = P + (size_t)b * SB * PC + C_ATV + kvh * 128; \
        bf16* Op = (bf16*)((unsigned char*)Y + (r0 * DM + 512 + h * 128) * (OUTPROJ_FP8 ? 1 : 2));
#define AT_CTX() const int b = cu & 7, h = cu >> 3, kvh = h >> 1; const size_t r0 = (size_t)b * SB; \
        const bf16* Qp = P + r0 * PC + C_ATQ + h * 128; const bf16* Kp = P + r0 * PC + C_ATK + kvh * 128; const bf16* Vp = P + r0 * PC + C_ATV + kvh * 128; \
        bf16* Op = (bf16*)((unsigned char*)Y + (r0 * DM + 512 + h * 128) * (OUTPROJ_FP8 ? 1 : 2));
    const int ex = fix ? 0 : 1;
    for (int u = bid; u < 512; u += G) { AT_LAT(u) att::attn_dense_body(Qp, Kp, Vp, Op, SB, ldsg, qg, ropet, qb * 256, -bound, ex); __syncthreads(); }
    if (hasc) { AT_CTX() att::attn_dense_body(Qp, Kp, Vp, Op, CTX, ldsg, qg, ropet, -1, -bound, ex); __syncthreads(); }
#undef AT_LAT
#undef AT_CTX
}

__device__ __forceinline__ void p_finish(const Args& a, int layer, int do_hg, int do_ml) {
    const int tid = otid(), lane = tid & 63, wave = tid >> 6; const int gw = obid() * NWAVE + wave, NGW = ogrid() * NWAVE;
    const bf16* P = (const bf16*)(a.ws + WS_P); bf16* Y = (bf16*)(a.ws + WS_Y);
    const float* OH = (const float*)(a.ws + WS_OH); const float* OM = (const float*)(a.ws + WS_OM);
    const float gh = a.in[11][layer * 64 + lane], gm = a.in[13][layer * 64 + lane];
    for (int r = gw; r < NR; r += NGW) { if (layer == DEPTH - 1 && (r % SB) < CTX) continue;
#pragma unroll
        for (int h = 0; h < 4; ++h) {
            if (do_hg) { const float o = OH[(size_t)r * 256 + h * 64 + lane] + OH[(size_t)(NR + r) * 256 + h * 64 + lane];
              const float y = o * (1.f / sqrtf(wave_sum(o * o) * (1.f / 64.f) + EPS)) * gh; const float g = bf2f(P[(size_t)r * PC + C_HGG + h * 64 + lane]);
              Y[(size_t)r * DM + h * 64 + lane] = (bf16)f2bf(y * g * sigm(g)); }
            if (do_ml) { const float o = OM[(size_t)r * 256 + h * 64 + lane] + OM[(size_t)(NR + r) * 256 + h * 64 + lane];
              const float y = o * (1.f / sqrtf(wave_sum(o * o) * (1.f / 64.f) + EPS)) * gm; const float g = bf2f(P[(size_t)r * PC + C_MLOG + h * 64 + lane]);
              Y[(size_t)r * DM + 256 + h * 64 + lane] = (bf16)f2bf(y * sigm(g)); }
        }
    }
}

__device__ __forceinline__ void p_router(const Args& a, int layer, LAS unsigned char* lds) {
    const int tid = otid(), lane = tid & 63, wave = tid >> 6, G = ogrid(), bid = obid();
    constexpr int TP = 2064;
    LAS unsigned char* TH = lds; LAS unsigned char* TL = lds + 32 * TP;
    LAS float* PART = (LAS float*)lds;
    LAS float* LOG = (LAS float*)(lds + 64 * TP);
    LAS int* LCNT = (LAS int*)(lds + 64 * TP + 32 * 33 * 4);
    bf16* H = (bf16*)(a.ws + WS_H);
    int* RE = (int*)(a.ws + WS_RE); int* RS = (int*)(a.ws + WS_RS); float* RG = (float*)(a.ws + WS_RG);
    const bool lastl = layer == DEPTH - 1;
    const int e_l = lane & 31, hh = lane >> 5;
    bf16x8 bh[8], bl[8];
#pragma unroll
    for (int ks = 0; ks < 8; ++ks) { const size_t o = ((size_t)(layer * 32 + e_l)) * 1024 + wave * 128 + ks * 16 + hh * 8;
        bh[ks] = *(const bf16x8*)((const bf16*)(a.ws + WS_WRH) + o); bl[ks] = *(const bf16x8*)((const bf16*)(a.ws + WS_WRL) + o); }
    if (tid < 32) LCNT[tid] = 0;
    __syncthreads();
    for (int tile = bid; tile < NR / 32; tile += G) {
        const int r0 = tile * 32; if (lastl && (r0 % SB) < CTX) continue;
#pragma unroll
        for (int q = 0; q < 4; ++q) { const int row = wave * 4 + q, r = r0 + row; f32x4 v[2][2]; load_row_bf((const bf16*)(a.ws + WS_XB) + (size_t)r * DM, v, lane);
            norm_mod_store(v, a.in[7] + (size_t)layer * DM, modv(a, layer, r, 4), modv(a, layer, r, 3), MOE_FP8 ? (bf16*)nullptr : H + (size_t)r * DM, lane);
            if (MOE_FP8) {
#pragma unroll
                for (int j = 0; j < 2; ++j) { u32x2 w8; w8.x = pk_fp8x4(8.f * v[j][0][0], 8.f * v[j][0][1], 8.f * v[j][0][2], 8.f * v[j][0][3]); w8.y = pk_fp8x4(8.f * v[j][1][0], 8.f * v[j][1][1], 8.f * v[j][1][2], 8.f * v[j][1][3]);
                    *(u32x2*)((unsigned char*)(a.ws + WS_H8) + (size_t)r * DM + 8 * lane + 512 * j) = w8; } }
#pragma unroll
            for (int j = 0; j < 2; ++j) { unsigned hi[4], lo[4];
#pragma unroll
                for (int p = 0; p < 4; ++p) { const float x0 = v[j][p >> 1][(p & 1) * 2], x1 = v[j][p >> 1][(p & 1) * 2 + 1]; const unsigned w = pk2(x0, x1); hi[p] = w; lo[p] = pk2(x0 - bflo(w), x1 - bfhi(w)); }
                *(LAS u32x4*)(TH + row * TP + (8 * lane + 512 * j) * 2) = (u32x4){hi[0], hi[1], hi[2], hi[3]};
                *(LAS u32x4*)(TL + row * TP + (8 * lane + 512 * j) * 2) = (u32x4){lo[0], lo[1], lo[2], lo[3]}; } }
        __syncthreads();
        f32x16 acc = {};
#pragma unroll
        for (int ks = 0; ks < 8; ++ks) { const int off = e_l * TP + (wave * 128 + ks * 16 + hh * 8) * 2;
            const bf16x8 ah = *(const LAS bf16x8*)(TH + off), al = *(const LAS bf16x8*)(TL + off);
            acc = __builtin_amdgcn_mfma_f32_32x32x16_bf16(ah, bh[ks], acc, 0, 0, 0);
            acc = __builtin_amdgcn_mfma_f32_32x32x16_bf16(ah, bl[ks], acc, 0, 0, 0);
            acc = __builtin_amdgcn_mfma_f32_32x32x16_bf16(al, bh[ks], acc, 0, 0, 0); }
        __syncthreads();
#pragma unroll
        for (int rg = 0; rg < 16; ++rg) { const int row = (rg & 3) + 8 * (rg >> 2) + 4 * hh; PART[(wave * 32 + row) * 32 + e_l] = acc[rg]; }
        __syncthreads();
#pragma unroll
        for (int q = 0; q < 2; ++q) { const int idx = tid + 512 * q, row = idx >> 5, e = idx & 31; float s = a.in[17][layer * 32 + e];
#pragma unroll
            for (int w = 0; w < 8; ++w) s += PART[(w * 32 + row) * 32 + e];
            LOG[row * 33 + e] = s; }
        __syncthreads();
        if (tid < 32) { const int r = r0 + tid; float tv[4]; int te[4];
#pragma unroll
            for (int k = 0; k < 4; ++k) { float best = -INFINITY; int bi = 0;
                for (int e = 0; e < 32; ++e) { const float v = LOG[tid * 33 + e]; if (v > best) { best = v; bi = e; } }
                tv[k] = best; te[k] = bi; LOG[tid * 33 + bi] = -INFINITY; }
            float p[4], ps = 0.f;
#pragma unroll
            for (int k = 0; k < 4; ++k) { p[k] = expf(tv[k] - tv[0]); ps += p[k]; }
#pragma unroll
            for (int k = 0; k < 4; ++k) { RE[r * 4 + k] = te[k]; RS[r * 4 + k] = atomicAdd((int*)&LCNT[te[k]], 1); RG[r * 4 + k] = p[k] / ps; } }
        __syncthreads();
    }
    if (tid < 32) ((int*)(a.ws + WS_CNT))[bid * 32 + tid] = LCNT[tid];
}

__device__ __forceinline__ void p_dispatch(const Args& a, int layer, LAS unsigned char* lds) {
    const int tid = otid(), G = ogrid(), bid = obid();
    LAS int* tot = (LAS int*)lds; LAS int* base = tot + 32; LAS int* pst = base + 32;
    const int* CNT = (const int*)(a.ws + WS_CNT);
    const int* RE = (const int*)(a.ws + WS_RE); const int* RS = (const int*)(a.ws + WS_RS); const float* RG = (const float*)(a.ws + WS_RG);
    int* POS = (int*)(a.ws + WS_POS); int* TOK = (int*)(a.ws + WS_TOK); float* GATEP = (float*)(a.ws + WS_GATEP); int* TILEE = (int*)(a.ws + WS_TILEE);
    const bool lastl = layer == DEPTH - 1;
    { LAS int* ptot = pst + 64; LAS int* pbase = ptot + 512;
      const int e = tid & 31, part = tid >> 5; int t = 0, bs = 0;
      for (int blk = part; blk < G; blk += 16) { const int c = CNT[blk * 32 + e]; if (blk < bid) bs += c; t += c; }
      ptot[tid] = t; pbase[tid] = bs;
      __syncthreads();
      if (tid < 32) { int tt = 0, bb = 0;
#pragma unroll
          for (int p = 0; p < 16; ++p) { tt += ptot[p * 32 + tid]; bb += pbase[p * 32 + tid]; }
          tot[tid] = tt; base[tid] = bb; } }
    __syncthreads();
    if (tid == 0) { int p = 0; for (int e = 0; e < 32; ++e) { pst[e] = p; p += (tot[e] + 255) & ~255; } pst[32] = p; }
    __syncthreads();
    for (int tile = bid; tile < NR / 32; tile += G) { const int r0 = tile * 32; if (lastl && (r0 % SB) < CTX) continue;
        if (tid < 128) { const int i = r0 * 4 + tid; const int e = RE[i]; const int pos = pst[e] + base[e] + RS[i]; TOK[pos] = r0 + (tid >> 2); GATEP[pos] = RG[i]; POS[i] = pos; } }
    for (int e = bid; e < 32; e += G) {
        for (int p = pst[e] + tot[e] + tid; p < pst[e + 1]; p += NTHR) { TOK[p] = 0; GATEP[p] = 0.f; }
        for (int rt = pst[e] / 256 + tid; rt < pst[e + 1] / 256; rt += NTHR) TILEE[rt] = e; }
    if (bid == 0 && tid == 0) *(int*)(a.ws + WS_NRT) = pst[32] / 256;
}

__device__ __forceinline__ void p_combine(const Args& a, int layer, bool dry = false) {
    const int tid = otid(), lane = tid & 63, wave = tid >> 6; const int gw = obid() * NWAVE + wave, NGW = ogrid() * NWAVE;
    const bf16* YM = (const bf16*)(a.ws + WS_YM); const int* POS = (const int*)(a.ws + WS_POS); bf16* H = (bf16*)(a.ws + WS_H);
    const bool lastl = layer == DEPTH - 1;
    for (int r = gw; r < NR; r += NGW) { if (lastl && (r % SB) < CTX) continue;
        const float* g2 = modv(a, layer, r, 5); bf16* xb = (bf16*)(a.ws + WS_XB) + (size_t)r * DM;
        float* xo = dry ? (float*)(a.ws + WS_ACT) + (size_t)r * DM : a.out + ((size_t)(r / SB) * SEQ + (r % SB) - CTX) * DM;
        bf16* xbo = dry ? (bf16*)(a.ws + WS_ACT) + (size_t)r * DM : xb; bf16* hw = dry ? (bf16*)(a.ws + WS_ACT + 160 * MiB) + (size_t)r * DM : H + (size_t)r * DM;
        int pos[4];
#pragma unroll
        for (int k = 0; k < 4; ++k) pos[k] = POS[r * 4 + k];
        f32x4 v[2][2]; load_row_bf(xb, v, lane);
#pragma unroll
        for (int j = 0; j < 2; ++j) { const int c = 8 * lane + 512 * j; float f[8];
#pragma unroll
            for (int i = 0; i < 8; ++i) f[i] = 0.f;
#pragma unroll
            for (int k = 0; k < 4; ++k) { const u32x4 y = *(const u32x4*)(YM + (size_t)pos[k] * DM + c);
                f[0] += bflo(y.x); f[1] += bfhi(y.x); f[2] += bflo(y.y); f[3] += bfhi(y.y); f[4] += bflo(y.z); f[5] += bfhi(y.z); f[6] += bflo(y.w); f[7] += bfhi(y.w); }
#pragma unroll
            for (int q = 0; q < 2; ++q) { const f32x4 g = *(const f32x4*)(g2 + c + 4 * q);
                v[j][q] = v[j][q] + g * (f32x4){f[4 * q], f[4 * q + 1], f[4 * q + 2], f[4 * q + 3]};
                if (lastl) *(f32x4*)(xo + c + 4 * q) = v[j][q]; }
            if (!lastl) { u32x4 w; w.x = pk2(v[j][0][0], v[j][0][1]); w.y = pk2(v[j][0][2], v[j][0][3]); w.z = pk2(v[j][1][0], v[j][1][1]); w.w = pk2(v[j][1][2], v[j][1][3]); *(u32x4*)(xbo + c) = w; } }
        if (!lastl) { norm_mod_store(v, a.in[6] + (size_t)(layer + 1) * DM, modv(a, layer + 1, r, 1), modv(a, layer + 1, r, 0), INPROJ_I8 ? (bf16*)nullptr : hw, lane);
            if (INPROJ_I8) store_row_i8(v, dry ? (unsigned char*)(a.ws + WS_ACT + 160 * MiB) + (size_t)r * DM : (unsigned char*)(a.ws + WS_H) + (size_t)r * DM, dry ? (float*)(a.ws + WS_ACT + 240 * MiB) + r : (float*)(a.ws + WS_HSC) + r, lane); }
    }
}

template <int PH>
__device__ __forceinline__ void run_phase(int layer, unsigned char* ldsg) {
    const Args a = fetch_args();
    LAS unsigned char* lds = (LAS unsigned char*)ldsg;
    const int G = ogrid(), bid = obid();
    if constexpr (PH == PH_PRO) p_prologue(a, lds);
    if constexpr (PH == PH_NORM1) { if (INPROJ_I8) p_quant_win(a); p_norm1(a, layer); }
    if constexpr (PH == PH_INPROJ) {
        if constexpr (INPROJ_I8) { pg8::SchedDense S; S.init(NR, PC, G, bid, nullptr); S.Bt = (const char*)(a.ws + WS_WIN) + (size_t)layer * PC * 1024; S.rb = 1024;
            pg8::EpiI8 E{(bf16*)(a.ws + WS_P), PC, (const float*)(a.ws + WS_HSC), (const float*)(a.ws + WS_WSC) + (size_t)layer * PC}; pg8::gemm_phase<2>(lds, (const void*)(a.ws + WS_H), S, E); }
        else { pg8::SchedDense S; S.init(NR, PC, G, bid, (const bf16*)(a.ws + WS_WIN) + (size_t)layer * PC * 1024);
            pg8::EpiBf16 E{(bf16*)(a.ws + WS_P), PC}; pg8::gemm_phase<0>(lds, (const bf16*)(a.ws + WS_H), S, E); } }
    if constexpr (PH == PH_PREP) { if (PROBE_DOUBLE == 96) p_prep(a, layer, true); p_prep(a, layer); if (NEW_HG || NEW_ML) scan::p_scanA(a, layer, lds, NEW_HG, NEW_ML); if (PROBE_DOUBLE == 20) scan::p_scanA(a, layer, lds, NEW_HG, NEW_ML); }
    if constexpr (PH == PH_SCAN) { if (!NEW_HG || !NEW_ML) p_scan(a, layer, lds, !NEW_HG, !NEW_ML); if (NEW_HG || NEW_ML) scan::p_scanB(a, NEW_HG, NEW_ML); if (PROBE_DOUBLE == 21) scan::p_scanB(a, NEW_HG, NEW_ML); }
    if constexpr (PH == PH_ATTN) { if (NEW_HG || NEW_ML) scan::p_scanC(a, layer, lds, NEW_HG, NEW_ML); if (PROBE_DOUBLE == 22) scan::p_scanC(a, layer, lds, NEW_HG, NEW_ML); p_attn(a, layer, (LAS char*)lds); }
    if constexpr (PH == PH_FINISH) { if (!NEW_HG || !NEW_ML) p_finish(a, layer, !NEW_HG, !NEW_ML); }
    if constexpr (PH == PH_OUTPROJ) { pg8::SchedDense S; S.init(NR, DM, G, bid, nullptr); S.rb = OUTPROJ_FP8 ? 1024 : 2048; S.Bt = (const char*)(a.ws + WS_WOUT) + (size_t)layer * 1024 * S.rb;
        pg8::EpiResid E{a.in[0], a.in[2], (bf16*)(a.ws + WS_XB), (const float*)(a.ws + WS_MOD) + (size_t)layer * 9 * 6144, 2, layer == DEPTH - 1, layer == 0, OUTPROJ_FP8 ? 1.f / 1024.f : 1.f};
        pg8::gemm_phase<OUTPROJ_FP8 ? 1 : 0>(lds, (const void*)(a.ws + WS_Y), S, E); }
    if constexpr (PH == PH_ROUTER) p_router(a, layer, lds);
    if constexpr (PH == PH_DISPATCH) p_dispatch(a, layer, lds);
    if constexpr (PH == PH_GU) { constexpr int RBW = MOE_FP8 ? 1024 : 2048;
        pg8::SchedMoe S{G, bid, 8, 2048, __builtin_amdgcn_readfirstlane(__hip_atomic_load((const int*)(a.ws + WS_NRT), __ATOMIC_RELAXED, __HIP_MEMORY_SCOPE_AGENT)), (const int*)(a.ws + WS_TILEE),
                        (const char*)(a.ws + WS_WGU) + (size_t)layer * 32 * 2048 * RBW, (const int*)(a.ws + WS_TOK), RBW};
        pg8::EpiGU E{(void*)(a.ws + WS_ACT), a.in[19] + (size_t)layer * 32 * 2048};
        pg8::gemm_phase<MOE_FP8>(lds, MOE_FP8 ? (const void*)(a.ws + WS_H8) : (const void*)(a.ws + WS_H), S, E); }
    if constexpr (PH == PH_DOWN) { constexpr int RBW = MOE_FP8 ? 1024 : 2048;
        pg8::SchedMoe S{G, bid, 4, 1024, __builtin_amdgcn_readfirstlane(__hip_atomic_load((const int*)(a.ws + WS_NRT), __ATOMIC_RELAXED, __HIP_MEMORY_SCOPE_AGENT)), (const int*)(a.ws + WS_TILEE),
                        (const char*)(a.ws + WS_WDN) + (size_t)layer * 32 * 1024 * RBW, nullptr, RBW};
        pg8::EpiDown E{(bf16*)(a.ws + WS_YM), a.in[21] + (size_t)layer * 32 * 1024, (const float*)(a.ws + WS_GATEP)}; pg8::gemm_phase<MOE_FP8>(lds, (const void*)(a.ws + WS_ACT), S, E); }
    if constexpr (PH == PH_COMBINE) { if (PROBE_DOUBLE == 97) p_combine(a, layer, true); p_combine(a, layer); }
}

template <int PH>
__global__ void __launch_bounds__(NTHR, 2) k_phase(Args a, int layer) {
    extern __shared__ __attribute__((aligned(16))) unsigned char lds[];
    kernel_setup(a);
    run_phase<PH>(layer, lds);
}


__global__ void __launch_bounds__(NTHR, 2) k_mega(Args a) {
    extern __shared__ __attribute__((aligned(16))) unsigned char lds[];
    kernel_setup(a);
    const XcdBarrier bar = xcd_barrier_post((unsigned*)(a.ws + WS_CTL) + CW_BAR, (volatile LAS unsigned*)(MISC_OFF + 32));
#define GRID_BAR() do { for (int rep_ = 0; rep_ < (PROBE_DOUBLE == 99 ? 2 : 1); ++rep_) { const Args b_ = fetch_args(); XcdBarrier bb; bb.bar = (unsigned*)(b_.ws + WS_CTL) + CW_BAR; bb.x = xb_xcc_id(); bb.st = (volatile LAS unsigned*)(MISC_OFF + 32); xcd_barrier(bb); } } while (0)
    run_phase<PH_PRO>(0, lds); GRID_BAR();
    if (PROBE_DOUBLE == PH_PRO) { run_phase<PH_PRO>(0, lds); GRID_BAR(); }
    run_phase<PH_NORM1>(0, lds); GRID_BAR();
#define RUNP(PH, l) do { run_phase<PH>(l, lds); if (PROBE_DOUBLE == PH) { GRID_BAR(); run_phase<PH>(l, lds); } } while (0)
#define LAYER_BODY(l) do { \
        RUNP(PH_INPROJ, l); GRID_BAR(); \
        run_phase<PH_PREP>(l, lds); GRID_BAR(); \
        RUNP(PH_SCAN, l); GRID_BAR(); \
        RUNP(PH_ATTN, l); GRID_BAR(); \
        if (!NEW_HG || !NEW_ML) { RUNP(PH_FINISH, l); GRID_BAR(); } \
        run_phase<PH_OUTPROJ>(l, lds); GRID_BAR(); \
        if (PROBE_DOUBLE == 98 && (l) == 0) { run_phase<PH_OUTPROJ>(l, lds); GRID_BAR(); } \
        RUNP(PH_ROUTER, l); GRID_BAR(); \
        RUNP(PH_DISPATCH, l); GRID_BAR(); \
        RUNP(PH_GU, l); GRID_BAR(); \
        RUNP(PH_DOWN, l); GRID_BAR(); \
        run_phase<PH_COMBINE>(l, lds); \
        if ((l) + 1 < DEPTH) GRID_BAR(); \
    } while (0)
    LAYER_BODY(0); LAYER_BODY(1); LAYER_BODY(2); LAYER_BODY(3);
#undef LAYER_BODY
#undef RUNP
#undef GRID_BAR
}

template <int PH> static void launch_phase(const Args& a, int layer, int grid, hipStream_t stream) {
    static bool attr = false;
    if (!attr) { (void)hipFuncSetAttribute((const void*)k_phase<PH>, hipFuncAttributeMaxDynamicSharedMemorySize, LDS_BYTES); attr = true; }
    hipLaunchKernelGGL(k_phase<PH>, dim3(grid), dim3(NTHR), LDS_BYTES, stream, a, layer);
}

extern "C" void kernel_launch(void* const* d_in, const int* in_sizes, int n_in, void* d_out, int out_size, void* d_ws, size_t ws_size, hipStream_t stream) {
    static int grid = 0;
    if (grid == 0) {
        if (n_in != 22 || out_size != NB * SEQ * DM || ws_size < WS_END) { fprintf(stderr, "kernel_launch: unexpected shapes (n_in %d, out %d, ws %zu < %zu)\n", n_in, out_size, ws_size, (size_t)WS_END); grid = -1; return; }
        int dev = 0, cus = 0;
        if (hipGetDevice(&dev) != hipSuccess || hipDeviceGetAttribute(&cus, hipDeviceAttributeMultiprocessorCount, dev) != hipSuccess) { grid = -1; return; }
        grid = cus;
    }
    if (grid < 0) return;
    (void)hipMemsetAsync((char*)d_ws + WS_CTL, 0, CTL_ZERO_BYTES, stream);
    Args a{};
    for (int i = 0; i < 22; ++i) a.in[i] = (const float*)d_in[i];
    a.out = (float*)d_out; a.ws = (unsigned char*)d_ws; a.ph_lo = 0; a.ph_hi = 0;
#if MK_MULTI
    launch_phase<PH_PRO>(a, 0, grid, stream);
    launch_phase<PH_NORM1>(a, 0, grid, stream);
    for (int l = 0; l < DEPTH; ++l) {
        launch_phase<PH_INPROJ>(a, l, grid, stream);
        launch_phase<PH_PREP>(a, l, grid, stream);
        launch_phase<PH_SCAN>(a, l, grid, stream);
        launch_phase<PH_ATTN>(a, l, grid, stream);
        launch_phase<PH_FINISH>(a, l, grid, stream);
        launch_phase<PH_OUTPROJ>(a, l, grid, stream);
        launch_phase<PH_ROUTER>(a, l, grid, stream);
        launch_phase<PH_DISPATCH>(a, l, grid, stream);
        launch_phase<PH_GU>(a, l, grid, stream);
        launch_phase<PH_DOWN>(a, l, grid, stream);
        launch_phase<PH_COMBINE>(a, l, grid, stream);
    }
#else
    static bool attr = false;
    if (!attr) { (void)hipFuncSetAttribute((const void*)k_mega, hipFuncAttributeMaxDynamicSharedMemorySize, LDS_BYTES); attr = true; }
    hipLaunchKernelGGL(k_mega, dim3(grid), dim3(NTHR), LDS_BYTES, stream, a);
#endif
}
```

```cpp
#include <hip/hip_runtime.h>
#include <cstdio>
#include <cstdint>
#include <cmath>

#ifndef MK_MULTI
#define MK_MULTI 0
#endif
#ifndef MOE_FP8
#define MOE_FP8 1
#endif
#ifndef OUTPROJ_FP8
#define OUTPROJ_FP8 1
#endif
#ifndef INPROJ_I8
#define INPROJ_I8 1
#endif
#ifndef GEMM_ALIGN
#define GEMM_ALIGN 1
#endif
#ifndef NEW_HG
#define NEW_HG 1
#endif
#ifndef NEW_ML
#define NEW_ML 1
#endif
#ifndef PROBE_DOUBLE
#define PROBE_DOUBLE -1
#endif

#define GAS __attribute__((address_space(1)))
#define LAS __attribute__((address_space(3)))
typedef unsigned short bf16;
typedef short bf16x8 __attribute__((ext_vector_type(8)));
typedef short s16x4 __attribute__((ext_vector_type(4)));
typedef float f32x2 __attribute__((ext_vector_type(2)));
typedef float f32x4 __attribute__((ext_vector_type(4)));
typedef float f32x16 __attribute__((ext_vector_type(16)));
typedef unsigned u32x2 __attribute__((ext_vector_type(2)));
typedef unsigned u32x4 __attribute__((ext_vector_type(4)));
typedef __bf16 bf16x2_t __attribute__((ext_vector_type(2)));
typedef int v8i __attribute__((ext_vector_type(8)));
typedef int v4i __attribute__((ext_vector_type(4)));
typedef unsigned u32x8 __attribute__((ext_vector_type(8)));

constexpr int DM = 1024, NB = 8, SEQ = 4096, CTX = 256, SB = SEQ + CTX  , NR = NB * SB  , DEPTH = 4;
constexpr int PC = 3584;
constexpr int C_ATQ = 0, C_ATK = 512, C_ATV = 768, C_HGQ = 1024, C_HGZF = 1280, C_HGZB = 1536, C_HGV = 1792, C_HGG = 2048,
              C_MLQ = 2304, C_MLK = 2560, C_MLV = 2816, C_MLOG = 3072, C_MLG = 3328;
constexpr int NIN = 3344;
constexpr int NEXP = 32, NPOS = 147456;
constexpr float EPS = 1e-6f;
constexpr int NTHR = 512, NWAVE = 8;

constexpr size_t MiB = 1u << 20;
constexpr size_t WS_CTL = 0, CTL_ZERO_BYTES = 1 * MiB;
constexpr size_t WS_MOD = 1 * MiB;
constexpr size_t WS_ROPE = 2 * MiB;
constexpr size_t WS_WRH = 2 * MiB + 65536, WS_WRL = WS_WRH + 262144;
constexpr size_t WS_WSC = 2 * MiB + 655360;
constexpr size_t WS_HSC = 2 * MiB + 720896;
constexpr size_t WS_RE = 3 * MiB, WS_RS = WS_RE + 600000, WS_RG = WS_RS + 600000, WS_POS = WS_RG + 600000;
constexpr size_t WS_CNT = WS_POS + 600000;
constexpr size_t WS_TOK = 6 * MiB, WS_GATEP = WS_TOK + 600000, WS_TILEE = WS_GATEP + 600000, WS_NRT = WS_TILEE + 8192;
constexpr size_t WS_WIN = 8 * MiB;
constexpr size_t WS_WOUT = 36 * MiB;
constexpr size_t WS_WGU = 44 * MiB;
constexpr size_t WS_WDN = 556 * MiB;
constexpr size_t WS_H = 812 * MiB;
constexpr size_t WS_P = 880 * MiB;
constexpr size_t WS_Y = 1118 * MiB;
constexpr size_t WS_XC = 1186 * MiB;
constexpr size_t WS_ACT = 1194 * MiB;
constexpr size_t WS_YM = 1482 * MiB;
constexpr size_t WS_OH = 1770 * MiB;
constexpr size_t WS_OM = 1838 * MiB;
constexpr size_t WS_UTH = 1906 * MiB, WS_SPH = 1940 * MiB, WS_UTM = 1974 * MiB, WS_SPM = 2008 * MiB;
constexpr size_t WS_DT = 2042 * MiB, WS_NU = WS_DT + 1310720, WS_NP = WS_NU + 1310720, WS_GL = WS_NP + 1310720, WS_MP = WS_GL + 131072;
constexpr size_t WS_H8 = 2046 * MiB;
constexpr size_t WS_XB = 2080 * MiB;
constexpr size_t WS_END = 2148 * MiB;
static_assert(WS_CNT + 32768 <= WS_TOK && WS_NRT + 64 <= WS_WIN, "ws map");
static_assert((size_t)NR * 4 * 4 <= 600000 && (size_t)NPOS * 4 <= 600000, "ws map");

constexpr int CW_CMAX = 16384;
constexpr int CW_BAR = 4096;

constexpr int LDS_BYTES = 147456;
constexpr int PH_LDS = 143360;
constexpr int MISC_OFF = PH_LDS;

struct Args { const float* in[22]; float* out; unsigned char* ws; int ph_lo, ph_hi; };

#define LDS_WAIT() asm volatile("s_waitcnt lgkmcnt(0)" ::: "memory")
#define VM_WAIT() asm volatile("s_waitcnt vmcnt(0)" ::: "memory")

__device__ __forceinline__ unsigned pk2(float lo, float hi) { f32x2 v = {lo, hi}; bf16x2_t b = __builtin_convertvector(v, bf16x2_t); return __builtin_bit_cast(unsigned, b); }
__device__ __forceinline__ unsigned f2bf(float f) { return pk2(f, 0.f) & 0xffffu; }
__device__ __forceinline__ float clamp8(float x) { return fminf(fmaxf(x, -448.f), 448.f); }
__device__ __forceinline__ unsigned pk_fp8x4(float a, float b, float c, float d) {
    int w = 0; w = __builtin_amdgcn_cvt_pk_fp8_f32(clamp8(a), clamp8(b), w, false); w = __builtin_amdgcn_cvt_pk_fp8_f32(clamp8(c), clamp8(d), w, true); return (unsigned)w; }
__device__ __forceinline__ unsigned fp8_1(float a) { return pk_fp8x4(a, 0.f, 0.f, 0.f) & 0xffu; }
__device__ __forceinline__ float bf2f(unsigned h) { return __uint_as_float(h << 16); }
__device__ __forceinline__ float bflo(unsigned w) { return __uint_as_float(w << 16); }
__device__ __forceinline__ float bfhi(unsigned w) { return __uint_as_float(w & 0xffff0000u); }
__device__ __forceinline__ float wave_sum(float v) {
#define WS_DPP(x, ctrl, rmask) __builtin_bit_cast(float, __builtin_amdgcn_update_dpp(0, __builtin_bit_cast(int, x), ctrl, rmask, 0xF, false))
    v += WS_DPP(v, 0xB1, 0xF);
    v += WS_DPP(v, 0x4E, 0xF);
    v += WS_DPP(v, 0x141, 0xF);
    v += WS_DPP(v, 0x140, 0xF);
    v += WS_DPP(v, 0x142, 0xA);
    v += WS_DPP(v, 0x143, 0xC);
#undef WS_DPP
    return __builtin_bit_cast(float, __builtin_amdgcn_readlane(__builtin_bit_cast(int, v), 63));
}
__device__ __forceinline__ float wave_max_nn(float v) {
#define WS_DPP(x, ctrl, rmask) __builtin_bit_cast(float, __builtin_amdgcn_update_dpp(0, __builtin_bit_cast(int, x), ctrl, rmask, 0xF, false))
    v = fmaxf(v, WS_DPP(v, 0xB1, 0xF)); v = fmaxf(v, WS_DPP(v, 0x4E, 0xF)); v = fmaxf(v, WS_DPP(v, 0x141, 0xF)); v = fmaxf(v, WS_DPP(v, 0x140, 0xF));
    v = fmaxf(v, WS_DPP(v, 0x142, 0xA)); v = fmaxf(v, WS_DPP(v, 0x143, 0xC));
#undef WS_DPP
    return __builtin_bit_cast(float, __builtin_amdgcn_readlane(__builtin_bit_cast(int, v), 63));
}
__device__ __forceinline__ unsigned pk_i8x4(float a, float b, float c, float d) {
    const int q0 = __float2int_rn(a), q1 = __float2int_rn(b), q2 = __float2int_rn(c), q3 = __float2int_rn(d);
    return (unsigned)(q0 & 0xff) | ((unsigned)(q1 & 0xff) << 8) | ((unsigned)(q2 & 0xff) << 16) | ((unsigned)q3 << 24); }
__device__ __forceinline__ float sigm(float x) { return __builtin_amdgcn_rcpf(1.f + __expf(-x)); }


constexpr int ARGS_OFF = MISC_OFF + 256, WTAB_OFF = MISC_OFF + 512;
__device__ __forceinline__ unsigned hw_slot() { return (unsigned)__builtin_amdgcn_s_getreg((5 << 11) | 4) & 63u; }
__device__ __forceinline__ int lane_id(unsigned zo) { return (int)__builtin_amdgcn_mbcnt_hi(~0u, __builtin_amdgcn_mbcnt_lo(~0u, zo)); }
__device__ __forceinline__ int otid() {
    unsigned zo = 0; asm volatile("" : "+v"(zo));
    const int wave = __builtin_amdgcn_readfirstlane(*(const LAS int*)(WTAB_OFF + hw_slot() * 4 + zo));
    int t = wave * 64 + lane_id(zo); asm volatile("" : "+v"(t)); return t;
}
__device__ __forceinline__ int obid() { int b = blockIdx.x; asm volatile("" : "+s"(b)); return b; }
__device__ __forceinline__ int ogrid() { int g = gridDim.x; asm volatile("" : "+s"(g)); return g; }
__device__ __forceinline__ const void* lds_ptr64(int byte_off, unsigned zo) {
    const u32x2 w = *(const LAS u32x2*)(byte_off + zo);
    const unsigned lo = __builtin_amdgcn_readfirstlane(w.x), hi = __builtin_amdgcn_readfirstlane(w.y);
    return (const void*)(const GAS void*)(((unsigned long long)hi << 32) | lo);
}
__device__ __forceinline__ Args fetch_args() {
    unsigned zo = 0; asm volatile("" : "+v"(zo));
    Args r;
#pragma unroll
    for (int i = 0; i < 22; ++i) r.in[i] = (const float*)lds_ptr64(ARGS_OFF + 8 * i, zo);
    r.out = (float*)lds_ptr64(ARGS_OFF + 8 * 22, zo); r.ws = (unsigned char*)lds_ptr64(ARGS_OFF + 8 * 23, zo); r.ph_lo = 0; r.ph_hi = 0;
    return r;
}
__device__ __forceinline__ void kernel_setup(const Args& a) {
    const int tid = threadIdx.x;
    LAS unsigned* M = (LAS unsigned*)MISC_OFF;
    if (tid < 64) M[tid] = 0u;
    if (tid == 0) { LAS unsigned long long* A = (LAS unsigned long long*)ARGS_OFF;
#pragma unroll
        for (int i = 0; i < 22; ++i) A[i] = (unsigned long long)a.in[i];
        A[22] = (unsigned long long)a.out; A[23] = (unsigned long long)a.ws; }
    if ((tid & 63) == 0) *(LAS int*)(WTAB_OFF + hw_slot() * 4) = tid >> 6;
    __syncthreads();
}

__device__ __forceinline__ const float* x_rd(const Args& a, bool from_input, int r) {
    const int b = r / SB, s = r - b * SB;
    if (s < CTX) return (from_input ? a.in[2] : (const float*)(a.ws + WS_XC)) + (size_t)(b * CTX + s) * DM;
    return (from_input ? a.in[0] : (const float*)a.out) + (size_t)(b * SEQ + s - CTX) * DM;
}
__device__ __forceinline__ float* x_wr(const Args& a, int r) {
    const int b = r / SB, s = r - b * SB;
    if (s < CTX) return (float*)(a.ws + WS_XC) + (size_t)(b * CTX + s) * DM;
    return a.out + (size_t)(b * SEQ + s - CTX) * DM;
}
__device__ __forceinline__ const float* modv(const Args& a, int layer, int r, int chunk) {
    const int b = r / SB, s = r - b * SB; const int j = s < CTX ? 8 : b;
    return (const float*)(a.ws + WS_MOD) + ((size_t)(layer * 9 + j) * 6 + chunk) * DM;
}

#define XB_TMO      128
#define XB_XCNT(j)  (256  + 64 * (j))
#define XB_XSUB(j)  (1280 + 64 * (j))
#define XB_XGEN(j)  (2304 + 64 * (j))
#define XB_TOP      3328
#define XB_TOPGEN   3392
#define XCD_BAR_WORDS 3456
#define XB_SPIN_CAP (1u << 18)
__device__ __forceinline__ unsigned xb_ld(unsigned* p)              { return __hip_atomic_load(p, __ATOMIC_RELAXED, __HIP_MEMORY_SCOPE_AGENT); }
__device__ __forceinline__ unsigned xb_add(unsigned* p, unsigned v) { return __hip_atomic_fetch_add(p, v, __ATOMIC_RELAXED, __HIP_MEMORY_SCOPE_AGENT); }
__device__ __forceinline__ unsigned xb_xcc_id() { return (unsigned)__builtin_amdgcn_s_getreg((3 << 11) | 20) & 0xFu; }
#define XB_SPIN(cond, bar) do { unsigned _sp = 0; while (cond) { __builtin_amdgcn_s_sleep(1); \
    if ((++_sp & 255u) == 0u) { if (xb_ld(&(bar)[XB_TMO])) break; if (_sp > XB_SPIN_CAP) { atomicAdd(&(bar)[XB_TMO], 1u); break; } } } } while (0)
struct XcdBarrier { unsigned* bar; unsigned x; volatile LAS unsigned* st; };
__device__ __forceinline__ XcdBarrier xcd_barrier_post(unsigned* bar, volatile LAS unsigned* st) {
    XcdBarrier b; b.bar = bar; b.x = xb_xcc_id(); b.st = st;
    if (otid() == 0) (void)xb_add(&bar[XB_XCNT(b.x)], 1u);
    return b;
}
__device__ __forceinline__ void xcd_barrier_complete(unsigned* bar, unsigned x, unsigned& nloc, unsigned& nx) {
    const unsigned G = gridDim.x * gridDim.y * gridDim.z;
    unsigned sum, cnt, mine, sp = 0u;
    for (;;) {
        sum = 0u; cnt = 0u; mine = 0u;
#pragma unroll
        for (unsigned j = 0; j < 16; ++j) { const unsigned c = xb_ld(&bar[XB_XCNT(j)]); sum += c; cnt += (c > 0u) ? 1u : 0u; mine = (j == x) ? c : mine; }
        if (sum == G) break;
        __builtin_amdgcn_s_sleep(1);
        if ((++sp & 255u) == 0u) { if (xb_ld(&bar[XB_TMO])) break; if (sp > XB_SPIN_CAP) { atomicAdd(&bar[XB_TMO], 1u); break; } }
    }
    nloc = mine > 0u ? mine : 1u; nx = cnt > 0u ? cnt : 1u;
}
__device__ __forceinline__ void xcd_barrier(const XcdBarrier& b) {
    asm volatile("s_waitcnt vmcnt(0)" ::: "memory");
    __syncthreads();
    if (otid() == 0) {
        unsigned* bar = b.bar;
        __builtin_amdgcn_s_waitcnt(0);
        unsigned nloc = b.st[0], nx = b.st[1];
        if (nloc == 0u) { xcd_barrier_complete(bar, b.x, nloc, nx); b.st[0] = nloc; b.st[1] = nx; }
        const unsigned old = xb_add(&bar[XB_XSUB(b.x)], 1u);
        const unsigned gen = old / nloc;
        if (old + 1u == (gen + 1u) * nloc) {
            __builtin_amdgcn_fence(__ATOMIC_RELEASE, "agent");
            asm volatile("s_waitcnt vmcnt(0)" ::: "memory");
            const unsigned og = xb_add(&bar[XB_TOP], 1u);
            const unsigned tg = og / nx;
            if (og + 1u == (tg + 1u) * nx) xb_add(&bar[XB_TOPGEN], 1u);
            else XB_SPIN(xb_ld(&bar[XB_TOPGEN]) == tg, bar);
            __builtin_amdgcn_fence(__ATOMIC_ACQUIRE, "agent");
            xb_add(&bar[XB_XGEN(b.x)], 1u);
            asm volatile("s_waitcnt vmcnt(0)" ::: "memory");
        } else {
            XB_SPIN(xb_ld(&bar[XB_XGEN(b.x)]) == gen, bar);
            __builtin_amdgcn_fence(__ATOMIC_ACQUIRE, "agent");
            asm volatile("s_waitcnt vmcnt(0)" ::: "memory");
        }
    }
    __syncthreads();
}

__device__ __forceinline__ void glds16s2(const void* sbase, unsigned voff0, unsigned voff1, unsigned lds0, unsigned lds1) {
    unsigned keep;
    asm volatile("s_mov_b32 %0, m0\n\ts_mov_b32 m0, %4\n\ts_nop 0\n\tglobal_load_lds_dwordx4 %1, %3\n\ts_mov_b32 m0, %5\n\ts_nop 0\n\tglobal_load_lds_dwordx4 %2, %3\n\ts_mov_b32 m0, %0"
                 : "=&s"(keep) : "v"(voff0), "v"(voff1), "s"(sbase), "s"(lds0), "s"(lds1) : "memory");
}

__device__ __forceinline__ void glds16s1(const void* sbase, unsigned voff, unsigned lds0) {
    unsigned keep;
    asm volatile("s_mov_b32 %0, m0\n\ts_mov_b32 m0, %3\n\ts_nop 0\n\tglobal_load_lds_dwordx4 %1, %2\n\ts_mov_b32 m0, %0" : "=&s"(keep) : "v"(voff), "s"(sbase), "s"(lds0) : "memory");
}
struct AuxSrc { const void* base; unsigned off; };

namespace pg8 {
constexpr int BM = 256, BK = 64, HALF = 128, HTB = HALF * BK * 2, STAGE_BYTES = 8 * HTB, NXCD = 8, WGM = 8, K = 1024;
__host__ __device__ __forceinline__ int lds_byte(int r, int c) { const int st = (r >> 4) * 2 + (c >> 5), rr = r & 15, cc = c & 31, ob = rr * 64 + cc * 2; return st * 1024 + (ob ^ (((ob >> 9) & 1) << 5)); }
__host__ __device__ __forceinline__ void stage_rc(int b, int& R, int& C) { const int st = b / 1024, sb = b % 1024, swz = sb ^ (((sb >> 9) & 1) << 5); R = (st >> 1) * 16 + swz / 64; C = (st & 1) * 32 + (swz % 64) / 2; }
__host__ __device__ __forceinline__ int perm32(int rho) { const int n = rho >> 4, i = rho & 15; return 8 * (i >> 2) + 4 * n + (i & 3); }

struct Unit { int pm, pn, e; const char* Bt; };

struct SchedDense {
    int nM, nN, nwg, G, c, rb; const char* Bt;
    __device__ void init(int M, int N, int G_, int c_, const bf16* Bt_) { nM = M / BM; nN = N / BM; nwg = nM * nN; G = G_; c = c_; Bt = (const char*)Bt_; rb = 2 * K; }
    __device__ __forceinline__ bool next(int i, Unit& u) const {
        const long L = (long)i * G + c; if (L >= nwg) return false;
        int wgid = (int)L; { const int q = nwg / NXCD, r = nwg % NXCD, xcd = wgid % NXCD, off = wgid / NXCD; wgid = (xcd < r ? xcd * (q + 1) : r * (q + 1) + (xcd - r) * q) + off; }
        const int nig = WGM * nN, gid = wgid / nig, fm = gid * WGM, gsz = (nM - fm) < WGM ? (nM - fm) : WGM;
        u.pm = fm + ((wgid % nig) % gsz); u.pn = (wgid % nig) / gsz; u.e = 0; u.Bt = Bt + (size_t)u.pn * BM * rb; return true;
    }
    __device__ __forceinline__ int row(const Unit& u, int local) const { return u.pm * BM + local; }
};
struct SchedMoe {
    int G, c, nct, ntot, nrt; const int* tile_e; const char* WT; const int* tok; int rb  ;
    __device__ __forceinline__ bool next(int i, Unit& u) const {
        int rt, pn;
        if ((G & 7) == 0) { const int x = c & 7, j = c >> 3, per = G >> 3, base = nrt >> 3, rem = nrt & 7;
            const int cnt = base + (x < rem ? 1 : 0), start = x * base + (x < rem ? x : rem), q = i * per + j;
            if (q >= cnt * nct) return false;
            const int rl = q / nct; pn = q - rl * nct; rt = start + rl; }
        else { const int L = i * G + c; if (L >= nrt * nct) return false; rt = L / nct; pn = L - rt * nct; }
        u.pm = rt; u.pn = pn; u.e = __builtin_amdgcn_readfirstlane(__hip_atomic_load(tile_e + rt, __ATOMIC_RELAXED, __HIP_MEMORY_SCOPE_AGENT));
        u.Bt = WT + ((size_t)u.e * ntot + (size_t)u.pn * BM) * rb; return true;
    }
    __device__ __forceinline__ int row(const Unit& u, int local) const { return tok ? tok[u.pm * BM + local] : u.pm * BM + local; }
};

template <int MODE  , class Epi, class Sched>
__device__ __forceinline__ void gemm_phase(LAS unsigned char* lds, const void* Abase, const Sched& S, const Epi& E) {
    const int tid = otid(), wid = __builtin_amdgcn_readfirstlane(tid >> 6), lane = tid & 63, wr = wid >> 2, wc = wid & 3, fr = lane & 15, fq = lane >> 4;
    constexpr bool FP8 = (MODE == 1), I8 = (MODE == 2);
    constexpr int RB = MODE ? K : 2 * K;
    constexpr int nt = RB / 128;
    int R0, C0; stage_rc(tid * 16, R0, C0);
    const unsigned voffB0 = (unsigned)((Epi::PERM ? ((R0 & ~31) + perm32(R0 & 31)) : R0) * RB + C0 * 2);
    constexpr size_t kstep = (size_t)(BK * 2);
    constexpr size_t hstep = (size_t)HALF * RB;
    const unsigned ldsw = (unsigned)wid * 1024u, ldsb = (unsigned)(size_t)lds;
    const int aoff = lds_byte(wr * 64 + fr, fq * 8), boff = lds_byte(wc * 32 + fr, fq * 8);
    const char* Ab = (const char*)Abase;
    LAS u32x4* nslot = (LAS u32x4*)(lds + STAGE_BYTES + tid * 16);
    constexpr int AUX_OFF = STAGE_BYTES + 8192;
#define PG8_AUX(u, idx) do { if (wid < 2) { const AuxSrc s_ = E.aux(wid, u, lane); if (s_.base) glds16s1(s_.base, s_.off, ldsb + (unsigned)(AUX_OFF + ((idx) & 1) * 2048 + wid * 1024)); } } while (0)
#define PG8_SA(b, h) (((b) * 2 + (h)) * HTB)
#define PG8_SB(b, h) ((4 + (b) * 2 + (h)) * HTB)
#define PG8_STAGEA(bufoff, gbase, voff) glds16s2((gbase), (voff)[0], (voff)[1], ldsb + (unsigned)(bufoff) + ldsw, ldsb + (unsigned)(bufoff) + ldsw + 8192u)
#define PG8_STAGEB(bufoff, gbase) glds16s2((gbase), voffB0, voffB0 + (unsigned)(64 * RB), ldsb + (unsigned)(bufoff) + ldsw, ldsb + (unsigned)(bufoff) + ldsw + 8192u)
#define PG8_LDA(dst, b, h) do { if constexpr (FP8) { _Pragma("unroll") for (int m = 0; m < 4; ++m) { dst##8[m].lo = *(const LAS u32x4*)(lds + PG8_SA(b, h) + aoff + m * 2048); dst##8[m].hi = *(const LAS u32x4*)(lds + PG8_SA(b, h) + aoff + m * 2048 + 1024); } } \
    else { _Pragma("unroll") for (int m = 0; m < 4; ++m) _Pragma("unroll") for (int k = 0; k < 2; ++k) dst[m][k] = *(const LAS bf16x8*)(lds + PG8_SA(b, h) + aoff + m * 2048 + k * 1024); } } while (0)
#define PG8_LDB(dst, b, h) do { if constexpr (FP8) { _Pragma("unroll") for (int n = 0; n < 2; ++n) { dst##8[n].lo = *(const LAS u32x4*)(lds + PG8_SB(b, h) + boff + n * 2048); dst##8[n].hi = *(const LAS u32x4*)(lds + PG8_SB(b, h) + boff + n * 2048 + 1024); } } \
    else { _Pragma("unroll") for (int n = 0; n < 2; ++n) _Pragma("unroll") for (int k = 0; k < 2; ++k) dst[n][k] = *(const LAS bf16x8*)(lds + PG8_SB(b, h) + boff + n * 2048 + k * 1024); } } while (0)
#define PG8_MMA(ai, bj, At, Bt) do { __builtin_amdgcn_s_setprio(1); if constexpr (FP8) { _Pragma("unroll") for (int m = 0; m < 4; ++m) _Pragma("unroll") for (int n = 0; n < 2; ++n) \
        acc[ai][bj][m][n] = __builtin_amdgcn_mfma_scale_f32_16x16x128_f8f6f4(__builtin_bit_cast(v8i, Bt##8[n]), __builtin_bit_cast(v8i, At##8[m]), acc[ai][bj][m][n], 0, 0, 0, 0x7f7f7f7f, 0, 0x7f7f7f7f); } \
        else if constexpr (I8) { _Pragma("unroll") for (int m = 0; m < 4; ++m) _Pragma("unroll") for (int n = 0; n < 2; ++n) _Pragma("unroll") for (int k = 0; k < 2; ++k) \
        acc[ai][bj][m][n] = __builtin_bit_cast(f32x4, __builtin_amdgcn_mfma_i32_16x16x64_i8(__builtin_bit_cast(v4i, Bt[n][k]), __builtin_bit_cast(v4i, At[m][k]), __builtin_bit_cast(v4i, acc[ai][bj][m][n]), 0, 0, 0)); } \
        else { _Pragma("unroll") for (int m = 0; m < 4; ++m) _Pragma("unroll") for (int n = 0; n < 2; ++n) _Pragma("unroll") for (int k = 0; k < 2; ++k) \
        acc[ai][bj][m][n] = __builtin_amdgcn_mfma_f32_16x16x32_bf16(Bt[n][k], At[m][k], acc[ai][bj][m][n], 0, 0, 0); } __builtin_amdgcn_s_setprio(0); } while (0)
#define PG8_WAIT_V(n) asm volatile("s_waitcnt vmcnt(" #n ")" ::: "memory")
#define PG8_WAIT_L(n) asm volatile("s_waitcnt lgkmcnt(" #n ")" ::: "memory")
#define PG8_BAR __builtin_amdgcn_s_barrier()
#define PG8_SCHED __builtin_amdgcn_sched_barrier(0)
#define PG8_VAOFF(u, h, i) ((unsigned)(S.row(u, (h) * HALF + R0 + 64 * (i)) * RB + C0 * 2))
    Unit cur, nxt; int ui = 0;
    if (!S.next(0, cur)) return;
    f32x4 acc[2][2][4][2];
#pragma unroll
    for (int a = 0; a < 2; ++a)
#pragma unroll
        for (int b = 0; b < 2; ++b)
#pragma unroll
            for (int m = 0; m < 4; ++m)
#pragma unroll
                for (int n = 0; n < 2; ++n) acc[a][b][m][n] = (f32x4){0.f, 0.f, 0.f, 0.f};
    bf16x8 At[4][2], B0[2][2], B1[2][2];
    u32x8 At8[4], B08[2], B18[2];
    unsigned vA[2][2];
#pragma unroll
    for (int h = 0; h < 2; ++h)
#pragma unroll
        for (int i = 0; i < 2; ++i) vA[h][i] = PG8_VAOFF(cur, h, i);
    const char* cB = cur.Bt;
    PG8_AUX(cur, 0);
    PG8_STAGEB(PG8_SB(0, 0), cB); PG8_STAGEB(PG8_SB(0, 1), cB + hstep); PG8_STAGEA(PG8_SA(0, 0), Ab, vA[0]); PG8_STAGEA(PG8_SA(0, 1), Ab, vA[1]);
    if (wr == 1) PG8_BAR;
    PG8_WAIT_V(2); PG8_BAR;
    PG8_STAGEB(PG8_SB(1, 0), cB + kstep); PG8_STAGEA(PG8_SA(1, 0), Ab + kstep, vA[0]); PG8_STAGEB(PG8_SB(1, 1), cB + hstep + kstep);
    PG8_WAIT_V(6); PG8_BAR;
    for (;;) {
        const bool has_next = S.next(ui + 1, nxt);
        if (has_next) *nslot = (u32x4){PG8_VAOFF(nxt, 0, 0), PG8_VAOFF(nxt, 0, 1), PG8_VAOFF(nxt, 1, 0), PG8_VAOFF(nxt, 1, 1)};
        const char* nB = has_next ? nxt.Bt : cB;
#pragma unroll 1
        for (int t = 0; t < nt; t += 2) {
            const bool last = (t == nt - 2);
            const char* a1 = Ab + (size_t)(t + 1) * kstep;
            const char* a2 = last ? Ab : Ab + (size_t)(t + 2) * kstep; const char* b2 = last ? nB : cB + (size_t)(t + 2) * kstep;
            const char* a3 = a2 + kstep; const char* b3 = b2 + kstep;
            PG8_LDB(B0, 0, 0); PG8_LDB(B1, 0, 1); PG8_SCHED; PG8_LDA(At, 0, 0); PG8_STAGEA(PG8_SA(1, 1), a1, vA[1]);
            if (last && has_next) { const u32x4 nv = *nslot; vA[0][0] = nv.x; vA[0][1] = nv.y; vA[1][0] = nv.z; vA[1][1] = nv.w; }
            PG8_WAIT_V(8); PG8_WAIT_L(0); PG8_BAR; PG8_MMA(0, 0, At, B0); PG8_MMA(0, 1, At, B1); PG8_BAR; PG8_SCHED;
            PG8_LDA(At, 0, 1); PG8_STAGEB(PG8_SB(0, 0), b2); PG8_STAGEB(PG8_SB(0, 1), b2 + hstep); PG8_STAGEA(PG8_SA(0, 0), a2, vA[0]);
            PG8_WAIT_V(8); PG8_WAIT_L(0); PG8_BAR; PG8_MMA(1, 0, At, B0); PG8_MMA(1, 1, At, B1); PG8_BAR; PG8_SCHED;
            PG8_LDB(B0, 1, 0); PG8_LDB(B1, 1, 1); PG8_SCHED; PG8_LDA(At, 1, 0); PG8_STAGEA(PG8_SA(0, 1), a2, vA[1]);
            PG8_WAIT_V(8); PG8_WAIT_L(0); PG8_BAR; PG8_MMA(0, 0, At, B0); PG8_MMA(0, 1, At, B1); PG8_BAR; PG8_SCHED;
            PG8_LDA(At, 1, 1); PG8_STAGEB(PG8_SB(1, 0), b3); PG8_STAGEB(PG8_SB(1, 1), b3 + hstep); PG8_STAGEA(PG8_SA(1, 0), a3, vA[0]);
            PG8_WAIT_V(8); PG8_WAIT_L(0); PG8_BAR; PG8_MMA(1, 0, At, B0); PG8_MMA(1, 1, At, B1); PG8_BAR; PG8_SCHED;
        }
        if (GEMM_ALIGN && wr == 0) PG8_BAR;
        { int fr_ = fr, fq_ = fq; asm volatile("" : "+v"(fr_), "+v"(fq_));
          E(acc, cur, wr, wc, fr_, fq_, (const LAS float*)(lds + AUX_OFF + (ui & 1) * 2048), (const LAS float*)(lds + AUX_OFF + (ui & 1) * 2048 + 1024)); }
        if (!has_next) break;
#pragma unroll
        for (int a = 0; a < 2; ++a)
#pragma unroll
            for (int b = 0; b < 2; ++b)
#pragma unroll
                for (int m = 0; m < 4; ++m)
#pragma unroll
                    for (int n = 0; n < 2; ++n) acc[a][b][m][n] = (f32x4){0.f, 0.f, 0.f, 0.f};
        cur = nxt; cB = nB; ++ui;
        PG8_AUX(cur, ui);
        if (GEMM_ALIGN && wr == 1) PG8_BAR;
    }
    PG8_WAIT_V(0);
    if (!GEMM_ALIGN && wr == 0) PG8_BAR;
    PG8_BAR;
#undef PG8_SA
#undef PG8_SB
#undef PG8_STAGEA
#undef PG8_STAGEB
#undef PG8_LDA
#undef PG8_LDB
#undef PG8_MMA
#undef PG8_WAIT_V
#undef PG8_WAIT_L
#undef PG8_BAR
#undef PG8_SCHED
#undef PG8_VAOFF
#undef PG8_AUX
}

struct EpiBf16 {
    static constexpr bool PERM = true;
    bf16* O; int ldc;
    __device__ __forceinline__ AuxSrc aux(int, const Unit&, int) const { return AuxSrc{nullptr, 0u}; }
    __device__ __forceinline__ void operator()(const f32x4 (&acc)[2][2][4][2], const Unit& u, int wr, int wc, int fr, int fq, const LAS float*, const LAS float*) const {
        const int row0 = u.pm * BM + wr * 64 + fr, col0 = u.pn * BM + wc * 32 + 8 * fq;
#pragma unroll
        for (int ai = 0; ai < 2; ++ai)
#pragma unroll
            for (int m = 0; m < 4; ++m) { bf16* rowp = O + (size_t)(row0 + ai * HALF + m * 16) * ldc + col0;
#pragma unroll
                for (int bj = 0; bj < 2; ++bj) { const f32x4 v0 = acc[ai][bj][m][0], v1 = acc[ai][bj][m][1];
                    u32x4 w; w.x = pk2(v0[0], v0[1]); w.y = pk2(v0[2], v0[3]); w.z = pk2(v1[0], v1[1]); w.w = pk2(v1[2], v1[3]);
                    *(u32x4*)(rowp + bj * HALF) = w; } }
    }
};
struct EpiI8 {
    static constexpr bool PERM = true;
    bf16* O; int ldc; const float* hs; const float* ws;
    __device__ __forceinline__ AuxSrc aux(int which, const Unit& u, int lane) const { return which == 0 ? AuxSrc{ws + u.pn * BM, (unsigned)lane * 16u} : AuxSrc{hs + u.pm * BM, (unsigned)lane * 16u}; }
    __device__ __forceinline__ void operator()(const f32x4 (&acc)[2][2][4][2], const Unit& u, int wr, int wc, int fr, int fq, const LAS float* a0, const LAS float* a1) const {
        const int row0 = u.pm * BM + wr * 64 + fr, col0 = u.pn * BM + wc * 32 + 8 * fq;
        f32x4 wv[2][2];
#pragma unroll
        for (int bj = 0; bj < 2; ++bj)
#pragma unroll
            for (int n = 0; n < 2; ++n) wv[bj][n] = *(const LAS f32x4*)(a0 + wc * 32 + 8 * fq + bj * HALF + 4 * n);
#pragma unroll
        for (int ai = 0; ai < 2; ++ai)
#pragma unroll
            for (int m = 0; m < 4; ++m) { const int row = row0 + ai * HALF + m * 16; const float hr = a1[wr * 64 + fr + ai * HALF + m * 16]; bf16* rowp = O + (size_t)row * ldc + col0;
#pragma unroll
                for (int bj = 0; bj < 2; ++bj) { const f32x4 v0 = __builtin_convertvector(__builtin_bit_cast(v4i, acc[ai][bj][m][0]), f32x4) * hr * wv[bj][0], v1 = __builtin_convertvector(__builtin_bit_cast(v4i, acc[ai][bj][m][1]), f32x4) * hr * wv[bj][1];
                    u32x4 w; w.x = pk2(v0[0], v0[1]); w.y = pk2(v0[2], v0[3]); w.z = pk2(v1[0], v1[1]); w.w = pk2(v1[2], v1[3]);
                    *(u32x4*)(rowp + bj * HALF) = w; } }
    }
};
struct EpiResid {
    static constexpr bool PERM = true;
    const float* xin_lat; const float* xin_ctx; bf16* xb; const float* mod  ; int chunk; bool skip_ctx, first; float sc;
    __device__ __forceinline__ AuxSrc aux(int which, const Unit& u, int lane) const { const int b = u.pm / 17, j = u.pm - b * 17;
        return which == 0 ? AuxSrc{mod + (size_t)((j == 0 ? 8 : b) * 6 + chunk) * DM + u.pn * BM, (unsigned)lane * 16u} : AuxSrc{nullptr, 0u}; }
    __device__ __forceinline__ void operator()(const f32x4 (&acc)[2][2][4][2], const Unit& u, int wr, int wc, int fr, int fq, const LAS float* a0, const LAS float*) const {
        const int b = u.pm / 17, j = u.pm - b * 17; const bool isctx = (j == 0);
        if (isctx && skip_ctx) return;
        const float* xin = isctx ? xin_ctx + (size_t)b * CTX * DM : xin_lat + ((size_t)b * SEQ + (size_t)(j - 1) * 256) * DM;
        bf16* xt = xb + (size_t)u.pm * BM * DM;
        const int col0 = u.pn * BM + wc * 32 + 8 * fq;
        f32x4 gv[2][2];
#pragma unroll
        for (int bj = 0; bj < 2; ++bj)
#pragma unroll
            for (int n = 0; n < 2; ++n) gv[bj][n] = *(const LAS f32x4*)(a0 + wc * 32 + 8 * fq + bj * HALF + 4 * n) * sc;
#pragma unroll
        for (int ai = 0; ai < 2; ++ai)
#pragma unroll
            for (int m = 0; m < 4; ++m) { const size_t ro = (size_t)(ai * HALF + wr * 64 + m * 16 + fr) * DM;
#pragma unroll
                for (int bj = 0; bj < 2; ++bj) { const int c = col0 + bj * HALF; f32x4 x0, x1;
                    if (first) { x0 = *(const f32x4*)(xin + ro + c); x1 = *(const f32x4*)(xin + ro + c + 4); }
                    else { const u32x4 w = *(const u32x4*)(xt + ro + c); x0 = (f32x4){bflo(w.x), bfhi(w.x), bflo(w.y), bfhi(w.y)}; x1 = (f32x4){bflo(w.z), bfhi(w.z), bflo(w.w), bfhi(w.w)}; }
                    x0 = x0 + gv[bj][0] * acc[ai][bj][m][0]; x1 = x1 + gv[bj][1] * acc[ai][bj][m][1];
                    u32x4 o; o.x = pk2(x0[0], x0[1]); o.y = pk2(x0[2], x0[3]); o.z = pk2(x1[0], x1[1]); o.w = pk2(x1[2], x1[3]);
                    *(u32x4*)(xt + ro + c) = o; } }
    }
};
struct EpiGU {
    static constexpr bool PERM = true;
    void* ACT; const float* bgu  ;
    __device__ __forceinline__ AuxSrc aux(int which, const Unit& u, int lane) const {
        return which == 0 ? AuxSrc{bgu + (size_t)u.e * 2048 + u.pn * HALF, lane < 32 ? (unsigned)lane * 16u : 4096u + (unsigned)(lane - 32) * 16u} : AuxSrc{nullptr, 0u}; }
    __device__ __forceinline__ void operator()(const f32x4 (&acc)[2][2][4][2], const Unit& u, int wr, int wc, int fr, int fq, const LAS float* a0, const LAS float*) const {
        const int row0 = u.pm * BM + wr * 64 + fr, col0 = u.pn * HALF + wc * 32 + 8 * fq;
        constexpr float SC = MOE_FP8 ? 1.f / 512.f : 1.f;
        f32x4 bgv[2], buv[2];
#pragma unroll
        for (int n = 0; n < 2; ++n) { bgv[n] = *(const LAS f32x4*)(a0 + wc * 32 + 8 * fq + 4 * n); buv[n] = *(const LAS f32x4*)(a0 + HALF + wc * 32 + 8 * fq + 4 * n); }
#pragma unroll
        for (int ai = 0; ai < 2; ++ai)
#pragma unroll
            for (int m = 0; m < 4; ++m) { float o[8];
#pragma unroll
                for (int n = 0; n < 2; ++n)
#pragma unroll
                    for (int i = 0; i < 4; ++i) { float gt = acc[ai][0][m][n][i] * SC + bgv[n][i], up = acc[ai][1][m][n][i] * SC + buv[n][i];
                        gt = fminf(gt, 7.f); up = fminf(fmaxf(up, -7.f), 7.f);
                        o[4 * n + i] = (up + 1.f) * gt * sigm(1.702f * gt); }
                const size_t eo = (size_t)(row0 + ai * HALF + m * 16) * DM + col0;
                if constexpr (MOE_FP8) { u32x2 w; w.x = pk_fp8x4(4.f * o[0], 4.f * o[1], 4.f * o[2], 4.f * o[3]); w.y = pk_fp8x4(4.f * o[4], 4.f * o[5], 4.f * o[6], 4.f * o[7]);
                    *(u32x2*)((unsigned char*)ACT + eo) = w; }
                else { u32x4 w; w.x = pk2(o[0], o[1]); w.y = pk2(o[2], o[3]); w.z = pk2(o[4], o[5]); w.w = pk2(o[6], o[7]); *(u32x4*)((bf16*)ACT + eo) = w; } }
    }
};
struct EpiDown {
    static constexpr bool PERM = true;
    bf16* YM; const float* bdn  ; const float* gatep;
    __device__ __forceinline__ AuxSrc aux(int which, const Unit& u, int lane) const {
        return which == 0 ? AuxSrc{bdn + (size_t)u.e * 1024 + u.pn * BM, (unsigned)lane * 16u} : AuxSrc{gatep + (size_t)u.pm * BM, (unsigned)lane * 16u}; }
    __device__ __forceinline__ void operator()(const f32x4 (&acc)[2][2][4][2], const Unit& u, int wr, int wc, int fr, int fq, const LAS float* a0, const LAS float* a1) const {
        const int row0 = u.pm * BM + wr * 64 + fr, col0 = u.pn * BM + wc * 32 + 8 * fq;
        constexpr float SC = MOE_FP8 ? 1.f / 256.f : 1.f;
        f32x4 bv[2][2];
#pragma unroll
        for (int bj = 0; bj < 2; ++bj)
#pragma unroll
            for (int n = 0; n < 2; ++n) bv[bj][n] = *(const LAS f32x4*)(a0 + wc * 32 + 8 * fq + bj * HALF + 4 * n);
#pragma unroll
        for (int ai = 0; ai < 2; ++ai)
#pragma unroll
            for (int m = 0; m < 4; ++m) { const int row = row0 + ai * HALF + m * 16; const float gt = a1[wr * 64 + fr + ai * HALF + m * 16]; bf16* rowp = YM + (size_t)row * DM + col0;
#pragma unroll
                for (int bj = 0; bj < 2; ++bj) { const f32x4 v0 = (acc[ai][bj][m][0] * SC + bv[bj][0]) * gt, v1 = (acc[ai][bj][m][1] * SC + bv[bj][1]) * gt;
                    u32x4 w; w.x = pk2(v0[0], v0[1]); w.y = pk2(v0[2], v0[3]); w.z = pk2(v1[0], v1[1]); w.w = pk2(v1[2], v1[3]);
                    *(u32x4*)(rowp + bj * HALF) = w; } }
    }
};
}

namespace att {
constexpr int D = 128, NW = 8, QBLK = 32, KVBLK = 64;
constexpr float SCALE = 0.088388347648318440f;
constexpr float THR = 8.f;
constexpr int LDQ = PC, LDK = PC, LDO = DM;
constexpr size_t SHM_V = KVBLK * D * 2, SHM_K = KVBLK * D * 2, SHM_ATTN = 2 * SHM_V + 2 * SHM_K + NW * 64 * 4;
#define KSWZ(row, colB) ((row) * 256 + ((colB) ^ (((row) & 15) << 4)))
#define SBAR() __builtin_amdgcn_sched_barrier(0)
__device__ __forceinline__ int crow(int r, int hi) { return (r & 3) + 8 * (r >> 2) + 4 * hi; }
__device__ __forceinline__ unsigned cvtpk(float lo, float hi) { unsigned r; asm volatile("v_cvt_pk_bf16_f32 %0, %1, %2" : "=v"(r) : "v"(lo), "v"(hi)); return r; }
__device__ __forceinline__ bf16x8 ld8(const bf16* p) { return *reinterpret_cast<const bf16x8*>(p); }
__device__ __forceinline__ void finishSM(f32x16& p0, f32x16& p1, float& l_reg, bf16x8& pa0, bf16x8& pa1, bf16x8& pa2, bf16x8& pa3) {
  for (int r = 0; r < 16; ++r) p1[r] = __builtin_amdgcn_exp2f(p1[r]);
  float ps = 0; for (int r = 0; r < 16; ++r) ps += p0[r]; for (int r = 0; r < 16; ++r) ps += p1[r];
  { auto rr = __builtin_amdgcn_permlane32_swap(__float_as_uint(ps), __float_as_uint(ps), false, false);
    ps = __uint_as_float(rr[0]) + __uint_as_float(rr[1]); }
  l_reg += ps;
#define PK4(P, BASE, OUT) do { unsigned a0 = cvtpk(P[BASE + 0], P[BASE + 1]), a1 = cvtpk(P[BASE + 2], P[BASE + 3]);   \
    unsigned b0 = cvtpk(P[BASE + 4], P[BASE + 5]), b1 = cvtpk(P[BASE + 6], P[BASE + 7]);                              \
    auto r0 = __builtin_amdgcn_permlane32_swap(a0, b0, false, false); auto r1 = __builtin_amdgcn_permlane32_swap(a1, b1, false, false); \
    u32x4 w = {r0[0], r1[0], r0[1], r1[1]}; OUT = *reinterpret_cast<bf16x8*>(&w); } while (0)
  PK4(p0, 0, pa0); PK4(p0, 8, pa1); PK4(p1, 0, pa2); PK4(p1, 8, pa3);
#undef PK4
}
__device__ __forceinline__ void qkt(f32x16& p0, f32x16& p1, const LAS char* Ks, const bf16x8* qr, int r32, int hi, float negm) {
#pragma unroll
  for (int r = 0; r < 16; ++r) { p0[r] = negm; p1[r] = negm; }
  for (int d0 = 0; d0 < 8; ++d0) { int cb = (d0 * 16 + hi * 8) * 2;
    bf16x8 b0 = *reinterpret_cast<const LAS bf16x8*>(Ks + KSWZ(r32, cb));
    bf16x8 b1 = *reinterpret_cast<const LAS bf16x8*>(Ks + KSWZ(32 + r32, cb));
    p0 = __builtin_amdgcn_mfma_f32_32x32x16_bf16(b0, qr[d0], p0, 0, 0, 0);
    p1 = __builtin_amdgcn_mfma_f32_32x32x16_bf16(b1, qr[d0], p1, 0, 0, 0); }
}
__device__ __forceinline__ void partialSM_fix(f32x16& p0) { for (int r = 0; r < 16; ++r) p0[r] = __builtin_amdgcn_exp2f(p0[r]); }
__device__ __forceinline__ int v_st(int k, int c) { const int kk = (k & ~0xC) | ((k & 4) << 1) | ((k & 8) >> 1); return ((kk >> 3) * 4 + (c >> 5)) * 512 + ((kk & 7) * 32 + (c & 31)) * 2; }
__device__ __forceinline__ int v_rd_base(int lane) { return ((lane & 3) << 3) | (((lane >> 2) & 3) << 6) | (((lane >> 4) & 1) << 5) | (((lane >> 5) & 1) << 8); }
constexpr int v_rd_off(int d0, int ks, int half) { return d0 * 512 + ks * 4096 + half * 2048; }
template <int OFF> __device__ __forceinline__ s16x4 tr_read(int vb) {
  s16x4 r; asm volatile("ds_read_b64_tr_b16 %0, %1 offset:%2" : "=&v"(r) : "v"(vb), "i"(OFF) : "memory"); return r;
}
template <int D0> __device__ __forceinline__ void pv_one(f32x16& od, int vb, bf16x8 pa0, bf16x8 pa1, bf16x8 pa2, bf16x8 pa3) {
  const s16x4 l0 = tr_read<v_rd_off(D0, 0, 0)>(vb), h0 = tr_read<v_rd_off(D0, 0, 1)>(vb), l1 = tr_read<v_rd_off(D0, 1, 0)>(vb), h1 = tr_read<v_rd_off(D0, 1, 1)>(vb);
  const s16x4 l2 = tr_read<v_rd_off(D0, 2, 0)>(vb), h2 = tr_read<v_rd_off(D0, 2, 1)>(vb), l3 = tr_read<v_rd_off(D0, 3, 0)>(vb), h3 = tr_read<v_rd_off(D0, 3, 1)>(vb);
  asm volatile("s_waitcnt lgkmcnt(0)" ::: "memory"); SBAR();
#define PK(L, H) (bf16x8){L[0], L[1], L[2], L[3], H[0], H[1], H[2], H[3]}
  od = __builtin_amdgcn_mfma_f32_32x32x16_bf16(pa0, PK(l0, h0), od, 0, 0, 0);
  od = __builtin_amdgcn_mfma_f32_32x32x16_bf16(pa1, PK(l1, h1), od, 0, 0, 0);
  od = __builtin_amdgcn_mfma_f32_32x32x16_bf16(pa2, PK(l2, h2), od, 0, 0, 0);
  od = __builtin_amdgcn_mfma_f32_32x32x16_bf16(pa3, PK(l3, h3), od, 0, 0, 0);
#undef PK
}
__device__ __forceinline__ void pv_d0(f32x16* o, int vb, bf16x8 pa0, bf16x8 pa1, bf16x8 pa2, bf16x8 pa3) {
  pv_one<0>(o[0], vb, pa0, pa1, pa2, pa3); pv_one<1>(o[1], vb, pa0, pa1, pa2, pa3); pv_one<2>(o[2], vb, pa0, pa1, pa2, pa3); pv_one<3>(o[3], vb, pa0, pa1, pa2, pa3);
}
__device__ __forceinline__ void attn_dense_body(const bf16* __restrict__ Qb, const bf16* __restrict__ Kh, const bf16* __restrict__ Vh, bf16* __restrict__ Ob, int seq, LAS char* lds,
                                                const float* __restrict__ qg, const float* __restrict__ ropet, int t0, float negm_u, int exactmax) {
  const int tid = otid(), wid = tid >> 6, lane = tid & 63, r32 = lane & 31, hi = lane >> 5;
  LAS char* V_lds = lds; LAS char* K_lds = lds + 2 * SHM_V;
  LAS float* ws = (LAS float*)(lds + 2 * SHM_V + 2 * SHM_K) + wid * 64; LAS float* li_l = ws;
  float l_reg = 0; f32x16 o[4] = {}; bf16x8 qr[8];
  const bf16* Qw = Qb + (long)(wid * QBLK + r32) * LDQ + hi * 8;
#pragma unroll
  for (int d0 = 0; d0 < 8; ++d0) qr[d0] = ld8(Qw + d0 * 16);
  { float x[8][8]; float ss = 0.f;
#pragma unroll
    for (int d0 = 0; d0 < 8; ++d0) { const u32x4 w = __builtin_bit_cast(u32x4, qr[d0]);
#pragma unroll
      for (int p = 0; p < 4; ++p) { x[d0][2 * p] = bflo(w[p]); x[d0][2 * p + 1] = bfhi(w[p]); ss += x[d0][2 * p] * x[d0][2 * p] + x[d0][2 * p + 1] * x[d0][2 * p + 1]; } }
    { auto rr = __builtin_amdgcn_permlane32_swap(__float_as_uint(ss), __float_as_uint(ss), false, false); ss = __uint_as_float(rr[0]) + __uint_as_float(rr[1]); }
    const float rstd = __builtin_amdgcn_rsqf(ss * (1.f / 128.f) + EPS) * (SCALE * 1.4426950408889634f);
#pragma unroll
    for (int d0 = 0; d0 < 8; ++d0) { const f32x4 g0 = *(const f32x4*)(qg + 16 * d0 + 8 * hi), g1 = *(const f32x4*)(qg + 16 * d0 + 8 * hi + 4);
#pragma unroll
      for (int j = 0; j < 4; ++j) { x[d0][j] *= rstd * g0[j]; x[d0][4 + j] *= rstd * g1[j]; } }
    if (t0 >= 0) { const int t = t0 + wid * QBLK + r32;
#pragma unroll
      for (int kind = 0; kind < 2; ++kind) { const int pos = kind == 0 ? (t >> 6) : (t & 63);
#pragma unroll
        for (int e = 0; e < 2; ++e) { const float* cp = ropet + pos * 32 + 16 * e + 8 * hi;
          const f32x4 c0 = *(const f32x4*)cp, c1 = *(const f32x4*)(cp + 4), s0 = *(const f32x4*)(cp + 2048), s1 = *(const f32x4*)(cp + 2048 + 4);
#pragma unroll
          for (int j = 0; j < 8; ++j) { const float cs = j < 4 ? c0[j & 3] : c1[j & 3], sn = j < 4 ? s0[j & 3] : s1[j & 3];
            const float a1 = x[4 * kind + e][j], a2 = x[4 * kind + 2 + e][j]; x[4 * kind + e][j] = a1 * cs - a2 * sn; x[4 * kind + 2 + e][j] = a2 * cs + a1 * sn; } } } }
#pragma unroll
    for (int d0 = 0; d0 < 8; ++d0) { u32x4 w; w.x = pk2(x[d0][0], x[d0][1]); w.y = pk2(x[d0][2], x[d0][3]); w.z = pk2(x[d0][4], x[d0][5]); w.w = pk2(x[d0][6], x[d0][7]); qr[d0] = __builtin_bit_cast(bf16x8, w); } }
  const int sr = tid >> 4, sc = (tid & 15) * 8, vst0 = v_st(sr, sc), vst1 = v_st(32 + sr, sc);
  const int vb0 = (int)(unsigned)(size_t)V_lds + v_rd_base(lane);
  const unsigned goff = (unsigned)(sr * LDK + sc) * 2u;
  const char* Kb0 = (const char*)Kh; const char* Vb0 = (const char*)Vh;
  const int NT = seq / KVBLK;
  float negm = negm_u;
  if (exactmax) {
    float mrow = -3.0e38f; f32x16 p0, p1;
    for (int j = 0; j < NT; ++j) { const size_t to_ = (size_t)j * KVBLK * LDK * 2;
      const bf16x8 k0 = *(const bf16x8*)(Kb0 + to_ + goff), k1 = *(const bf16x8*)(Kb0 + to_ + (size_t)32 * LDK * 2 + goff);
      __syncthreads();
      *(LAS bf16x8*)(K_lds + KSWZ(sr, sc * 2)) = k0; *(LAS bf16x8*)(K_lds + KSWZ(32 + sr, sc * 2)) = k1;
      __syncthreads();
      qkt(p0, p1, K_lds, qr, r32, hi, 0.f);
#pragma unroll
      for (int r = 0; r < 16; ++r) mrow = fmaxf(mrow, fmaxf(p0[r], p1[r])); }
    { auto rr = __builtin_amdgcn_permlane32_swap(__float_as_uint(mrow), __float_as_uint(mrow), false, false); mrow = fmaxf(__uint_as_float(rr[0]), __uint_as_float(rr[1])); }
    negm = -mrow; __syncthreads(); }
  struct { bf16x8 vs0, vs1, ks0, ks1; } sr_[1];
#define SLOAD(i, k0) do { const size_t to_ = (size_t)(k0) * LDK * 2; \
    sr_[i].vs0 = *(const bf16x8*)(Vb0 + to_ + goff); sr_[i].vs1 = *(const bf16x8*)(Vb0 + to_ + (size_t)32 * LDK * 2 + goff); \
    sr_[i].ks0 = *(const bf16x8*)(Kb0 + to_ + goff); sr_[i].ks1 = *(const bf16x8*)(Kb0 + to_ + (size_t)32 * LDK * 2 + goff); } while (0)
#define SWRITE(b, i) do { *(LAS bf16x8*)(V_lds + (b) * SHM_V + vst0) = sr_[i].vs0;          \
    *(LAS bf16x8*)(V_lds + (b) * SHM_V + vst1) = sr_[i].vs1; int kc = sc * 2;               \
    *(LAS bf16x8*)(K_lds + (b) * SHM_K + KSWZ(sr, kc)) = sr_[i].ks0;                       \
    *(LAS bf16x8*)(K_lds + (b) * SHM_K + KSWZ(32 + sr, kc)) = sr_[i].ks1; } while (0)
#define SWAIT() asm volatile("s_waitcnt vmcnt(0)" ::: "memory")
#define PSM(P0) do { for (int r_ = 0; r_ < 16; ++r_) P0[r_] = __builtin_amdgcn_exp2f(P0[r_]); } while (0)
  f32x16 pA0, pA1, pB0, pB1; bf16x8 pa0, pa1, pa2, pa3;
  constexpr int SE = 0, SO = 0;
  SLOAD(SE, 0); asm volatile("s_waitcnt vmcnt(0)" ::: "memory"); SWRITE(0, SE); __syncthreads();
  qkt(pA0, pA1, K_lds, qr, r32, hi, negm); PSM(pA0);
  SLOAD(SO, KVBLK);
  SWAIT(); SWRITE(1, SO); if (2 < NT) SLOAD(SE, 2 * KVBLK); __syncthreads();
  for (int j = 1; j + 1 < NT; j += 2) {
    SBAR(); qkt(pB0, pB1, K_lds + SHM_K, qr, r32, hi, negm);
    finishSM(pA0, pA1, l_reg, pa0, pa1, pa2, pa3); SBAR();
    pv_d0(o, vb0, pa0, pa1, pa2, pa3); PSM(pB0);
    __syncthreads(); SWAIT(); SWRITE(0, SE); SBAR(); SLOAD(SO, (j + 2) * KVBLK); SBAR();
    __syncthreads();
    SBAR(); qkt(pA0, pA1, K_lds, qr, r32, hi, negm);
    finishSM(pB0, pB1, l_reg, pa0, pa1, pa2, pa3); SBAR();
    pv_d0(o, vb0 + (int)SHM_V, pa0, pa1, pa2, pa3); PSM(pA0);
    __syncthreads(); SWAIT(); SWRITE(1, SO); SBAR(); if (j + 3 < NT) SLOAD(SE, (j + 3) * KVBLK); SBAR();
    __syncthreads();
  }
  SBAR(); qkt(pB0, pB1, K_lds + SHM_K, qr, r32, hi, negm);
  finishSM(pA0, pA1, l_reg, pa0, pa1, pa2, pa3); SBAR();
  pv_d0(o, vb0, pa0, pa1, pa2, pa3); PSM(pB0);
  __syncthreads();
  finishSM(pB0, pB1, l_reg, pa0, pa1, pa2, pa3); SBAR();
  pv_d0(o, vb0 + (int)SHM_V, pa0, pa1, pa2, pa3);
#undef PSM
  if (hi == 0) li_l[r32] = l_reg; asm volatile("s_waitcnt lgkmcnt(0)" ::: "memory");
  float rli[16];
#pragma unroll
  for (int r = 0; r < 16; ++r) rli[r] = __builtin_amdgcn_rcpf(li_l[crow(r, hi)]);
  bf16* Ow = Ob + (long)(wid * QBLK) * LDO;
#pragma unroll
  for (int r = 0; r < 16; ++r) { int orow = crow(r, hi);
    for (int d0 = 0; d0 < 4; ++d0) { if (OUTPROJ_FP8) ((unsigned char*)Ob)[(long)(wid * QBLK + orow) * LDO + d0 * 32 + r32] = (unsigned char)fp8_1(16.f * o[d0][r] * rli[r]); else Ow[(long)orow * LDO + d0 * 32 + r32] = (bf16)f2bf(o[d0][r] * rli[r]); } }
#undef SLOAD
#undef SWRITE
#undef SWAIT
}
}

enum { PH_PRO = 0, PH_NORM1 = 1, PH_INPROJ = 2, PH_PREP = 3, PH_SCAN = 4, PH_ATTN = 5, PH_FINISH = 6, PH_OUTPROJ = 7, PH_ROUTER = 8, PH_DISPATCH = 9, PH_GU = 10, PH_DOWN = 11, PH_COMBINE = 12, NPH = 13 };

struct MapIn  { __device__ __forceinline__ int operator()(int n) const { return n < 2320 ? n + 1024 : n - 2320; } };
struct MapId  { __device__ __forceinline__ int operator()(int n) const { return n; } };
struct MapGU  { __device__ __forceinline__ int operator()(int n) const { const int bj = n >> 10, w = n & 1023; return (w >> 7) * 256 + bj * 128 + (w & 127); } };
struct TrItem { const float* W; unsigned char* WT; int N, kind  , kb, nb, m  ; unsigned* cmax; };
__device__ __forceinline__ int tr_map(int kind, int n) {
    if (kind == 0) return n < 2320 ? n + 1024 : n - 2320;
    if (kind == 2) { const int bj = n >> 10, w = n & 1023; return (w >> 7) * 256 + bj * 128 + (w & 127); }
    return n;
}
__device__ __forceinline__ void tr_load(f32x4 (&v)[16], const TrItem& t, int lane) {
    const int nq = (lane & 15) * 4, kr = lane >> 4; const bool okn = 64 * t.nb + nq < t.N;
#pragma unroll
    for (int j = 0; j < 16; ++j) v[j] = okn ? *(const f32x4*)(t.W + (size_t)(64 * t.kb + kr + 4 * j) * t.N + 64 * t.nb + nq) : (f32x4){0.f, 0.f, 0.f, 0.f};
}
__device__ __forceinline__ void tr_store(const f32x4 (&v)[16], const TrItem& t, LAS float* scr, int lane) {
    const int k0 = 64 * t.kb, n0 = 64 * t.nb, nq = (lane & 15) * 4, kr = lane >> 4;
#pragma unroll
    for (int j = 0; j < 16; ++j) { LAS float* s = scr + (kr + 4 * j) * 65 + nq; s[0] = v[j][0]; s[1] = v[j][1]; s[2] = v[j][2]; s[3] = v[j][3]; }
    LDS_WAIT(); asm volatile("" ::: "memory");
    if (INPROJ_I8 && t.kind == 0) {
        const int n = n0 + lane; float mx = 0.f;
#pragma unroll 8
        for (int k = 0; k < 64; ++k) mx = fmaxf(mx, fabsf(scr[k * 65 + lane]));
        if (n < t.N) __hip_atomic_fetch_max(t.cmax + t.m * PC + tr_map(0, n), __float_as_uint(mx), __ATOMIC_RELAXED, __HIP_MEMORY_SCOPE_AGENT);
        LDS_WAIT(); asm volatile("" ::: "memory"); return; }
    if ((MOE_FP8 && t.kind >= 2) || (OUTPROJ_FP8 && t.kind == 1)) { const int c = lane & 3;
#pragma unroll
        for (int j = 0; j < 4; ++j) { const int nl = (lane >> 2) + 16 * j, n = n0 + nl; const LAS float* s = scr + (16 * c) * 65 + nl;
            u32x4 o; o.x = pk_fp8x4(64.f * s[0 * 65], 64.f * s[1 * 65], 64.f * s[2 * 65], 64.f * s[3 * 65]); o.y = pk_fp8x4(64.f * s[4 * 65], 64.f * s[5 * 65], 64.f * s[6 * 65], 64.f * s[7 * 65]);
            o.z = pk_fp8x4(64.f * s[8 * 65], 64.f * s[9 * 65], 64.f * s[10 * 65], 64.f * s[11 * 65]); o.w = pk_fp8x4(64.f * s[12 * 65], 64.f * s[13 * 65], 64.f * s[14 * 65], 64.f * s[15 * 65]);
            if (n < t.N) *(u32x4*)(t.WT + (size_t)tr_map(t.kind, n) * 1024 + k0 + 16 * c) = o; } }
    else { const int c = lane & 7;
#pragma unroll
        for (int j = 0; j < 8; ++j) { const int nl = (lane >> 3) + 8 * j, n = n0 + nl; const LAS float* s = scr + (8 * c) * 65 + nl;
            u32x4 o; o.x = pk2(s[0 * 65], s[1 * 65]); o.y = pk2(s[2 * 65], s[3 * 65]); o.z = pk2(s[4 * 65], s[5 * 65]); o.w = pk2(s[6 * 65], s[7 * 65]);
            if (n < t.N) *(u32x4*)((bf16*)t.WT + (size_t)tr_map(t.kind, n) * 1024 + k0 + 8 * c) = o; } }
    LDS_WAIT(); asm volatile("" ::: "memory");
}
__device__ __forceinline__ void tr_load_w(f32x4 (&v)[16], const TrItem& t, int lane) {
    const int nq = (lane & 7) * 4, kr = lane >> 3;
#pragma unroll
    for (int j = 0; j < 16; ++j) v[j] = *(const f32x4*)(t.W + (size_t)(128 * t.kb + kr + 8 * j) * t.N + 32 * t.nb + nq);
}
__device__ __forceinline__ void tr_store_w(const f32x4 (&v)[16], const TrItem& t, LAS float* scr, int lane) {
    const int k0 = 128 * t.kb, n0 = 32 * t.nb, nq = (lane & 7) * 4, kr = lane >> 3;
#pragma unroll
    for (int j = 0; j < 16; ++j) { LAS float* s = scr + (kr + 8 * j) * 33 + nq; s[0] = v[j][0]; s[1] = v[j][1]; s[2] = v[j][2]; s[3] = v[j][3]; }
    LDS_WAIT(); asm volatile("" ::: "memory");
    const int c = lane & 7;
#pragma unroll
    for (int j = 0; j < 4; ++j) { const int nl = (lane >> 3) + 8 * j, n = n0 + nl; const LAS float* s = scr + (16 * c) * 33 + nl;
        u32x4 o; o.x = pk_fp8x4(64.f * s[0 * 33], 64.f * s[1 * 33], 64.f * s[2 * 33], 64.f * s[3 * 33]); o.y = pk_fp8x4(64.f * s[4 * 33], 64.f * s[5 * 33], 64.f * s[6 * 33], 64.f * s[7 * 33]);
        o.z = pk_fp8x4(64.f * s[8 * 33], 64.f * s[9 * 33], 64.f * s[10 * 33], 64.f * s[11 * 33]); o.w = pk_fp8x4(64.f * s[12 * 33], 64.f * s[13 * 33], 64.f * s[14 * 33], 64.f * s[15 * 33]);
        *(u32x4*)(t.WT + (size_t)tr_map(t.kind, n) * 1024 + k0 + 16 * c) = o; }
    LDS_WAIT(); asm volatile("" ::: "memory");
}
__device__ __forceinline__ void p_prologue(const Args& a, LAS unsigned char* lds) {
    const int tid = otid(), lane = tid & 63, wave = tid >> 6, G = ogrid(), bid = obid();
    const int gw = bid * NWAVE + wave, NGW = G * NWAVE;
    const int gt = bid * NTHR + tid, NGT = G * NTHR;
    LAS float* scr = (LAS float*)(lds + wave * 16896);
    constexpr int NNB_IN = (NIN + 63) / 64;
    constexpr int I_IN = 16 * NNB_IN, I_OUT = 16 * 16, I_GU = 16 * 32, I_DN = 16 * 16;
    constexpr int T_IN = DEPTH * I_IN, T_OUT = DEPTH * I_OUT, T_GU = DEPTH * NEXP * I_GU, T_DN = DEPTH * NEXP * I_DN;
    constexpr int NITEMS = T_IN + T_OUT + T_GU + T_DN;
    constexpr size_t WB = MOE_FP8 ? 1 : 2;
    auto decode = [&](int it) { TrItem t; int r = it;
        if (r < T_IN) { const int m = r / I_IN, q = r % I_IN; t.W = a.in[8] + (size_t)m * 1024 * NIN; t.WT = a.ws + WS_WIN + (size_t)m * PC * 1024 * 2; t.N = NIN; t.kind = 0; t.kb = q / NNB_IN; t.nb = q % NNB_IN; t.m = m; t.cmax = (unsigned*)(a.ws + WS_CTL) + CW_CMAX; return t; } r -= T_IN;
        if (r < T_OUT) { const int m = r / I_OUT, q = r % I_OUT; t.W = a.in[9] + (size_t)m * 1024 * 1024; t.WT = a.ws + WS_WOUT + (size_t)m * 1024 * 1024 * (OUTPROJ_FP8 ? 1 : 2); t.N = 1024; t.kind = 1; t.kb = q / 16; t.nb = q % 16; return t; } r -= T_OUT;
        if (r < T_GU) { const int m = r / I_GU, q = r % I_GU; t.W = a.in[18] + (size_t)m * 1024 * 2048; t.WT = a.ws + WS_WGU + (size_t)m * 2048 * 1024 * WB; t.N = 2048; t.kind = 2; if (MOE_FP8) { t.kb = q / 64; t.nb = q % 64; } else { t.kb = q / 32; t.nb = q % 32; } return t; } r -= T_GU;
        { const int m = r / I_DN, q = r % I_DN; t.W = a.in[20] + (size_t)m * 1024 * 1024; t.WT = a.ws + WS_WDN + (size_t)m * 1024 * 1024 * WB; t.N = 1024; t.kind = 3; if (MOE_FP8) { t.kb = q / 32; t.nb = q % 32; } else { t.kb = q / 16; t.nb = q % 16; } return t; } };
    if (gw < NITEMS) {
        TrItem cur = decode(gw); f32x4 vc[16]; if (MOE_FP8 && cur.kind >= 2) tr_load_w(vc, cur, lane); else tr_load(vc, cur, lane);
        for (int it = gw; it < NITEMS; it += NGW) {
            const bool more = it + NGW < NITEMS; TrItem nxt = cur; f32x4 vn[16];
            if (more) { nxt = decode(it + NGW); if (MOE_FP8 && nxt.kind >= 2) tr_load_w(vn, nxt, lane); else tr_load(vn, nxt, lane); }
            if (MOE_FP8 && cur.kind >= 2) tr_store_w(vc, cur, scr, lane); else tr_store(vc, cur, scr, lane);
            if (more) { cur = nxt;
#pragma unroll
                for (int j = 0; j < 16; ++j) vc[j] = vn[j]; }
        }
    }
    if (!INPROJ_I8) for (int i = gt; i < DEPTH * (PC - NIN) * 128; i += NGT) { const int m = i / ((PC - NIN) * 128), q = i % ((PC - NIN) * 128);
        *(u32x4*)((bf16*)(a.ws + WS_WIN) + ((size_t)m * PC + NIN) * 1024 + (size_t)q * 8) = (u32x4){0u, 0u, 0u, 0u}; }
    for (int i = gt; i < DEPTH * 32 * 1024; i += NGT) { const int l = i >> 15, e = (i >> 10) & 31, k = i & 1023;
        const float w = a.in[16][((size_t)l * 1024 + k) * 32 + e]; const unsigned h = f2bf(w); const float lo = w - bf2f(h);
        ((bf16*)(a.ws + WS_WRH))[i] = (bf16)h; ((bf16*)(a.ws + WS_WRL))[i] = (bf16)f2bf(lo); }
    for (int i = gt; i < 64 * 32; i += NGT) { const int pos = i >> 5, fi = i & 31;
        const float inv = powf(10000.f, -(float)(2 * fi) / 64.f); const float ang = (float)pos * inv;
        ((float*)(a.ws + WS_ROPE))[i] = cosf(ang); ((float*)(a.ws + WS_ROPE))[2048 + i] = sinf(ang); }
    __syncthreads();
    {
        LAS float* SL = (LAS float*)lds;
        LAS float* PT = (LAS float*)(lds + 40960);
        bool have = false;
        for (int it = bid; it < DEPTH * 96; it += G) {
            if (!have) { for (int i = tid; i < 9 * 1024; i += NTHR) { const float v = i < 8192 ? a.in[1][i] : a.in[3][i - 8192]; SL[i] = v / (1.f + expf(-v)); } have = true; __syncthreads(); }
            const int l = it / 96, n = (it % 96) * 64 + lane;
            const float* W = a.in[4] + ((size_t)l * 1024 + wave * 128) * 6144 + n;
            float acc[9];
#pragma unroll
            for (int j = 0; j < 9; ++j) acc[j] = 0.f;
#pragma unroll 8
            for (int k = 0; k < 128; ++k) { const float w = W[(size_t)k * 6144];
#pragma unroll
                for (int j = 0; j < 9; ++j) acc[j] += SL[j * 1024 + wave * 128 + k] * w; }
#pragma unroll
            for (int j = 0; j < 9; ++j) PT[(wave * 9 + j) * 64 + lane] = acc[j];
            __syncthreads();
            for (int i = tid; i < 9 * 64; i += NTHR) { const int j = i >> 6, c = i & 63; float s = 0.f;
#pragma unroll
                for (int w = 0; w < 8; ++w) s += PT[(w * 9 + j) * 64 + c];
                const int nn = (it % 96) * 64 + c;
                ((float*)(a.ws + WS_MOD))[(size_t)(l * 9 + j) * 6144 + nn] = s + a.in[5][(size_t)l * 6144 + nn]; }
            __syncthreads();
        }
    }
}

__device__ __forceinline__ void norm_mod_store(f32x4 (&v)[2][2], const float* gn, const float* sc, const float* sh, bf16* hrow, int lane) {
    float ss = 0.f;
#pragma unroll
    for (int j = 0; j < 2; ++j)
#pragma unroll
        for (int q = 0; q < 2; ++q) ss += (v[j][q][0] * v[j][q][0] + v[j][q][1] * v[j][q][1]) + (v[j][q][2] * v[j][q][2] + v[j][q][3] * v[j][q][3]);
    const float rstd = 1.f / sqrtf(wave_sum(ss) * (1.f / DM) + EPS);
#pragma unroll
    for (int j = 0; j < 2; ++j) { const int c = 8 * lane + 512 * j;
#pragma unroll
        for (int q = 0; q < 2; ++q) { const f32x4 g = *(const f32x4*)(gn + c + 4 * q), s1 = *(const f32x4*)(sc + c + 4 * q), s0 = *(const f32x4*)(sh + c + 4 * q);
            v[j][q] = v[j][q] * rstd * g * (1.f + s1) + s0; }
        if (hrow) { u32x4 w; w.x = pk2(v[j][0][0], v[j][0][1]); w.y = pk2(v[j][0][2], v[j][0][3]); w.z = pk2(v[j][1][0], v[j][1][1]); w.w = pk2(v[j][1][2], v[j][1][3]);
            *(u32x4*)(hrow + c) = w; } }
}
__device__ __forceinline__ void load_row_bf(const bf16* xr, f32x4 (&v)[2][2], int lane) {
#pragma unroll
    for (int j = 0; j < 2; ++j) { const u32x4 w = *(const u32x4*)(xr + 8 * lane + 512 * j);
        v[j][0] = (f32x4){bflo(w.x), bfhi(w.x), bflo(w.y), bfhi(w.y)}; v[j][1] = (f32x4){bflo(w.z), bfhi(w.z), bflo(w.w), bfhi(w.w)}; }
}
__device__ __forceinline__ void load_row(const float* xr, f32x4 (&v)[2][2], int lane) {
#pragma unroll
    for (int j = 0; j < 2; ++j)
#pragma unroll
        for (int q = 0; q < 2; ++q) v[j][q] = *(const f32x4*)(xr + 8 * lane + 512 * j + 4 * q);
}

__device__ __forceinline__ void p_quant_win(const Args& a) {
    const int gt = obid() * NTHR + otid(), NGT = ogrid() * NTHR;
    const unsigned* CM = (const unsigned*)(a.ws + WS_CTL) + CW_CMAX; float* WSC = (float*)(a.ws + WS_WSC); unsigned char* W8 = (unsigned char*)(a.ws + WS_WIN);
    for (int idx = gt; idx < DEPTH * 64 * PC; idx += NGT) { const int l = idx / (64 * PC), rem = idx - l * (64 * PC), kc = rem / PC, j = rem - kc * PC;
        u32x4 o = {0u, 0u, 0u, 0u}; float s = 0.f;
        if (j < NIN) { const int n = j < 1024 ? j + 2320 : j - 1024; const float cm = __uint_as_float(__hip_atomic_load(CM + l * PC + j, __ATOMIC_RELAXED, __HIP_MEMORY_SCOPE_AGENT));
            s = cm * (1.f / 127.f); const float inv = cm > 0.f ? 127.f / cm : 0.f; const float* wp = a.in[8] + ((size_t)l * 1024 + 16 * kc) * NIN + n; float w[16];
#pragma unroll
            for (int i = 0; i < 16; ++i) w[i] = wp[(size_t)i * NIN] * inv;
            o.x = pk_i8x4(w[0], w[1], w[2], w[3]); o.y = pk_i8x4(w[4], w[5], w[6], w[7]); o.z = pk_i8x4(w[8], w[9], w[10], w[11]); o.w = pk_i8x4(w[12], w[13], w[14], w[15]); }
        *(u32x4*)(W8 + ((size_t)l * PC + j) * 1024 + 16 * kc) = o;
        if (kc == 0) WSC[l * PC + j] = s; }
}
__device__ __forceinline__ void store_row_i8(const f32x4 (&v)[2][2], unsigned char* hrow, float* hs, int lane) {
    float mx = 0.f;
#pragma unroll
    for (int j = 0; j < 2; ++j)
#pragma unroll
        for (int q = 0; q < 2; ++q) mx = fmaxf(fmaxf(mx, fmaxf(fabsf(v[j][q][0]), fabsf(v[j][q][1]))), fmaxf(fabsf(v[j][q][2]), fabsf(v[j][q][3])));
    mx = fmaxf(wave_max_nn(mx), 1e-20f); const float inv = 127.f / mx;
#pragma unroll
    for (int j = 0; j < 2; ++j) { u32x2 w; w.x = pk_i8x4(v[j][0][0] * inv, v[j][0][1] * inv, v[j][0][2] * inv, v[j][0][3] * inv); w.y = pk_i8x4(v[j][1][0] * inv, v[j][1][1] * inv, v[j][1][2] * inv, v[j][1][3] * inv);
        *(u32x2*)(hrow + 8 * lane + 512 * j) = w; }
    if (lane == 0) *hs = mx * (1.f / 127.f);
}
__device__ __forceinline__ void p_norm1(const Args& a, int layer) {
    const int tid = otid(), lane = tid & 63, wave = tid >> 6; const int gw = obid() * NWAVE + wave, NGW = ogrid() * NWAVE;
    bf16* H = (bf16*)(a.ws + WS_H);
    for (int r = gw; r < NR; r += NGW) { f32x4 v[2][2]; load_row(x_rd(a, layer == 0, r), v, lane);
        norm_mod_store(v, a.in[6] + (size_t)layer * DM, modv(a, layer, r, 1), modv(a, layer, r, 0), INPROJ_I8 ? (bf16*)nullptr : H + (size_t)r * DM, lane);
        if (INPROJ_I8) store_row_i8(v, (unsigned char*)(a.ws + WS_H) + (size_t)r * DM, (float*)(a.ws + WS_HSC) + r, lane); }
}

__device__ __forceinline__ void p_prep(const Args& a, int layer, bool dry = false) {
    const int tid = otid(), lane = tid & 63, wave = tid >> 6; const int gw = obid() * NWAVE + wave, NGW = ogrid() * NWAVE;
    bf16* P = (bf16*)(a.ws + WS_P); const float* COS = (const float*)(a.ws + WS_ROPE); const float* SIN = COS + 2048;
    const int half = lane >> 5, fi = lane & 31;
    const float gq1 = a.in[14][layer * 128 + half * 64 + fi], gq2 = a.in[14][layer * 128 + half * 64 + 32 + fi];
    const float gk1 = a.in[15][layer * 128 + half * 64 + fi], gk2 = a.in[15][layer * 128 + half * 64 + 32 + fi];
    for (int r = gw; r < NR; r += NGW) { const int s = r % SB; const bool lat = s >= CTX; const int t = s - CTX;
        float cs = 1.f, sn = 0.f;
        if (lat) { const int pos = half == 0 ? (t >> 6) : (t & 63); cs = COS[pos * 32 + fi]; sn = SIN[pos * 32 + fi]; }
        bf16* pr = P + (size_t)r * PC;
#pragma unroll
        for (int hh = 4; hh < 6; ++hh) { bf16* p1 = pr + hh * 128 + half * 64 + fi;
            const float x1 = bf2f(p1[0]), x2 = bf2f(p1[32]);
            const float rstd = __builtin_amdgcn_rsqf(wave_sum(x1 * x1 + x2 * x2) * (1.f / 128.f) + EPS);
            const float y1 = x1 * rstd * gk1, y2 = x2 * rstd * gk2;
            bf16* po = dry ? (bf16*)(a.ws + WS_ACT) + (size_t)r * 1024 + hh * 128 + half * 64 + fi : p1;
            po[0] = (bf16)f2bf(y1 * cs - y2 * sn); po[32] = (bf16)f2bf(y2 * cs + y1 * sn); }
    }
}

__device__ __forceinline__ int seq_step_s(int dir, int n) { return dir == 0 ? n : (n < CTX ? CTX - 1 - n : SB + CTX - 1 - n); }
__device__ __forceinline__ void hg_seq(const Args& a, int layer, int sid, LAS unsigned char* lds) {
    const int tid = otid(), lane = tid & 63, wave = tid >> 6;
    const int dir = sid & 1, h = (sid >> 1) & 3, b = sid >> 3;
    LAS float* qs = (LAS float*)lds; LAS float* ks = qs + 2048; LAS float* fs = ks + 2048; LAS float* vs = fs + 2048; LAS float* part = vs + 2048;
    const bf16* P = (const bf16*)(a.ws + WS_P);
    float* OH = (float*)(a.ws + WS_OH) + (size_t)dir * NR * 256;
    float lb;
    { const float* lg = a.in[10] + (size_t)dir * DEPTH * 256 + h * 64 + lane;
      const float l0 = lg[0], l1 = lg[256], l2 = lg[512], l3 = lg[768]; const float mx = fmaxf(fmaxf(l0, l1), fmaxf(l2, l3));
      const float e0 = expf(l0 - mx), e1 = expf(l1 - mx), e2 = expf(l2 - mx), e3 = expf(l3 - mx);
      lb = ((layer >= 1 ? e1 : 0.f) + (layer >= 2 ? e2 : 0.f) + (layer >= 3 ? e3 : 0.f)) / (e0 + e1 + e2 + e3); }
    float S[8];
#pragma unroll
    for (int i = 0; i < 8; ++i) S[i] = 0.f;
    for (int n0 = 0; n0 < SB; n0 += 32) {
#pragma unroll
        for (int jj = 0; jj < 4; ++jj) { const int j = wave + 8 * jj; const int s = seq_step_s(dir, n0 + j);
            const bf16* pr = P + (size_t)(b * SB + s) * PC + h * 64 + lane;
            const float q = bf2f(pr[C_HGQ]), z = bf2f(pr[dir ? C_HGZB : C_HGZF]), v = bf2f(pr[C_HGV]);
            const float sg = 1.f / (1.f + expf(-z));
            qs[j * 64 + lane] = q; fs[j * 64 + lane] = lb + (1.f - lb) * sg; ks[j * 64 + lane] = (1.f - lb) * (1.f - sg); vs[j * 64 + lane] = v; }
        __syncthreads();
        for (int j = 0; j < 32; ++j) { const float v = vs[j * 64 + lane]; float p = 0.f;
#pragma unroll
            for (int i = 0; i < 8; ++i) { const int d = wave * 8 + i; S[i] = fs[j * 64 + d] * S[i] + ks[j * 64 + d] * v; p += S[i] * qs[j * 64 + d]; }
            part[(wave * 32 + j) * 64 + lane] = p; }
        __syncthreads();
#pragma unroll
        for (int jj = 0; jj < 4; ++jj) { const int j = wave + 8 * jj; float o = 0.f;
#pragma unroll
            for (int w = 0; w < 8; ++w) o += part[(w * 32 + j) * 64 + lane];
            const int s = seq_step_s(dir, n0 + j); OH[(size_t)(b * SB + s) * 256 + h * 64 + lane] = o; }
        __syncthreads();
    }
}
__device__ __forceinline__ void ml_seq(const Args& a, int layer, int sid, LAS unsigned char* lds) {
    const int tid = otid(), lane = tid & 63, wave = tid >> 6;
    const int dir = sid & 1, h = (sid >> 1) & 3, b = sid >> 3;
    LAS float* qs = (LAS float*)lds; LAS float* ks = qs + 2048; LAS float* vs = ks + 2048; LAS float* part = vs + 2048;
    LAS float* ip = part + 8 * 2048; LAS float* lf = ip + 32; LAS float* dp = lf + 32; LAS float* ms = dp + 8 * 32;
    const bf16* P = (const bf16*)(a.ws + WS_P);
    float* OM = (float*)(a.ws + WS_OM) + (size_t)dir * NR * 256;
    const float bi = a.in[12][layer * 16 + dir * 4 + h], bfg = a.in[12][layer * 16 + 8 + dir * 4 + h];
    float C[8], nn[8], m = 0.f;
#pragma unroll
    for (int i = 0; i < 8; ++i) { C[i] = 0.f; nn[i] = 0.f; }
    for (int n0 = 0; n0 < SB; n0 += 32) {
#pragma unroll
        for (int jj = 0; jj < 4; ++jj) { const int j = wave + 8 * jj; const int s = seq_step_s(dir, n0 + j);
            const bf16* pr = P + (size_t)(b * SB + s) * PC;
            qs[j * 64 + lane] = bf2f(pr[C_MLQ + h * 64 + lane]); ks[j * 64 + lane] = bf2f(pr[C_MLK + h * 64 + lane]) * 0.125f; vs[j * 64 + lane] = bf2f(pr[C_MLV + h * 64 + lane]);
            if (lane == 0) { ip[j] = bf2f(pr[C_MLG + dir * 4 + h]) + bi; const float fp = bf2f(pr[C_MLG + 8 + dir * 4 + h]) + bfg;
                lf[j] = fminf(fp, 0.f) - log1pf(expf(-fabsf(fp))); } }
        __syncthreads();
        for (int j = 0; j < 32; ++j) { const float v = vs[j * 64 + lane]; const float ipj = ip[j], lfj = lf[j];
            const float mn = fmaxf(lfj + m, ipj); const float aa = expf(lfj + m - mn), bb = expf(ipj - mn); m = mn;
            float p = 0.f, dn = 0.f;
#pragma unroll
            for (int i = 0; i < 8; ++i) { const int d = wave * 8 + i; const float kk = ks[j * 64 + d] * bb, qq = qs[j * 64 + d];
                C[i] = aa * C[i] + kk * v; nn[i] = aa * nn[i] + kk; p += C[i] * qq; dn += nn[i] * qq; }
            part[(wave * 32 + j) * 64 + lane] = p; if (lane == 0) { dp[wave * 32 + j] = dn; if (wave == 0) ms[j] = mn; } }
        __syncthreads();
#pragma unroll
        for (int jj = 0; jj < 4; ++jj) { const int j = wave + 8 * jj; float o = 0.f, dn = 0.f;
#pragma unroll
            for (int w = 0; w < 8; ++w) { o += part[(w * 32 + j) * 64 + lane]; dn += dp[w * 32 + j]; }
            const int s = seq_step_s(dir, n0 + j); OM[(size_t)(b * SB + s) * 256 + h * 64 + lane] = o / fmaxf(fabsf(dn), expf(-ms[j])); }
        __syncthreads();
    }
}
__device__ __forceinline__ void p_scan(const Args& a, int layer, LAS unsigned char* lds, int do_hg, int do_ml) {
    for (int u = obid(); u < 128; u += ogrid()) { if (u < 64) { if (do_hg) hg_seq(a, layer, u, lds); } else { if (do_ml) ml_seq(a, layer, u - 64, lds); } }
}


namespace scan {
constexpr int NCH = 68, NTASK = NB * 4 * 2 * NCH;
__device__ __forceinline__ int swz(int row, int unit) { return row * 128 + ((unit ^ ((row >> 1) & 7)) << 4); }
__device__ __forceinline__ bf16x8 frag(const LAS char* arr, int row, int unit) { return *(const LAS bf16x8*)(arr + swz(row, unit)); }
__device__ __forceinline__ void put2(LAS char* arr, int row, int col_even, float lo, float hi) { *(LAS unsigned*)(arr + swz(row, col_even >> 3) + (col_even & 7) * 2) = pk2(lo, hi); }
__device__ __forceinline__ void put1(LAS char* arr, int row, int col, float x) { *(LAS bf16*)(arr + swz(row, col >> 3) + (col & 7) * 2) = (bf16)f2bf(x); }
__device__ __forceinline__ int crow(int r, int hh) { return (r & 3) + 8 * (r >> 2) + 4 * hh; }
__device__ __forceinline__ void mm64(f32x16 (&acc)[2][2], const LAS char* A, const LAS char* B, int r32, int hh, int skip_a, int skip_b) {
#pragma unroll
    for (int st = 0; st < 4; ++st) { bf16x8 af[2], bfr[2];
#pragma unroll
        for (int i = 0; i < 2; ++i) { af[i] = frag(A, 32 * i + r32, 2 * st + hh); bfr[i] = frag(B, 32 * i + r32, 2 * st + hh); }
#pragma unroll
        for (int ai = 0; ai < 2; ++ai)
#pragma unroll
            for (int bi = 0; bi < 2; ++bi) if (!(ai == skip_a && bi == skip_b)) acc[ai][bi] = __builtin_amdgcn_mfma_f32_32x32x16_bf16(af[ai], bfr[bi], acc[ai][bi], 0, 0, 0); }
}
#define SC_PK4(P, BASE, OUT) do { unsigned a0 = pk2(P[BASE + 0], P[BASE + 1]), a1 = pk2(P[BASE + 2], P[BASE + 3]);   \
    unsigned b0 = pk2(P[BASE + 4], P[BASE + 5]), b1 = pk2(P[BASE + 6], P[BASE + 7]);                              \
    auto r0 = __builtin_amdgcn_permlane32_swap(a0, b0, false, false); auto r1 = __builtin_amdgcn_permlane32_swap(a1, b1, false, false); \
    u32x4 w = {r0[0], r1[0], r0[1], r1[1]}; OUT = __builtin_bit_cast(bf16x8, w); } while (0)
__device__ __forceinline__ float hg_lb(const Args& a, int layer, int dir, int h, int lane) {
    const float* lg = a.in[10] + (size_t)dir * DEPTH * 256 + h * 64 + lane;
    const float l0 = lg[0], l1 = lg[256], l2 = lg[512], l3 = lg[768]; const float mx = fmaxf(fmaxf(l0, l1), fmaxf(l2, l3));
    const float e0 = __expf(l0 - mx), e1 = __expf(l1 - mx), e2 = __expf(l2 - mx), e3 = __expf(l3 - mx);
    return ((layer >= 1 ? e1 : 0.f) + (layer >= 2 ? e2 : 0.f) + (layer >= 3 ? e3 : 0.f)) / (e0 + e1 + e2 + e3);
}
__device__ __forceinline__ float scan_add(float x, int lane, int dir) {
#pragma unroll
    for (int o = 1; o < 64; o <<= 1) { const float y = dir ? __shfl_down(x, o) : __shfl_up(x, o); const bool ok = dir ? (lane + o < 64) : (lane >= o); x += ok ? y : 0.f; }
    return x;
}
__device__ __forceinline__ float scan_max(float x, int lane, int dir) {
#pragma unroll
    for (int o = 1; o < 64; o <<= 1) { const float y = dir ? __shfl_down(x, o) : __shfl_up(x, o); const bool ok = dir ? (lane + o < 64) : (lane >= o); x = ok ? fmaxf(x, y) : x; }
    return x;
}
__device__ __forceinline__ float wave_max(float v) {
#pragma unroll
    for (int o = 1; o < 64; o <<= 1) v = fmaxf(v, __shfl_xor(v, o));
    return v;
}
__device__ __forceinline__ float logsig(float x) { return fminf(x, 0.f) - __logf(1.f + __expf(-fabsf(x))); }
__device__ __forceinline__ void store_ut(bf16* UT, const f32x16 (&acc)[2][2], int r32, int hh) {
#pragma unroll
    for (int vi = 0; vi < 2; ++vi)
#pragma unroll
        for (int di = 0; di < 2; ++di)
#pragma unroll
            for (int rg = 0; rg < 16; ++rg) UT[(32 * vi + crow(rg, hh)) * 64 + 32 * di + r32] = (bf16)f2bf(acc[vi][di][rg]);
}
__device__ __forceinline__ void stage_vt(LAS char* X, const bf16* Pr, int vcol, int lane) {
#pragma unroll 8
    for (int p = 0; p < 32; ++p) put2(X, lane, 2 * p, bf2f(Pr[(size_t)(2 * p) * PC + vcol + lane]), bf2f(Pr[(size_t)(2 * p + 1) * PC + vcol + lane]));
}
__device__ __forceinline__ void stage_copy(LAS char* X, const bf16* G, int ldg, int lane) {
#pragma unroll
    for (int j = 0; j < 8; ++j) { const int u = lane + 64 * j, row = u >> 3, unit = u & 7; *(LAS u32x4*)(X + swz(row, unit)) = *(const u32x4*)(G + (size_t)row * ldg + unit * 8); }
}

__device__ __forceinline__ int tile8_row(int lane, int j) { return 2 * (lane >> 3) + (j & 1) + 16 * (j >> 1); }
__device__ __forceinline__ void load_tile8(u32x4 (&vr)[8], const bf16* G, int ldg, int lane) {
#pragma unroll
    for (int j = 0; j < 8; ++j) vr[j] = *(const u32x4*)(G + (size_t)tile8_row(lane, j) * ldg + 8 * (lane & 7));
}
__device__ __forceinline__ void put_tile8_t(LAS char* X, const u32x4 (&vr)[8], int lane) {
#pragma unroll
    for (int j = 0; j < 8; j += 2) { const int t = tile8_row(lane, j);
#pragma unroll
        for (int e = 0; e < 8; ++e) { const int v = 8 * (lane & 7) + e; const unsigned w0 = vr[j][e >> 1], w1 = vr[j + 1][e >> 1];
            const unsigned pk = (e & 1) ? ((w0 >> 16) | (w1 & 0xffff0000u)) : ((w0 & 0xffffu) | (w1 << 16));
            *(LAS unsigned*)(X + swz(v, t >> 3) + (t & 7) * 2) = pk; } }
}
__device__ __forceinline__ void put_tile8(LAS char* X, const u32x4 (&vr)[8], int lane) {
#pragma unroll
    for (int j = 0; j < 8; ++j) *(LAS u32x4*)(X + swz(tile8_row(lane, j), lane & 7)) = vr[j];
}
__device__ __forceinline__ float get1(const LAS char* arr, int row, int col) { return bf2f(*(const LAS bf16*)(arr + swz(row, col >> 3) + (col & 7) * 2)); }

__device__ __forceinline__ void hgA(const Args& a, int layer, int b, int c, int h, int dir, LAS char* X, LAS char* Y, int lane) {
    const bf16* Pr = (const bf16*)(a.ws + WS_P) + (size_t)(b * SB + 64 * c) * PC;
    stage_copy(X, Pr + (dir ? C_HGZB : C_HGZF) + h * 64, PC, lane);
    u32x4 vr[8]; load_tile8(vr, Pr + C_HGV + h * 64, PC, lane);
    const float lb = hg_lb(a, layer, dir, h, lane), omlb = 1.f - lb;
    float R = 1.f;
#pragma unroll 4
    for (int p = 0; p < 32; ++p) { const int t0 = dir ? 2 * p : 63 - 2 * p, t1 = dir ? 2 * p + 1 : 62 - 2 * p;
        const float f0 = lb + omlb * sigm(get1(X, t0, lane)); const float k0 = (1.f - f0) * R; R *= f0;
        const float f1 = lb + omlb * sigm(get1(X, t1, lane)); const float k1 = (1.f - f1) * R; R *= f1;
        put2(Y, lane, dir ? t0 : t1, dir ? k0 : k1, dir ? k1 : k0); }
    put_tile8_t(X, vr, lane);
    const int tk = ((b * 4 + h) * 2 + dir) * NCH + c;
    ((float*)(a.ws + WS_DT))[(size_t)tk * 64 + lane] = R;
    f32x16 acc[2][2] = {};
    mm64(acc, X, Y, lane & 31, lane >> 5, -1, -1);
    store_ut((bf16*)(a.ws + WS_UTH) + (size_t)tk * 4096, acc, lane & 31, lane >> 5);
}
__device__ __forceinline__ void mlA(const Args& a, int layer, int b, int c, int h, int dir, LAS char* X, LAS char* Y, int lane) {
    const bf16* Pr = (const bf16*)(a.ws + WS_P) + (size_t)(b * SB + 64 * c) * PC;
    stage_copy(X, Pr + C_MLK + h * 64, PC, lane);
    u32x4 vr[8]; load_tile8(vr, Pr + C_MLV + h * 64, PC, lane);
    const float ip = bf2f(Pr[(size_t)lane * PC + C_MLG + dir * 4 + h]) + a.in[12][layer * 16 + dir * 4 + h];
    const float lf = logsig(bf2f(Pr[(size_t)lane * PC + C_MLG + 8 + dir * 4 + h]) + a.in[12][layer * 16 + 8 + dir * 4 + h]);
    const float bt = scan_add(lf, lane, dir), g = wave_sum(lf);
    const float at = g - bt + ip, l = wave_max(at), w = __expf(at - l);
    float nu = 0.f;
#pragma unroll
    for (int p = 0; p < 32; ++p) { const float w0 = __builtin_bit_cast(float, __builtin_amdgcn_readlane(__builtin_bit_cast(int, w), 2 * p)), w1 = __builtin_bit_cast(float, __builtin_amdgcn_readlane(__builtin_bit_cast(int, w), 2 * p + 1));
        const float k0 = get1(X, 2 * p, lane) * 0.125f * w0, k1 = get1(X, 2 * p + 1, lane) * 0.125f * w1;
        nu += k0 + k1; put2(Y, lane, 2 * p, k0, k1); }
    put_tile8_t(X, vr, lane);
    const int tk = ((b * 4 + h) * 2 + dir) * NCH + c;
    ((float*)(a.ws + WS_NU))[(size_t)tk * 64 + lane] = nu;
    if (lane == 0) { ((float*)(a.ws + WS_GL))[tk * 2] = g; ((float*)(a.ws + WS_GL))[tk * 2 + 1] = l; }
    f32x16 acc[2][2] = {};
    mm64(acc, X, Y, lane & 31, lane >> 5, -1, -1);
    store_ut((bf16*)(a.ws + WS_UTM) + (size_t)tk * 4096, acc, lane & 31, lane >> 5);
}
__device__ __forceinline__ void p_scanA(const Args& a, int layer, LAS unsigned char* lds, int do_hg, int do_ml) {
    const int tid = otid(), lane = tid & 63, wave = __builtin_amdgcn_readfirstlane(tid >> 6), G = ogrid(), h = wave >> 1, dir = wave & 1;
    LAS char* X = (LAS char*)lds + wave * 16384; LAS char* Y = X + 8192;
    for (int u = obid(); u < 2 * NB * NCH; u += G) { const int mixer = u / (NB * NCH), q = u % (NB * NCH), b = q / NCH, c = q % NCH;
        int ln = lane; asm volatile("" : "+v"(ln));
        if (mixer == 0) { if (do_hg) hgA(a, layer, b, c, h, dir, X, Y, ln); } else { if (do_ml) mlA(a, layer, b, c, h, dir, X, Y, ln); } }
}

__device__ __forceinline__ int chunk_of(int dir, int k) { return dir == 0 ? k : (k < 4 ? 3 - k : NCH + 3 - k); }
__device__ __forceinline__ void p_scanB(const Args& a, int do_hg, int do_ml) {
    const int tid = otid(), G = ogrid();
    for (int g = obid() * NTHR + tid; g < 128 * 1024; g += G * NTHR) {
        const int seq = g >> 10, mixer = seq >> 6, sq = seq & 63, dir = sq & 1, e4 = g & 1023, d0 = (e4 & 15) * 4;
        if (mixer == 0) { if (!do_hg) continue;
            const bf16* UT = (const bf16*)(a.ws + WS_UTH); bf16* SP = (bf16*)(a.ws + WS_SPH); const float* DT = (const float*)(a.ws + WS_DT);
            f32x4 S = {0.f, 0.f, 0.f, 0.f};
#pragma unroll 4
            for (int k = 0; k < NCH; ++k) { const size_t tk = (size_t)sq * NCH + chunk_of(dir, k);
                const u32x2 u = *(const u32x2*)(UT + tk * 4096 + e4 * 4); const f32x4 dd = *(const f32x4*)(DT + tk * 64 + d0);
                u32x2 o; o.x = pk2(S[0], S[1]); o.y = pk2(S[2], S[3]); *(u32x2*)(SP + tk * 4096 + e4 * 4) = o;
                S = S * dd + (f32x4){bflo(u.x), bfhi(u.x), bflo(u.y), bfhi(u.y)}; }
        } else { if (!do_ml) continue;
            const bf16* UT = (const bf16*)(a.ws + WS_UTM); bf16* SP = (bf16*)(a.ws + WS_SPM); const float* NU = (const float*)(a.ws + WS_NU);
            float* NP = (float*)(a.ws + WS_NP); const float* GL = (const float*)(a.ws + WS_GL); float* MP = (float*)(a.ws + WS_MP);
            f32x4 S = {0.f, 0.f, 0.f, 0.f}, n = {0.f, 0.f, 0.f, 0.f}; float m = 0.f;
#pragma unroll 4
            for (int k = 0; k < NCH; ++k) { const size_t tk = (size_t)sq * NCH + chunk_of(dir, k);
                const u32x2 u = *(const u32x2*)(UT + tk * 4096 + e4 * 4); const f32x4 nu = *(const f32x4*)(NU + tk * 64 + d0); const f32x2 gl = *(const f32x2*)(GL + tk * 2);
                u32x2 o; o.x = pk2(S[0], S[1]); o.y = pk2(S[2], S[3]); *(u32x2*)(SP + tk * 4096 + e4 * 4) = o;
                if (e4 < 16) { *(f32x4*)(NP + tk * 64 + d0) = n; if (e4 == 0) MP[tk] = m; }
                const float mn = fmaxf(gl[0] + m, gl[1]), aa = __expf(gl[0] + m - mn), bb = __expf(gl[1] - mn); m = mn;
                S = S * aa + (f32x4){bflo(u.x), bfhi(u.x), bflo(u.y), bfhi(u.y)} * bb; n = n * aa + nu * bb; }
        }
    }
}

__device__ __forceinline__ void hgC(const Args& a, int layer, int b, int c, int h, int dir, LAS char* X, LAS char* Y, int lane) {
    const int r32 = lane & 31, hh = lane >> 5;
    const bf16* Pr = (const bf16*)(a.ws + WS_P) + (size_t)(b * SB + 64 * c) * PC;
    const int tk = ((b * 4 + h) * 2 + dir) * NCH + c;
    u32x4 qr_[8], zr_[8], vr[8], sp[8];
    load_tile8(qr_, Pr + C_HGQ + h * 64, PC, lane); load_tile8(zr_, Pr + (dir ? C_HGZB : C_HGZF) + h * 64, PC, lane);
    load_tile8(vr, Pr + C_HGV + h * 64, PC, lane); load_tile8(sp, (const bf16*)(a.ws + WS_SPH) + (size_t)tk * 4096, 64, lane);
    put_tile8(X, qr_, lane); put_tile8(Y, zr_, lane);
    const float lb = hg_lb(a, layer, dir, h, lane), omlb = 1.f - lb;
    float Gp = 1.f;
#pragma unroll 4
    for (int i = 32; i < 64; ++i) { const int t = dir ? 63 - i : i; const float f = lb + omlb * sigm(get1(Y, t, lane)); Gp *= f;
        const float q = get1(X, t, lane) * Gp, k = (1.f - f) * __builtin_amdgcn_rcpf(Gp); put1(X, t, lane, q); put1(Y, t, lane, k); }
    float Hp = 1.f;
#pragma unroll 4
    for (int i = 31; i >= 0; --i) { const int t = dir ? 63 - i : i; const float f = lb + omlb * sigm(get1(Y, t, lane));
        const float q = get1(X, t, lane) * __builtin_amdgcn_rcpf(Hp), k = (1.f - f) * Hp; Hp *= f; put1(X, t, lane, q); put1(Y, t, lane, k); }
    f32x16 sc[2][2] = {};
    mm64(sc, Y, X, r32, hh, dir ? 0 : 1, dir ? 1 : 0);
    bf16x8 pa[2][4];
#pragma unroll
    for (int ti = 0; ti < 2; ++ti)
#pragma unroll
        for (int si = 0; si < 2; ++si) { const bool dead = dir ? (si == 0 && ti == 1) : (si == 1 && ti == 0);
            if (dead) { pa[ti][2 * si] = (bf16x8){0, 0, 0, 0, 0, 0, 0, 0}; pa[ti][2 * si + 1] = (bf16x8){0, 0, 0, 0, 0, 0, 0, 0}; }
            else { f32x16 p = sc[si][ti];
                if (si == ti) {
#pragma unroll
                    for (int rg = 0; rg < 16; ++rg) { const int s = crow(rg, hh); const bool ok = dir ? (s >= r32) : (s <= r32); p[rg] = ok ? p[rg] : 0.f; } }
                SC_PK4(p, 0, pa[ti][2 * si]); SC_PK4(p, 8, pa[ti][2 * si + 1]); } }
    { const float eb = Hp;
#pragma unroll 8
      for (int t = 0; t < 64; ++t) put1(Y, t, lane, get1(X, t, lane) * eb); }
    put_tile8_t(X, vr, lane);
    f32x16 o[2][2] = {};
#pragma unroll
    for (int ss = 0; ss < 4; ++ss) { bf16x8 vf[2];
#pragma unroll
        for (int vi = 0; vi < 2; ++vi) vf[vi] = frag(X, 32 * vi + r32, 2 * ss + hh);
#pragma unroll
        for (int ti = 0; ti < 2; ++ti)
#pragma unroll
            for (int vi = 0; vi < 2; ++vi) o[ti][vi] = __builtin_amdgcn_mfma_f32_32x32x16_bf16(pa[ti][ss], vf[vi], o[ti][vi], 0, 0, 0); }
    put_tile8(X, sp, lane);
    mm64(o, Y, X, r32, hh, -1, -1);
    LAS float* O = (LAS float*)X;
#pragma unroll
    for (int ti = 0; ti < 2; ++ti)
#pragma unroll
        for (int vi = 0; vi < 2; ++vi)
#pragma unroll
            for (int rg = 0; rg < 16; ++rg) O[(32 * ti + crow(rg, hh)) * 64 + 32 * vi + r32] = o[ti][vi][rg];
}
__device__ __forceinline__ void mlC(const Args& a, int layer, int b, int c, int h, int dir, LAS char* X, LAS char* Y, LAS float* T, int lane) {
    const int r32 = lane & 31, hh = lane >> 5;
    const bf16* Pr = (const bf16*)(a.ws + WS_P) + (size_t)(b * SB + 64 * c) * PC;
    const int tk = ((b * 4 + h) * 2 + dir) * NCH + c;
    LAS float* TMU = T; LAS float* TCS = T + 64; LAS float* TEM = T + 128; LAS float* TAP = T + 192;
    { const float ip = bf2f(Pr[(size_t)lane * PC + C_MLG + dir * 4 + h]) + a.in[12][layer * 16 + dir * 4 + h];
      const float lf = logsig(bf2f(Pr[(size_t)lane * PC + C_MLG + 8 + dir * 4 + h]) + a.in[12][layer * 16 + 8 + dir * 4 + h]);
      const float bt = scan_add(lf, lane, dir), cs = ip - bt, mp = ((const float*)(a.ws + WS_MP))[tk];
      const float mu = fmaxf(mp, scan_max(cs, lane, dir));
      TMU[lane] = mu; TCS[lane] = cs; TEM[lane] = __expf(-bt - mu); TAP[lane] = __expf(mp - mu); }
    u32x4 qr_[8], kr_[8], vr[8], sp[8];
    load_tile8(qr_, Pr + C_MLQ + h * 64, PC, lane); load_tile8(kr_, Pr + C_MLK + h * 64, PC, lane);
    load_tile8(vr, Pr + C_MLV + h * 64, PC, lane); load_tile8(sp, (const bf16*)(a.ws + WS_SPM) + (size_t)tk * 4096, 64, lane);
    put_tile8(X, qr_, lane); put_tile8(Y, kr_, lane);
    f32x16 sc[2][2] = {};
    mm64(sc, Y, X, r32, hh, dir ? 0 : 1, dir ? 1 : 0);
    bf16x8 pa[2][4];
#pragma unroll
    for (int ti = 0; ti < 2; ++ti) { const float mu = TMU[32 * ti + r32];
#pragma unroll
        for (int si = 0; si < 2; ++si) { const bool dead = dir ? (si == 0 && ti == 1) : (si == 1 && ti == 0);
            if (dead) { pa[ti][2 * si] = (bf16x8){0, 0, 0, 0, 0, 0, 0, 0}; pa[ti][2 * si + 1] = (bf16x8){0, 0, 0, 0, 0, 0, 0, 0}; }
            else { f32x16 p = sc[si][ti];
#pragma unroll
                for (int g4 = 0; g4 < 4; ++g4) { const f32x4 cs = *(const LAS f32x4*)(TCS + 32 * si + 8 * g4 + 4 * hh);
#pragma unroll
                    for (int i = 0; i < 4; ++i) { const int rg = 4 * g4 + i, s = crow(rg, hh); const bool ok = (si != ti) || (dir ? (s >= r32) : (s <= r32));
                        const float w = p[rg] * 0.125f * __expf(cs[i] - mu); p[rg] = ok ? w : 0.f; } }
                SC_PK4(p, 0, pa[ti][2 * si]); SC_PK4(p, 8, pa[ti][2 * si + 1]); } } }
#pragma unroll
    for (int j = 0; j < 8; ++j) { const int u = lane + 64 * j, row = u >> 3, unit = u & 7; const float ap = TAP[row];
        const u32x4 qv = *(const LAS u32x4*)(X + swz(row, unit)); u32x4 o;
        o.x = pk2(bflo(qv.x) * ap, bfhi(qv.x) * ap); o.y = pk2(bflo(qv.y) * ap, bfhi(qv.y) * ap); o.z = pk2(bflo(qv.z) * ap, bfhi(qv.z) * ap); o.w = pk2(bflo(qv.w) * ap, bfhi(qv.w) * ap);
        *(LAS u32x4*)(Y + swz(row, unit)) = o; }
    put_tile8_t(X, vr, lane);
    f32x16 o[2][2] = {}; f32x16 dn[2] = {};
    const bf16x8 ones = {0x3f80, 0x3f80, 0x3f80, 0x3f80, 0x3f80, 0x3f80, 0x3f80, 0x3f80};
#pragma unroll
    for (int ss = 0; ss < 4; ++ss) { bf16x8 vf[2];
#pragma unroll
        for (int vi = 0; vi < 2; ++vi) vf[vi] = frag(X, 32 * vi + r32, 2 * ss + hh);
#pragma unroll
        for (int ti = 0; ti < 2; ++ti) { dn[ti] = __builtin_amdgcn_mfma_f32_32x32x16_bf16(pa[ti][ss], ones, dn[ti], 0, 0, 0);
#pragma unroll
            for (int vi = 0; vi < 2; ++vi) o[ti][vi] = __builtin_amdgcn_mfma_f32_32x32x16_bf16(pa[ti][ss], vf[vi], o[ti][vi], 0, 0, 0); } }
    put_tile8(X, sp, lane);
    mm64(o, Y, X, r32, hh, -1, -1);
    { const float* NPg = (const float*)(a.ws + WS_NP) + (size_t)tk * 64;
#pragma unroll
      for (int st = 0; st < 4; ++st) { const f32x4 n0 = *(const f32x4*)(NPg + 16 * st + 8 * hh), n1 = *(const f32x4*)(NPg + 16 * st + 8 * hh + 4);
          u32x4 w; w.x = pk2(n0[0], n0[1]); w.y = pk2(n0[2], n0[3]); w.z = pk2(n1[0], n1[1]); w.w = pk2(n1[2], n1[3]); const bf16x8 nf = __builtin_bit_cast(bf16x8, w);
#pragma unroll
          for (int ti = 0; ti < 2; ++ti) dn[ti] = __builtin_amdgcn_mfma_f32_32x32x16_bf16(frag(Y, 32 * ti + r32, 2 * st + hh), nf, dn[ti], 0, 0, 0); } }
    float em[2][16];
#pragma unroll
    for (int ti = 0; ti < 2; ++ti)
#pragma unroll
        for (int g4 = 0; g4 < 4; ++g4) { const f32x4 e = *(const LAS f32x4*)(TEM + 32 * ti + 8 * g4 + 4 * hh);
#pragma unroll
            for (int i = 0; i < 4; ++i) em[ti][4 * g4 + i] = e[i]; }
    LAS float* O = (LAS float*)X;
#pragma unroll
    for (int ti = 0; ti < 2; ++ti)
#pragma unroll
        for (int rg = 0; rg < 16; ++rg) { const float rd = __builtin_amdgcn_rcpf(fmaxf(fabsf(dn[ti][rg]), em[ti][rg]));
#pragma unroll
            for (int vi = 0; vi < 2; ++vi) O[(32 * ti + crow(rg, hh)) * 64 + 32 * vi + r32] = o[ti][vi][rg] * rd; }
}
__device__ __forceinline__ void p_scanC(const Args& a, int layer, LAS unsigned char* lds, int do_hg, int do_ml) {
    const int tid = otid(), lane = tid & 63, wave = __builtin_amdgcn_readfirstlane(tid >> 6), G = ogrid(), h = wave >> 1, dir = wave & 1;
    LAS char* X = (LAS char*)lds + wave * 16384; LAS char* Y = X + 8192; LAS float* T = (LAS float*)(lds + 131072 + wave * 1024);
    const bf16* P = (const bf16*)(a.ws + WS_P); bf16* Yo = (bf16*)(a.ws + WS_Y);
    const bool lastl = layer == DEPTH - 1;
    for (int u = obid(); u < 2 * NB * NCH; u += G) { const int mixer = u / (NB * NCH), q = u % (NB * NCH), b = q / NCH, c = q % NCH;
        if (lastl && c < 4) continue;
        if (mixer == 0 ? !do_hg : !do_ml) continue;
        int ln = lane; asm volatile("" : "+v"(ln));
        if (mixer == 0) hgC(a, layer, b, c, h, dir, X, Y, ln); else mlC(a, layer, b, c, h, dir, X, Y, T, ln);
        __syncthreads();
        asm volatile("" : "+v"(ln));
        { const LAS float* Of = (const LAS float*)((LAS char*)lds + (2 * h) * 16384); const LAS float* Ob = (const LAS float*)((LAS char*)lds + (2 * h + 1) * 16384);
          const float gn = mixer == 0 ? a.in[11][layer * 64 + ln] : a.in[13][layer * 64 + ln];
          const int gcol = (mixer == 0 ? C_HGG : C_MLOG) + h * 64 + ln;
#pragma unroll 8
          for (int i = 0; i < 32; ++i) { const int t = 32 * dir + i; const size_t r = (size_t)(b * SB + 64 * c + t);
              const float ov = Of[t * 64 + ln] + Ob[t * 64 + ln]; const float y = ov * __builtin_amdgcn_rsqf(wave_sum(ov * ov) * (1.f / 64.f) + EPS) * gn;
              const float gt = bf2f(P[r * PC + gcol]); const float outv = mixer == 0 ? y * gt * sigm(gt) : y * sigm(gt);
              if (OUTPROJ_FP8) ((unsigned char*)Yo)[r * DM + mixer * 256 + h * 64 + ln] = (unsigned char)fp8_1(16.f * outv); else Yo[r * DM + mixer * 256 + h * 64 + ln] = (bf16)f2bf(outv); } }
        __syncthreads();
    }
}
#undef SC_PK4
}

__device__ __forceinline__ void p_attn(const Args& a, int layer, LAS char* ldsg) {
    asm volatile("" ::: "memory");
    const bf16* P = (const bf16*)(a.ws + WS_P); bf16* Y = (bf16*)(a.ws + WS_Y); const int G = ogrid();
    const int bid = obid(), lane = otid() & 63;
    const float* qg = a.in[14] + layer * 128; const float* kg = a.in[15] + layer * 128;
    const float mq = wave_max_nn(fmaxf(fabsf(qg[lane]), fabsf(qg[lane + 64]))), mk = wave_max_nn(fmaxf(fabsf(kg[lane]), fabsf(kg[lane + 64])));
    const float bound = 128.f * mq * mk * (att::SCALE * 1.4426950408889634f) * 1.02f;
    const bool fix = bound <= 60.f;
    const int cu = (layer != DEPTH - 1) ? (G >= 96 ? bid - 64 : bid) : -1; const bool hasc = cu >= 0 && cu < 32;
    const float* ropet = (const float*)(a.ws + WS_ROPE);
#define AT_LAT(u) const int b = (u) & 7, idx = ((u) >> 3) & 31, kvh = (u) >> 8, h = kvh * 2 + (idx >> 4), qb = idx & 15; const size_t r0 = (size_t)b * SB + CTX + (size_t)qb * 256; \
        const bf16* Qp = P + r0 * PC + C_ATQ + h * 128; const bf16* Kp = P + (size_t)b * SB * PC + C_ATK + kvh * 128; const bf16* Vp = P + (size_t)b * SB * PC + C_ATV + kvh * 128; \
        bf16* Op = (bf16*)((unsigned char*)Y + (r0 * DM + 512 + h * 128) * (OUTPROJ_FP8 ? 1 : 2));
#define AT_CTX() const int b = cu & 7, h = cu >> 3, kvh = h >> 1; const size_t r0 = (size_t)b * SB; \
        const bf16* Qp = P + r0 * PC + C_ATQ + h * 128; const bf16* Kp = P + r0 * PC + C_ATK + kvh * 128; const bf16* Vp = P + r0 * PC + C_ATV + kvh * 128; \
        bf16* Op = (bf16*)((unsigned char*)Y + (r0 * DM + 512 + h * 128) * (OUTPROJ_FP8 ? 1 : 2));
    const int ex = fix ? 0 : 1;
    for (int u = bid; u < 512; u += G) { AT_LAT(u) att::attn_dense_body(Qp, Kp, Vp, Op, SB, ldsg, qg, ropet, qb * 256, -bound, ex); __syncthreads(); }
    if (hasc) { AT_CTX() att::attn_dense_body(Qp, Kp, Vp, Op, CTX, ldsg, qg, ropet, -1, -bound, ex); __syncthreads(); }
#undef AT_LAT
#undef AT_CTX
}

__device__ __forceinline__ void p_finish(const Args& a, int layer, int do_hg, int do_ml) {
    const int tid = otid(), lane = tid & 63, wave = tid >> 6; const int gw = obid() * NWAVE + wave, NGW = ogrid() * NWAVE;
    const bf16* P = (const bf16*)(a.ws + WS_P); bf16* Y = (bf16*)(a.ws + WS_Y);
    const float* OH = (const float*)(a.ws + WS_OH); const float* OM = (const float*)(a.ws + WS_OM);
    const float gh = a.in[11][layer * 64 + lane], gm = a.in[13][layer * 64 + lane];
    for (int r = gw; r < NR; r += NGW) { if (layer == DEPTH - 1 && (r % SB) < CTX) continue;
#pragma unroll
        for (int h = 0; h < 4; ++h) {
            if (do_hg) { const float o = OH[(size_t)r * 256 + h * 64 + lane] + OH[(size_t)(NR + r) * 256 + h * 64 + lane];
              const float y = o * (1.f / sqrtf(wave_sum(o * o) * (1.f / 64.f) + EPS)) * gh; const float g = bf2f(P[(size_t)r * PC + C_HGG + h * 64 + lane]);
              Y[(size_t)r * DM + h * 64 + lane] = (bf16)f2bf(y * g * sigm(g)); }
            if (do_ml) { const float o = OM[(size_t)r * 256 + h * 64 + lane] + OM[(size_t)(NR + r) * 256 + h * 64 + lane];
              const float y = o * (1.f / sqrtf(wave_sum(o * o) * (1.f / 64.f) + EPS)) * gm; const float g = bf2f(P[(size_t)r * PC + C_MLOG + h * 64 + lane]);
              Y[(size_t)r * DM + 256 + h * 64 + lane] = (bf16)f2bf(y * sigm(g)); }
        }
    }
}

__device__ __forceinline__ void p_router(const Args& a, int layer, LAS unsigned char* lds) {
    const int tid = otid(), lane = tid & 63, wave = tid >> 6, G = ogrid(), bid = obid();
    constexpr int TP = 2064;
    LAS unsigned char* TH = lds; LAS unsigned char* TL = lds + 32 * TP;
    LAS float* PART = (LAS float*)lds;
    LAS float* LOG = (LAS float*)(lds + 64 * TP);
    LAS int* LCNT = (LAS int*)(lds + 64 * TP + 32 * 33 * 4);
    bf16* H = (bf16*)(a.ws + WS_H);
    int* RE = (int*)(a.ws + WS_RE); int* RS = (int*)(a.ws + WS_RS); float* RG = (float*)(a.ws + WS_RG);
    const bool lastl = layer == DEPTH - 1;
    const int e_l = lane & 31, hh = lane >> 5;
    bf16x8 bh[8], bl[8];
#pragma unroll
    for (int ks = 0; ks < 8; ++ks) { const size_t o = ((size_t)(layer * 32 + e_l)) * 1024 + wave * 128 + ks * 16 + hh * 8;
        bh[ks] = *(const bf16x8*)((const bf16*)(a.ws + WS_WRH) + o); bl[ks] = *(const bf16x8*)((const bf16*)(a.ws + WS_WRL) + o); }
    if (tid < 32) LCNT[tid] = 0;
    __syncthreads();
    for (int tile = bid; tile < NR / 32; tile += G) {
        const int r0 = tile * 32; if (lastl && (r0 % SB) < CTX) continue;
#pragma unroll
        for (int q = 0; q < 4; ++q) { const int row = wave * 4 + q, r = r0 + row; f32x4 v[2][2]; load_row_bf((const bf16*)(a.ws + WS_XB) + (size_t)r * DM, v, lane);
            norm_mod_store(v, a.in[7] + (size_t)layer * DM, modv(a, layer, r, 4), modv(a, layer, r, 3), MOE_FP8 ? (bf16*)nullptr : H + (size_t)r * DM, lane);
            if (MOE_FP8) {
#pragma unroll
                for (int j = 0; j < 2; ++j) { u32x2 w8; w8.x = pk_fp8x4(8.f * v[j][0][0], 8.f * v[j][0][1], 8.f * v[j][0][2], 8.f * v[j][0][3]); w8.y = pk_fp8x4(8.f * v[j][1][0], 8.f * v[j][1][1], 8.f * v[j][1][2], 8.f * v[j][1][3]);
                    *(u32x2*)((unsigned char*)(a.ws + WS_H8) + (size_t)r * DM + 8 * lane + 512 * j) = w8; } }
#pragma unroll
            for (int j = 0; j < 2; ++j) { unsigned hi[4], lo[4];
#pragma unroll
                for (int p = 0; p < 4; ++p) { const float x0 = v[j][p >> 1][(p & 1) * 2], x1 = v[j][p >> 1][(p & 1) * 2 + 1]; const unsigned w = pk2(x0, x1); hi[p] = w; lo[p] = pk2(x0 - bflo(w), x1 - bfhi(w)); }
                *(LAS u32x4*)(TH + row * TP + (8 * lane + 512 * j) * 2) = (u32x4){hi[0], hi[1], hi[2], hi[3]};
                *(LAS u32x4*)(TL + row * TP + (8 * lane + 512 * j) * 2) = (u32x4){lo[0], lo[1], lo[2], lo[3]}; } }
        __syncthreads();
        f32x16 acc = {};
#pragma unroll
        for (int ks = 0; ks < 8; ++ks) { const int off = e_l * TP + (wave * 128 + ks * 16 + hh * 8) * 2;
            const bf16x8 ah = *(const LAS bf16x8*)(TH + off), al = *(const LAS bf16x8*)(TL + off);
            acc = __builtin_amdgcn_mfma_f32_32x32x16_bf16(ah, bh[ks], acc, 0, 0, 0);
            acc = __builtin_amdgcn_mfma_f32_32x32x16_bf16(ah, bl[ks], acc, 0, 0, 0);
            acc = __builtin_amdgcn_mfma_f32_32x32x16_bf16(al, bh[ks], acc, 0, 0, 0); }
        __syncthreads();
#pragma unroll
        for (int rg = 0; rg < 16; ++rg) { const int row = (rg & 3) + 8 * (rg >> 2) + 4 * hh; PART[(wave * 32 + row) * 32 + e_l] = acc[rg]; }
        __syncthreads();
#pragma unroll
        for (int q = 0; q < 2; ++q) { const int idx = tid + 512 * q, row = idx >> 5, e = idx & 31; float s = a.in[17][layer * 32 + e];
#pragma unroll
            for (int w = 0; w < 8; ++w) s += PART[(w * 32 + row) * 32 + e];
            LOG[row * 33 + e] = s; }
        __syncthreads();
        if (tid < 32) { const int r = r0 + tid; float tv[4]; int te[4];
#pragma unroll
            for (int k = 0; k < 4; ++k) { float best = -INFINITY; int bi = 0;
                for (int e = 0; e < 32; ++e) { const float v = LOG[tid * 33 + e]; if (v > best) { best = v; bi = e; } }
                tv[k] = best; te[k] = bi; LOG[tid * 33 + bi] = -INFINITY; }
            float p[4], ps = 0.f;
#pragma unroll
            for (int k = 0; k < 4; ++k) { p[k] = expf(tv[k] - tv[0]); ps += p[k]; }
#pragma unroll
            for (int k = 0; k < 4; ++k) { RE[r * 4 + k] = te[k]; RS[r * 4 + k] = atomicAdd((int*)&LCNT[te[k]], 1); RG[r * 4 + k] = p[k] / ps; } }
        __syncthreads();
    }
    if (tid < 32) ((int*)(a.ws + WS_CNT))[bid * 32 + tid] = LCNT[tid];
}

__device__ __forceinline__ void p_dispatch(const Args& a, int layer, LAS unsigned char* lds) {
    const int tid = otid(), G = ogrid(), bid = obid();
    LAS int* tot = (LAS int*)lds; LAS int* base = tot + 32; LAS int* pst = base + 32;
    const int* CNT = (const int*)(a.ws + WS_CNT);
    const int* RE = (const int*)(a.ws + WS_RE); const int* RS = (const int*)(a.ws + WS_RS); const float* RG = (const float*)(a.ws + WS_RG);
    int* POS = (int*)(a.ws + WS_POS); int* TOK = (int*)(a.ws + WS_TOK); float* GATEP = (float*)(a.ws + WS_GATEP); int* TILEE = (int*)(a.ws + WS_TILEE);
    const bool lastl = layer == DEPTH - 1;
    { LAS int* ptot = pst + 64; LAS int* pbase = ptot + 512;
      const int e = tid & 31, part = tid >> 5; int t = 0, bs = 0;
      for (int blk = part; blk < G; blk += 16) { const int c = CNT[blk * 32 + e]; if (blk < bid) bs += c; t += c; }
      ptot[tid] = t; pbase[tid] = bs;
      __syncthreads();
      if (tid < 32) { int tt = 0, bb = 0;
#pragma unroll
          for (int p = 0; p < 16; ++p) { tt += ptot[p * 32 + tid]; bb += pbase[p * 32 + tid]; }
          tot[tid] = tt; base[tid] = bb; } }
    __syncthreads();
    if (tid == 0) { int p = 0; for (int e = 0; e < 32; ++e) { pst[e] = p; p += (tot[e] + 255) & ~255; } pst[32] = p; }
    __syncthreads();
    for (int tile = bid; tile < NR / 32; tile += G) { const int r0 = tile * 32; if (lastl && (r0 % SB) < CTX) continue;
        if (tid < 128) { const int i = r0 * 4 + tid; const int e = RE[i]; const int pos = pst[e] + base[e] + RS[i]; TOK[pos] = r0 + (tid >> 2); GATEP[pos] = RG[i]; POS[i] = pos; } }
    for (int e = bid; e < 32; e += G) {
        for (int p = pst[e] + tot[e] + tid; p < pst[e + 1]; p += NTHR) { TOK[p] = 0; GATEP[p] = 0.f; }
        for (int rt = pst[e] / 256 + tid; rt < pst[e + 1] / 256; rt += NTHR) TILEE[rt] = e; }
    if (bid == 0 && tid == 0) *(int*)(a.ws + WS_NRT) = pst[32] / 256;
}

__device__ __forceinline__ void p_combine(const Args& a, int layer, bool dry = false) {
    const int tid = otid(), lane = tid & 63, wave = tid >> 6; const int gw = obid() * NWAVE + wave, NGW = ogrid() * NWAVE;
    const bf16* YM = (const bf16*)(a.ws + WS_YM); const int* POS = (const int*)(a.ws + WS_POS); bf16* H = (bf16*)(a.ws + WS_H);
    const bool lastl = layer == DEPTH - 1;
    for (int r = gw; r < NR; r += NGW) { if (lastl && (r % SB) < CTX) continue;
        const float* g2 = modv(a, layer, r, 5); bf16* xb = (bf16*)(a.ws + WS_XB) + (size_t)r * DM;
        float* xo = dry ? (float*)(a.ws + WS_ACT) + (size_t)r * DM : a.out + ((size_t)(r / SB) * SEQ + (r % SB) - CTX) * DM;
        bf16* xbo = dry ? (bf16*)(a.ws + WS_ACT) + (size_t)r * DM : xb; bf16* hw = dry ? (bf16*)(a.ws + WS_ACT + 160 * MiB) + (size_t)r * DM : H + (size_t)r * DM;
        int pos[4];
#pragma unroll
        for (int k = 0; k < 4; ++k) pos[k] = POS[r * 4 + k];
        f32x4 v[2][2]; load_row_bf(xb, v, lane);
#pragma unroll
        for (int j = 0; j < 2; ++j) { const int c = 8 * lane + 512 * j; float f[8];
#pragma unroll
            for (int i = 0; i < 8; ++i) f[i] = 0.f;
#pragma unroll
            for (int k = 0; k < 4; ++k) { const u32x4 y = *(const u32x4*)(YM + (size_t)pos[k] * DM + c);
                f[0] += bflo(y.x); f[1] += bfhi(y.x); f[2] += bflo(y.y); f[3] += bfhi(y.y); f[4] += bflo(y.z); f[5] += bfhi(y.z); f[6] += bflo(y.w); f[7] += bfhi(y.w); }
#pragma unroll
            for (int q = 0; q < 2; ++q) { const f32x4 g = *(const f32x4*)(g2 + c + 4 * q);
                v[j][q] = v[j][q] + g * (f32x4){f[4 * q], f[4 * q + 1], f[4 * q + 2], f[4 * q + 3]};
                if (lastl) *(f32x4*)(xo + c + 4 * q) = v[j][q]; }
            if (!lastl) { u32x4 w; w.x = pk2(v[j][0][0], v[j][0][1]); w.y = pk2(v[j][0][2], v[j][0][3]); w.z = pk2(v[j][1][0], v[j][1][1]); w.w = pk2(v[j][1][2], v[j][1][3]); *(u32x4*)(xbo + c) = w; } }
        if (!lastl) { norm_mod_store(v, a.in[6] + (size_t)(layer + 1) * DM, modv(a, layer + 1, r, 1), modv(a, layer + 1, r, 0), INPROJ_I8 ? (bf16*)nullptr : hw, lane);
            if (INPROJ_I8) store_row_i8(v, dry ? (unsigned char*)(a.ws + WS_ACT + 160 * MiB) + (size_t)r * DM : (unsigned char*)(a.ws + WS_H) + (size_t)r * DM, dry ? (float*)(a.ws + WS_ACT + 240 * MiB) + r : (float*)(a.ws + WS_HSC) + r, lane); }
    }
}

template <int PH>
__device__ __forceinline__ void run_phase(int layer, unsigned char* ldsg) {
    const Args a = fetch_args();
    LAS unsigned char* lds = (LAS unsigned char*)ldsg;
    const int G = ogrid(), bid = obid();
    if constexpr (PH == PH_PRO) p_prologue(a, lds);
    if constexpr (PH == PH_NORM1) { if (INPROJ_I8) p_quant_win(a); p_norm1(a, layer); }
    if constexpr (PH == PH_INPROJ) {
        if constexpr (INPROJ_I8) { pg8::SchedDense S; S.init(NR, PC, G, bid, nullptr); S.Bt = (const char*)(a.ws + WS_WIN) + (size_t)layer * PC * 1024; S.rb = 1024;
            pg8::EpiI8 E{(bf16*)(a.ws + WS_P), PC, (const float*)(a.ws + WS_HSC), (const float*)(a.ws + WS_WSC) + (size_t)layer * PC}; pg8::gemm_phase<2>(lds, (const void*)(a.ws + WS_H), S, E); }
        else { pg8::SchedDense S; S.init(NR, PC, G, bid, (const bf16*)(a.ws + WS_WIN) + (size_t)layer * PC * 1024);
            pg8::EpiBf16 E{(bf16*)(a.ws + WS_P), PC}; pg8::gemm_phase<0>(lds, (const bf16*)(a.ws + WS_H), S, E); } }
    if constexpr (PH == PH_PREP) { if (PROBE_DOUBLE == 96) p_prep(a, layer, true); p_prep(a, layer); if (NEW_HG || NEW_ML) scan::p_scanA(a, layer, lds, NEW_HG, NEW_ML); if (PROBE_DOUBLE == 20) scan::p_scanA(a, layer, lds, NEW_HG, NEW_ML); }
    if constexpr (PH == PH_SCAN) { if (!NEW_HG || !NEW_ML) p_scan(a, layer, lds, !NEW_HG, !NEW_ML); if (NEW_HG || NEW_ML) scan::p_scanB(a, NEW_HG, NEW_ML); if (PROBE_DOUBLE == 21) scan::p_scanB(a, NEW_HG, NEW_ML); }
    if constexpr (PH == PH_ATTN) { if (NEW_HG || NEW_ML) scan::p_scanC(a, layer, lds, NEW_HG, NEW_ML); if (PROBE_DOUBLE == 22) scan::p_scanC(a, layer, lds, NEW_HG, NEW_ML); p_attn(a, layer, (LAS char*)lds); }
    if constexpr (PH == PH_FINISH) { if (!NEW_HG || !NEW_ML) p_finish(a, layer, !NEW_HG, !NEW_ML); }
    if constexpr (PH == PH_OUTPROJ) { pg8::SchedDense S; S.init(NR, DM, G, bid, nullptr); S.rb = OUTPROJ_FP8 ? 1024 : 2048; S.Bt = (const char*)(a.ws + WS_WOUT) + (size_t)layer * 1024 * S.rb;
        pg8::EpiResid E{a.in[0], a.in[2], (bf16*)(a.ws + WS_XB), (const float*)(a.ws + WS_MOD) + (size_t)layer * 9 * 6144, 2, layer == DEPTH - 1, layer == 0, OUTPROJ_FP8 ? 1.f / 1024.f : 1.f};
        pg8::gemm_phase<OUTPROJ_FP8 ? 1 : 0>(lds, (const void*)(a.ws + WS_Y), S, E); }
    if constexpr (PH == PH_ROUTER) p_router(a, layer, lds);
    if constexpr (PH == PH_DISPATCH) p_dispatch(a, layer, lds);
    if constexpr (PH == PH_GU) { constexpr int RBW = MOE_FP8 ? 1024 : 2048;
        pg8::SchedMoe S{G, bid, 8, 2048, __builtin_amdgcn_readfirstlane(__hip_atomic_load((const int*)(a.ws + WS_NRT), __ATOMIC_RELAXED, __HIP_MEMORY_SCOPE_AGENT)), (const int*)(a.ws + WS_TILEE),
                        (const char*)(a.ws + WS_WGU) + (size_t)layer * 32 * 2048 * RBW, (const int*)(a.ws + WS_TOK), RBW};
        pg8::EpiGU E{(void*)(a.ws + WS_ACT), a.in[19] + (size_t)layer * 32 * 2048};
        pg8::gemm_phase<MOE_FP8>(lds, MOE_FP8 ? (const void*)(a.ws + WS_H8) : (const void*)(a.ws + WS_H), S, E); }
    if constexpr (PH == PH_DOWN) { constexpr int RBW = MOE_FP8 ? 1024 : 2048;
        pg8::SchedMoe S{G, bid, 4, 1024, __builtin_amdgcn_readfirstlane(__hip_atomic_load((const int*)(a.ws + WS_NRT), __ATOMIC_RELAXED, __HIP_MEMORY_SCOPE_AGENT)), (const int*)(a.ws + WS_TILEE),
                        (const char*)(a.ws + WS_WDN) + (size_t)layer * 32 * 1024 * RBW, nullptr, RBW};
        pg8::EpiDown E{(bf16*)(a.ws + WS_YM), a.in[21] + (size_t)layer * 32 * 1024, (const float*)(a.ws + WS_GATEP)}; pg8::gemm_phase<MOE_FP8>(lds, (const void*)(a.ws + WS_ACT), S, E); }
    if constexpr (PH == PH_COMBINE) { if (PROBE_DOUBLE == 97) p_combine(a, layer, true); p_combine(a, layer); }
}

template <int PH>
__global__ void __launch_bounds__(NTHR, 2) k_phase(Args a, int layer) {
    extern __shared__ __attribute__((aligned(16))) unsigned char lds[];
    kernel_setup(a);
    run_phase<PH>(layer, lds);
}


__global__ void __launch_bounds__(NTHR, 2) k_mega(Args a) {
    extern __shared__ __attribute__((aligned(16))) unsigned char lds[];
    kernel_setup(a);
    const XcdBarrier bar = xcd_barrier_post((unsigned*)(a.ws + WS_CTL) + CW_BAR, (volatile LAS unsigned*)(MISC_OFF + 32));
#define GRID_BAR() do { for (int rep_ = 0; rep_ < (PROBE_DOUBLE == 99 ? 2 : 1); ++rep_) { const Args b_ = fetch_args(); XcdBarrier bb; bb.bar = (unsigned*)(b_.ws + WS_CTL) + CW_BAR; bb.x = xb_xcc_id(); bb.st = (volatile LAS unsigned*)(MISC_OFF + 32); xcd_barrier(bb); } } while (0)
    run_phase<PH_PRO>(0, lds); GRID_BAR();
    if (PROBE_DOUBLE == PH_PRO) { run_phase<PH_PRO>(0, lds); GRID_BAR(); }
    run_phase<PH_NORM1>(0, lds); GRID_BAR();
#define RUNP(PH, l) do { run_phase<PH>(l, lds); if (PROBE_DOUBLE == PH) { GRID_BAR(); run_phase<PH>(l, lds); } } while (0)
#define LAYER_BODY(l) do { \
        RUNP(PH_INPROJ, l); GRID_BAR(); \
        run_phase<PH_PREP>(l, lds); GRID_BAR(); \
        RUNP(PH_SCAN, l); GRID_BAR(); \
        RUNP(PH_ATTN, l); GRID_BAR(); \
        if (!NEW_HG || !NEW_ML) { RUNP(PH_FINISH, l); GRID_BAR(); } \
        run_phase<PH_OUTPROJ>(l, lds); GRID_BAR(); \
        if (PROBE_DOUBLE == 98 && (l) == 0) { run_phase<PH_OUTPROJ>(l, lds); GRID_BAR(); } \
        RUNP(PH_ROUTER, l); GRID_BAR(); \
        RUNP(PH_DISPATCH, l); GRID_BAR(); \
        RUNP(PH_GU, l); GRID_BAR(); \
        RUNP(PH_DOWN, l); GRID_BAR(); \
        run_phase<PH_COMBINE>(l, lds); \
        if ((l) + 1 < DEPTH) GRID_BAR(); \
    } while (0)
    LAYER_BODY(0); LAYER_BODY(1); LAYER_BODY(2); LAYER_BODY(3);
#undef LAYER_BODY
#undef RUNP
#undef GRID_BAR
}

template <int PH> static void launch_phase(const Args& a, int layer, int grid, hipStream_t stream) {
    static bool attr = false;
    if (!attr) { (void)hipFuncSetAttribute((const void*)k_phase<PH>, hipFuncAttributeMaxDynamicSharedMemorySize, LDS_BYTES); attr = true; }
    hipLaunchKernelGGL(k_phase<PH>, dim3(grid), dim3(NTHR), LDS_BYTES, stream, a, layer);
}

extern "C" void kernel_launch(void* const* d_in, const int* in_sizes, int n_in, void* d_out, int out_size, void* d_ws, size_t ws_size, hipStream_t stream) {
    static int grid = 0;
    if (grid == 0) {
        if (n_in != 22 || out_size != NB * SEQ * DM || ws_size < WS_END) { fprintf(stderr, "kernel_launch: unexpected shapes (n_in %d, out %d, ws %zu < %zu)\n", n_in, out_size, ws_size, (size_t)WS_END); grid = -1; return; }
        int dev = 0, cus = 0;
        if (hipGetDevice(&dev) != hipSuccess || hipDeviceGetAttribute(&cus, hipDeviceAttributeMultiprocessorCount, dev) != hipSuccess) { grid = -1; return; }
        grid = cus;
    }
    if (grid < 0) return;
    (void)hipMemsetAsync((char*)d_ws + WS_CTL, 0, CTL_ZERO_BYTES, stream);
    Args a{};
    for (int i = 0; i < 22; ++i) a.in[i] = (const float*)d_in[i];
    a.out = (float*)d_out; a.ws = (unsigned char*)d_ws; a.ph_lo = 0; a.ph_hi = 0;
#if MK_MULTI
    launch_phase<PH_PRO>(a, 0, grid, stream);
    launch_phase<PH_NORM1>(a, 0, grid, stream);
    for (int l = 0; l < DEPTH; ++l) {
        launch_phase<PH_INPROJ>(a, l, grid, stream);
        launch_phase<PH_PREP>(a, l, grid, stream);
        launch_phase<PH_SCAN>(a, l, grid, stream);
        launch_phase<PH_ATTN>(a, l, grid, stream);
        launch_phase<PH_FINISH>(a, l, grid, stream);
        launch_phase<PH_OUTPROJ>(a, l, grid, stream);
        launch_phase<PH_ROUTER>(a, l, grid, stream);
        launch_phase<PH_DISPATCH>(a, l, grid, stream);
        launch_phase<PH_GU>(a, l, grid, stream);
        launch_phase<PH_DOWN>(a, l, grid, stream);
        launch_phase<PH_COMBINE>(a, l, grid, stream);
    }
#else
    static bool attr = false;
    if (!attr) { (void)hipFuncSetAttribute((const void*)k_mega, hipFuncAttributeMaxDynamicSharedMemorySize, LDS_BYTES); attr = true; }
    hipLaunchKernelGGL(k_mega, dim3(grid), dim3(NTHR), LDS_BYTES, stream, a);
#endif
}
```

```cpp
#include <hip/hip_runtime.h>
#include <cstdio>
#include <cstdint>
#include <cmath>

#ifndef MK_MULTI
#define MK_MULTI 0
#endif
#ifndef MOE_FP8
#define MOE_FP8 1
#endif
#ifndef OUTPROJ_FP8
#define OUTPROJ_FP8 1
#endif
#ifndef INPROJ_I8
#define INPROJ_I8 1
#endif
#ifndef GEMM_ALIGN
#define GEMM_ALIGN 1
#endif
#ifndef NEW_HG
#define NEW_HG 1
#endif
#ifndef NEW_ML
#define NEW_ML 1
#endif
#ifndef PROBE_DOUBLE
#define PROBE_DOUBLE -1
#define L2PF 0
#define STAGGER_DOWN 0
#define PROBE_NOSTORE 0
#endif

#define GAS __attribute__((address_space(1)))
#define LAS __attribute__((address_space(3)))
typedef unsigned short bf16;
typedef short bf16x8 __attribute__((ext_vector_type(8)));
typedef short s16x4 __attribute__((ext_vector_type(4)));
typedef float f32x2 __attribute__((ext_vector_type(2)));
typedef float f32x4 __attribute__((ext_vector_type(4)));
typedef float f32x16 __attribute__((ext_vector_type(16)));
typedef unsigned u32x2 __attribute__((ext_vector_type(2)));
typedef unsigned u32x4 __attribute__((ext_vector_type(4)));
typedef __bf16 bf16x2_t __attribute__((ext_vector_type(2)));
typedef int v8i __attribute__((ext_vector_type(8)));
typedef int v4i __attribute__((ext_vector_type(4)));
typedef unsigned u32x8 __attribute__((ext_vector_type(8)));

constexpr int DM = 1024, NB = 8, SEQ = 4096, CTX = 256, SB = SEQ + CTX  , NR = NB * SB  , DEPTH = 4;
constexpr int PC = 3584;
constexpr int C_ATQ = 0, C_ATK = 512, C_ATV = 768, C_HGQ = 1024, C_HGZF = 1280, C_HGZB = 1536, C_HGV = 1792, C_HGG = 2048,
              C_MLQ = 2304, C_MLK = 2560, C_MLV = 2816, C_MLOG = 3072, C_MLG = 3328;
constexpr int NIN = 3344;
constexpr int NEXP = 32, NPOS = 147456;
constexpr float EPS = 1e-6f;
constexpr int NTHR = 512, NWAVE = 8;

constexpr size_t MiB = 1u << 20;
constexpr size_t WS_CTL = 0, CTL_ZERO_BYTES = 1 * MiB;
constexpr size_t WS_MOD = 1 * MiB;
constexpr size_t WS_ROPE = 2 * MiB;
constexpr size_t WS_WRH = 2 * MiB + 65536, WS_WRL = WS_WRH + 262144;
constexpr size_t WS_WSC = 2 * MiB + 655360;
constexpr size_t WS_HSC = 2 * MiB + 720896;
constexpr size_t WS_RE = 3 * MiB, WS_RS = WS_RE + 600000, WS_RG = WS_RS + 600000, WS_POS = WS_RG + 600000;
constexpr size_t WS_CNT = WS_POS + 600000;
constexpr size_t WS_TOK = 6 * MiB, WS_GATEP = WS_TOK + 600000, WS_TILEE = WS_GATEP + 600000, WS_NRT = WS_TILEE + 8192;
constexpr size_t WS_WIN = 8 * MiB;
constexpr size_t WS_WOUT = 36 * MiB;
constexpr size_t WS_WGU = 44 * MiB;
constexpr size_t WS_WDN = 556 * MiB;
constexpr size_t WS_H = 812 * MiB;
constexpr size_t WS_P = 880 * MiB;
constexpr size_t WS_Y = 1118 * MiB;
constexpr size_t WS_XC = 1186 * MiB;
constexpr size_t WS_ACT = 1194 * MiB;
constexpr size_t WS_YM = 1482 * MiB;
constexpr size_t WS_OH = 1770 * MiB;
constexpr size_t WS_OM = 1838 * MiB;
constexpr size_t WS_UTH = 1906 * MiB, WS_SPH = 1940 * MiB, WS_UTM = 1974 * MiB, WS_SPM = 2008 * MiB;
constexpr size_t WS_DT = 2042 * MiB, WS_NU = WS_DT + 1310720, WS_NP = WS_NU + 1310720, WS_GL = WS_NP + 1310720, WS_MP = WS_GL + 131072;
constexpr size_t WS_H8 = 2046 * MiB;
constexpr size_t WS_XB = 2080 * MiB;
constexpr size_t WS_END = 2148 * MiB;
static_assert(WS_CNT + 32768 <= WS_TOK && WS_NRT + 64 <= WS_WIN, "ws map");
static_assert((size_t)NR * 4 * 4 <= 600000 && (size_t)NPOS * 4 <= 600000, "ws map");

constexpr int CW_CMAX = 16384;
constexpr int CW_BAR = 4096;

constexpr int LDS_BYTES = 147456;
constexpr int PH_LDS = 143360;
constexpr int MISC_OFF = PH_LDS;

struct Args { const float* in[22]; float* out; unsigned char* ws; int ph_lo, ph_hi; };

#define LDS_WAIT() asm volatile("s_waitcnt lgkmcnt(0)" ::: "memory")
#define VM_WAIT() asm volatile("s_waitcnt vmcnt(0)" ::: "memory")

__device__ __forceinline__ unsigned pk2(float lo, float hi) { f32x2 v = {lo, hi}; bf16x2_t b = __builtin_convertvector(v, bf16x2_t); return __builtin_bit_cast(unsigned, b); }
__device__ __forceinline__ unsigned f2bf(float f) { return pk2(f, 0.f) & 0xffffu; }
__device__ __forceinline__ float clamp8(float x) { return fminf(fmaxf(x, -448.f), 448.f); }
__device__ __forceinline__ unsigned pk_fp8x4(float a, float b, float c, float d) {
    int w = 0; w = __builtin_amdgcn_cvt_pk_fp8_f32(clamp8(a), clamp8(b), w, false); w = __builtin_amdgcn_cvt_pk_fp8_f32(clamp8(c), clamp8(d), w, true); return (unsigned)w; }
__device__ __forceinline__ unsigned fp8_1(float a) { return pk_fp8x4(a, 0.f, 0.f, 0.f) & 0xffu; }
__device__ __forceinline__ float bf2f(unsigned h) { return __uint_as_float(h << 16); }
__device__ __forceinline__ float bflo(unsigned w) { return __uint_as_float(w << 16); }
__device__ __forceinline__ float bfhi(unsigned w) { return __uint_as_float(w & 0xffff0000u); }
__device__ __forceinline__ float row16_sum(float v) {
#define WS_DPP(x, ctrl, rmask) __builtin_bit_cast(float, __builtin_amdgcn_update_dpp(0, __builtin_bit_cast(int, x), ctrl, rmask, 0xF, false))
    v += WS_DPP(v, 0xB1, 0xF); v += WS_DPP(v, 0x4E, 0xF); v += WS_DPP(v, 0x141, 0xF); v += WS_DPP(v, 0x140, 0xF);
#undef WS_DPP
    return v;
}
__device__ __forceinline__ float wave_sum(float v) {
#define WS_DPP(x, ctrl, rmask) __builtin_bit_cast(float, __builtin_amdgcn_update_dpp(0, __builtin_bit_cast(int, x), ctrl, rmask, 0xF, false))
    v += WS_DPP(v, 0xB1, 0xF);
    v += WS_DPP(v, 0x4E, 0xF);
    v += WS_DPP(v, 0x141, 0xF);
    v += WS_DPP(v, 0x140, 0xF);
    v += WS_DPP(v, 0x142, 0xA);
    v += WS_DPP(v, 0x143, 0xC);
#undef WS_DPP
    return __builtin_bit_cast(float, __builtin_amdgcn_readlane(__builtin_bit_cast(int, v), 63));
}
__device__ __forceinline__ float wave_max_nn(float v) {
#define WS_DPP(x, ctrl, rmask) __builtin_bit_cast(float, __builtin_amdgcn_update_dpp(0, __builtin_bit_cast(int, x), ctrl, rmask, 0xF, false))
    v = fmaxf(v, WS_DPP(v, 0xB1, 0xF)); v = fmaxf(v, WS_DPP(v, 0x4E, 0xF)); v = fmaxf(v, WS_DPP(v, 0x141, 0xF)); v = fmaxf(v, WS_DPP(v, 0x140, 0xF));
    v = fmaxf(v, WS_DPP(v, 0x142, 0xA)); v = fmaxf(v, WS_DPP(v, 0x143, 0xC));
#undef WS_DPP
    return __builtin_bit_cast(float, __builtin_amdgcn_readlane(__builtin_bit_cast(int, v), 63));
}
__device__ __forceinline__ unsigned pk_i8x4(float a, float b, float c, float d) {
    const int q0 = __float2int_rn(a), q1 = __float2int_rn(b), q2 = __float2int_rn(c), q3 = __float2int_rn(d);
    return (unsigned)(q0 & 0xff) | ((unsigned)(q1 & 0xff) << 8) | ((unsigned)(q2 & 0xff) << 16) | ((unsigned)q3 << 24); }
__device__ __forceinline__ float sigm(float x) { return __builtin_amdgcn_rcpf(1.f + __expf(-x)); }


constexpr int ARGS_OFF = MISC_OFF + 256, WTAB_OFF = MISC_OFF + 512;
__device__ __forceinline__ unsigned hw_slot() { return (unsigned)__builtin_amdgcn_s_getreg((5 << 11) | 4) & 63u; }
__device__ __forceinline__ int lane_id(unsigned zo) { return (int)__builtin_amdgcn_mbcnt_hi(~0u, __builtin_amdgcn_mbcnt_lo(~0u, zo)); }
__device__ __forceinline__ int otid() {
    unsigned zo = 0; asm volatile("" : "+v"(zo));
    const int wave = __builtin_amdgcn_readfirstlane(*(const LAS int*)(WTAB_OFF + hw_slot() * 4 + zo));
    int t = wave * 64 + lane_id(zo); asm volatile("" : "+v"(t)); return t;
}
__device__ __forceinline__ int obid() { int b = blockIdx.x; asm volatile("" : "+s"(b)); return b; }
__device__ __forceinline__ int ogrid() { int g = gridDim.x; asm volatile("" : "+s"(g)); return g; }
__device__ __forceinline__ const void* lds_ptr64(int byte_off, unsigned zo) {
    const u32x2 w = *(const LAS u32x2*)(byte_off + zo);
    const unsigned lo = __builtin_amdgcn_readfirstlane(w.x), hi = __builtin_amdgcn_readfirstlane(w.y);
    return (const void*)(const GAS void*)(((unsigned long long)hi << 32) | lo);
}
__device__ __forceinline__ Args fetch_args() {
    unsigned zo = 0; asm volatile("" : "+v"(zo));
    Args r;
#pragma unroll
    for (int i = 0; i < 22; ++i) r.in[i] = (const float*)lds_ptr64(ARGS_OFF + 8 * i, zo);
    r.out = (float*)lds_ptr64(ARGS_OFF + 8 * 22, zo); r.ws = (unsigned char*)lds_ptr64(ARGS_OFF + 8 * 23, zo); r.ph_lo = 0; r.ph_hi = 0;
    return r;
}
__device__ __forceinline__ void kernel_setup(const Args& a) {
    const int tid = threadIdx.x;
    LAS unsigned* M = (LAS unsigned*)MISC_OFF;
    if (tid < 64) M[tid] = 0u;
    if (tid == 0) { LAS unsigned long long* A = (LAS unsigned long long*)ARGS_OFF;
#pragma unroll
        for (int i = 0; i < 22; ++i) A[i] = (unsigned long long)a.in[i];
        A[22] = (unsigned long long)a.out; A[23] = (unsigned long long)a.ws; }
    if ((tid & 63) == 0) *(LAS int*)(WTAB_OFF + hw_slot() * 4) = tid >> 6;
    __syncthreads();
}

__device__ __forceinline__ const float* x_rd(const Args& a, bool from_input, int r) {
    const int b = r / SB, s = r - b * SB;
    if (s < CTX) return (from_input ? a.in[2] : (const float*)(a.ws + WS_XC)) + (size_t)(b * CTX + s) * DM;
    return (from_input ? a.in[0] : (const float*)a.out) + (size_t)(b * SEQ + s - CTX) * DM;
}
__device__ __forceinline__ float* x_wr(const Args& a, int r) {
    const int b = r / SB, s = r - b * SB;
    if (s < CTX) return (float*)(a.ws + WS_XC) + (size_t)(b * CTX + s) * DM;
    return a.out + (size_t)(b * SEQ + s - CTX) * DM;
}
__device__ __forceinline__ const float* modv(const Args& a, int layer, int r, int chunk) {
    const int b = r / SB, s = r - b * SB; const int j = s < CTX ? 8 : b;
    return (const float*)(a.ws + WS_MOD) + ((size_t)(layer * 9 + j) * 6 + chunk) * DM;
}

#define XB_TMO      128
#define XB_XCNT(j)  (256  + 64 * (j))
#define XB_XSUB(j)  (1280 + 64 * (j))
#define XB_XGEN(j)  (2304 + 64 * (j))
#define XB_TOP      3328
#define XB_TOPGEN   3392
#define XCD_BAR_WORDS 3456
#define XB_SPIN_CAP (1u << 18)
__device__ __forceinline__ unsigned xb_ld(unsigned* p)              { return __hip_atomic_load(p, __ATOMIC_RELAXED, __HIP_MEMORY_SCOPE_AGENT); }
__device__ __forceinline__ unsigned xb_add(unsigned* p, unsigned v) { return __hip_atomic_fetch_add(p, v, __ATOMIC_RELAXED, __HIP_MEMORY_SCOPE_AGENT); }
__device__ __forceinline__ unsigned xb_xcc_id() { return (unsigned)__builtin_amdgcn_s_getreg((3 << 11) | 20) & 0xFu; }
#define XB_SPIN(cond, bar) do { unsigned _sp = 0; while (cond) { __builtin_amdgcn_s_sleep(1); \
    if ((++_sp & 255u) == 0u) { if (xb_ld(&(bar)[XB_TMO])) break; if (_sp > XB_SPIN_CAP) { atomicAdd(&(bar)[XB_TMO], 1u); break; } } } } while (0)
struct XcdBarrier { unsigned* bar; unsigned x; volatile LAS unsigned* st; };
__device__ __forceinline__ XcdBarrier xcd_barrier_post(unsigned* bar, volatile LAS unsigned* st) {
    XcdBarrier b; b.bar = bar; b.x = xb_xcc_id(); b.st = st;
    if (otid() == 0) (void)xb_add(&bar[XB_XCNT(b.x)], 1u);
    return b;
}
__device__ __forceinline__ void xcd_barrier_complete(unsigned* bar, unsigned x, unsigned& nloc, unsigned& nx) {
    const unsigned G = gridDim.x * gridDim.y * gridDim.z;
    unsigned sum, cnt, mine, sp = 0u;
    for (;;) {
        sum = 0u; cnt = 0u; mine = 0u;
#pragma unroll
        for (unsigned j = 0; j < 16; ++j) { const unsigned c = xb_ld(&bar[XB_XCNT(j)]); sum += c; cnt += (c > 0u) ? 1u : 0u; mine = (j == x) ? c : mine; }
        if (sum == G) break;
        __builtin_amdgcn_s_sleep(1);
        if ((++sp & 255u) == 0u) { if (xb_ld(&bar[XB_TMO])) break; if (sp > XB_SPIN_CAP) { atomicAdd(&bar[XB_TMO], 1u); break; } }
    }
    nloc = mine > 0u ? mine : 1u; nx = cnt > 0u ? cnt : 1u;
}
__device__ __forceinline__ void xcd_barrier(const XcdBarrier& b) {
    asm volatile("s_waitcnt vmcnt(0)" ::: "memory");
    __syncthreads();
    if (otid() == 0) {
        unsigned* bar = b.bar;
        __builtin_amdgcn_s_waitcnt(0);
        unsigned nloc = b.st[0], nx = b.st[1];
        if (nloc == 0u) { xcd_barrier_complete(bar, b.x, nloc, nx); b.st[0] = nloc; b.st[1] = nx; }
        const unsigned old = xb_add(&bar[XB_XSUB(b.x)], 1u);
        const unsigned gen = old / nloc;
        if (old + 1u == (gen + 1u) * nloc) {
            __builtin_amdgcn_fence(__ATOMIC_RELEASE, "agent");
            asm volatile("s_waitcnt vmcnt(0)" ::: "memory");
            const unsigned og = xb_add(&bar[XB_TOP], 1u);
            const unsigned tg = og / nx;
            if (og + 1u == (tg + 1u) * nx) xb_add(&bar[XB_TOPGEN], 1u);
            else XB_SPIN(xb_ld(&bar[XB_TOPGEN]) == tg, bar);
            __builtin_amdgcn_fence(__ATOMIC_ACQUIRE, "agent");
            xb_add(&bar[XB_XGEN(b.x)], 1u);
            asm volatile("s_waitcnt vmcnt(0)" ::: "memory");
        } else {
            XB_SPIN(xb_ld(&bar[XB_XGEN(b.x)]) == gen, bar);
            __builtin_amdgcn_fence(__ATOMIC_ACQUIRE, "agent");
            asm volatile("s_waitcnt vmcnt(0)" ::: "memory");
        }
    }
    __syncthreads();
}

__device__ __forceinline__ void glds16s2(const void* sbase, unsigned voff0, unsigned voff1, unsigned lds0, unsigned lds1) {
    unsigned keep;
    asm volatile("s_mov_b32 %0, m0\n\ts_mov_b32 m0, %4\n\ts_nop 0\n\tglobal_load_lds_dwordx4 %1, %3\n\ts_mov_b32 m0, %5\n\ts_nop 0\n\tglobal_load_lds_dwordx4 %2, %3\n\ts_mov_b32 m0, %0"
                 : "=&s"(keep) : "v"(voff0), "v"(voff1), "s"(sbase), "s"(lds0), "s"(lds1) : "memory");
}

__device__ __forceinline__ void glds16s1(const void* sbase, unsigned voff, unsigned lds0) {
    unsigned keep;
    asm volatile("s_mov_b32 %0, m0\n\ts_mov_b32 m0, %3\n\ts_nop 0\n\tglobal_load_lds_dwordx4 %1, %2\n\ts_mov_b32 m0, %0" : "=&s"(keep) : "v"(voff), "s"(sbase), "s"(lds0) : "memory");
}
__device__ __forceinline__ void glds4s1(const void* sbase, unsigned voff, unsigned lds0) {
    unsigned keep;
    asm volatile("s_mov_b32 %0, m0\n\ts_mov_b32 m0, %3\n\ts_nop 0\n\tglobal_load_lds_dword %1, %2\n\ts_mov_b32 m0, %0" : "=&s"(keep) : "v"(voff), "s"(sbase), "s"(lds0) : "memory");
}
struct AuxSrc { const void* base; unsigned off; };

namespace pg8 {
constexpr int BM = 256, BK = 64, HALF = 128, HTB = HALF * BK * 2, STAGE_BYTES = 8 * HTB, NXCD = 8, WGM = 8, K = 1024;
__host__ __device__ __forceinline__ int lds_byte(int r, int c) { const int st = (r >> 4) * 2 + (c >> 5), rr = r & 15, cc = c & 31, ob = rr * 64 + cc * 2; return st * 1024 + (ob ^ (((ob >> 9) & 1) << 5)); }
__host__ __device__ __forceinline__ void stage_rc(int b, int& R, int& C) { const int st = b / 1024, sb = b % 1024, swz = sb ^ (((sb >> 9) & 1) << 5); R = (st >> 1) * 16 + swz / 64; C = (st & 1) * 32 + (swz % 64) / 2; }
__host__ __device__ __forceinline__ int perm32(int rho) { const int n = rho >> 4, i = rho & 15; return 8 * (i >> 2) + 4 * n + (i & 3); }

struct Unit { int pm, pn, e; const char* Bt; };

struct SchedDense {
    int nM, nN, nwg, G, c, rb; const char* Bt;
    __device__ void init(int M, int N, int G_, int c_, const bf16* Bt_) { nM = M / BM; nN = N / BM; nwg = nM * nN; G = G_; c = c_; Bt = (const char*)Bt_; rb = 2 * K; }
    __device__ __forceinline__ bool next(int i, Unit& u) const {
        const long L = (long)i * G + c; if (L >= nwg) return false;
        int wgid = (int)L; { const int q = nwg / NXCD, r = nwg % NXCD, xcd = wgid % NXCD, off = wgid / NXCD; wgid = (xcd < r ? xcd * (q + 1) : r * (q + 1) + (xcd - r) * q) + off; }
        const int nig = WGM * nN, gid = wgid / nig, fm = gid * WGM, gsz = (nM - fm) < WGM ? (nM - fm) : WGM;
        u.pm = fm + ((wgid % nig) % gsz); u.pn = (wgid % nig) / gsz; u.e = 0; u.Bt = Bt + (size_t)u.pn * BM * rb; return true;
    }
    __device__ __forceinline__ int row(const Unit& u, int local) const { return u.pm * BM + local; }
    __device__ __forceinline__ bool tiledA() const { return false; }
};
struct SchedMoe {
    int G, c, nct, ntot, nrt; const int* tile_e; const char* WT; const int* tok; int rb  ; bool tiled; bool rev  ;
    __device__ __forceinline__ bool next(int i, Unit& u) const {
        int rt, pn;
        if ((G & 7) == 0) { const int x = c & 7, j = c >> 3, per = G >> 3, base = nrt >> 3, rem = nrt & 7;
            const int cnt = base + (x < rem ? 1 : 0), start = x * base + (x < rem ? x : rem), q = i * per + j;
            if (q >= cnt * nct) return false;
            const int rl = q / nct; pn = q - rl * nct; rt = start + (rev ? cnt - 1 - rl : rl); }
        else { const int L = i * G + c; if (L >= nrt * nct) return false; rt = L / nct; pn = L - rt * nct; }
        u.pm = rt; u.pn = pn; u.e = __builtin_amdgcn_readfirstlane(__hip_atomic_load(tile_e + rt, __ATOMIC_RELAXED, __HIP_MEMORY_SCOPE_AGENT));
        u.Bt = WT + ((size_t)u.e * ntot + (size_t)u.pn * BM) * rb; return true;
    }
    __device__ __forceinline__ int row(const Unit& u, int local) const { return tok ? tok[u.pm * BM + local] : u.pm * BM + local; }
    __device__ __forceinline__ bool tiledA() const { return tiled; }
};

template <int MODE  , class Epi, class Sched>
__device__ __forceinline__ void gemm_phase(LAS unsigned char* lds, const void* Abase, const Sched& S, const Epi& E) {
    const int tid = otid(), wid = __builtin_amdgcn_readfirstlane(tid >> 6), lane = tid & 63, wr = wid >> 2, wc = wid & 3, fr = lane & 15, fq = lane >> 4;
    constexpr bool FP8 = (MODE == 1), I8 = (MODE == 2);
    constexpr int RB = MODE ? K : 2 * K;
    constexpr int nt = RB / 128;
    int R0, C0; stage_rc(tid * 16, R0, C0);
    constexpr bool TB = (MODE != 0);
    static_assert(!TB || Epi::PERM, "staging-order weights assume the permuted column order");
    const unsigned voffB0 = TB ? (unsigned)tid * 16u : (unsigned)((Epi::PERM ? ((R0 & ~31) + perm32(R0 & 31)) : R0) * RB + C0 * 2);
    constexpr size_t kstep = (size_t)(BK * 2);
    const size_t kstepA = S.tiledA() ? (size_t)32768 : kstep;
    constexpr size_t kstepB = TB ? (size_t)32768 : kstep;
    constexpr size_t hstep = TB ? (size_t)16384 : (size_t)HALF * RB;
    const unsigned ldsw = (unsigned)wid * 1024u, ldsb = (unsigned)(size_t)lds;
    const int aoff = lds_byte(wr * 64 + fr, fq * 8), boff = lds_byte(wc * 32 + fr, fq * 8);
    const char* Ab = (const char*)Abase;
    LAS u32x4* nslot = (LAS u32x4*)(lds + STAGE_BYTES + tid * 16);
    constexpr int AUX_OFF = STAGE_BYTES + 8192;
#define PG8_AUX(u, idx) do { if (wid < 2) { const AuxSrc s_ = E.aux(wid, u, lane); if (s_.base) glds16s1(s_.base, s_.off, ldsb + (unsigned)(AUX_OFF + ((idx) & 1) * 2048 + wid * 1024)); } } while (0)
#define PG8_SA(b, h) (((b) * 2 + (h)) * HTB)
#define PG8_SB(b, h) ((4 + (b) * 2 + (h)) * HTB)
#define PG8_STAGEA(bufoff, gbase, voff) glds16s2((gbase), (voff)[0], (voff)[1], ldsb + (unsigned)(bufoff) + ldsw, ldsb + (unsigned)(bufoff) + ldsw + 8192u)
#define PG8_STAGEB(bufoff, gbase) glds16s2((gbase), voffB0, voffB0 + (unsigned)(TB ? 8192 : 64 * RB), ldsb + (unsigned)(bufoff) + ldsw, ldsb + (unsigned)(bufoff) + ldsw + 8192u)
#define PG8_LDA(dst, b, h) do { if constexpr (FP8) { _Pragma("unroll") for (int m = 0; m < 4; ++m) { dst##8[m].lo = *(const LAS u32x4*)(lds + PG8_SA(b, h) + aoff + m * 2048); dst##8[m].hi = *(const LAS u32x4*)(lds + PG8_SA(b, h) + aoff + m * 2048 + 1024); } } \
    else { _Pragma("unroll") for (int m = 0; m < 4; ++m) _Pragma("unroll") for (int k = 0; k < 2; ++k) dst[m][k] = *(const LAS bf16x8*)(lds + PG8_SA(b, h) + aoff + m * 2048 + k * 1024); } } while (0)
#define PG8_LDB(dst, b, h) do { if constexpr (FP8) { _Pragma("unroll") for (int n = 0; n < 2; ++n) { dst##8[n].lo = *(const LAS u32x4*)(lds + PG8_SB(b, h) + boff + n * 2048); dst##8[n].hi = *(const LAS u32x4*)(lds + PG8_SB(b, h) + boff + n * 2048 + 1024); } } \
    else { _Pragma("unroll") for (int n = 0; n < 2; ++n) _Pragma("unroll") for (int k = 0; k < 2; ++k) dst[n][k] = *(const LAS bf16x8*)(lds + PG8_SB(b, h) + boff + n * 2048 + k * 1024); } } while (0)
#define PG8_MMA(ai, bj, At, Bt) do { __builtin_amdgcn_s_setprio(1); if constexpr (FP8) { _Pragma("unroll") for (int m = 0; m < 4; ++m) _Pragma("unroll") for (int n = 0; n < 2; ++n) \
        acc[ai][bj][m][n] = __builtin_amdgcn_mfma_scale_f32_16x16x128_f8f6f4(__builtin_bit_cast(v8i, Bt##8[n]), __builtin_bit_cast(v8i, At##8[m]), acc[ai][bj][m][n], 0, 0, 0, 0x7f7f7f7f, 0, 0x7f7f7f7f); } \
        else if constexpr (I8) { _Pragma("unroll") for (int m = 0; m < 4; ++m) _Pragma("unroll") for (int n = 0; n < 2; ++n) _Pragma("unroll") for (int k = 0; k < 2; ++k) \
        acc[ai][bj][m][n] = __builtin_bit_cast(f32x4, __builtin_amdgcn_mfma_i32_16x16x64_i8(__builtin_bit_cast(v4i, Bt[n][k]), __builtin_bit_cast(v4i, At[m][k]), __builtin_bit_cast(v4i, acc[ai][bj][m][n]), 0, 0, 0)); } \
        else { _Pragma("unroll") for (int m = 0; m < 4; ++m) _Pragma("unroll") for (int n = 0; n < 2; ++n) _Pragma("unroll") for (int k = 0; k < 2; ++k) \
        acc[ai][bj][m][n] = __builtin_amdgcn_mfma_f32_16x16x32_bf16(Bt[n][k], At[m][k], acc[ai][bj][m][n], 0, 0, 0); } __builtin_amdgcn_s_setprio(0); } while (0)
#define PG8_WAIT_V(n) asm volatile("s_waitcnt vmcnt(" #n ")" ::: "memory")
#define PG8_WAIT_L(n) asm volatile("s_waitcnt lgkmcnt(" #n ")" ::: "memory")
#define PG8_BAR __builtin_amdgcn_s_barrier()
#define PG8_SCHED __builtin_amdgcn_sched_barrier(0)
#define PG8_VAOFF(u, h, i) (S.tiledA() ? (unsigned)((u).pm * 262144 + (((((h) * 4 + (R0 >> 4)) * 2 + (i)) * 4 + (C0 >> 4)) * 512) + ((R0 & 15) * 4 + ((C0 >> 2) & 3)) * 8) \
                                       : (unsigned)(S.row(u, (h) * HALF + R0 + 64 * (i)) * RB + C0 * 2))
    Unit cur, nxt; int ui = 0;
    if (!S.next(0, cur)) return;
    f32x4 acc[2][2][4][2];
#pragma unroll
    for (int a = 0; a < 2; ++a)
#pragma unroll
        for (int b = 0; b < 2; ++b)
#pragma unroll
            for (int m = 0; m < 4; ++m)
#pragma unroll
                for (int n = 0; n < 2; ++n) acc[a][b][m][n] = (f32x4){0.f, 0.f, 0.f, 0.f};
    bf16x8 At[4][2], B0[2][2], B1[2][2];
    u32x8 At8[4], B08[2], B18[2];
    unsigned vA[2][2];
#pragma unroll
    for (int h = 0; h < 2; ++h)
#pragma unroll
        for (int i = 0; i < 2; ++i) vA[h][i] = PG8_VAOFF(cur, h, i);
    const char* cB = cur.Bt;
    PG8_AUX(cur, 0);
    PG8_STAGEB(PG8_SB(0, 0), cB); PG8_STAGEB(PG8_SB(0, 1), cB + hstep); PG8_STAGEA(PG8_SA(0, 0), Ab, vA[0]); PG8_STAGEA(PG8_SA(0, 1), Ab, vA[1]);
    if (wr == 1) PG8_BAR;
    PG8_WAIT_V(2); PG8_BAR;
    PG8_STAGEB(PG8_SB(1, 0), cB + kstepB); PG8_STAGEA(PG8_SA(1, 0), Ab + kstepA, vA[0]); PG8_STAGEB(PG8_SB(1, 1), cB + hstep + kstepB);
    PG8_WAIT_V(6); PG8_BAR;
    for (;;) {
        const bool has_next = S.next(ui + 1, nxt);
        if (has_next) *nslot = (u32x4){PG8_VAOFF(nxt, 0, 0), PG8_VAOFF(nxt, 0, 1), PG8_VAOFF(nxt, 1, 0), PG8_VAOFF(nxt, 1, 1)};
        const char* nB = has_next ? nxt.Bt : cB;
#pragma unroll 1
        for (int t = 0; t < nt; t += 2) {
            const bool last = (t == nt - 2);
            const char* a1 = Ab + (size_t)(t + 1) * kstepA;
            const char* a2 = last ? Ab : Ab + (size_t)(t + 2) * kstepA; const char* b2 = last ? nB : cB + (size_t)(t + 2) * kstepB;
            const char* a3 = a2 + kstepA; const char* b3 = b2 + kstepB;
            PG8_LDB(B0, 0, 0); PG8_LDB(B1, 0, 1); PG8_SCHED; PG8_LDA(At, 0, 0); PG8_STAGEA(PG8_SA(1, 1), a1, vA[1]);
            if (last && has_next) { const u32x4 nv = *nslot; vA[0][0] = nv.x; vA[0][1] = nv.y; vA[1][0] = nv.z; vA[1][1] = nv.w; }
            PG8_WAIT_V(8); PG8_WAIT_L(0); PG8_BAR; PG8_MMA(0, 0, At, B0); PG8_MMA(0, 1, At, B1); PG8_BAR; PG8_SCHED;
            PG8_LDA(At, 0, 1); PG8_STAGEB(PG8_SB(0, 0), b2); PG8_STAGEB(PG8_SB(0, 1), b2 + hstep); PG8_STAGEA(PG8_SA(0, 0), a2, vA[0]);
            PG8_WAIT_V(8); PG8_WAIT_L(0); PG8_BAR; PG8_MMA(1, 0, At, B0); PG8_MMA(1, 1, At, B1); PG8_BAR; PG8_SCHED;
            PG8_LDB(B0, 1, 0); PG8_LDB(B1, 1, 1); PG8_SCHED; PG8_LDA(At, 1, 0); PG8_STAGEA(PG8_SA(0, 1), a2, vA[1]);
            PG8_WAIT_V(8); PG8_WAIT_L(0); PG8_BAR; PG8_MMA(0, 0, At, B0); PG8_MMA(0, 1, At, B1); PG8_BAR; PG8_SCHED;
            PG8_LDA(At, 1, 1); PG8_STAGEB(PG8_SB(1, 0), b3); PG8_STAGEB(PG8_SB(1, 1), b3 + hstep); PG8_STAGEA(PG8_SA(1, 0), a3, vA[0]);
            PG8_WAIT_V(8); PG8_WAIT_L(0); PG8_BAR; PG8_MMA(1, 0, At, B0); PG8_MMA(1, 1, At, B1); PG8_BAR; PG8_SCHED;
        }
        if (GEMM_ALIGN && wr == 0) PG8_BAR;
        if constexpr (L2PF && MODE != 0) { if (has_next) {
            const int sa = nxt.pn & 3, sb = nxt.pm & 3;
            const unsigned oA = (sa == 0 ? vA[0][0] : sa == 1 ? vA[0][1] : sa == 2 ? vA[1][0] : vA[1][1]) + (unsigned)C0 * 14u;
            const unsigned oB = voffB0 + (unsigned)((sb & 1) * 64 * RB) + (unsigned)((sb >> 1) * (int)hstep) + (unsigned)C0 * 14u;
            const unsigned pfd = (unsigned)(MISC_OFF + 2048) + (unsigned)wid * 256u;
            glds4s1(Ab, oA, pfd); glds4s1(nB, oB, pfd); } }
        { int fr_ = fr, fq_ = fq; asm volatile("" : "+v"(fr_), "+v"(fq_));
          if (!E.skip()) E(acc, cur, wr, wc, fr_, fq_, (const LAS float*)(lds + AUX_OFF + (ui & 1) * 2048), (const LAS float*)(lds + AUX_OFF + (ui & 1) * 2048 + 1024)); }
        if (!has_next) break;
#pragma unroll
        for (int a = 0; a < 2; ++a)
#pragma unroll
            for (int b = 0; b < 2; ++b)
#pragma unroll
                for (int m = 0; m < 4; ++m)
#pragma unroll
                    for (int n = 0; n < 2; ++n) acc[a][b][m][n] = (f32x4){0.f, 0.f, 0.f, 0.f};
        cur = nxt; cB = nB; ++ui;
        PG8_AUX(cur, ui);
        if (GEMM_ALIGN && wr == 1) PG8_BAR;
    }
    PG8_WAIT_V(0);
    if (!GEMM_ALIGN && wr == 0) PG8_BAR;
    PG8_BAR;
#undef PG8_SA
#undef PG8_SB
#undef PG8_STAGEA
#undef PG8_STAGEB
#undef PG8_LDA
#undef PG8_LDB
#undef PG8_MMA
#undef PG8_WAIT_V
#undef PG8_WAIT_L
#undef PG8_BAR
#undef PG8_SCHED
#undef PG8_VAOFF
#undef PG8_AUX
}

struct EpiBf16 {
    static constexpr bool PERM = true;
    bf16* O; int ldc;
    __device__ __forceinline__ bool skip() const { return false; }
    __device__ __forceinline__ AuxSrc aux(int, const Unit&, int) const { return AuxSrc{nullptr, 0u}; }
    __device__ __forceinline__ void operator()(const f32x4 (&acc)[2][2][4][2], const Unit& u, int wr, int wc, int fr, int fq, const LAS float*, const LAS float*) const {
        const int row0 = u.pm * BM + wr * 64 + fr, col0 = u.pn * BM + wc * 32 + 8 * fq;
#pragma unroll
        for (int ai = 0; ai < 2; ++ai)
#pragma unroll
            for (int m = 0; m < 4; ++m) { bf16* rowp = O + (size_t)(row0 + ai * HALF + m * 16) * ldc + col0;
#pragma unroll
                for (int bj = 0; bj < 2; ++bj) { const f32x4 v0 = acc[ai][bj][m][0], v1 = acc[ai][bj][m][1];
                    u32x4 w; w.x = pk2(v0[0], v0[1]); w.y = pk2(v0[2], v0[3]); w.z = pk2(v1[0], v1[1]); w.w = pk2(v1[2], v1[3]);
                    *(u32x4*)(rowp + bj * HALF) = w; } }
    }
};
struct EpiI8 {
    static constexpr bool PERM = true;
    bf16* O; int ldc; const float* hs; const float* ws; bool nost;
    __device__ __forceinline__ bool skip() const { return PROBE_NOSTORE == 2 && nost; }
    __device__ __forceinline__ AuxSrc aux(int which, const Unit& u, int lane) const { return which == 0 ? AuxSrc{ws + u.pn * BM, (unsigned)lane * 16u} : AuxSrc{hs + u.pm * BM, (unsigned)lane * 16u}; }
    __device__ __forceinline__ void operator()(const f32x4 (&acc)[2][2][4][2], const Unit& u, int wr, int wc, int fr, int fq, const LAS float* a0, const LAS float* a1) const {
        const int row0 = u.pm * BM + wr * 64 + fr, col0 = u.pn * BM + wc * 32 + 8 * fq;
        f32x4 wv[2][2];
#pragma unroll
        for (int bj = 0; bj < 2; ++bj)
#pragma unroll
            for (int n = 0; n < 2; ++n) wv[bj][n] = *(const LAS f32x4*)(a0 + wc * 32 + 8 * fq + bj * HALF + 4 * n);
#pragma unroll
        for (int ai = 0; ai < 2; ++ai)
#pragma unroll
            for (int m = 0; m < 4; ++m) { const int row = row0 + ai * HALF + m * 16; const float hr = a1[wr * 64 + fr + ai * HALF + m * 16]; bf16* rowp = O + (size_t)row * ldc + col0;
#pragma unroll
                for (int bj = 0; bj < 2; ++bj) { const f32x4 v0 = __builtin_convertvector(__builtin_bit_cast(v4i, acc[ai][bj][m][0]), f32x4) * hr * wv[bj][0], v1 = __builtin_convertvector(__builtin_bit_cast(v4i, acc[ai][bj][m][1]), f32x4) * hr * wv[bj][1];
                    u32x4 w; w.x = pk2(v0[0], v0[1]); w.y = pk2(v0[2], v0[3]); w.z = pk2(v1[0], v1[1]); w.w = pk2(v1[2], v1[3]);
                    if (!nost) *(u32x4*)(rowp + bj * HALF) = w; } }
    }
};
struct EpiResid {
    static constexpr bool PERM = true;
    const float* xin_lat; const float* xin_ctx; bf16* xb; const float* mod  ; int chunk; bool skip_ctx, first; float sc;
    __device__ __forceinline__ bool skip() const { return false; }
    __device__ __forceinline__ AuxSrc aux(int which, const Unit& u, int lane) const { const int b = u.pm / 17, j = u.pm - b * 17;
        return which == 0 ? AuxSrc{mod + (size_t)((j == 0 ? 8 : b) * 6 + chunk) * DM + u.pn * BM, (unsigned)lane * 16u} : AuxSrc{nullptr, 0u}; }
    __device__ __forceinline__ void operator()(const f32x4 (&acc)[2][2][4][2], const Unit& u, int wr, int wc, int fr, int fq, const LAS float* a0, const LAS float*) const {
        const int b = u.pm / 17, j = u.pm - b * 17; const bool isctx = (j == 0);
        if (isctx && skip_ctx) return;
        const float* xin = isctx ? xin_ctx + (size_t)b * CTX * DM : xin_lat + ((size_t)b * SEQ + (size_t)(j - 1) * 256) * DM;
        bf16* xt = xb + (size_t)u.pm * BM * DM;
        const int col0 = u.pn * BM + wc * 32 + 8 * fq;
        f32x4 gv[2][2];
#pragma unroll
        for (int bj = 0; bj < 2; ++bj)
#pragma unroll
            for (int n = 0; n < 2; ++n) gv[bj][n] = *(const LAS f32x4*)(a0 + wc * 32 + 8 * fq + bj * HALF + 4 * n) * sc;
#pragma unroll
        for (int ai = 0; ai < 2; ++ai)
#pragma unroll
            for (int m = 0; m < 4; ++m) { const size_t ro = (size_t)(ai * HALF + wr * 64 + m * 16 + fr) * DM;
#pragma unroll
                for (int bj = 0; bj < 2; ++bj) { const int c = col0 + bj * HALF; f32x4 x0, x1;
                    if (first) { x0 = *(const f32x4*)(xin + ro + c); x1 = *(const f32x4*)(xin + ro + c + 4); }
                    else { const u32x4 w = *(const u32x4*)(xt + ro + c); x0 = (f32x4){bflo(w.x), bfhi(w.x), bflo(w.y), bfhi(w.y)}; x1 = (f32x4){bflo(w.z), bfhi(w.z), bflo(w.w), bfhi(w.w)}; }
                    x0 = x0 + gv[bj][0] * acc[ai][bj][m][0]; x1 = x1 + gv[bj][1] * acc[ai][bj][m][1];
                    u32x4 o; o.x = pk2(x0[0], x0[1]); o.y = pk2(x0[2], x0[3]); o.z = pk2(x1[0], x1[1]); o.w = pk2(x1[2], x1[3]);
                    *(u32x4*)(xt + ro + c) = o; } }
    }
};
struct EpiGU {
    static constexpr bool PERM = true;
    void* ACT; const float* bgu  ; bool nost;
    __device__ __forceinline__ bool skip() const { return PROBE_NOSTORE == 2 && nost; }
    __device__ __forceinline__ AuxSrc aux(int which, const Unit& u, int lane) const {
        return which == 0 ? AuxSrc{bgu + (size_t)u.e * 2048 + u.pn * HALF, lane < 32 ? (unsigned)lane * 16u : 4096u + (unsigned)(lane - 32) * 16u} : AuxSrc{nullptr, 0u}; }
    __device__ __forceinline__ void operator()(const f32x4 (&acc)[2][2][4][2], const Unit& u, int wr, int wc, int fr, int fq, const LAS float* a0, const LAS float*) const {
        const int row0 = u.pm * BM + wr * 64 + fr, col0 = u.pn * HALF + wc * 32 + 8 * fq;
        constexpr float SC = MOE_FP8 ? 1.f / 512.f : 1.f;
        f32x4 bgv[2], buv[2];
#pragma unroll
        for (int n = 0; n < 2; ++n) { bgv[n] = *(const LAS f32x4*)(a0 + wc * 32 + 8 * fq + 4 * n); buv[n] = *(const LAS f32x4*)(a0 + HALF + wc * 32 + 8 * fq + 4 * n); }
#pragma unroll
        for (int ai = 0; ai < 2; ++ai)
#pragma unroll
            for (int m = 0; m < 4; ++m) { float o[8];
#pragma unroll
                for (int n = 0; n < 2; ++n)
#pragma unroll
                    for (int i = 0; i < 4; ++i) { float gt = acc[ai][0][m][n][i] * SC + bgv[n][i], up = acc[ai][1][m][n][i] * SC + buv[n][i];
                        gt = fminf(gt, 7.f); up = fminf(fmaxf(up, -7.f), 7.f);
                        o[4 * n + i] = (up + 1.f) * gt * sigm(1.702f * gt); }
                const size_t eo = MOE_FP8 ? (size_t)(u.pm * 8 + u.pn) * 32768 + (size_t)(((((ai * 4 + m) * 2 + wr) * 4 + wc) * 512) + (fr * 4 + fq) * 8)
                                          : (size_t)(row0 + ai * HALF + m * 16) * DM + col0;
                if constexpr (MOE_FP8) { u32x2 w; w.x = pk_fp8x4(4.f * o[0], 4.f * o[1], 4.f * o[2], 4.f * o[3]); w.y = pk_fp8x4(4.f * o[4], 4.f * o[5], 4.f * o[6], 4.f * o[7]);
                    if (!nost) *(u32x2*)((unsigned char*)ACT + eo) = w; }
                else { u32x4 w; w.x = pk2(o[0], o[1]); w.y = pk2(o[2], o[3]); w.z = pk2(o[4], o[5]); w.w = pk2(o[6], o[7]); *(u32x4*)((bf16*)ACT + eo) = w; } }
    }
};
struct EpiDown {
    static constexpr bool PERM = true;
    bf16* YM; const float* bdn  ; const float* gatep; bool nost;
    __device__ __forceinline__ bool skip() const { return PROBE_NOSTORE == 2 && nost; }
    __device__ __forceinline__ AuxSrc aux(int which, const Unit& u, int lane) const {
        return which == 0 ? AuxSrc{bdn + (size_t)u.e * 1024 + u.pn * BM, (unsigned)lane * 16u} : AuxSrc{gatep + (size_t)u.pm * BM, (unsigned)lane * 16u}; }
    __device__ __forceinline__ void operator()(const f32x4 (&acc)[2][2][4][2], const Unit& u, int wr, int wc, int fr, int fq, const LAS float* a0, const LAS float* a1) const {
        const int row0 = u.pm * BM + wr * 64 + fr, col0 = u.pn * BM + wc * 32 + 8 * fq;
        constexpr float SC = MOE_FP8 ? 1.f / 256.f : 1.f;
        f32x4 bv[2][2];
#pragma unroll
        for (int bj = 0; bj < 2; ++bj)
#pragma unroll
            for (int n = 0; n < 2; ++n) bv[bj][n] = *(const LAS f32x4*)(a0 + wc * 32 + 8 * fq + bj * HALF + 4 * n);
#pragma unroll
        for (int ai = 0; ai < 2; ++ai)
#pragma unroll
            for (int m = 0; m < 4; ++m) { const int row = row0 + ai * HALF + m * 16; const float gt = a1[wr * 64 + fr + ai * HALF + m * 16]; bf16* rowp = YM + (size_t)row * DM + col0;
#pragma unroll
                for (int bj = 0; bj < 2; ++bj) { const f32x4 v0 = (acc[ai][bj][m][0] * SC + bv[bj][0]) * gt, v1 = (acc[ai][bj][m][1] * SC + bv[bj][1]) * gt;
                    u32x4 w; w.x = pk2(v0[0], v0[1]); w.y = pk2(v0[2], v0[3]); w.z = pk2(v1[0], v1[1]); w.w = pk2(v1[2], v1[3]);
                    if (!nost) *(u32x4*)(rowp + bj * HALF) = w; } }
    }
};
}

namespace att {
constexpr int D = 128, NW = 8, QBLK = 32, KVBLK = 64;
constexpr float SCALE = 0.088388347648318440f;
constexpr float THR = 8.f;
constexpr int LDQ = PC, LDK = PC, LDO = DM;
constexpr size_t SHM_V = KVBLK * D * 2, SHM_K = KVBLK * D * 2, SHM_ATTN = 2 * SHM_V + 2 * SHM_K + NW * 64 * 4;
#define KSWZ(row, colB) ((row) * 256 + ((colB) ^ (((row) & 15) << 4)))
#define SBAR() __builtin_amdgcn_sched_barrier(0)
__device__ __forceinline__ int crow(int r, int hi) { return (r & 3) + 8 * (r >> 2) + 4 * hi; }
__device__ __forceinline__ unsigned cvtpk(float lo, float hi) { unsigned r; asm volatile("v_cvt_pk_bf16_f32 %0, %1, %2" : "=v"(r) : "v"(lo), "v"(hi)); return r; }
__device__ __forceinline__ bf16x8 ld8(const bf16* p) { return *reinterpret_cast<const bf16x8*>(p); }
__device__ __forceinline__ void finishSM(f32x16& p0, f32x16& p1, float& l_reg, bf16x8& pa0, bf16x8& pa1, bf16x8& pa2, bf16x8& pa3) {
  for (int r = 0; r < 16; ++r) p1[r] = __builtin_amdgcn_exp2f(p1[r]);
  float ps = 0; for (int r = 0; r < 16; ++r) ps += p0[r]; for (int r = 0; r < 16; ++r) ps += p1[r];
  { auto rr = __builtin_amdgcn_permlane32_swap(__float_as_uint(ps), __float_as_uint(ps), false, false);
    ps = __uint_as_float(rr[0]) + __uint_as_float(rr[1]); }
  l_reg += ps;
#define PK4(P, BASE, OUT) do { unsigned a0 = cvtpk(P[BASE + 0], P[BASE + 1]), a1 = cvtpk(P[BASE + 2], P[BASE + 3]);   \
    unsigned b0 = cvtpk(P[BASE + 4], P[BASE + 5]), b1 = cvtpk(P[BASE + 6], P[BASE + 7]);                              \
    auto r0 = __builtin_amdgcn_permlane32_swap(a0, b0, false, false); auto r1 = __builtin_amdgcn_permlane32_swap(a1, b1, false, false); \
    u32x4 w = {r0[0], r1[0], r0[1], r1[1]}; OUT = *reinterpret_cast<bf16x8*>(&w); } while (0)
  PK4(p0, 0, pa0); PK4(p0, 8, pa1); PK4(p1, 0, pa2); PK4(p1, 8, pa3);
#undef PK4
}
__device__ __forceinline__ void qkt(f32x16& p0, f32x16& p1, const LAS char* Ks, const bf16x8* qr, int r32, int hi, float negm) {
#pragma unroll
  for (int r = 0; r < 16; ++r) { p0[r] = negm; p1[r] = negm; }
  for (int d0 = 0; d0 < 8; ++d0) { int cb = (d0 * 16 + hi * 8) * 2;
    bf16x8 b0 = *reinterpret_cast<const LAS bf16x8*>(Ks + KSWZ(r32, cb));
    bf16x8 b1 = *reinterpret_cast<const LAS bf16x8*>(Ks + KSWZ(32 + r32, cb));
    p0 = __builtin_amdgcn_mfma_f32_32x32x16_bf16(b0, qr[d0], p0, 0, 0, 0);
    p1 = __builtin_amdgcn_mfma_f32_32x32x16_bf16(b1, qr[d0], p1, 0, 0, 0); }
}
__device__ __forceinline__ void partialSM_fix(f32x16& p0) { for (int r = 0; r < 16; ++r) p0[r] = __builtin_amdgcn_exp2f(p0[r]); }
__device__ __forceinline__ int v_st(int k, int c) { const int kk = (k & ~0xC) | ((k & 4) << 1) | ((k & 8) >> 1); return ((kk >> 3) * 4 + (c >> 5)) * 512 + ((kk & 7) * 32 + (c & 31)) * 2; }
__device__ __forceinline__ int v_rd_base(int lane) { return ((lane & 3) << 3) | (((lane >> 2) & 3) << 6) | (((lane >> 4) & 1) << 5) | (((lane >> 5) & 1) << 8); }
constexpr int v_rd_off(int d0, int ks, int half) { return d0 * 512 + ks * 4096 + half * 2048; }
template <int OFF> __device__ __forceinline__ s16x4 tr_read(int vb) {
  s16x4 r; asm volatile("ds_read_b64_tr_b16 %0, %1 offset:%2" : "=&v"(r) : "v"(vb), "i"(OFF) : "memory"); return r;
}
template <int D0> __device__ __forceinline__ void pv_one(f32x16& od, int vb, bf16x8 pa0, bf16x8 pa1, bf16x8 pa2, bf16x8 pa3) {
  const s16x4 l0 = tr_read<v_rd_off(D0, 0, 0)>(vb), h0 = tr_read<v_rd_off(D0, 0, 1)>(vb), l1 = tr_read<v_rd_off(D0, 1, 0)>(vb), h1 = tr_read<v_rd_off(D0, 1, 1)>(vb);
  const s16x4 l2 = tr_read<v_rd_off(D0, 2, 0)>(vb), h2 = tr_read<v_rd_off(D0, 2, 1)>(vb), l3 = tr_read<v_rd_off(D0, 3, 0)>(vb), h3 = tr_read<v_rd_off(D0, 3, 1)>(vb);
  asm volatile("s_waitcnt lgkmcnt(0)" ::: "memory"); SBAR();
#define PK(L, H) (bf16x8){L[0], L[1], L[2], L[3], H[0], H[1], H[2], H[3]}
  od = __builtin_amdgcn_mfma_f32_32x32x16_bf16(pa0, PK(l0, h0), od, 0, 0, 0);
  od = __builtin_amdgcn_mfma_f32_32x32x16_bf16(pa1, PK(l1, h1), od, 0, 0, 0);
  od = __builtin_amdgcn_mfma_f32_32x32x16_bf16(pa2, PK(l2, h2), od, 0, 0, 0);
  od = __builtin_amdgcn_mfma_f32_32x32x16_bf16(pa3, PK(l3, h3), od, 0, 0, 0);
#undef PK
}
__device__ __forceinline__ void pv_d0(f32x16* o, int vb, bf16x8 pa0, bf16x8 pa1, bf16x8 pa2, bf16x8 pa3) {
  pv_one<0>(o[0], vb, pa0, pa1, pa2, pa3); pv_one<1>(o[1], vb, pa0, pa1, pa2, pa3); pv_one<2>(o[2], vb, pa0, pa1, pa2, pa3); pv_one<3>(o[3], vb, pa0, pa1, pa2, pa3);
}
__device__ __forceinline__ void attn_dense_body(const bf16* __restrict__ Qb, const bf16* __restrict__ Kh, const bf16* __restrict__ Vh, bf16* __restrict__ Ob, int seq, LAS char* lds,
                                                const float* __restrict__ qg, const float* __restrict__ ropet, int t0, float negm_u, int exactmax) {
  const int tid = otid(), wid = tid >> 6, lane = tid & 63, r32 = lane & 31, hi = lane >> 5;
  LAS char* V_lds = lds; LAS char* K_lds = lds + 2 * SHM_V;
  LAS float* ws = (LAS float*)(lds + 2 * SHM_V + 2 * SHM_K) + wid * 64; LAS float* li_l = ws;
  float l_reg = 0; f32x16 o[4] = {}; bf16x8 qr[8];
  const bf16* Qw = Qb + (long)(wid * QBLK + r32) * LDQ + hi * 8;
#pragma unroll
  for (int d0 = 0; d0 < 8; ++d0) qr[d0] = ld8(Qw + d0 * 16);
  { float x[8][8]; float ss = 0.f;
#pragma unroll
    for (int d0 = 0; d0 < 8; ++d0) { const u32x4 w = __builtin_bit_cast(u32x4, qr[d0]);
#pragma unroll
      for (int p = 0; p < 4; ++p) { x[d0][2 * p] = bflo(w[p]); x[d0][2 * p + 1] = bfhi(w[p]); ss += x[d0][2 * p] * x[d0][2 * p] + x[d0][2 * p + 1] * x[d0][2 * p + 1]; } }
    { auto rr = __builtin_amdgcn_permlane32_swap(__float_as_uint(ss), __float_as_uint(ss), false, false); ss = __uint_as_float(rr[0]) + __uint_as_float(rr[1]); }
    const float rstd = __builtin_amdgcn_rsqf(ss * (1.f / 128.f) + EPS) * (SCALE * 1.4426950408889634f);
#pragma unroll
    for (int d0 = 0; d0 < 8; ++d0) { const f32x4 g0 = *(const f32x4*)(qg + 16 * d0 + 8 * hi), g1 = *(const f32x4*)(qg + 16 * d0 + 8 * hi + 4);
#pragma unroll
      for (int j = 0; j < 4; ++j) { x[d0][j] *= rstd * g0[j]; x[d0][4 + j] *= rstd * g1[j]; } }
    if (t0 >= 0) { const int t = t0 + wid * QBLK + r32;
#pragma unroll
      for (int kind = 0; kind < 2; ++kind) { const int pos = kind == 0 ? (t >> 6) : (t & 63);
#pragma unroll
        for (int e = 0; e < 2; ++e) { const float* cp = ropet + pos * 32 + 16 * e + 8 * hi;
          const f32x4 c0 = *(const f32x4*)cp, c1 = *(const f32x4*)(cp + 4), s0 = *(const f32x4*)(cp + 2048), s1 = *(const f32x4*)(cp + 2048 + 4);
#pragma unroll
          for (int j = 0; j < 8; ++j) { const float cs = j < 4 ? c0[j & 3] : c1[j & 3], sn = j < 4 ? s0[j & 3] : s1[j & 3];
            const float a1 = x[4 * kind + e][j], a2 = x[4 * kind + 2 + e][j]; x[4 * kind + e][j] = a1 * cs - a2 * sn; x[4 * kind + 2 + e][j] = a2 * cs + a1 * sn; } } } }
#pragma unroll
    for (int d0 = 0; d0 < 8; ++d0) { u32x4 w; w.x = pk2(x[d0][0], x[d0][1]); w.y = pk2(x[d0][2], x[d0][3]); w.z = pk2(x[d0][4], x[d0][5]); w.w = pk2(x[d0][6], x[d0][7]); qr[d0] = __builtin_bit_cast(bf16x8, w); } }
  const int sr = tid >> 4, sc = (tid & 15) * 8, vst0 = v_st(sr, sc), vst1 = v_st(32 + sr, sc);
  const int vb0 = (int)(unsigned)(size_t)V_lds + v_rd_base(lane);
  const unsigned goff = (unsigned)(sr * LDK + sc) * 2u;
  const char* Kb0 = (const char*)Kh; const char* Vb0 = (const char*)Vh;
  const int NT = seq / KVBLK;
  float negm = negm_u;
  if (exactmax) {
    float mrow = -3.0e38f; f32x16 p0, p1;
    for (int j = 0; j < NT; ++j) { const size_t to_ = (size_t)j * KVBLK * LDK * 2;
      const bf16x8 k0 = *(const bf16x8*)(Kb0 + to_ + goff), k1 = *(const bf16x8*)(Kb0 + to_ + (size_t)32 * LDK * 2 + goff);
      __syncthreads();
      *(LAS bf16x8*)(K_lds + KSWZ(sr, sc * 2)) = k0; *(LAS bf16x8*)(K_lds + KSWZ(32 + sr, sc * 2)) = k1;
      __syncthreads();
      qkt(p0, p1, K_lds, qr, r32, hi, 0.f);
#pragma unroll
      for (int r = 0; r < 16; ++r) mrow = fmaxf(mrow, fmaxf(p0[r], p1[r])); }
    { auto rr = __builtin_amdgcn_permlane32_swap(__float_as_uint(mrow), __float_as_uint(mrow), false, false); mrow = fmaxf(__uint_as_float(rr[0]), __uint_as_float(rr[1])); }
    negm = -mrow; __syncthreads(); }
  struct { bf16x8 vs0, vs1, ks0, ks1; } sr_[1];
#define SLOAD(i, k0) do { const size_t to_ = (size_t)(k0) * LDK * 2; \
    sr_[i].vs0 = *(const bf16x8*)(Vb0 + to_ + goff); sr_[i].vs1 = *(const bf16x8*)(Vb0 + to_ + (size_t)32 * LDK * 2 + goff); \
    sr_[i].ks0 = *(const bf16x8*)(Kb0 + to_ + goff); sr_[i].ks1 = *(const bf16x8*)(Kb0 + to_ + (size_t)32 * LDK * 2 + goff); } while (0)
#define SWRITE(b, i) do { *(LAS bf16x8*)(V_lds + (b) * SHM_V + vst0) = sr_[i].vs0;          \
    *(LAS bf16x8*)(V_lds + (b) * SHM_V + vst1) = sr_[i].vs1; int kc = sc * 2;               \
    *(LAS bf16x8*)(K_lds + (b) * SHM_K + KSWZ(sr, kc)) = sr_[i].ks0;                       \
    *(LAS bf16x8*)(K_lds + (b) * SHM_K + KSWZ(32 + sr, kc)) = sr_[i].ks1; } while (0)
#define SWAIT() asm volatile("s_waitcnt vmcnt(0)" ::: "memory")
#define PSM(P0) do { for (int r_ = 0; r_ < 16; ++r_) P0[r_] = __builtin_amdgcn_exp2f(P0[r_]); } while (0)
  f32x16 pA0, pA1, pB0, pB1; bf16x8 pa0, pa1, pa2, pa3;
  constexpr int SE = 0, SO = 0;
  SLOAD(SE, 0); asm volatile("s_waitcnt vmcnt(0)" ::: "memory"); SWRITE(0, SE); __syncthreads();
  qkt(pA0, pA1, K_lds, qr, r32, hi, negm); PSM(pA0);
  SLOAD(SO, KVBLK);
  SWAIT(); SWRITE(1, SO); if (2 < NT) SLOAD(SE, 2 * KVBLK); __syncthreads();
  for (int j = 1; j + 1 < NT; j += 2) {
    SBAR(); qkt(pB0, pB1, K_lds + SHM_K, qr, r32, hi, negm);
    finishSM(pA0, pA1, l_reg, pa0, pa1, pa2, pa3); SBAR();
    pv_d0(o, vb0, pa0, pa1, pa2, pa3); PSM(pB0);
    __syncthreads(); SWAIT(); SWRITE(0, SE); SBAR(); SLOAD(SO, (j + 2) * KVBLK); SBAR();
    __syncthreads();
    SBAR(); qkt(pA0, pA1, K_lds, qr, r32, hi, negm);
    finishSM(pB0, pB1, l_reg, pa0, pa1, pa2, pa3); SBAR();
    pv_d0(o, vb0 + (int)SHM_V, pa0, pa1, pa2, pa3); PSM(pA0);
    __syncthreads(); SWAIT(); SWRITE(1, SO); SBAR(); if (j + 3 < NT) SLOAD(SE, (j + 3) * KVBLK); SBAR();
    __syncthreads();
  }
  SBAR(); qkt(pB0, pB1, K_lds + SHM_K, qr, r32, hi, negm);
  finishSM(pA0, pA1, l_reg, pa0, pa1, pa2, pa3); SBAR();
  pv_d0(o, vb0, pa0, pa1, pa2, pa3); PSM(pB0);
  __syncthreads();
  finishSM(pB0, pB1, l_reg, pa0, pa1, pa2, pa3); SBAR();
  pv_d0(o, vb0 + (int)SHM_V, pa0, pa1, pa2, pa3);
#undef PSM
  if (hi == 0) li_l[r32] = l_reg; asm volatile("s_waitcnt lgkmcnt(0)" ::: "memory");
  float rli[16];
#pragma unroll
  for (int r = 0; r < 16; ++r) rli[r] = __builtin_amdgcn_rcpf(li_l[crow(r, hi)]);
  bf16* Ow = Ob + (long)(wid * QBLK) * LDO;
#pragma unroll
  for (int r = 0; r < 16; ++r) { int orow = crow(r, hi);
    for (int d0 = 0; d0 < 4; ++d0) { if (OUTPROJ_FP8) ((unsigned char*)Ob)[(long)(wid * QBLK + orow) * LDO + d0 * 32 + r32] = (unsigned char)fp8_1(16.f * o[d0][r] * rli[r]); else Ow[(long)orow * LDO + d0 * 32 + r32] = (bf16)f2bf(o[d0][r] * rli[r]); } }
#undef SLOAD
#undef SWRITE
#undef SWAIT
}
}

enum { PH_PRO = 0, PH_NORM1 = 1, PH_INPROJ = 2, PH_PREP = 3, PH_SCAN = 4, PH_ATTN = 5, PH_FINISH = 6, PH_OUTPROJ = 7, PH_ROUTER = 8, PH_DISPATCH = 9, PH_GU = 10, PH_DOWN = 11, PH_COMBINE = 12, NPH = 13 };

struct MapIn  { __device__ __forceinline__ int operator()(int n) const { return n < 2320 ? n + 1024 : n - 2320; } };
struct MapId  { __device__ __forceinline__ int operator()(int n) const { return n; } };
struct MapGU  { __device__ __forceinline__ int operator()(int n) const { const int bj = n >> 10, w = n & 1023; return (w >> 7) * 256 + bj * 128 + (w & 127); } };
__device__ __forceinline__ size_t wt_off(int nrow, int kbyte) {
    const int ntile = nrow >> 8, nl = nrow & 255, h = nl >> 7, g = nl & 127, g5 = g & 31;
    const int rho = (g & ~31) + ((g5 >> 2) & 1) * 16 + (g5 >> 3) * 4 + (g5 & 3);
    const int i = rho >> 6, R0 = rho & 63, st = (R0 >> 4) * 2 + ((kbyte >> 6) & 1), swz = (R0 & 15) * 64 + (kbyte & 63), sb = swz ^ (((swz >> 9) & 1) << 5);
    return (size_t)ntile * 262144 + (size_t)(kbyte >> 7) * 32768 + (size_t)(((h * 2 + i) * 8 + st) * 1024 + sb);
}
struct TrItem { const float* W; unsigned char* WT; int N, kind  , kb, nb, m  ; unsigned* cmax; };
__device__ __forceinline__ int tr_map(int kind, int n) {
    if (kind == 0) return n < 2320 ? n + 1024 : n - 2320;
    if (kind == 2) { const int bj = n >> 10, w = n & 1023; return (w >> 7) * 256 + bj * 128 + (w & 127); }
    return n;
}
__device__ __forceinline__ void tr_load(f32x4 (&v)[16], const TrItem& t, int lane) {
    const int nq = (lane & 15) * 4, kr = lane >> 4; const bool okn = 64 * t.nb + nq < t.N;
#pragma unroll
    for (int j = 0; j < 16; ++j) v[j] = okn ? *(const f32x4*)(t.W + (size_t)(64 * t.kb + kr + 4 * j) * t.N + 64 * t.nb + nq) : (f32x4){0.f, 0.f, 0.f, 0.f};
}
__device__ __forceinline__ void tr_store(const f32x4 (&v)[16], const TrItem& t, LAS float* scr, int lane) {
    const int k0 = 64 * t.kb, n0 = 64 * t.nb, nq = (lane & 15) * 4, kr = lane >> 4;
#pragma unroll
    for (int j = 0; j < 16; ++j) { LAS float* s = scr + (kr + 4 * j) * 65 + nq; s[0] = v[j][0]; s[1] = v[j][1]; s[2] = v[j][2]; s[3] = v[j][3]; }
    LDS_WAIT(); asm volatile("" ::: "memory");
    if (INPROJ_I8 && t.kind == 0) {
        const int n = n0 + lane; float mx = 0.f;
#pragma unroll 8
        for (int k = 0; k < 64; ++k) mx = fmaxf(mx, fabsf(scr[k * 65 + lane]));
        if (n < t.N) __hip_atomic_fetch_max(t.cmax + t.m * PC + tr_map(0, n), __float_as_uint(mx), __ATOMIC_RELAXED, __HIP_MEMORY_SCOPE_AGENT);
        LDS_WAIT(); asm volatile("" ::: "memory"); return; }
    if ((MOE_FP8 && t.kind >= 2) || (OUTPROJ_FP8 && t.kind == 1)) { const int c = lane & 3;
#pragma unroll
        for (int j = 0; j < 4; ++j) { const int nl = (lane >> 2) + 16 * j, n = n0 + nl; const LAS float* s = scr + (16 * c) * 65 + nl;
            u32x4 o; o.x = pk_fp8x4(64.f * s[0 * 65], 64.f * s[1 * 65], 64.f * s[2 * 65], 64.f * s[3 * 65]); o.y = pk_fp8x4(64.f * s[4 * 65], 64.f * s[5 * 65], 64.f * s[6 * 65], 64.f * s[7 * 65]);
            o.z = pk_fp8x4(64.f * s[8 * 65], 64.f * s[9 * 65], 64.f * s[10 * 65], 64.f * s[11 * 65]); o.w = pk_fp8x4(64.f * s[12 * 65], 64.f * s[13 * 65], 64.f * s[14 * 65], 64.f * s[15 * 65]);
            if (n < t.N) *(u32x4*)(t.WT + wt_off(tr_map(t.kind, n), k0 + 16 * c)) = o; } }
    else { const int c = lane & 7;
#pragma unroll
        for (int j = 0; j < 8; ++j) { const int nl = (lane >> 3) + 8 * j, n = n0 + nl; const LAS float* s = scr + (8 * c) * 65 + nl;
            u32x4 o; o.x = pk2(s[0 * 65], s[1 * 65]); o.y = pk2(s[2 * 65], s[3 * 65]); o.z = pk2(s[4 * 65], s[5 * 65]); o.w = pk2(s[6 * 65], s[7 * 65]);
            if (n < t.N) *(u32x4*)((bf16*)t.WT + (size_t)tr_map(t.kind, n) * 1024 + k0 + 8 * c) = o; } }
    LDS_WAIT(); asm volatile("" ::: "memory");
}
__device__ __forceinline__ void tr_load_w(f32x4 (&v)[16], const TrItem& t, int lane) {
    const int nq = (lane & 7) * 4, kr = lane >> 3;
#pragma unroll
    for (int j = 0; j < 16; ++j) v[j] = *(const f32x4*)(t.W + (size_t)(128 * t.kb + kr + 8 * j) * t.N + 32 * t.nb + nq);
}
__device__ __forceinline__ void tr_store_w(const f32x4 (&v)[16], const TrItem& t, LAS float* scr, int lane) {
    const int k0 = 128 * t.kb, n0 = 32 * t.nb, nq = (lane & 7) * 4, kr = lane >> 3;
#pragma unroll
    for (int j = 0; j < 16; ++j) { LAS float* s = scr + (kr + 8 * j) * 33 + nq; s[0] = v[j][0]; s[1] = v[j][1]; s[2] = v[j][2]; s[3] = v[j][3]; }
    LDS_WAIT(); asm volatile("" ::: "memory");
    const int row0 = tr_map(t.kind, n0), q32 = (row0 & 127) >> 5;
    unsigned char* sub0 = t.WT + (size_t)(row0 >> 8) * 262144 + (size_t)t.kb * 32768 + (size_t)((((row0 & 255) >> 7) * 2 + (q32 >> 1)) * 8 + (q32 & 1) * 4) * 1024;
    const int lane16 = (lane ^ (((lane >> 5) & 1) << 1)) * 16;
#pragma unroll
    for (int j = 0; j < 4; ++j) { const int c = (lane & 3) + 4 * (j & 1), rr16 = lane >> 2, nl = 8 * (rr16 >> 2) + 4 * (j >> 1) + (rr16 & 3); const LAS float* s = scr + (16 * c) * 33 + nl;
        u32x4 o; o.x = pk_fp8x4(64.f * s[0 * 33], 64.f * s[1 * 33], 64.f * s[2 * 33], 64.f * s[3 * 33]); o.y = pk_fp8x4(64.f * s[4 * 33], 64.f * s[5 * 33], 64.f * s[6 * 33], 64.f * s[7 * 33]);
        o.z = pk_fp8x4(64.f * s[8 * 33], 64.f * s[9 * 33], 64.f * s[10 * 33], 64.f * s[11 * 33]); o.w = pk_fp8x4(64.f * s[12 * 33], 64.f * s[13 * 33], 64.f * s[14 * 33], 64.f * s[15 * 33]);
        *(u32x4*)(sub0 + ((j >> 1) * 2 + (j & 1)) * 1024 + lane16) = o; }
    LDS_WAIT(); asm volatile("" ::: "memory");
}
__device__ __forceinline__ void p_prologue(const Args& a, LAS unsigned char* lds) {
    const int tid = otid(), lane = tid & 63, wave = tid >> 6, G = ogrid(), bid = obid();
    const int gw = bid * NWAVE + wave, NGW = G * NWAVE;
    const int gt = bid * NTHR + tid, NGT = G * NTHR;
    LAS float* scr = (LAS float*)(lds + wave * 16896);
    constexpr int NNB_IN = (NIN + 63) / 64;
    constexpr int I_IN = 16 * NNB_IN, I_OUT = 16 * 16, I_GU = 16 * 32, I_DN = 16 * 16;
    constexpr int T_IN = DEPTH * I_IN, T_OUT = DEPTH * I_OUT, T_GU = DEPTH * NEXP * I_GU, T_DN = DEPTH * NEXP * I_DN;
    constexpr int NITEMS = T_IN + T_OUT + T_GU + T_DN;
    constexpr size_t WB = MOE_FP8 ? 1 : 2;
    auto decode = [&](int it) { TrItem t; int r = it;
        if (r < T_IN) { const int m = r / I_IN, q = r % I_IN; t.W = a.in[8] + (size_t)m * 1024 * NIN; t.WT = a.ws + WS_WIN + (size_t)m * PC * 1024 * 2; t.N = NIN; t.kind = 0; t.kb = q / NNB_IN; t.nb = q % NNB_IN; t.m = m; t.cmax = (unsigned*)(a.ws + WS_CTL) + CW_CMAX; return t; } r -= T_IN;
        if (r < T_OUT) { const int m = r / I_OUT, q = r % I_OUT; t.W = a.in[9] + (size_t)m * 1024 * 1024; t.WT = a.ws + WS_WOUT + (size_t)m * 1024 * 1024 * (OUTPROJ_FP8 ? 1 : 2); t.N = 1024; t.kind = 1; t.kb = q / 16; t.nb = q % 16; return t; } r -= T_OUT;
        if (r < T_GU) { const int m = r / I_GU, q = r % I_GU; t.W = a.in[18] + (size_t)m * 1024 * 2048; t.WT = a.ws + WS_WGU + (size_t)m * 2048 * 1024 * WB; t.N = 2048; t.kind = 2; if (MOE_FP8) { t.kb = q / 64; t.nb = q % 64; } else { t.kb = q / 32; t.nb = q % 32; } return t; } r -= T_GU;
        { const int m = r / I_DN, q = r % I_DN; t.W = a.in[20] + (size_t)m * 1024 * 1024; t.WT = a.ws + WS_WDN + (size_t)m * 1024 * 1024 * WB; t.N = 1024; t.kind = 3; if (MOE_FP8) { t.kb = q / 32; t.nb = q % 32; } else { t.kb = q / 16; t.nb = q % 16; } return t; } };
    if (gw < NITEMS) {
        TrItem cur = decode(gw); f32x4 vc[16]; if (MOE_FP8 && cur.kind >= 2) tr_load_w(vc, cur, lane); else tr_load(vc, cur, lane);
        for (int it = gw; it < NITEMS; it += NGW) {
            const bool more = it + NGW < NITEMS; TrItem nxt = cur; f32x4 vn[16];
            if (more) { nxt = decode(it + NGW); if (MOE_FP8 && nxt.kind >= 2) tr_load_w(vn, nxt, lane); else tr_load(vn, nxt, lane); }
            if (MOE_FP8 && cur.kind >= 2) tr_store_w(vc, cur, scr, lane); else tr_store(vc, cur, scr, lane);
            if (more) { cur = nxt;
#pragma unroll
                for (int j = 0; j < 16; ++j) vc[j] = vn[j]; }
        }
    }
    if (!INPROJ_I8) for (int i = gt; i < DEPTH * (PC - NIN) * 128; i += NGT) { const int m = i / ((PC - NIN) * 128), q = i % ((PC - NIN) * 128);
        *(u32x4*)((bf16*)(a.ws + WS_WIN) + ((size_t)m * PC + NIN) * 1024 + (size_t)q * 8) = (u32x4){0u, 0u, 0u, 0u}; }
    for (int i = gt; i < DEPTH * 32 * 1024; i += NGT) { const int l = i >> 15, e = (i >> 10) & 31, k = i & 1023;
        const float w = a.in[16][((size_t)l * 1024 + k) * 32 + e]; const unsigned h = f2bf(w); const float lo = w - bf2f(h);
        ((bf16*)(a.ws + WS_WRH))[i] = (bf16)h; ((bf16*)(a.ws + WS_WRL))[i] = (bf16)f2bf(lo); }
    for (int i = gt; i < 64 * 32; i += NGT) { const int pos = i >> 5, fi = i & 31;
        const float inv = powf(10000.f, -(float)(2 * fi) / 64.f); const float ang = (float)pos * inv;
        ((float*)(a.ws + WS_ROPE))[i] = cosf(ang); ((float*)(a.ws + WS_ROPE))[2048 + i] = sinf(ang); }
    __syncthreads();
    {
        LAS float* SL = (LAS float*)lds;
        LAS float* PT = (LAS float*)(lds + 40960);
        bool have = false;
        for (int it = bid; it < DEPTH * 96; it += G) {
            if (!have) { for (int i = tid; i < 9 * 1024; i += NTHR) { const float v = i < 8192 ? a.in[1][i] : a.in[3][i - 8192]; SL[i] = v / (1.f + expf(-v)); } have = true; __syncthreads(); }
            const int l = it / 96, n = (it % 96) * 64 + lane;
            const float* W = a.in[4] + ((size_t)l * 1024 + wave * 128) * 6144 + n;
            float acc[9];
#pragma unroll
            for (int j = 0; j < 9; ++j) acc[j] = 0.f;
            for (int k0 = 0; k0 < 128; k0 += 32) { float wv[32];
#pragma unroll
                for (int i = 0; i < 32; ++i) wv[i] = W[(size_t)(k0 + i) * 6144];
#pragma unroll
                for (int i4 = 0; i4 < 32; i4 += 4)
#pragma unroll
                    for (int j = 0; j < 9; ++j) { const f32x4 sv = *(const LAS f32x4*)(SL + j * 1024 + wave * 128 + k0 + i4);
                        acc[j] += sv[0] * wv[i4] + sv[1] * wv[i4 + 1] + sv[2] * wv[i4 + 2] + sv[3] * wv[i4 + 3]; } }
#pragma unroll
            for (int j = 0; j < 9; ++j) PT[(wave * 9 + j) * 64 + lane] = acc[j];
            __syncthreads();
            for (int i = tid; i < 9 * 64; i += NTHR) { const int j = i >> 6, c = i & 63; float s = 0.f;
#pragma unroll
                for (int w = 0; w < 8; ++w) s += PT[(w * 9 + j) * 64 + c];
                const int nn = (it % 96) * 64 + c;
                ((float*)(a.ws + WS_MOD))[(size_t)(l * 9 + j) * 6144 + nn] = s + a.in[5][(size_t)l * 6144 + nn]; }
            __syncthreads();
        }
    }
}

__device__ __forceinline__ void norm_mod_store(f32x4 (&v)[2][2], const float* gn, const float* sc, const float* sh, bf16* hrow, int lane) {
    float ss = 0.f;
#pragma unroll
    for (int j = 0; j < 2; ++j)
#pragma unroll
        for (int q = 0; q < 2; ++q) ss += (v[j][q][0] * v[j][q][0] + v[j][q][1] * v[j][q][1]) + (v[j][q][2] * v[j][q][2] + v[j][q][3] * v[j][q][3]);
    const float rstd = 1.f / sqrtf(wave_sum(ss) * (1.f / DM) + EPS);
#pragma unroll
    for (int j = 0; j < 2; ++j) { const int c = 8 * lane + 512 * j;
#pragma unroll
        for (int q = 0; q < 2; ++q) { const f32x4 g = *(const f32x4*)(gn + c + 4 * q), s1 = *(const f32x4*)(sc + c + 4 * q), s0 = *(const f32x4*)(sh + c + 4 * q);
            v[j][q] = v[j][q] * rstd * g * (1.f + s1) + s0; }
        if (hrow) { u32x4 w; w.x = pk2(v[j][0][0], v[j][0][1]); w.y = pk2(v[j][0][2], v[j][0][3]); w.z = pk2(v[j][1][0], v[j][1][1]); w.w = pk2(v[j][1][2], v[j][1][3]);
            *(u32x4*)(hrow + c) = w; } }
}
__device__ __forceinline__ void load_row_bf(const bf16* xr, f32x4 (&v)[2][2], int lane) {
#pragma unroll
    for (int j = 0; j < 2; ++j) { const u32x4 w = *(const u32x4*)(xr + 8 * lane + 512 * j);
        v[j][0] = (f32x4){bflo(w.x), bfhi(w.x), bflo(w.y), bfhi(w.y)}; v[j][1] = (f32x4){bflo(w.z), bfhi(w.z), bflo(w.w), bfhi(w.w)}; }
}
__device__ __forceinline__ void load_row(const float* xr, f32x4 (&v)[2][2], int lane) {
#pragma unroll
    for (int j = 0; j < 2; ++j)
#pragma unroll
        for (int q = 0; q < 2; ++q) v[j][q] = *(const f32x4*)(xr + 8 * lane + 512 * j + 4 * q);
}

__device__ __forceinline__ void p_quant_win(const Args& a) {
    const int gt = obid() * NTHR + otid(), NGT = ogrid() * NTHR;
    const unsigned* CM = (const unsigned*)(a.ws + WS_CTL) + CW_CMAX; float* WSC = (float*)(a.ws + WS_WSC); unsigned char* W8 = (unsigned char*)(a.ws + WS_WIN);
    for (int idx = gt; idx < DEPTH * 64 * PC; idx += NGT) { const int l = idx / (64 * PC), rem = idx - l * (64 * PC), kc = rem / PC, j = rem - kc * PC;
        u32x4 o = {0u, 0u, 0u, 0u}; float s = 0.f;
        if (j < NIN) { const int n = j < 1024 ? j + 2320 : j - 1024; const float cm = __uint_as_float(__hip_atomic_load(CM + l * PC + j, __ATOMIC_RELAXED, __HIP_MEMORY_SCOPE_AGENT));
            s = cm * (1.f / 127.f); const float inv = cm > 0.f ? 127.f / cm : 0.f; const float* wp = a.in[8] + ((size_t)l * 1024 + 16 * kc) * NIN + n; float w[16];
#pragma unroll
            for (int i = 0; i < 16; ++i) w[i] = wp[(size_t)i * NIN] * inv;
            o.x = pk_i8x4(w[0], w[1], w[2], w[3]); o.y = pk_i8x4(w[4], w[5], w[6], w[7]); o.z = pk_i8x4(w[8], w[9], w[10], w[11]); o.w = pk_i8x4(w[12], w[13], w[14], w[15]); }
        *(u32x4*)(W8 + (size_t)l * PC * 1024 + wt_off(j, 16 * kc)) = o;
        if (kc == 0) WSC[l * PC + j] = s; }
}
__device__ __forceinline__ void store_row_i8(const f32x4 (&v)[2][2], unsigned char* hrow, float* hs, int lane) {
    float mx = 0.f;
#pragma unroll
    for (int j = 0; j < 2; ++j)
#pragma unroll
        for (int q = 0; q < 2; ++q) mx = fmaxf(fmaxf(mx, fmaxf(fabsf(v[j][q][0]), fabsf(v[j][q][1]))), fmaxf(fabsf(v[j][q][2]), fabsf(v[j][q][3])));
    mx = fmaxf(wave_max_nn(mx), 1e-20f); const float inv = 127.f / mx;
#pragma unroll
    for (int j = 0; j < 2; ++j) { u32x2 w; w.x = pk_i8x4(v[j][0][0] * inv, v[j][0][1] * inv, v[j][0][2] * inv, v[j][0][3] * inv); w.y = pk_i8x4(v[j][1][0] * inv, v[j][1][1] * inv, v[j][1][2] * inv, v[j][1][3] * inv);
        *(u32x2*)(hrow + 8 * lane + 512 * j) = w; }
    if (lane == 0) *hs = mx * (1.f / 127.f);
}
__device__ __forceinline__ void p_norm1(const Args& a, int layer) {
    const int tid = otid(), lane = tid & 63, wave = tid >> 6; const int gw = obid() * NWAVE + wave, NGW = ogrid() * NWAVE;
    bf16* H = (bf16*)(a.ws + WS_H);
    for (int r = gw; r < NR; r += NGW) { f32x4 v[2][2]; load_row(x_rd(a, layer == 0, r), v, lane);
        norm_mod_store(v, a.in[6] + (size_t)layer * DM, modv(a, layer, r, 1), modv(a, layer, r, 0), INPROJ_I8 ? (bf16*)nullptr : H + (size_t)r * DM, lane);
        if (INPROJ_I8) store_row_i8(v, (unsigned char*)(a.ws + WS_H) + (size_t)r * DM, (float*)(a.ws + WS_HSC) + r, lane); }
}

__device__ __forceinline__ void p_prep(const Args& a, int layer, bool dry = false) {
    const int tid = otid(), lane = tid & 63, wave = tid >> 6; const int gw = obid() * NWAVE + wave, NGW = ogrid() * NWAVE;
    bf16* P = (bf16*)(a.ws + WS_P); const float* COS = (const float*)(a.ws + WS_ROPE); const float* SIN = COS + 2048;
    const int half = lane >> 5, fi = lane & 31;
    const float gq1 = a.in[14][layer * 128 + half * 64 + fi], gq2 = a.in[14][layer * 128 + half * 64 + 32 + fi];
    const float gk1 = a.in[15][layer * 128 + half * 64 + fi], gk2 = a.in[15][layer * 128 + half * 64 + 32 + fi];
    for (int r = gw; r < NR; r += NGW) { const int s = r % SB; const bool lat = s >= CTX; const int t = s - CTX;
        float cs = 1.f, sn = 0.f;
        if (lat) { const int pos = half == 0 ? (t >> 6) : (t & 63); cs = COS[pos * 32 + fi]; sn = SIN[pos * 32 + fi]; }
        bf16* pr = P + (size_t)r * PC;
#pragma unroll
        for (int hh = 4; hh < 6; ++hh) { bf16* p1 = pr + hh * 128 + half * 64 + fi;
            const float x1 = bf2f(p1[0]), x2 = bf2f(p1[32]);
            const float rstd = __builtin_amdgcn_rsqf(wave_sum(x1 * x1 + x2 * x2) * (1.f / 128.f) + EPS);
            const float y1 = x1 * rstd * gk1, y2 = x2 * rstd * gk2;
            bf16* po = dry ? (bf16*)(a.ws + WS_ACT) + (size_t)r * 1024 + hh * 128 + half * 64 + fi : p1;
            po[0] = (bf16)f2bf(y1 * cs - y2 * sn); po[32] = (bf16)f2bf(y2 * cs + y1 * sn); }
    }
}

__device__ __forceinline__ int seq_step_s(int dir, int n) { return dir == 0 ? n : (n < CTX ? CTX - 1 - n : SB + CTX - 1 - n); }
__device__ __forceinline__ void hg_seq(const Args& a, int layer, int sid, LAS unsigned char* lds) {
    const int tid = otid(), lane = tid & 63, wave = tid >> 6;
    const int dir = sid & 1, h = (sid >> 1) & 3, b = sid >> 3;
    LAS float* qs = (LAS float*)lds; LAS float* ks = qs + 2048; LAS float* fs = ks + 2048; LAS float* vs = fs + 2048; LAS float* part = vs + 2048;
    const bf16* P = (const bf16*)(a.ws + WS_P);
    float* OH = (float*)(a.ws + WS_OH) + (size_t)dir * NR * 256;
    float lb;
    { const float* lg = a.in[10] + (size_t)dir * DEPTH * 256 + h * 64 + lane;
      const float l0 = lg[0], l1 = lg[256], l2 = lg[512], l3 = lg[768]; const float mx = fmaxf(fmaxf(l0, l1), fmaxf(l2, l3));
      const float e0 = expf(l0 - mx), e1 = expf(l1 - mx), e2 = expf(l2 - mx), e3 = expf(l3 - mx);
      lb = ((layer >= 1 ? e1 : 0.f) + (layer >= 2 ? e2 : 0.f) + (layer >= 3 ? e3 : 0.f)) / (e0 + e1 + e2 + e3); }
    float S[8];
#pragma unroll
    for (int i = 0; i < 8; ++i) S[i] = 0.f;
    for (int n0 = 0; n0 < SB; n0 += 32) {
#pragma unroll
        for (int jj = 0; jj < 4; ++jj) { const int j = wave + 8 * jj; const int s = seq_step_s(dir, n0 + j);
            const bf16* pr = P + (size_t)(b * SB + s) * PC + h * 64 + lane;
            const float q = bf2f(pr[C_HGQ]), z = bf2f(pr[dir ? C_HGZB : C_HGZF]), v = bf2f(pr[C_HGV]);
            const float sg = 1.f / (1.f + expf(-z));
            qs[j * 64 + lane] = q; fs[j * 64 + lane] = lb + (1.f - lb) * sg; ks[j * 64 + lane] = (1.f - lb) * (1.f - sg); vs[j * 64 + lane] = v; }
        __syncthreads();
        for (int j = 0; j < 32; ++j) { const float v = vs[j * 64 + lane]; float p = 0.f;
#pragma unroll
            for (int i = 0; i < 8; ++i) { const int d = wave * 8 + i; S[i] = fs[j * 64 + d] * S[i] + ks[j * 64 + d] * v; p += S[i] * qs[j * 64 + d]; }
            part[(wave * 32 + j) * 64 + lane] = p; }
        __syncthreads();
#pragma unroll
        for (int jj = 0; jj < 4; ++jj) { const int j = wave + 8 * jj; float o = 0.f;
#pragma unroll
            for (int w = 0; w < 8; ++w) o += part[(w * 32 + j) * 64 + lane];
            const int s = seq_step_s(dir, n0 + j); OH[(size_t)(b * SB + s) * 256 + h * 64 + lane] = o; }
        __syncthreads();
    }
}
__device__ __forceinline__ void ml_seq(const Args& a, int layer, int sid, LAS unsigned char* lds) {
    const int tid = otid(), lane = tid & 63, wave = tid >> 6;
    const int dir = sid & 1, h = (sid >> 1) & 3, b = sid >> 3;
    LAS float* qs = (LAS float*)lds; LAS float* ks = qs + 2048; LAS float* vs = ks + 2048; LAS float* part = vs + 2048;
    LAS float* ip = part + 8 * 2048; LAS float* lf = ip + 32; LAS float* dp = lf + 32; LAS float* ms = dp + 8 * 32;
    const bf16* P = (const bf16*)(a.ws + WS_P);
    float* OM = (float*)(a.ws + WS_OM) + (size_t)dir * NR * 256;
    const float bi = a.in[12][layer * 16 + dir * 4 + h], bfg = a.in[12][layer * 16 + 8 + dir * 4 + h];
    float C[8], nn[8], m = 0.f;
#pragma unroll
    for (int i = 0; i < 8; ++i) { C[i] = 0.f; nn[i] = 0.f; }
    for (int n0 = 0; n0 < SB; n0 += 32) {
#pragma unroll
        for (int jj = 0; jj < 4; ++jj) { const int j = wave + 8 * jj; const int s = seq_step_s(dir, n0 + j);
            const bf16* pr = P + (size_t)(b * SB + s) * PC;
            qs[j * 64 + lane] = bf2f(pr[C_MLQ + h * 64 + lane]); ks[j * 64 + lane] = bf2f(pr[C_MLK + h * 64 + lane]) * 0.125f; vs[j * 64 + lane] = bf2f(pr[C_MLV + h * 64 + lane]);
            if (lane == 0) { ip[j] = bf2f(pr[C_MLG + dir * 4 + h]) + bi; const float fp = bf2f(pr[C_MLG + 8 + dir * 4 + h]) + bfg;
                lf[j] = fminf(fp, 0.f) - log1pf(expf(-fabsf(fp))); } }
        __syncthreads();
        for (int j = 0; j < 32; ++j) { const float v = vs[j * 64 + lane]; const float ipj = ip[j], lfj = lf[j];
            const float mn = fmaxf(lfj + m, ipj); const float aa = expf(lfj + m - mn), bb = expf(ipj - mn); m = mn;
            float p = 0.f, dn = 0.f;
#pragma unroll
            for (int i = 0; i < 8; ++i) { const int d = wave * 8 + i; const float kk = ks[j * 64 + d] * bb, qq = qs[j * 64 + d];
                C[i] = aa * C[i] + kk * v; nn[i] = aa * nn[i] + kk; p += C[i] * qq; dn += nn[i] * qq; }
            part[(wave * 32 + j) * 64 + lane] = p; if (lane == 0) { dp[wave * 32 + j] = dn; if (wave == 0) ms[j] = mn; } }
        __syncthreads();
#pragma unroll
        for (int jj = 0; jj < 4; ++jj) { const int j = wave + 8 * jj; float o = 0.f, dn = 0.f;
#pragma unroll
            for (int w = 0; w < 8; ++w) { o += part[(w * 32 + j) * 64 + lane]; dn += dp[w * 32 + j]; }
            const int s = seq_step_s(dir, n0 + j); OM[(size_t)(b * SB + s) * 256 + h * 64 + lane] = o / fmaxf(fabsf(dn), expf(-ms[j])); }
        __syncthreads();
    }
}
__device__ __forceinline__ void p_scan(const Args& a, int layer, LAS unsigned char* lds, int do_hg, int do_ml) {
    for (int u = obid(); u < 128; u += ogrid()) { if (u < 64) { if (do_hg) hg_seq(a, layer, u, lds); } else { if (do_ml) ml_seq(a, layer, u - 64, lds); } }
}


namespace scan {
constexpr int NCH = 68, NTASK = NB * 4 * 2 * NCH;
__device__ __forceinline__ int swz(int row, int unit) { return row * 128 + ((unit ^ ((row >> 1) & 7)) << 4); }
__device__ __forceinline__ bf16x8 frag(const LAS char* arr, int row, int unit) { return *(const LAS bf16x8*)(arr + swz(row, unit)); }
__device__ __forceinline__ void put2(LAS char* arr, int row, int col_even, float lo, float hi) { *(LAS unsigned*)(arr + swz(row, col_even >> 3) + (col_even & 7) * 2) = pk2(lo, hi); }
__device__ __forceinline__ void put1(LAS char* arr, int row, int col, float x) { *(LAS bf16*)(arr + swz(row, col >> 3) + (col & 7) * 2) = (bf16)f2bf(x); }
__device__ __forceinline__ int crow(int r, int hh) { return (r & 3) + 8 * (r >> 2) + 4 * hh; }
__device__ __forceinline__ void mm64(f32x16 (&acc)[2][2], const LAS char* A, const LAS char* B, int r32, int hh, int skip_a, int skip_b) {
#pragma unroll
    for (int st = 0; st < 4; ++st) { bf16x8 af[2], bfr[2];
#pragma unroll
        for (int i = 0; i < 2; ++i) { af[i] = frag(A, 32 * i + r32, 2 * st + hh); bfr[i] = frag(B, 32 * i + r32, 2 * st + hh); }
#pragma unroll
        for (int ai = 0; ai < 2; ++ai)
#pragma unroll
            for (int bi = 0; bi < 2; ++bi) if (!(ai == skip_a && bi == skip_b)) acc[ai][bi] = __builtin_amdgcn_mfma_f32_32x32x16_bf16(af[ai], bfr[bi], acc[ai][bi], 0, 0, 0); }
}
#define SC_PK4(P, BASE, OUT) do { unsigned a0 = pk2(P[BASE + 0], P[BASE + 1]), a1 = pk2(P[BASE + 2], P[BASE + 3]);   \
    unsigned b0 = pk2(P[BASE + 4], P[BASE + 5]), b1 = pk2(P[BASE + 6], P[BASE + 7]);                              \
    auto r0 = __builtin_amdgcn_permlane32_swap(a0, b0, false, false); auto r1 = __builtin_amdgcn_permlane32_swap(a1, b1, false, false); \
    u32x4 w = {r0[0], r1[0], r0[1], r1[1]}; OUT = __builtin_bit_cast(bf16x8, w); } while (0)
__device__ __forceinline__ float hg_lb(const Args& a, int layer, int dir, int h, int lane) {
    const float* lg = a.in[10] + (size_t)dir * DEPTH * 256 + h * 64 + lane;
    const float l0 = lg[0], l1 = lg[256], l2 = lg[512], l3 = lg[768]; const float mx = fmaxf(fmaxf(l0, l1), fmaxf(l2, l3));
    const float e0 = __expf(l0 - mx), e1 = __expf(l1 - mx), e2 = __expf(l2 - mx), e3 = __expf(l3 - mx);
    return ((layer >= 1 ? e1 : 0.f) + (layer >= 2 ? e2 : 0.f) + (layer >= 3 ? e3 : 0.f)) / (e0 + e1 + e2 + e3);
}
__device__ __forceinline__ float scan_add(float x, int lane, int dir) {
#pragma unroll
    for (int o = 1; o < 64; o <<= 1) { const float y = dir ? __shfl_down(x, o) : __shfl_up(x, o); const bool ok = dir ? (lane + o < 64) : (lane >= o); x += ok ? y : 0.f; }
    return x;
}
__device__ __forceinline__ float scan_max(float x, int lane, int dir) {
#pragma unroll
    for (int o = 1; o < 64; o <<= 1) { const float y = dir ? __shfl_down(x, o) : __shfl_up(x, o); const bool ok = dir ? (lane + o < 64) : (lane >= o); x = ok ? fmaxf(x, y) : x; }
    return x;
}
__device__ __forceinline__ float wave_max(float v) {
#pragma unroll
    for (int o = 1; o < 64; o <<= 1) v = fmaxf(v, __shfl_xor(v, o));
    return v;
}
__device__ __forceinline__ float logsig(float x) { return fminf(x, 0.f) - __logf(1.f + __expf(-fabsf(x))); }
__device__ __forceinline__ void store_ut(bf16* UT, const f32x16 (&acc)[2][2], int r32, int hh) {
#pragma unroll
    for (int vi = 0; vi < 2; ++vi)
#pragma unroll
        for (int di = 0; di < 2; ++di)
#pragma unroll
            for (int rg = 0; rg < 16; ++rg) UT[(32 * vi + crow(rg, hh)) * 64 + 32 * di + r32] = (bf16)f2bf(acc[vi][di][rg]);
}
__device__ __forceinline__ void stage_vt(LAS char* X, const bf16* Pr, int vcol, int lane) {
#pragma unroll 8
    for (int p = 0; p < 32; ++p) put2(X, lane, 2 * p, bf2f(Pr[(size_t)(2 * p) * PC + vcol + lane]), bf2f(Pr[(size_t)(2 * p + 1) * PC + vcol + lane]));
}
__device__ __forceinline__ void stage_copy(LAS char* X, const bf16* G, int ldg, int lane) {
#pragma unroll
    for (int j = 0; j < 8; ++j) { const int u = lane + 64 * j, row = u >> 3, unit = u & 7; *(LAS u32x4*)(X + swz(row, unit)) = *(const u32x4*)(G + (size_t)row * ldg + unit * 8); }
}

__device__ __forceinline__ int tile8_row(int lane, int j) { return 2 * (lane >> 3) + (j & 1) + 16 * (j >> 1); }
__device__ __forceinline__ void load_tile8(u32x4 (&vr)[8], const bf16* G, int ldg, int lane) {
#pragma unroll
    for (int j = 0; j < 8; ++j) vr[j] = *(const u32x4*)(G + (size_t)tile8_row(lane, j) * ldg + 8 * (lane & 7));
}
__device__ __forceinline__ void put_tile8_t(LAS char* X, const u32x4 (&vr)[8], int lane) {
#pragma unroll
    for (int j = 0; j < 8; j += 2) { const int t = tile8_row(lane, j);
#pragma unroll
        for (int e = 0; e < 8; ++e) { const int v = 8 * (lane & 7) + e; const unsigned w0 = vr[j][e >> 1], w1 = vr[j + 1][e >> 1];
            const unsigned pk = (e & 1) ? ((w0 >> 16) | (w1 & 0xffff0000u)) : ((w0 & 0xffffu) | (w1 << 16));
            *(LAS unsigned*)(X + swz(v, t >> 3) + (t & 7) * 2) = pk; } }
}
__device__ __forceinline__ void put_tile8(LAS char* X, const u32x4 (&vr)[8], int lane) {
#pragma unroll
    for (int j = 0; j < 8; ++j) *(LAS u32x4*)(X + swz(tile8_row(lane, j), lane & 7)) = vr[j];
}
__device__ __forceinline__ float get1(const LAS char* arr, int row, int col) { return bf2f(*(const LAS bf16*)(arr + swz(row, col >> 3) + (col & 7) * 2)); }

__device__ __forceinline__ void hgA(const Args& a, int layer, int b, int c, int h, int dir, LAS char* X, LAS char* Y, int lane) {
    const bf16* Pr = (const bf16*)(a.ws + WS_P) + (size_t)(b * SB + 64 * c) * PC;
    stage_copy(X, Pr + (dir ? C_HGZB : C_HGZF) + h * 64, PC, lane);
    u32x4 vr[8]; load_tile8(vr, Pr + C_HGV + h * 64, PC, lane);
    const float lb = hg_lb(a, layer, dir, h, lane), omlb = 1.f - lb;
    float R = 1.f;
#pragma unroll 4
    for (int p = 0; p < 32; ++p) { const int t0 = dir ? 2 * p : 63 - 2 * p, t1 = dir ? 2 * p + 1 : 62 - 2 * p;
        const float f0 = lb + omlb * sigm(get1(X, t0, lane)); const float k0 = (1.f - f0) * R; R *= f0;
        const float f1 = lb + omlb * sigm(get1(X, t1, lane)); const float k1 = (1.f - f1) * R; R *= f1;
        put2(Y, lane, dir ? t0 : t1, dir ? k0 : k1, dir ? k1 : k0); }
    put_tile8_t(X, vr, lane);
    const int tk = ((b * 4 + h) * 2 + dir) * NCH + c;
    ((float*)(a.ws + WS_DT))[(size_t)tk * 64 + lane] = R;
    f32x16 acc[2][2] = {};
    mm64(acc, X, Y, lane & 31, lane >> 5, -1, -1);
    store_ut((bf16*)(a.ws + WS_UTH) + (size_t)tk * 4096, acc, lane & 31, lane >> 5);
}
__device__ __forceinline__ void mlA(const Args& a, int layer, int b, int c, int h, int dir, LAS char* X, LAS char* Y, int lane) {
    const bf16* Pr = (const bf16*)(a.ws + WS_P) + (size_t)(b * SB + 64 * c) * PC;
    stage_copy(X, Pr + C_MLK + h * 64, PC, lane);
    u32x4 vr[8]; load_tile8(vr, Pr + C_MLV + h * 64, PC, lane);
    const float ip = bf2f(Pr[(size_t)lane * PC + C_MLG + dir * 4 + h]) + a.in[12][layer * 16 + dir * 4 + h];
    const float lf = logsig(bf2f(Pr[(size_t)lane * PC + C_MLG + 8 + dir * 4 + h]) + a.in[12][layer * 16 + 8 + dir * 4 + h]);
    const float bt = scan_add(lf, lane, dir), g = wave_sum(lf);
    const float at = g - bt + ip, l = wave_max(at), w = __expf(at - l);
    float nu = 0.f;
#pragma unroll
    for (int p = 0; p < 32; ++p) { const float w0 = __builtin_bit_cast(float, __builtin_amdgcn_readlane(__builtin_bit_cast(int, w), 2 * p)), w1 = __builtin_bit_cast(float, __builtin_amdgcn_readlane(__builtin_bit_cast(int, w), 2 * p + 1));
        const float k0 = get1(X, 2 * p, lane) * 0.125f * w0, k1 = get1(X, 2 * p + 1, lane) * 0.125f * w1;
        nu += k0 + k1; put2(Y, lane, 2 * p, k0, k1); }
    put_tile8_t(X, vr, lane);
    const int tk = ((b * 4 + h) * 2 + dir) * NCH + c;
    ((float*)(a.ws + WS_NU))[(size_t)tk * 64 + lane] = nu;
    if (lane == 0) { ((float*)(a.ws + WS_GL))[tk * 2] = g; ((float*)(a.ws + WS_GL))[tk * 2 + 1] = l; }
    f32x16 acc[2][2] = {};
    mm64(acc, X, Y, lane & 31, lane >> 5, -1, -1);
    store_ut((bf16*)(a.ws + WS_UTM) + (size_t)tk * 4096, acc, lane & 31, lane >> 5);
}
__device__ __forceinline__ void p_scanA(const Args& a, int layer, LAS unsigned char* lds, int do_hg, int do_ml) {
    const int tid = otid(), lane = tid & 63, wave = __builtin_amdgcn_readfirstlane(tid >> 6), G = ogrid(), h = wave >> 1, dir = wave & 1;
    LAS char* X = (LAS char*)lds + wave * 16384; LAS char* Y = X + 8192;
    for (int u = obid(); u < 2 * NB * NCH; u += G) { const int mixer = u / (NB * NCH), q = u % (NB * NCH), b = q / NCH, c = q % NCH;
        int ln = lane; asm volatile("" : "+v"(ln));
        if (mixer == 0) { if (do_hg) hgA(a, layer, b, c, h, dir, X, Y, ln); } else { if (do_ml) mlA(a, layer, b, c, h, dir, X, Y, ln); } }
}

__device__ __forceinline__ int chunk_of(int dir, int k) { return dir == 0 ? k : (k < 4 ? 3 - k : NCH + 3 - k); }
__device__ __forceinline__ void p_scanB(const Args& a, int do_hg, int do_ml) {
    constexpr int KB = 17;
    const int tid = otid(), G = ogrid();
    for (int g = obid() * NTHR + tid; g < 128 * 1024; g += G * NTHR) {
        const int seq = __builtin_amdgcn_readfirstlane(g >> 10), mixer = seq >> 6, sq = seq & 63, dir = sq & 1, e4 = g & 1023, d0 = (e4 & 15) * 4;
        if (mixer == 0) { if (!do_hg) continue;
            const bf16* UT = (const bf16*)(a.ws + WS_UTH); bf16* SP = (bf16*)(a.ws + WS_SPH); const float* DT = (const float*)(a.ws + WS_DT);
            f32x4 S = {0.f, 0.f, 0.f, 0.f};
            for (int kb = 0; kb < NCH; kb += KB) {
                u32x2 uu[KB]; f32x4 dv[KB];
#pragma unroll
                for (int i = 0; i < KB; ++i) { const size_t tk = (size_t)sq * NCH + chunk_of(dir, kb + i);
                    uu[i] = *(const u32x2*)(UT + tk * 4096 + e4 * 4); dv[i] = *(const f32x4*)(DT + tk * 64 + d0); }
#pragma unroll
                for (int i = 0; i < KB; ++i) { const size_t tk = (size_t)sq * NCH + chunk_of(dir, kb + i);
                    u32x2 o; o.x = pk2(S[0], S[1]); o.y = pk2(S[2], S[3]); *(u32x2*)(SP + tk * 4096 + e4 * 4) = o;
                    S = S * dv[i] + (f32x4){bflo(uu[i].x), bfhi(uu[i].x), bflo(uu[i].y), bfhi(uu[i].y)}; } }
        } else { if (!do_ml) continue;
            const bf16* UT = (const bf16*)(a.ws + WS_UTM); bf16* SP = (bf16*)(a.ws + WS_SPM); const float* NU = (const float*)(a.ws + WS_NU);
            float* NP = (float*)(a.ws + WS_NP); const float* GL = (const float*)(a.ws + WS_GL); float* MP = (float*)(a.ws + WS_MP);
            f32x4 S = {0.f, 0.f, 0.f, 0.f}, n = {0.f, 0.f, 0.f, 0.f}; float m = 0.f;
            for (int kb = 0; kb < NCH; kb += KB) {
                u32x2 uu[KB]; f32x4 nv[KB]; f32x2 gv[KB];
#pragma unroll
                for (int i = 0; i < KB; ++i) { const size_t tk = (size_t)sq * NCH + chunk_of(dir, kb + i);
                    uu[i] = *(const u32x2*)(UT + tk * 4096 + e4 * 4); nv[i] = *(const f32x4*)(NU + tk * 64 + d0); gv[i] = *(const f32x2*)(GL + tk * 2); }
#pragma unroll
                for (int i = 0; i < KB; ++i) { const size_t tk = (size_t)sq * NCH + chunk_of(dir, kb + i);
                    u32x2 o; o.x = pk2(S[0], S[1]); o.y = pk2(S[2], S[3]); *(u32x2*)(SP + tk * 4096 + e4 * 4) = o;
                    if (e4 < 16) { *(f32x4*)(NP + tk * 64 + d0) = n; if (e4 == 0) MP[tk] = m; }
                    const float mn = fmaxf(gv[i][0] + m, gv[i][1]), aa = __expf(gv[i][0] + m - mn), bb = __expf(gv[i][1] - mn); m = mn;
                    S = S * aa + (f32x4){bflo(uu[i].x), bfhi(uu[i].x), bflo(uu[i].y), bfhi(uu[i].y)} * bb; n = n * aa + nv[i] * bb; } }
        }
    }
}

__device__ __forceinline__ void loadC(const Args& a, int mixer, int b, int c, int h, int dir, u32x4 (&tq)[8], u32x4 (&tz)[8], int lane) {
    const bf16* Pr = (const bf16*)(a.ws + WS_P) + (size_t)(b * SB + 64 * c) * PC + h * 64;
    load_tile8(tq, Pr + (mixer == 0 ? C_HGQ : C_MLQ), PC, lane); load_tile8(tz, Pr + (mixer == 0 ? (dir ? C_HGZB : C_HGZF) : C_MLK), PC, lane);
}
__device__ __forceinline__ void hgC(const Args& a, int layer, int b, int c, int h, int dir, LAS char* X, LAS char* Y, int lane, const u32x4 (&qr_)[8], const u32x4 (&zr_)[8]) {
    const int r32 = lane & 31, hh = lane >> 5;
    const bf16* Pr = (const bf16*)(a.ws + WS_P) + (size_t)(b * SB + 64 * c) * PC;
    const int tk = ((b * 4 + h) * 2 + dir) * NCH + c;
    u32x4 vr[8], sp[8];
    load_tile8(vr, Pr + C_HGV + h * 64, PC, lane); load_tile8(sp, (const bf16*)(a.ws + WS_SPH) + (size_t)tk * 4096, 64, lane);
    put_tile8(X, qr_, lane); put_tile8(Y, zr_, lane);
    const float lb = hg_lb(a, layer, dir, h, lane), omlb = 1.f - lb;
    float Gp = 1.f;
#pragma unroll 4
    for (int i = 32; i < 64; ++i) { const int t = dir ? 63 - i : i; const float f = lb + omlb * sigm(get1(Y, t, lane)); Gp *= f;
        const float q = get1(X, t, lane) * Gp, k = (1.f - f) * __builtin_amdgcn_rcpf(Gp); put1(X, t, lane, q); put1(Y, t, lane, k); }
    float Hp = 1.f;
#pragma unroll 4
    for (int i = 31; i >= 0; --i) { const int t = dir ? 63 - i : i; const float f = lb + omlb * sigm(get1(Y, t, lane));
        const float q = get1(X, t, lane) * __builtin_amdgcn_rcpf(Hp), k = (1.f - f) * Hp; Hp *= f; put1(X, t, lane, q); put1(Y, t, lane, k); }
    f32x16 sc[2][2] = {};
    mm64(sc, Y, X, r32, hh, dir ? 0 : 1, dir ? 1 : 0);
    bf16x8 pa[2][4];
#pragma unroll
    for (int ti = 0; ti < 2; ++ti)
#pragma unroll
        for (int si = 0; si < 2; ++si) { const bool dead = dir ? (si == 0 && ti == 1) : (si == 1 && ti == 0);
            if (dead) { pa[ti][2 * si] = (bf16x8){0, 0, 0, 0, 0, 0, 0, 0}; pa[ti][2 * si + 1] = (bf16x8){0, 0, 0, 0, 0, 0, 0, 0}; }
            else { f32x16 p = sc[si][ti];
                if (si == ti) {
#pragma unroll
                    for (int rg = 0; rg < 16; ++rg) { const int s = crow(rg, hh); const bool ok = dir ? (s >= r32) : (s <= r32); p[rg] = ok ? p[rg] : 0.f; } }
                SC_PK4(p, 0, pa[ti][2 * si]); SC_PK4(p, 8, pa[ti][2 * si + 1]); } }
    { const float eb = Hp;
#pragma unroll 8
      for (int t = 0; t < 64; ++t) put1(Y, t, lane, get1(X, t, lane) * eb); }
    put_tile8_t(X, vr, lane);
    f32x16 o[2][2] = {};
#pragma unroll
    for (int ss = 0; ss < 4; ++ss) { bf16x8 vf[2];
#pragma unroll
        for (int vi = 0; vi < 2; ++vi) vf[vi] = frag(X, 32 * vi + r32, 2 * ss + hh);
#pragma unroll
        for (int ti = 0; ti < 2; ++ti)
#pragma unroll
            for (int vi = 0; vi < 2; ++vi) o[ti][vi] = __builtin_amdgcn_mfma_f32_32x32x16_bf16(pa[ti][ss], vf[vi], o[ti][vi], 0, 0, 0); }
    put_tile8(X, sp, lane);
    mm64(o, Y, X, r32, hh, -1, -1);
    LAS float* O = (LAS float*)X;
#pragma unroll
    for (int ti = 0; ti < 2; ++ti)
#pragma unroll
        for (int vi = 0; vi < 2; ++vi)
#pragma unroll
            for (int rg = 0; rg < 16; ++rg) O[(32 * ti + crow(rg, hh)) * 64 + 32 * vi + r32] = o[ti][vi][rg];
}
__device__ __forceinline__ void mlC(const Args& a, int layer, int b, int c, int h, int dir, LAS char* X, LAS char* Y, LAS float* T, int lane, const u32x4 (&qr_)[8], const u32x4 (&kr_)[8]) {
    const int r32 = lane & 31, hh = lane >> 5;
    const bf16* Pr = (const bf16*)(a.ws + WS_P) + (size_t)(b * SB + 64 * c) * PC;
    const int tk = ((b * 4 + h) * 2 + dir) * NCH + c;
    LAS float* TMU = T; LAS float* TCS = T + 64; LAS float* TEM = T + 128; LAS float* TAP = T + 192;
    u32x4 vr[8], sp[8];
    load_tile8(vr, Pr + C_MLV + h * 64, PC, lane); load_tile8(sp, (const bf16*)(a.ws + WS_SPM) + (size_t)tk * 4096, 64, lane);
    { const float ip = bf2f(Pr[(size_t)lane * PC + C_MLG + dir * 4 + h]) + a.in[12][layer * 16 + dir * 4 + h];
      const float lf = logsig(bf2f(Pr[(size_t)lane * PC + C_MLG + 8 + dir * 4 + h]) + a.in[12][layer * 16 + 8 + dir * 4 + h]);
      const float bt = scan_add(lf, lane, dir), cs = ip - bt, mp = ((const float*)(a.ws + WS_MP))[tk];
      const float mu = fmaxf(mp, scan_max(cs, lane, dir));
      TMU[lane] = mu; TCS[lane] = cs; TEM[lane] = __expf(-bt - mu); TAP[lane] = __expf(mp - mu); }
    put_tile8(X, qr_, lane); put_tile8(Y, kr_, lane);
    f32x16 sc[2][2] = {};
    mm64(sc, Y, X, r32, hh, dir ? 0 : 1, dir ? 1 : 0);
    bf16x8 pa[2][4];
#pragma unroll
    for (int ti = 0; ti < 2; ++ti) { const float mu = TMU[32 * ti + r32];
#pragma unroll
        for (int si = 0; si < 2; ++si) { const bool dead = dir ? (si == 0 && ti == 1) : (si == 1 && ti == 0);
            if (dead) { pa[ti][2 * si] = (bf16x8){0, 0, 0, 0, 0, 0, 0, 0}; pa[ti][2 * si + 1] = (bf16x8){0, 0, 0, 0, 0, 0, 0, 0}; }
            else { f32x16 p = sc[si][ti];
#pragma unroll
                for (int g4 = 0; g4 < 4; ++g4) { const f32x4 cs = *(const LAS f32x4*)(TCS + 32 * si + 8 * g4 + 4 * hh);
#pragma unroll
                    for (int i = 0; i < 4; ++i) { const int rg = 4 * g4 + i, s = crow(rg, hh); const bool ok = (si != ti) || (dir ? (s >= r32) : (s <= r32));
                        const float w = p[rg] * 0.125f * __expf(cs[i] - mu); p[rg] = ok ? w : 0.f; } }
                SC_PK4(p, 0, pa[ti][2 * si]); SC_PK4(p, 8, pa[ti][2 * si + 1]); } } }
#pragma unroll
    for (int j = 0; j < 8; ++j) { const int u = lane + 64 * j, row = u >> 3, unit = u & 7; const float ap = TAP[row];
        const u32x4 qv = *(const LAS u32x4*)(X + swz(row, unit)); u32x4 o;
        o.x = pk2(bflo(qv.x) * ap, bfhi(qv.x) * ap); o.y = pk2(bflo(qv.y) * ap, bfhi(qv.y) * ap); o.z = pk2(bflo(qv.z) * ap, bfhi(qv.z) * ap); o.w = pk2(bflo(qv.w) * ap, bfhi(qv.w) * ap);
        *(LAS u32x4*)(Y + swz(row, unit)) = o; }
    put_tile8_t(X, vr, lane);
    f32x16 o[2][2] = {}; f32x16 dn[2] = {};
    const bf16x8 ones = {0x3f80, 0x3f80, 0x3f80, 0x3f80, 0x3f80, 0x3f80, 0x3f80, 0x3f80};
#pragma unroll
    for (int ss = 0; ss < 4; ++ss) { bf16x8 vf[2];
#pragma unroll
        for (int vi = 0; vi < 2; ++vi) vf[vi] = frag(X, 32 * vi + r32, 2 * ss + hh);
#pragma unroll
        for (int ti = 0; ti < 2; ++ti) { dn[ti] = __builtin_amdgcn_mfma_f32_32x32x16_bf16(pa[ti][ss], ones, dn[ti], 0, 0, 0);
#pragma unroll
            for (int vi = 0; vi < 2; ++vi) o[ti][vi] = __builtin_amdgcn_mfma_f32_32x32x16_bf16(pa[ti][ss], vf[vi], o[ti][vi], 0, 0, 0); } }
    put_tile8(X, sp, lane);
    mm64(o, Y, X, r32, hh, -1, -1);
    { const float* NPg = (const float*)(a.ws + WS_NP) + (size_t)tk * 64;
#pragma unroll
      for (int st = 0; st < 4; ++st) { const f32x4 n0 = *(const f32x4*)(NPg + 16 * st + 8 * hh), n1 = *(const f32x4*)(NPg + 16 * st + 8 * hh + 4);
          u32x4 w; w.x = pk2(n0[0], n0[1]); w.y = pk2(n0[2], n0[3]); w.z = pk2(n1[0], n1[1]); w.w = pk2(n1[2], n1[3]); const bf16x8 nf = __builtin_bit_cast(bf16x8, w);
#pragma unroll
          for (int ti = 0; ti < 2; ++ti) dn[ti] = __builtin_amdgcn_mfma_f32_32x32x16_bf16(frag(Y, 32 * ti + r32, 2 * st + hh), nf, dn[ti], 0, 0, 0); } }
    float em[2][16];
#pragma unroll
    for (int ti = 0; ti < 2; ++ti)
#pragma unroll
        for (int g4 = 0; g4 < 4; ++g4) { const f32x4 e = *(const LAS f32x4*)(TEM + 32 * ti + 8 * g4 + 4 * hh);
#pragma unroll
            for (int i = 0; i < 4; ++i) em[ti][4 * g4 + i] = e[i]; }
    LAS float* O = (LAS float*)X;
#pragma unroll
    for (int ti = 0; ti < 2; ++ti)
#pragma unroll
        for (int rg = 0; rg < 16; ++rg) { const float rd = __builtin_amdgcn_rcpf(fmaxf(fabsf(dn[ti][rg]), em[ti][rg]));
#pragma unroll
            for (int vi = 0; vi < 2; ++vi) O[(32 * ti + crow(rg, hh)) * 64 + 32 * vi + r32] = o[ti][vi][rg] * rd; }
}
__device__ __forceinline__ void p_scanC(const Args& a, int layer, LAS unsigned char* lds, int do_hg, int do_ml) {
    const int tid = otid(), lane = tid & 63, wave = __builtin_amdgcn_readfirstlane(tid >> 6), G = ogrid(), h = wave >> 1, dir = wave & 1;
    LAS char* X = (LAS char*)lds + wave * 16384; LAS char* Y = X + 8192; LAS float* T = (LAS float*)(lds + 131072 + wave * 1024);
    const bf16* P = (const bf16*)(a.ws + WS_P); bf16* Yo = (bf16*)(a.ws + WS_Y);
    const bool lastl = layer == DEPTH - 1;
#define SC_SKIP(u_) ((lastl && ((u_) % (NB * NCH)) % NCH < 4) || (((u_) / (NB * NCH)) == 0 ? !do_hg : !do_ml))
    int u = obid(); while (u < 2 * NB * NCH && SC_SKIP(u)) u += G;
    u32x4 tq[8], tz[8];
    if (u < 2 * NB * NCH) { const int mixer = u / (NB * NCH), q = u % (NB * NCH); loadC(a, mixer, q / NCH, q % NCH, h, dir, tq, tz, lane); }
    while (u < 2 * NB * NCH) { const int mixer = u / (NB * NCH), q = u % (NB * NCH), b = q / NCH, c = q % NCH;
        int ln = lane; asm volatile("" : "+v"(ln));
        if (mixer == 0) hgC(a, layer, b, c, h, dir, X, Y, ln, tq, tz); else mlC(a, layer, b, c, h, dir, X, Y, T, ln, tq, tz);
        asm volatile("" : "+v"(ln));
        __builtin_amdgcn_sched_barrier(0);
        int un = u + G; while (un < 2 * NB * NCH && SC_SKIP(un)) un += G;
        if (un < 2 * NB * NCH) { const int mixer2 = un / (NB * NCH), q2 = un % (NB * NCH); loadC(a, mixer2, q2 / NCH, q2 % NCH, h, dir, tq, tz, ln); }
        __builtin_amdgcn_sched_barrier(0);
        const int fh = ln >> 4, fv = (ln & 15) * 4, fw = __builtin_amdgcn_readfirstlane(otid() >> 6);
        u32x2 gq2[8];
        { const bf16* gp = P + (size_t)(b * SB + 64 * c + 8 * fw) * PC + (mixer == 0 ? C_HGG : C_MLOG) + fh * 64 + fv;
#pragma unroll
          for (int i = 0; i < 8; ++i) gq2[i] = *(const u32x2*)(gp + (size_t)i * PC); }
        const f32x4 gn4 = *(const f32x4*)((mixer == 0 ? a.in[11] : a.in[13]) + layer * 64 + fv);
        __builtin_amdgcn_sched_barrier(0);
        __syncthreads();
        { const LAS float* Of = (const LAS float*)((LAS char*)lds + (2 * fh) * 16384); const LAS float* Ob = (const LAS float*)((LAS char*)lds + (2 * fh + 1) * 16384);
#pragma unroll
          for (int i = 0; i < 8; ++i) { const int t = 8 * fw + i; const size_t r = (size_t)(b * SB + 64 * c + t);
              const f32x4 ov = *(const LAS f32x4*)(Of + t * 64 + fv) + *(const LAS f32x4*)(Ob + t * 64 + fv);
              const float rs = __builtin_amdgcn_rsqf(row16_sum(ov[0] * ov[0] + ov[1] * ov[1] + ov[2] * ov[2] + ov[3] * ov[3]) * (1.f / 64.f) + EPS);
              const float g4[4] = {bflo(gq2[i].x), bfhi(gq2[i].x), bflo(gq2[i].y), bfhi(gq2[i].y)}; float ow[4];
#pragma unroll
              for (int e = 0; e < 4; ++e) { const float y = ov[e] * rs * gn4[e]; ow[e] = mixer == 0 ? y * g4[e] * sigm(g4[e]) : y * sigm(g4[e]); }
              if (OUTPROJ_FP8) *(unsigned*)((unsigned char*)Yo + r * DM + mixer * 256 + fh * 64 + fv) = pk_fp8x4(16.f * ow[0], 16.f * ow[1], 16.f * ow[2], 16.f * ow[3]);
              else { u32x2 w; w.x = pk2(ow[0], ow[1]); w.y = pk2(ow[2], ow[3]); *(u32x2*)(Yo + r * DM + mixer * 256 + fh * 64 + fv) = w; } } }
        __syncthreads();
        u = un;
    }
#undef SC_SKIP
}
#undef SC_PK4
}

__device__ __forceinline__ void p_attn(const Args& a, int layer, LAS char* ldsg) {
    asm volatile("" ::: "memory");
    const bf16* P = (const bf16*)(a.ws + WS_P); bf16* Y = (bf16*)(a.ws + WS_Y); const int G = ogrid();
    const int bid = obid(), lane = otid() & 63;
    const float* qg = a.in[14] + layer * 128; const float* kg = a.in[15] + layer * 128;
    const float mq = wave_max_nn(fmaxf(fabsf(qg[lane]), fabsf(qg[lane + 64]))), mk = wave_max_nn(fmaxf(fabsf(kg[lane]), fabsf(kg[lane + 64])));
    unsigned sbnd; { const float vb = 128.f * mq * mk * (att::SCALE * 1.4426950408889634f) * 1.02f; asm volatile("s_nop 0\n\tv_readfirstlane_b32 %0, %1\n\ts_nop 3" : "=s"(sbnd) : "v"(vb)); }
    const float bound = __builtin_bit_cast(float, sbnd);
    const bool fix = bound <= 60.f;
    const int cu = (layer != DEPTH - 1) ? (G >= 96 ? bid - 64 : bid) : -1; const bool hasc = cu >= 0 && cu < 32;
    const float* ropet = (const float*)(a.ws + WS_ROPE);
#define AT_LAT(u) const int b = (u) & 7, idx = ((u) >> 3) & 31, kvh = (u) >> 8, h = kvh * 2 + (idx >> 4), qb = idx & 15; const size_t r0 = (size_t)b * SB + CTX + (size_t)qb * 256; \
        const bf16* Qp = P + r0 * PC + C_ATQ + h * 128; const bf16* Kp = P + (size_t)b * SB * PC + C_ATK + kvh * 128; const bf16* Vp = P + (size_t)b * SB * PC + C_ATV + kvh * 128; \
        bf16* Op = (bf16*)((unsigned char*)Y + (r0 * DM + 512 + h * 128) * (OUTPROJ_FP8 ? 1 : 2));
#define AT_CTX() const int b = cu & 7, h = cu >> 3, kvh = h >> 1; const size_t r0 = (size_t)b * SB; \
        const bf16* Qp = P + r0 * PC + C_ATQ + h * 128; const bf16* Kp = P + r0 * PC + C_ATK + kvh * 128; const bf16* Vp = P + r0 * PC + C_ATV + kvh * 128; \
        bf16* Op = (bf16*)((unsigned char*)Y + (r0 * DM + 512 + h * 128) * (OUTPROJ_FP8 ? 1 : 2));
    const int ex = fix ? 0 : 1;
    for (int u = bid; u < 512; u += G) { AT_LAT(u) att::attn_dense_body(Qp, Kp, Vp, Op, SB, ldsg, qg, ropet, qb * 256, -bound, ex); __syncthreads(); }
    if (hasc) { AT_CTX() att::attn_dense_body(Qp, Kp, Vp, Op, CTX, ldsg, qg, ropet, -1, -bound, ex); __syncthreads(); }
#undef AT_LAT
#undef AT_CTX
}

__device__ __forceinline__ void p_finish(const Args& a, int layer, int do_hg, int do_ml) {
    const int tid = otid(), lane = tid & 63, wave = tid >> 6; const int gw = obid() * NWAVE + wave, NGW = ogrid() * NWAVE;
    const bf16* P = (const bf16*)(a.ws + WS_P); bf16* Y = (bf16*)(a.ws + WS_Y);
    const float* OH = (const float*)(a.ws + WS_OH); const float* OM = (const float*)(a.ws + WS_OM);
    const float gh = a.in[11][layer * 64 + lane], gm = a.in[13][layer * 64 + lane];
    for (int r = gw; r < NR; r += NGW) { if (layer == DEPTH - 1 && (r % SB) < CTX) continue;
#pragma unroll
        for (int h = 0; h < 4; ++h) {
            if (do_hg) { const float o = OH[(size_t)r * 256 + h * 64 + lane] + OH[(size_t)(NR + r) * 256 + h * 64 + lane];
              const float y = o * (1.f / sqrtf(wave_sum(o * o) * (1.f / 64.f) + EPS)) * gh; const float g = bf2f(P[(size_t)r * PC + C_HGG + h * 64 + lane]);
              Y[(size_t)r * DM + h * 64 + lane] = (bf16)f2bf(y * g * sigm(g)); }
            if (do_ml) { const float o = OM[(size_t)r * 256 + h * 64 + lane] + OM[(size_t)(NR + r) * 256 + h * 64 + lane];
              const float y = o * (1.f / sqrtf(wave_sum(o * o) * (1.f / 64.f) + EPS)) * gm; const float g = bf2f(P[(size_t)r * PC + C_MLOG + h * 64 + lane]);
              Y[(size_t)r * DM + 256 + h * 64 + lane] = (bf16)f2bf(y * sigm(g)); }
        }
    }
}

__device__ __forceinline__ void p_router(const Args& a, int layer, LAS unsigned char* lds) {
    const int tid = otid(), lane = tid & 63, wave = tid >> 6, G = ogrid(), bid = obid();
    constexpr int TP = 2064;
    LAS unsigned char* TH = lds; LAS unsigned char* TL = lds + 32 * TP;
    LAS float* PART = (LAS float*)lds;
    LAS float* LOG = (LAS float*)(lds + 64 * TP);
    LAS int* LCNT = (LAS int*)(lds + 64 * TP + 32 * 33 * 4);
    bf16* H = (bf16*)(a.ws + WS_H);
    int* RE = (int*)(a.ws + WS_RE); int* RS = (int*)(a.ws + WS_RS); float* RG = (float*)(a.ws + WS_RG);
    const bool lastl = layer == DEPTH - 1;
    const int e_l = lane & 31, hh = lane >> 5;
    bf16x8 bh[8], bl[8];
#pragma unroll
    for (int ks = 0; ks < 8; ++ks) { const size_t o = ((size_t)(layer * 32 + e_l)) * 1024 + wave * 128 + ks * 16 + hh * 8;
        bh[ks] = *(const bf16x8*)((const bf16*)(a.ws + WS_WRH) + o); bl[ks] = *(const bf16x8*)((const bf16*)(a.ws + WS_WRL) + o); }
    if (tid < 32) LCNT[tid] = 0;
    __syncthreads();
#define RT_SKIP(t_) (lastl && (((t_) * 32) % SB) < CTX)
    int tile = bid; while (tile < NR / 32 && RT_SKIP(tile)) tile += G;
    u32x4 rw[4][2];
    if (tile < NR / 32) {
#pragma unroll
        for (int q = 0; q < 4; ++q)
#pragma unroll
            for (int j = 0; j < 2; ++j) rw[q][j] = *(const u32x4*)((const bf16*)(a.ws + WS_XB) + (size_t)(tile * 32 + wave * 4 + q) * DM + 8 * lane + 512 * j); }
    while (tile < NR / 32) {
        const int r0 = tile * 32;
#pragma unroll
        for (int q = 0; q < 4; ++q) { const int row = wave * 4 + q, r = r0 + row; f32x4 v[2][2];
#pragma unroll
            for (int j = 0; j < 2; ++j) { const u32x4 w = rw[q][j]; v[j][0] = (f32x4){bflo(w.x), bfhi(w.x), bflo(w.y), bfhi(w.y)}; v[j][1] = (f32x4){bflo(w.z), bfhi(w.z), bflo(w.w), bfhi(w.w)}; }
            norm_mod_store(v, a.in[7] + (size_t)layer * DM, modv(a, layer, r, 4), modv(a, layer, r, 3), MOE_FP8 ? (bf16*)nullptr : H + (size_t)r * DM, lane);
            if (MOE_FP8) {
#pragma unroll
                for (int j = 0; j < 2; ++j) { u32x2 w8; w8.x = pk_fp8x4(8.f * v[j][0][0], 8.f * v[j][0][1], 8.f * v[j][0][2], 8.f * v[j][0][3]); w8.y = pk_fp8x4(8.f * v[j][1][0], 8.f * v[j][1][1], 8.f * v[j][1][2], 8.f * v[j][1][3]);
                    *(u32x2*)((unsigned char*)(a.ws + WS_H8) + (size_t)r * DM + 8 * lane + 512 * j) = w8; } }
#pragma unroll
            for (int j = 0; j < 2; ++j) { unsigned hi[4], lo[4];
#pragma unroll
                for (int p = 0; p < 4; ++p) { const float x0 = v[j][p >> 1][(p & 1) * 2], x1 = v[j][p >> 1][(p & 1) * 2 + 1]; const unsigned w = pk2(x0, x1); hi[p] = w; lo[p] = pk2(x0 - bflo(w), x1 - bfhi(w)); }
                *(LAS u32x4*)(TH + row * TP + (8 * lane + 512 * j) * 2) = (u32x4){hi[0], hi[1], hi[2], hi[3]};
                *(LAS u32x4*)(TL + row * TP + (8 * lane + 512 * j) * 2) = (u32x4){lo[0], lo[1], lo[2], lo[3]}; } }
        __syncthreads();
        int ntile = tile + G; while (ntile < NR / 32 && RT_SKIP(ntile)) ntile += G;
        if (ntile < NR / 32) {
#pragma unroll
            for (int q = 0; q < 4; ++q)
#pragma unroll
                for (int j = 0; j < 2; ++j) rw[q][j] = *(const u32x4*)((const bf16*)(a.ws + WS_XB) + (size_t)(ntile * 32 + wave * 4 + q) * DM + 8 * lane + 512 * j); }
        f32x16 acc = {};
#pragma unroll
        for (int ks = 0; ks < 8; ++ks) { const int off = e_l * TP + (wave * 128 + ks * 16 + hh * 8) * 2;
            const bf16x8 ah = *(const LAS bf16x8*)(TH + off), al = *(const LAS bf16x8*)(TL + off);
            acc = __builtin_amdgcn_mfma_f32_32x32x16_bf16(ah, bh[ks], acc, 0, 0, 0);
            acc = __builtin_amdgcn_mfma_f32_32x32x16_bf16(ah, bl[ks], acc, 0, 0, 0);
            acc = __builtin_amdgcn_mfma_f32_32x32x16_bf16(al, bh[ks], acc, 0, 0, 0); }
        __syncthreads();
#pragma unroll
        for (int rg = 0; rg < 16; ++rg) { const int row = (rg & 3) + 8 * (rg >> 2) + 4 * hh; PART[(wave * 32 + row) * 32 + e_l] = acc[rg]; }
        __syncthreads();
#pragma unroll
        for (int q = 0; q < 2; ++q) { const int idx = tid + 512 * q, row = idx >> 5, e = idx & 31; float s = a.in[17][layer * 32 + e];
#pragma unroll
            for (int w = 0; w < 8; ++w) s += PART[(w * 32 + row) * 32 + e];
            LOG[row * 33 + e] = s; }
        __syncthreads();
        if (tid < 32) { const int r = r0 + tid; float tv[4]; int te[4];
#pragma unroll
            for (int k = 0; k < 4; ++k) { float best = -INFINITY; int bi = 0;
                for (int e = 0; e < 32; ++e) { const float v = LOG[tid * 33 + e]; if (v > best) { best = v; bi = e; } }
                tv[k] = best; te[k] = bi; LOG[tid * 33 + bi] = -INFINITY; }
            float p[4], ps = 0.f;
#pragma unroll
            for (int k = 0; k < 4; ++k) { p[k] = expf(tv[k] - tv[0]); ps += p[k]; }
#pragma unroll
            for (int k = 0; k < 4; ++k) { RE[r * 4 + k] = te[k]; RS[r * 4 + k] = atomicAdd((int*)&LCNT[te[k]], 1); RG[r * 4 + k] = p[k] / ps; } }
        __syncthreads();
        tile = ntile;
    }
#undef RT_SKIP
    if (tid < 32) ((int*)(a.ws + WS_CNT))[bid * 32 + tid] = LCNT[tid];
}

__device__ __forceinline__ void p_dispatch(const Args& a, int layer, LAS unsigned char* lds) {
    const int tid = otid(), G = ogrid(), bid = obid();
    LAS int* tot = (LAS int*)lds; LAS int* base = tot + 32; LAS int* pst = base + 32;
    const int* CNT = (const int*)(a.ws + WS_CNT);
    const int* RE = (const int*)(a.ws + WS_RE); const int* RS = (const int*)(a.ws + WS_RS); const float* RG = (const float*)(a.ws + WS_RG);
    int* POS = (int*)(a.ws + WS_POS); int* TOK = (int*)(a.ws + WS_TOK); float* GATEP = (float*)(a.ws + WS_GATEP); int* TILEE = (int*)(a.ws + WS_TILEE);
    const bool lastl = layer == DEPTH - 1;
    { LAS int* ptot = pst + 64; LAS int* pbase = ptot + 512;
      const int e = tid & 31, part = tid >> 5; int t = 0, bs = 0;
      for (int blk = part; blk < G; blk += 16) { const int c = CNT[blk * 32 + e]; if (blk < bid) bs += c; t += c; }
      ptot[tid] = t; pbase[tid] = bs;
      __syncthreads();
      if (tid < 32) { int tt = 0, bb = 0;
#pragma unroll
          for (int p = 0; p < 16; ++p) { tt += ptot[p * 32 + tid]; bb += pbase[p * 32 + tid]; }
          tot[tid] = tt; base[tid] = bb; } }
    __syncthreads();
    if (tid == 0) { int p = 0; for (int e = 0; e < 32; ++e) { pst[e] = p; p += (tot[e] + 255) & ~255; } pst[32] = p; }
    __syncthreads();
    for (int tile = bid; tile < NR / 32; tile += G) { const int r0 = tile * 32; if (lastl && (r0 % SB) < CTX) continue;
        if (tid < 128) { const int i = r0 * 4 + tid; const int e = RE[i]; const int pos = pst[e] + base[e] + RS[i]; TOK[pos] = r0 + (tid >> 2); GATEP[pos] = RG[i]; POS[i] = pos; } }
    for (int e = bid; e < 32; e += G) {
        for (int p = pst[e] + tot[e] + tid; p < pst[e + 1]; p += NTHR) { TOK[p] = 0; GATEP[p] = 0.f; }
        for (int rt = pst[e] / 256 + tid; rt < pst[e + 1] / 256; rt += NTHR) TILEE[rt] = e; }
    if (bid == 0 && tid == 0) *(int*)(a.ws + WS_NRT) = pst[32] / 256;
}

__device__ __forceinline__ void p_combine(const Args& a, int layer, bool dry = false) {
    const int tid = otid(), lane = tid & 63, wave = tid >> 6; const int gw = obid() * NWAVE + wave, NGW = ogrid() * NWAVE;
    const bf16* YM = (const bf16*)(a.ws + WS_YM); const int* POS = (const int*)(a.ws + WS_POS); bf16* H = (bf16*)(a.ws + WS_H);
    const bool lastl = layer == DEPTH - 1;
    for (int r = gw; r < NR; r += NGW) { if (lastl && (r % SB) < CTX) continue;
        const float* g2 = modv(a, layer, r, 5); bf16* xb = (bf16*)(a.ws + WS_XB) + (size_t)r * DM;
        float* xo = dry ? (float*)(a.ws + WS_ACT) + (size_t)r * DM : a.out + ((size_t)(r / SB) * SEQ + (r % SB) - CTX) * DM;
        bf16* xbo = dry ? (bf16*)(a.ws + WS_ACT) + (size_t)r * DM : xb; bf16* hw = dry ? (bf16*)(a.ws + WS_ACT + 160 * MiB) + (size_t)r * DM : H + (size_t)r * DM;
        int pos[4];
#pragma unroll
        for (int k = 0; k < 4; ++k) pos[k] = POS[r * 4 + k];
        f32x4 v[2][2]; load_row_bf(xb, v, lane);
#pragma unroll
        for (int j = 0; j < 2; ++j) { const int c = 8 * lane + 512 * j; float f[8];
#pragma unroll
            for (int i = 0; i < 8; ++i) f[i] = 0.f;
#pragma unroll
            for (int k = 0; k < 4; ++k) { const u32x4 y = *(const u32x4*)(YM + (size_t)pos[k] * DM + c);
                f[0] += bflo(y.x); f[1] += bfhi(y.x); f[2] += bflo(y.y); f[3] += bfhi(y.y); f[4] += bflo(y.z); f[5] += bfhi(y.z); f[6] += bflo(y.w); f[7] += bfhi(y.w); }
#pragma unroll
            for (int q = 0; q < 2; ++q) { const f32x4 g = *(const f32x4*)(g2 + c + 4 * q);
                v[j][q] = v[j][q] + g * (f32x4){f[4 * q], f[4 * q + 1], f[4 * q + 2], f[4 * q + 3]};
                if (lastl) *(f32x4*)(xo + c + 4 * q) = v[j][q]; }
            if (!lastl) { u32x4 w; w.x = pk2(v[j][0][0], v[j][0][1]); w.y = pk2(v[j][0][2], v[j][0][3]); w.z = pk2(v[j][1][0], v[j][1][1]); w.w = pk2(v[j][1][2], v[j][1][3]); *(u32x4*)(xbo + c) = w; } }
        if (!lastl) { norm_mod_store(v, a.in[6] + (size_t)(layer + 1) * DM, modv(a, layer + 1, r, 1), modv(a, layer + 1, r, 0), INPROJ_I8 ? (bf16*)nullptr : hw, lane);
            if (INPROJ_I8) store_row_i8(v, dry ? (unsigned char*)(a.ws + WS_ACT + 160 * MiB) + (size_t)r * DM : (unsigned char*)(a.ws + WS_H) + (size_t)r * DM, dry ? (float*)(a.ws + WS_ACT + 240 * MiB) + r : (float*)(a.ws + WS_HSC) + r, lane); }
    }
}

template <int PH>
__device__ __forceinline__ void run_phase(int layer, unsigned char* ldsg, int rep = 0) {
    const Args a = fetch_args();
    const bool nost = PROBE_NOSTORE && rep && ogrid() < 100000;
    LAS unsigned char* lds = (LAS unsigned char*)ldsg;
    const int G = ogrid(), bid = obid();
    if constexpr (PH == PH_PRO) p_prologue(a, lds);
    if constexpr (PH == PH_NORM1) { if (INPROJ_I8) p_quant_win(a); p_norm1(a, layer); }
    if constexpr (PH == PH_INPROJ) {
        if constexpr (INPROJ_I8) { pg8::SchedDense S; S.init(NR, PC, G, bid, nullptr); S.Bt = (const char*)(a.ws + WS_WIN) + (size_t)layer * PC * 1024; S.rb = 1024;
            pg8::EpiI8 E{(bf16*)(a.ws + WS_P), PC, (const float*)(a.ws + WS_HSC), (const float*)(a.ws + WS_WSC) + (size_t)layer * PC, nost}; pg8::gemm_phase<2>(lds, (const void*)(a.ws + WS_H), S, E); }
        else { pg8::SchedDense S; S.init(NR, PC, G, bid, (const bf16*)(a.ws + WS_WIN) + (size_t)layer * PC * 1024);
            pg8::EpiBf16 E{(bf16*)(a.ws + WS_P), PC}; pg8::gemm_phase<0>(lds, (const bf16*)(a.ws + WS_H), S, E); } }
    if constexpr (PH == PH_PREP) { if (PROBE_DOUBLE == 96) p_prep(a, layer, true); p_prep(a, layer); if (NEW_HG || NEW_ML) scan::p_scanA(a, layer, lds, NEW_HG, NEW_ML); if (PROBE_DOUBLE == 20) scan::p_scanA(a, layer, lds, NEW_HG, NEW_ML); }
    if constexpr (PH == PH_SCAN) { if (!NEW_HG || !NEW_ML) p_scan(a, layer, lds, !NEW_HG, !NEW_ML); if (NEW_HG || NEW_ML) scan::p_scanB(a, NEW_HG, NEW_ML); if (PROBE_DOUBLE == 21) scan::p_scanB(a, NEW_HG, NEW_ML); }
    if constexpr (PH == PH_ATTN) { if (NEW_HG || NEW_ML) scan::p_scanC(a, layer, lds, NEW_HG, NEW_ML); if (PROBE_DOUBLE == 22) scan::p_scanC(a, layer, lds, NEW_HG, NEW_ML); p_attn(a, layer, (LAS char*)lds); }
    if constexpr (PH == PH_FINISH) { if (!NEW_HG || !NEW_ML) p_finish(a, layer, !NEW_HG, !NEW_ML); }
    if constexpr (PH == PH_OUTPROJ) { pg8::SchedDense S; S.init(NR, DM, G, bid, nullptr); S.rb = OUTPROJ_FP8 ? 1024 : 2048; S.Bt = (const char*)(a.ws + WS_WOUT) + (size_t)layer * 1024 * S.rb;
        pg8::EpiResid E{a.in[0], a.in[2], (bf16*)(a.ws + WS_XB), (const float*)(a.ws + WS_MOD) + (size_t)layer * 9 * 6144, 2, layer == DEPTH - 1, layer == 0, OUTPROJ_FP8 ? 1.f / 1024.f : 1.f};
        pg8::gemm_phase<OUTPROJ_FP8 ? 1 : 0>(lds, (const void*)(a.ws + WS_Y), S, E); }
    if constexpr (PH == PH_ROUTER) p_router(a, layer, lds);
    if constexpr (PH == PH_DISPATCH) p_dispatch(a, layer, lds);
    if constexpr (PH == PH_GU) { constexpr int RBW = MOE_FP8 ? 1024 : 2048;
        pg8::SchedMoe S{G, bid, 8, 2048, __builtin_amdgcn_readfirstlane(__hip_atomic_load((const int*)(a.ws + WS_NRT), __ATOMIC_RELAXED, __HIP_MEMORY_SCOPE_AGENT)), (const int*)(a.ws + WS_TILEE),
                        (const char*)(a.ws + WS_WGU) + (size_t)layer * 32 * 2048 * RBW, (const int*)(a.ws + WS_TOK), RBW, false, false};
        pg8::EpiGU E{(void*)(a.ws + WS_ACT), a.in[19] + (size_t)layer * 32 * 2048, nost};
        pg8::gemm_phase<MOE_FP8>(lds, MOE_FP8 ? (const void*)(a.ws + WS_H8) : (const void*)(a.ws + WS_H), S, E); }
    if constexpr (PH == PH_DOWN) { constexpr int RBW = MOE_FP8 ? 1024 : 2048;
        pg8::SchedMoe S{G, bid, 4, 1024, __builtin_amdgcn_readfirstlane(__hip_atomic_load((const int*)(a.ws + WS_NRT), __ATOMIC_RELAXED, __HIP_MEMORY_SCOPE_AGENT)), (const int*)(a.ws + WS_TILEE),
                        (const char*)(a.ws + WS_WDN) + (size_t)layer * 32 * 1024 * RBW, nullptr, RBW, MOE_FP8 ? true : false, false};
        if (STAGGER_DOWN > 0 && ((bid >> 5) & 1)) { const unsigned long long t0 = wall_clock64(); while (wall_clock64() - t0 < (unsigned long long)STAGGER_DOWN) __builtin_amdgcn_s_sleep(16); }
        pg8::EpiDown E{(bf16*)(a.ws + WS_YM), a.in[21] + (size_t)layer * 32 * 1024, (const float*)(a.ws + WS_GATEP), nost}; pg8::gemm_phase<MOE_FP8>(lds, (const void*)(a.ws + WS_ACT), S, E); }
    if constexpr (PH == PH_COMBINE) { if (PROBE_DOUBLE == 97) p_combine(a, layer, true); p_combine(a, layer); }
}

template <int PH>
__global__ void __launch_bounds__(NTHR, 2) k_phase(Args a, int layer) {
    extern __shared__ __attribute__((aligned(16))) unsigned char lds[];
    kernel_setup(a);
    run_phase<PH>(layer, lds);
}


__global__ void __launch_bounds__(NTHR, 2) k_mega(Args a) {
    extern __shared__ __attribute__((aligned(16))) unsigned char lds[];
    kernel_setup(a);
    const XcdBarrier bar = xcd_barrier_post((unsigned*)(a.ws + WS_CTL) + CW_BAR, (volatile LAS unsigned*)(MISC_OFF + 32));
#define GRID_BAR() do { for (int rep_ = 0; rep_ < (PROBE_DOUBLE == 99 ? 2 : 1); ++rep_) { const Args b_ = fetch_args(); XcdBarrier bb; bb.bar = (unsigned*)(b_.ws + WS_CTL) + CW_BAR; bb.x = xb_xcc_id(); bb.st = (volatile LAS unsigned*)(MISC_OFF + 32); xcd_barrier(bb); } } while (0)
    run_phase<PH_PRO>(0, lds); GRID_BAR();
    if (PROBE_DOUBLE == PH_PRO) { run_phase<PH_PRO>(0, lds); GRID_BAR(); }
    run_phase<PH_NORM1>(0, lds); GRID_BAR();
#define RUNP(PH, l) do { run_phase<PH>(l, lds); if (PROBE_DOUBLE == PH) { GRID_BAR(); run_phase<PH>(l, lds, 1); } } while (0)
#define LAYER_BODY(l) do { \
        RUNP(PH_INPROJ, l); GRID_BAR(); \
        run_phase<PH_PREP>(l, lds); GRID_BAR(); \
        RUNP(PH_SCAN, l); GRID_BAR(); \
        RUNP(PH_ATTN, l); GRID_BAR(); \
        if (!NEW_HG || !NEW_ML) { RUNP(PH_FINISH, l); GRID_BAR(); } \
        run_phase<PH_OUTPROJ>(l, lds); GRID_BAR(); \
        if (PROBE_DOUBLE == 98 && (l) == 0) { run_phase<PH_OUTPROJ>(l, lds); GRID_BAR(); } \
        RUNP(PH_ROUTER, l); GRID_BAR(); \
        RUNP(PH_DISPATCH, l); GRID_BAR(); \
        RUNP(PH_GU, l); GRID_BAR(); \
        RUNP(PH_DOWN, l); GRID_BAR(); \
        run_phase<PH_COMBINE>(l, lds); \
        if ((l) + 1 < DEPTH) GRID_BAR(); \
    } while (0)
    LAYER_BODY(0); LAYER_BODY(1); LAYER_BODY(2); LAYER_BODY(3);
#undef LAYER_BODY
#undef RUNP
#undef GRID_BAR
}

template <int PH> static void launch_phase(const Args& a, int layer, int grid, hipStream_t stream) {
    static bool attr = false;
    if (!attr) { (void)hipFuncSetAttribute((const void*)k_phase<PH>, hipFuncAttributeMaxDynamicSharedMemorySize, LDS_BYTES); attr = true; }
    hipLaunchKernelGGL(k_phase<PH>, dim3(grid), dim3(NTHR), LDS_BYTES, stream, a, layer);
}

extern "C" void kernel_launch(void* const* d_in, const int* in_sizes, int n_in, void* d_out, int out_size, void* d_ws, size_t ws_size, hipStream_t stream) {
    static int grid = 0;
    if (grid == 0) {
        if (n_in != 22 || out_size != NB * SEQ * DM || ws_size < WS_END) { fprintf(stderr, "kernel_launch: unexpected shapes (n_in %d, out %d, ws %zu < %zu)\n", n_in, out_size, ws_size, (size_t)WS_END); grid = -1; return; }
        int dev = 0, cus = 0;
        if (hipGetDevice(&dev) != hipSuccess || hipDeviceGetAttribute(&cus, hipDeviceAttributeMultiprocessorCount, dev) != hipSuccess) { grid = -1; return; }
        grid = cus;
    }
    if (grid < 0) return;
    (void)hipMemsetAsync((char*)d_ws + WS_CTL, 0, CTL_ZERO_BYTES, stream);
    Args a{};
    for (int i = 0; i < 22; ++i) a.in[i] = (const float*)d_in[i];
    a.out = (float*)d_out; a.ws = (unsigned char*)d_ws; a.ph_lo = 0; a.ph_hi = 0;
#if MK_MULTI
    launch_phase<PH_PRO>(a, 0, grid, stream);
    launch_phase<PH_NORM1>(a, 0, grid, stream);
    for (int l = 0; l < DEPTH; ++l) {
        launch_phase<PH_INPROJ>(a, l, grid, stream);
        launch_phase<PH_PREP>(a, l, grid, stream);
        launch_phase<PH_SCAN>(a, l, grid, stream);
        launch_phase<PH_ATTN>(a, l, grid, stream);
        launch_phase<PH_FINISH>(a, l, grid, stream);
        launch_phase<PH_OUTPROJ>(a, l, grid, stream);
        launch_phase<PH_ROUTER>(a, l, grid, stream);
        launch_phase<PH_DISPATCH>(a, l, grid, stream);
        launch_phase<PH_GU>(a, l, grid, stream);
        launch_phase<PH_DOWN>(a, l, grid, stream);
        launch_phase<PH_COMBINE>(a, l, grid, stream);
    }
#else
    static bool attr = false;
    if (!attr) { (void)hipFuncSetAttribute((const void*)k_mega, hipFuncAttributeMaxDynamicSharedMemorySize, LDS_BYTES); attr = true; }
    hipLaunchKernelGGL(k_mega, dim3(grid), dim3(NTHR), LDS_BYTES, stream, a);
#endif
}
```

```cpp
#include <hip/hip_runtime.h>
#include <cstdio>
#include <cstdint>
#include <cmath>

#ifndef MK_MULTI
#define MK_MULTI 0
#endif
#ifndef MOE_FP8
#define MOE_FP8 1
#endif
#ifndef OUTPROJ_FP8
#define OUTPROJ_FP8 1
#endif
#ifndef INPROJ_I8
#define INPROJ_I8 1
#endif
#ifndef GEMM_ALIGN
#define GEMM_ALIGN 1
#endif
#ifndef NEW_HG
#define NEW_HG 1
#endif
#ifndef NEW_ML
#define NEW_ML 1
#endif
#ifndef PROBE_DOUBLE
#define PROBE_DOUBLE -1
#define L2PF 0
#define STAGGER_DOWN 0
#define PROBE_NOSTORE 0
#endif

#define GAS __attribute__((address_space(1)))
#define LAS __attribute__((address_space(3)))
typedef unsigned short bf16;
typedef short bf16x8 __attribute__((ext_vector_type(8)));
typedef short s16x4 __attribute__((ext_vector_type(4)));
typedef float f32x2 __attribute__((ext_vector_type(2)));
typedef float f32x4 __attribute__((ext_vector_type(4)));
typedef float f32x16 __attribute__((ext_vector_type(16)));
typedef unsigned u32x2 __attribute__((ext_vector_type(2)));
typedef unsigned u32x4 __attribute__((ext_vector_type(4)));
typedef __bf16 bf16x2_t __attribute__((ext_vector_type(2)));
typedef int v8i __attribute__((ext_vector_type(8)));
typedef int v4i __attribute__((ext_vector_type(4)));
typedef unsigned u32x8 __attribute__((ext_vector_type(8)));

constexpr int DM = 1024, NB = 8, SEQ = 4096, CTX = 256, SB = SEQ + CTX  , NR = NB * SB  , DEPTH = 4;
constexpr int PC = 3584;
constexpr int C_ATQ = 0, C_ATK = 512, C_ATV = 768, C_HGQ = 1024, C_HGZF = 1280, C_HGZB = 1536, C_HGV = 1792, C_HGG = 2048,
              C_MLQ = 2304, C_MLK = 2560, C_MLV = 2816, C_MLOG = 3072, C_MLG = 3328;
constexpr int NIN = 3344;
constexpr int NEXP = 32, NPOS = 147456;
constexpr float EPS = 1e-6f;
constexpr int NTHR = 512, NWAVE = 8;

constexpr size_t MiB = 1u << 20;
constexpr size_t WS_CTL = 0, CTL_ZERO_BYTES = 1 * MiB;
constexpr size_t WS_MOD = 1 * MiB;
constexpr size_t WS_ROPE = 2 * MiB;
constexpr size_t WS_WRH = 2 * MiB + 65536, WS_WRL = WS_WRH + 262144;
constexpr size_t WS_WSC = 2 * MiB + 655360;
constexpr size_t WS_HSC = 2 * MiB + 720896;
constexpr size_t WS_RE = 3 * MiB, WS_RS = WS_RE + 600000, WS_RG = WS_RS + 600000, WS_POS = WS_RG + 600000;
constexpr size_t WS_CNT = WS_POS + 600000;
constexpr size_t WS_TOK = 6 * MiB, WS_GATEP = WS_TOK + 600000, WS_TILEE = WS_GATEP + 600000, WS_NRT = WS_TILEE + 8192;
constexpr size_t WS_WIN = 8 * MiB;
constexpr size_t WS_WOUT = 36 * MiB;
constexpr size_t WS_WGU = 44 * MiB;
constexpr size_t WS_WDN = 556 * MiB;
constexpr size_t WS_H = 812 * MiB;
constexpr size_t WS_P = 880 * MiB;
constexpr size_t WS_Y = 1118 * MiB;
constexpr size_t WS_XC = 1186 * MiB;
constexpr size_t WS_ACT = 1194 * MiB;
constexpr size_t WS_YM = 1482 * MiB;
constexpr size_t WS_OH = 1770 * MiB;
constexpr size_t WS_OM = 1838 * MiB;
constexpr size_t WS_UTH = 1906 * MiB, WS_SPH = 1940 * MiB, WS_UTM = 1974 * MiB, WS_SPM = 2008 * MiB;
constexpr size_t WS_DT = 2042 * MiB, WS_NU = WS_DT + 1310720, WS_NP = WS_NU + 1310720, WS_GL = WS_NP + 1310720, WS_MP = WS_GL + 131072;
constexpr size_t WS_H8 = 2046 * MiB;
constexpr size_t WS_XB = 2080 * MiB;
constexpr size_t WS_END = 2148 * MiB;
static_assert(WS_CNT + 32768 <= WS_TOK && WS_NRT + 64 <= WS_WIN, "ws map");
static_assert((size_t)NR * 4 * 4 <= 600000 && (size_t)NPOS * 4 <= 600000, "ws map");

constexpr int CW_CMAX = 16384;
constexpr int CW_BAR = 4096;

constexpr int LDS_BYTES = 147456;
constexpr int PH_LDS = 143360;
constexpr int MISC_OFF = PH_LDS;

struct Args { const float* in[22]; float* out; unsigned char* ws; int ph_lo, ph_hi; };

#define LDS_WAIT() asm volatile("s_waitcnt lgkmcnt(0)" ::: "memory")
#define VM_WAIT() asm volatile("s_waitcnt vmcnt(0)" ::: "memory")

__device__ __forceinline__ unsigned pk2(float lo, float hi) { f32x2 v = {lo, hi}; bf16x2_t b = __builtin_convertvector(v, bf16x2_t); return __builtin_bit_cast(unsigned, b); }
__device__ __forceinline__ unsigned f2bf(float f) { return pk2(f, 0.f) & 0xffffu; }
__device__ __forceinline__ float clamp8(float x) { return fminf(fmaxf(x, -448.f), 448.f); }
__device__ __forceinline__ unsigned pk_fp8x4(float a, float b, float c, float d) {
    int w = 0; w = __builtin_amdgcn_cvt_pk_fp8_f32(clamp8(a), clamp8(b), w, false); w = __builtin_amdgcn_cvt_pk_fp8_f32(clamp8(c), clamp8(d), w, true); return (unsigned)w; }
__device__ __forceinline__ unsigned fp8_1(float a) { return pk_fp8x4(a, 0.f, 0.f, 0.f) & 0xffu; }
__device__ __forceinline__ float bf2f(unsigned h) { return __uint_as_float(h << 16); }
__device__ __forceinline__ float bflo(unsigned w) { return __uint_as_float(w << 16); }
__device__ __forceinline__ float bfhi(unsigned w) { return __uint_as_float(w & 0xffff0000u); }
__device__ __forceinline__ float row16_sum(float v) {
#define WS_DPP(x, ctrl, rmask) __builtin_bit_cast(float, __builtin_amdgcn_update_dpp(0, __builtin_bit_cast(int, x), ctrl, rmask, 0xF, false))
    v += WS_DPP(v, 0xB1, 0xF); v += WS_DPP(v, 0x4E, 0xF); v += WS_DPP(v, 0x141, 0xF); v += WS_DPP(v, 0x140, 0xF);
#undef WS_DPP
    return v;
}
__device__ __forceinline__ float wave_sum(float v) {
#define WS_DPP(x, ctrl, rmask) __builtin_bit_cast(float, __builtin_amdgcn_update_dpp(0, __builtin_bit_cast(int, x), ctrl, rmask, 0xF, false))
    v += WS_DPP(v, 0xB1, 0xF);
    v += WS_DPP(v, 0x4E, 0xF);
    v += WS_DPP(v, 0x141, 0xF);
    v += WS_DPP(v, 0x140, 0xF);
    v += WS_DPP(v, 0x142, 0xA);
    v += WS_DPP(v, 0x143, 0xC);
#undef WS_DPP
    return __builtin_bit_cast(float, __builtin_amdgcn_readlane(__builtin_bit_cast(int, v), 63));
}
__device__ __forceinline__ float wave_max_nn(float v) {
#define WS_DPP(x, ctrl, rmask) __builtin_bit_cast(float, __builtin_amdgcn_update_dpp(0, __builtin_bit_cast(int, x), ctrl, rmask, 0xF, false))
    v = fmaxf(v, WS_DPP(v, 0xB1, 0xF)); v = fmaxf(v, WS_DPP(v, 0x4E, 0xF)); v = fmaxf(v, WS_DPP(v, 0x141, 0xF)); v = fmaxf(v, WS_DPP(v, 0x140, 0xF));
    v = fmaxf(v, WS_DPP(v, 0x142, 0xA)); v = fmaxf(v, WS_DPP(v, 0x143, 0xC));
#undef WS_DPP
    return __builtin_bit_cast(float, __builtin_amdgcn_readlane(__builtin_bit_cast(int, v), 63));
}
__device__ __forceinline__ unsigned pk_i8x4(float a, float b, float c, float d) {
    const int q0 = __float2int_rn(a), q1 = __float2int_rn(b), q2 = __float2int_rn(c), q3 = __float2int_rn(d);
    return (unsigned)(q0 & 0xff) | ((unsigned)(q1 & 0xff) << 8) | ((unsigned)(q2 & 0xff) << 16) | ((unsigned)q3 << 24); }
__device__ __forceinline__ float sigm(float x) { return __builtin_amdgcn_rcpf(1.f + __expf(-x)); }


constexpr int ARGS_OFF = MISC_OFF + 256, WTAB_OFF = MISC_OFF + 512;
__device__ __forceinline__ unsigned hw_slot() { return (unsigned)__builtin_amdgcn_s_getreg((5 << 11) | 4) & 63u; }
__device__ __forceinline__ int lane_id(unsigned zo) { return (int)__builtin_amdgcn_mbcnt_hi(~0u, __builtin_amdgcn_mbcnt_lo(~0u, zo)); }
__device__ __forceinline__ int otid() {
    unsigned zo = 0; asm volatile("" : "+v"(zo));
    const int wave = __builtin_amdgcn_readfirstlane(*(const LAS int*)(WTAB_OFF + hw_slot() * 4 + zo));
    int t = wave * 64 + lane_id(zo); asm volatile("" : "+v"(t)); return t;
}
__device__ __forceinline__ int obid() { int b = blockIdx.x; asm volatile("" : "+s"(b)); return b; }
__device__ __forceinline__ int ogrid() { int g = gridDim.x; asm volatile("" : "+s"(g)); return g; }
__device__ __forceinline__ const void* lds_ptr64(int byte_off, unsigned zo) {
    const u32x2 w = *(const LAS u32x2*)(byte_off + zo);
    const unsigned lo = __builtin_amdgcn_readfirstlane(w.x), hi = __builtin_amdgcn_readfirstlane(w.y);
    return (const void*)(const GAS void*)(((unsigned long long)hi << 32) | lo);
}
__device__ __forceinline__ Args fetch_args() {
    unsigned zo = 0; asm volatile("" : "+v"(zo));
    Args r;
#pragma unroll
    for (int i = 0; i < 22; ++i) r.in[i] = (const float*)lds_ptr64(ARGS_OFF + 8 * i, zo);
    r.out = (float*)lds_ptr64(ARGS_OFF + 8 * 22, zo); r.ws = (unsigned char*)lds_ptr64(ARGS_OFF + 8 * 23, zo); r.ph_lo = 0; r.ph_hi = 0;
    return r;
}
__device__ __forceinline__ void kernel_setup(const Args& a) {
    const int tid = threadIdx.x;
    LAS unsigned* M = (LAS unsigned*)MISC_OFF;
    if (tid < 64) M[tid] = 0u;
    if (tid == 0) { LAS unsigned long long* A = (LAS unsigned long long*)ARGS_OFF;
#pragma unroll
        for (int i = 0; i < 22; ++i) A[i] = (unsigned long long)a.in[i];
        A[22] = (unsigned long long)a.out; A[23] = (unsigned long long)a.ws; }
    if ((tid & 63) == 0) *(LAS int*)(WTAB_OFF + hw_slot() * 4) = tid >> 6;
    __syncthreads();
}

__device__ __forceinline__ const float* x_rd(const Args& a, bool from_input, int r) {
    const int b = r / SB, s = r - b * SB;
    if (s < CTX) return (from_input ? a.in[2] : (const float*)(a.ws + WS_XC)) + (size_t)(b * CTX + s) * DM;
    return (from_input ? a.in[0] : (const float*)a.out) + (size_t)(b * SEQ + s - CTX) * DM;
}
__device__ __forceinline__ float* x_wr(const Args& a, int r) {
    const int b = r / SB, s = r - b * SB;
    if (s < CTX) return (float*)(a.ws + WS_XC) + (size_t)(b * CTX + s) * DM;
    return a.out + (size_t)(b * SEQ + s - CTX) * DM;
}
__device__ __forceinline__ const float* modv(const Args& a, int layer, int r, int chunk) {
    const int b = r / SB, s = r - b * SB; const int j = s < CTX ? 8 : b;
    return (const float*)(a.ws + WS_MOD) + ((size_t)(layer * 9 + j) * 6 + chunk) * DM;
}

#define XB_TMO      128
#define XB_XCNT(j)  (256  + 64 * (j))
#define XB_XSUB(j)  (1280 + 64 * (j))
#define XB_XGEN(j)  (2304 + 64 * (j))
#define XB_TOP      3328
#define XB_TOPGEN   3392
#define XCD_BAR_WORDS 3456
#define XB_SPIN_CAP (1u << 18)
__device__ __forceinline__ unsigned xb_ld(unsigned* p)              { return __hip_atomic_load(p, __ATOMIC_RELAXED, __HIP_MEMORY_SCOPE_AGENT); }
__device__ __forceinline__ unsigned xb_add(unsigned* p, unsigned v) { return __hip_atomic_fetch_add(p, v, __ATOMIC_RELAXED, __HIP_MEMORY_SCOPE_AGENT); }
__device__ __forceinline__ unsigned xb_xcc_id() { return (unsigned)__builtin_amdgcn_s_getreg((3 << 11) | 20) & 0xFu; }
#define XB_SPIN(cond, bar) do { unsigned _sp = 0; while (cond) { __builtin_amdgcn_s_sleep(1); \
    if ((++_sp & 255u) == 0u) { if (xb_ld(&(bar)[XB_TMO])) break; if (_sp > XB_SPIN_CAP) { atomicAdd(&(bar)[XB_TMO], 1u); break; } } } } while (0)
struct XcdBarrier { unsigned* bar; unsigned x; volatile LAS unsigned* st; };
__device__ __forceinline__ XcdBarrier xcd_barrier_post(unsigned* bar, volatile LAS unsigned* st) {
    XcdBarrier b; b.bar = bar; b.x = xb_xcc_id(); b.st = st;
    if (otid() == 0) (void)xb_add(&bar[XB_XCNT(b.x)], 1u);
    return b;
}
__device__ __forceinline__ void xcd_barrier_complete(unsigned* bar, unsigned x, unsigned& nloc, unsigned& nx) {
    const unsigned G = gridDim.x * gridDim.y * gridDim.z;
    unsigned sum, cnt, mine, sp = 0u;
    for (;;) {
        sum = 0u; cnt = 0u; mine = 0u;
#pragma unroll
        for (unsigned j = 0; j < 16; ++j) { const unsigned c = xb_ld(&bar[XB_XCNT(j)]); sum += c; cnt += (c > 0u) ? 1u : 0u; mine = (j == x) ? c : mine; }
        if (sum == G) break;
        __builtin_amdgcn_s_sleep(1);
        if ((++sp & 255u) == 0u) { if (xb_ld(&bar[XB_TMO])) break; if (sp > XB_SPIN_CAP) { atomicAdd(&bar[XB_TMO], 1u); break; } }
    }
    nloc = mine > 0u ? mine : 1u; nx = cnt > 0u ? cnt : 1u;
}
__device__ __forceinline__ void xcd_barrier(const XcdBarrier& b) {
    asm volatile("s_waitcnt vmcnt(0)" ::: "memory");
    __syncthreads();
    if (otid() == 0) {
        unsigned* bar = b.bar;
        __builtin_amdgcn_s_waitcnt(0);
        unsigned nloc = b.st[0], nx = b.st[1];
        if (nloc == 0u) { xcd_barrier_complete(bar, b.x, nloc, nx); b.st[0] = nloc; b.st[1] = nx; }
        const unsigned old = xb_add(&bar[XB_XSUB(b.x)], 1u);
        const unsigned gen = old / nloc;
        if (old + 1u == (gen + 1u) * nloc) {
            __builtin_amdgcn_fence(__ATOMIC_RELEASE, "agent");
            asm volatile("s_waitcnt vmcnt(0)" ::: "memory");
            const unsigned og = xb_add(&bar[XB_TOP], 1u);
            const unsigned tg = og / nx;
            if (og + 1u == (tg + 1u) * nx) xb_add(&bar[XB_TOPGEN], 1u);
            else XB_SPIN(xb_ld(&bar[XB_TOPGEN]) == tg, bar);
            __builtin_amdgcn_fence(__ATOMIC_ACQUIRE, "agent");
            xb_add(&bar[XB_XGEN(b.x)], 1u);
            asm volatile("s_waitcnt vmcnt(0)" ::: "memory");
        } else {
            XB_SPIN(xb_ld(&bar[XB_XGEN(b.x)]) == gen, bar);
            __builtin_amdgcn_fence(__ATOMIC_ACQUIRE, "agent");
            asm volatile("s_waitcnt vmcnt(0)" ::: "memory");
        }
    }
    __syncthreads();
}

__device__ __forceinline__ void glds16s2(const void* sbase, unsigned voff0, unsigned voff1, unsigned lds0, unsigned lds1) {
    unsigned keep;
    asm volatile("s_mov_b32 %0, m0\n\ts_mov_b32 m0, %4\n\ts_nop 0\n\tglobal_load_lds_dwordx4 %1, %3\n\ts_mov_b32 m0, %5\n\ts_nop 0\n\tglobal_load_lds_dwordx4 %2, %3\n\ts_mov_b32 m0, %0"
                 : "=&s"(keep) : "v"(voff0), "v"(voff1), "s"(sbase), "s"(lds0), "s"(lds1) : "memory");
}

__device__ __forceinline__ void glds16s1(const void* sbase, unsigned voff, unsigned lds0) {
    unsigned keep;
    asm volatile("s_mov_b32 %0, m0\n\ts_mov_b32 m0, %3\n\ts_nop 0\n\tglobal_load_lds_dwordx4 %1, %2\n\ts_mov_b32 m0, %0" : "=&s"(keep) : "v"(voff), "s"(sbase), "s"(lds0) : "memory");
}
__device__ __forceinline__ void glds4s1(const void* sbase, unsigned voff, unsigned lds0) {
    unsigned keep;
    asm volatile("s_mov_b32 %0, m0\n\ts_mov_b32 m0, %3\n\ts_nop 0\n\tglobal_load_lds_dword %1, %2\n\ts_mov_b32 m0, %0" : "=&s"(keep) : "v"(voff), "s"(sbase), "s"(lds0) : "memory");
}
struct AuxSrc { const void* base; unsigned off; };

namespace pg8 {
constexpr int BM = 256, BK = 64, HALF = 128, HTB = HALF * BK * 2, STAGE_BYTES = 8 * HTB, NXCD = 8, WGM = 8, K = 1024;
__host__ __device__ __forceinline__ int lds_byte(int r, int c) { const int st = (r >> 4) * 2 + (c >> 5), rr = r & 15, cc = c & 31, ob = rr * 64 + cc * 2; return st * 1024 + (ob ^ (((ob >> 9) & 1) << 5)); }
__host__ __device__ __forceinline__ void stage_rc(int b, int& R, int& C) { const int st = b / 1024, sb = b % 1024, swz = sb ^ (((sb >> 9) & 1) << 5); R = (st >> 1) * 16 + swz / 64; C = (st & 1) * 32 + (swz % 64) / 2; }
__host__ __device__ __forceinline__ int perm32(int rho) { const int n = rho >> 4, i = rho & 15; return 8 * (i >> 2) + 4 * n + (i & 3); }

struct Unit { int pm, pn, e; const char* Bt; };

struct SchedDense {
    int nM, nN, nwg, G, c, rb; const char* Bt;
    __device__ void init(int M, int N, int G_, int c_, const bf16* Bt_) { nM = M / BM; nN = N / BM; nwg = nM * nN; G = G_; c = c_; Bt = (const char*)Bt_; rb = 2 * K; }
    __device__ __forceinline__ bool next(int i, Unit& u) const {
        const long L = (long)i * G + c; if (L >= nwg) return false;
        int wgid = (int)L; { const int q = nwg / NXCD, r = nwg % NXCD, xcd = wgid % NXCD, off = wgid / NXCD; wgid = (xcd < r ? xcd * (q + 1) : r * (q + 1) + (xcd - r) * q) + off; }
        const int nig = WGM * nN, gid = wgid / nig, fm = gid * WGM, gsz = (nM - fm) < WGM ? (nM - fm) : WGM;
        u.pm = fm + ((wgid % nig) % gsz); u.pn = (wgid % nig) / gsz; u.e = 0; u.Bt = Bt + (size_t)u.pn * BM * rb; return true;
    }
    __device__ __forceinline__ int row(const Unit& u, int local) const { return u.pm * BM + local; }
    __device__ __forceinline__ bool tiledA() const { return false; }
};
struct SchedMoe {
    int G, c, nct, ntot, nrt; const int* tile_e; const char* WT; const int* tok; int rb  ; bool tiled; bool rev  ;
    __device__ __forceinline__ bool next(int i, Unit& u) const {
        int rt, pn;
        if ((G & 7) == 0) { const int x = c & 7, j = c >> 3, per = G >> 3, base = nrt >> 3, rem = nrt & 7;
            const int cnt = base + (x < rem ? 1 : 0), start = x * base + (x < rem ? x : rem), q = i * per + j;
            if (q >= cnt * nct) return false;
            const int rl = q / nct; pn = q - rl * nct; rt = start + (rev ? cnt - 1 - rl : rl); }
        else { const int L = i * G + c; if (L >= nrt * nct) return false; rt = L / nct; pn = L - rt * nct; }
        u.pm = rt; u.pn = pn; u.e = __builtin_amdgcn_readfirstlane(__hip_atomic_load(tile_e + rt, __ATOMIC_RELAXED, __HIP_MEMORY_SCOPE_AGENT));
        u.Bt = WT + ((size_t)u.e * ntot + (size_t)u.pn * BM) * rb; return true;
    }
    __device__ __forceinline__ int row(const Unit& u, int local) const { return tok ? tok[u.pm * BM + local] : u.pm * BM + local; }
    __device__ __forceinline__ bool tiledA() const { return tiled; }
};

template <int MODE  , class Epi, class Sched>
__device__ __forceinline__ void gemm_phase(LAS unsigned char* lds, const void* Abase, const Sched& S, const Epi& E) {
    const int tid = otid(), wid = __builtin_amdgcn_readfirstlane(tid >> 6), lane = tid & 63, wr = wid >> 2, wc = wid & 3, fr = lane & 15, fq = lane >> 4;
    constexpr bool FP8 = (MODE == 1), I8 = (MODE == 2);
    constexpr int RB = MODE ? K : 2 * K;
    constexpr int nt = RB / 128;
    int R0, C0; stage_rc(tid * 16, R0, C0);
    constexpr bool TB = (MODE != 0);
    static_assert(!TB || Epi::PERM, "staging-order weights assume the permuted column order");
    const unsigned voffB0 = TB ? (unsigned)tid * 16u : (unsigned)((Epi::PERM ? ((R0 & ~31) + perm32(R0 & 31)) : R0) * RB + C0 * 2);
    constexpr size_t kstep = (size_t)(BK * 2);
    const size_t kstepA = S.tiledA() ? (size_t)32768 : kstep;
    constexpr size_t kstepB = TB ? (size_t)32768 : kstep;
    constexpr size_t hstep = TB ? (size_t)16384 : (size_t)HALF * RB;
    const unsigned ldsw = (unsigned)wid * 1024u, ldsb = (unsigned)(size_t)lds;
    const int aoff = lds_byte(wr * 64 + fr, fq * 8), boff = lds_byte(wc * 32 + fr, fq * 8);
    const char* Ab = (const char*)Abase;
    LAS u32x4* nslot = (LAS u32x4*)(lds + STAGE_BYTES + tid * 16);
    constexpr int AUX_OFF = STAGE_BYTES + 8192;
#define PG8_AUX(u, idx) do { if (wid < 2) { const AuxSrc s_ = E.aux(wid, u, lane); if (s_.base) glds16s1(s_.base, s_.off, ldsb + (unsigned)(AUX_OFF + ((idx) & 1) * 2048 + wid * 1024)); } } while (0)
#define PG8_SA(b, h) (((b) * 2 + (h)) * HTB)
#define PG8_SB(b, h) ((4 + (b) * 2 + (h)) * HTB)
#define PG8_STAGEA(bufoff, gbase, voff) glds16s2((gbase), (voff)[0], (voff)[1], ldsb + (unsigned)(bufoff) + ldsw, ldsb + (unsigned)(bufoff) + ldsw + 8192u)
#define PG8_STAGEB(bufoff, gbase) glds16s2((gbase), voffB0, voffB0 + (unsigned)(TB ? 8192 : 64 * RB), ldsb + (unsigned)(bufoff) + ldsw, ldsb + (unsigned)(bufoff) + ldsw + 8192u)
#define PG8_LDA(dst, b, h) do { if constexpr (FP8) { _Pragma("unroll") for (int m = 0; m < 4; ++m) { dst##8[m].lo = *(const LAS u32x4*)(lds + PG8_SA(b, h) + aoff + m * 2048); dst##8[m].hi = *(const LAS u32x4*)(lds + PG8_SA(b, h) + aoff + m * 2048 + 1024); } } \
    else { _Pragma("unroll") for (int m = 0; m < 4; ++m) _Pragma("unroll") for (int k = 0; k < 2; ++k) dst[m][k] = *(const LAS bf16x8*)(lds + PG8_SA(b, h) + aoff + m * 2048 + k * 1024); } } while (0)
#define PG8_LDB(dst, b, h) do { if constexpr (FP8) { _Pragma("unroll") for (int n = 0; n < 2; ++n) { dst##8[n].lo = *(const LAS u32x4*)(lds + PG8_SB(b, h) + boff + n * 2048); dst##8[n].hi = *(const LAS u32x4*)(lds + PG8_SB(b, h) + boff + n * 2048 + 1024); } } \
    else { _Pragma("unroll") for (int n = 0; n < 2; ++n) _Pragma("unroll") for (int k = 0; k < 2; ++k) dst[n][k] = *(const LAS bf16x8*)(lds + PG8_SB(b, h) + boff + n * 2048 + k * 1024); } } while (0)
#define PG8_MMA(ai, bj, At, Bt) do { __builtin_amdgcn_s_setprio(1); if constexpr (FP8) { _Pragma("unroll") for (int m = 0; m < 4; ++m) _Pragma("unroll") for (int n = 0; n < 2; ++n) \
        acc[ai][bj][m][n] = __builtin_amdgcn_mfma_scale_f32_16x16x128_f8f6f4(__builtin_bit_cast(v8i, Bt##8[n]), __builtin_bit_cast(v8i, At##8[m]), acc[ai][bj][m][n], 0, 0, 0, 0x7f7f7f7f, 0, 0x7f7f7f7f); } \
        else if constexpr (I8) { _Pragma("unroll") for (int m = 0; m < 4; ++m) _Pragma("unroll") for (int n = 0; n < 2; ++n) _Pragma("unroll") for (int k = 0; k < 2; ++k) \
        acc[ai][bj][m][n] = __builtin_bit_cast(f32x4, __builtin_amdgcn_mfma_i32_16x16x64_i8(__builtin_bit_cast(v4i, Bt[n][k]), __builtin_bit_cast(v4i, At[m][k]), __builtin_bit_cast(v4i, acc[ai][bj][m][n]), 0, 0, 0)); } \
        else { _Pragma("unroll") for (int m = 0; m < 4; ++m) _Pragma("unroll") for (int n = 0; n < 2; ++n) _Pragma("unroll") for (int k = 0; k < 2; ++k) \
        acc[ai][bj][m][n] = __builtin_amdgcn_mfma_f32_16x16x32_bf16(Bt[n][k], At[m][k], acc[ai][bj][m][n], 0, 0, 0); } __builtin_amdgcn_s_setprio(0); } while (0)
#define PG8_WAIT_V(n) asm volatile("s_waitcnt vmcnt(" #n ")" ::: "memory")
#define PG8_WAIT_L(n) asm volatile("s_waitcnt lgkmcnt(" #n ")" ::: "memory")
#define PG8_BAR __builtin_amdgcn_s_barrier()
#define PG8_SCHED __builtin_amdgcn_sched_barrier(0)
#define PG8_VAOFF(u, h, i) (S.tiledA() ? (unsigned)((u).pm * 262144 + (((((h) * 4 + (R0 >> 4)) * 2 + (i)) * 4 + (C0 >> 4)) * 512) + ((R0 & 15) * 4 + ((C0 >> 2) & 3)) * 8) \
                                       : (unsigned)(S.row(u, (h) * HALF + R0 + 64 * (i)) * RB + C0 * 2))
    Unit cur, nxt; int ui = 0;
    if (!S.next(0, cur)) return;
    f32x4 acc[2][2][4][2];
#pragma unroll
    for (int a = 0; a < 2; ++a)
#pragma unroll
        for (int b = 0; b < 2; ++b)
#pragma unroll
            for (int m = 0; m < 4; ++m)
#pragma unroll
                for (int n = 0; n < 2; ++n) acc[a][b][m][n] = (f32x4){0.f, 0.f, 0.f, 0.f};
    bf16x8 At[4][2], B0[2][2], B1[2][2];
    u32x8 At8[4], B08[2], B18[2];
    unsigned vA[2][2];
#pragma unroll
    for (int h = 0; h < 2; ++h)
#pragma unroll
        for (int i = 0; i < 2; ++i) vA[h][i] = PG8_VAOFF(cur, h, i);
    const char* cB = cur.Bt;
    PG8_AUX(cur, 0);
    PG8_STAGEB(PG8_SB(0, 0), cB); PG8_STAGEB(PG8_SB(0, 1), cB + hstep); PG8_STAGEA(PG8_SA(0, 0), Ab, vA[0]); PG8_STAGEA(PG8_SA(0, 1), Ab, vA[1]);
    if (wr == 1) PG8_BAR;
    PG8_WAIT_V(2); PG8_BAR;
    PG8_STAGEB(PG8_SB(1, 0), cB + kstepB); PG8_STAGEA(PG8_SA(1, 0), Ab + kstepA, vA[0]); PG8_STAGEB(PG8_SB(1, 1), cB + hstep + kstepB);
    PG8_WAIT_V(6); PG8_BAR;
    for (;;) {
        const bool has_next = S.next(ui + 1, nxt);
        if (has_next) *nslot = (u32x4){PG8_VAOFF(nxt, 0, 0), PG8_VAOFF(nxt, 0, 1), PG8_VAOFF(nxt, 1, 0), PG8_VAOFF(nxt, 1, 1)};
        const char* nB = has_next ? nxt.Bt : cB;
#pragma unroll 1
        for (int t = 0; t < nt; t += 2) {
            const bool last = (t == nt - 2);
            const char* a1 = Ab + (size_t)(t + 1) * kstepA;
            const char* a2 = last ? Ab : Ab + (size_t)(t + 2) * kstepA; const char* b2 = last ? nB : cB + (size_t)(t + 2) * kstepB;
            const char* a3 = a2 + kstepA; const char* b3 = b2 + kstepB;
            PG8_LDB(B0, 0, 0); PG8_LDB(B1, 0, 1); PG8_SCHED; PG8_LDA(At, 0, 0); PG8_STAGEA(PG8_SA(1, 1), a1, vA[1]);
            if (last && has_next) { const u32x4 nv = *nslot; vA[0][0] = nv.x; vA[0][1] = nv.y; vA[1][0] = nv.z; vA[1][1] = nv.w; }
            PG8_WAIT_V(8); PG8_WAIT_L(0); PG8_BAR; PG8_MMA(0, 0, At, B0); PG8_MMA(0, 1, At, B1); PG8_BAR; PG8_SCHED;
            PG8_LDA(At, 0, 1); PG8_STAGEB(PG8_SB(0, 0), b2); PG8_STAGEB(PG8_SB(0, 1), b2 + hstep); PG8_STAGEA(PG8_SA(0, 0), a2, vA[0]);
            PG8_WAIT_V(8); PG8_WAIT_L(0); PG8_BAR; PG8_MMA(1, 0, At, B0); PG8_MMA(1, 1, At, B1); PG8_BAR; PG8_SCHED;
            PG8_LDB(B0, 1, 0); PG8_LDB(B1, 1, 1); PG8_SCHED; PG8_LDA(At, 1, 0); PG8_STAGEA(PG8_SA(0, 1), a2, vA[1]);
            PG8_WAIT_V(8); PG8_WAIT_L(0); PG8_BAR; PG8_MMA(0, 0, At, B0); PG8_MMA(0, 1, At, B1); PG8_BAR; PG8_SCHED;
            PG8_LDA(At, 1, 1); PG8_STAGEB(PG8_SB(1, 0), b3); PG8_STAGEB(PG8_SB(1, 1), b3 + hstep); PG8_STAGEA(PG8_SA(1, 0), a3, vA[0]);
            PG8_WAIT_V(8); PG8_WAIT_L(0); PG8_BAR; PG8_MMA(1, 0, At, B0); PG8_MMA(1, 1, At, B1); PG8_BAR; PG8_SCHED;
        }
        if (GEMM_ALIGN && wr == 0) PG8_BAR;
        if constexpr (L2PF && MODE != 0) { if (has_next) {
            const int sa = nxt.pn & 3, sb = nxt.pm & 3;
            const unsigned oA = (sa == 0 ? vA[0][0] : sa == 1 ? vA[0][1] : sa == 2 ? vA[1][0] : vA[1][1]) + (unsigned)C0 * 14u;
            const unsigned oB = voffB0 + (unsigned)((sb & 1) * 64 * RB) + (unsigned)((sb >> 1) * (int)hstep) + (unsigned)C0 * 14u;
            const unsigned pfd = (unsigned)(MISC_OFF + 2048) + (unsigned)wid * 256u;
            glds4s1(Ab, oA, pfd); glds4s1(nB, oB, pfd); } }
        { int fr_ = fr, fq_ = fq; asm volatile("" : "+v"(fr_), "+v"(fq_));
          if (!E.skip()) E(acc, cur, wr, wc, fr_, fq_, (const LAS float*)(lds + AUX_OFF + (ui & 1) * 2048), (const LAS float*)(lds + AUX_OFF + (ui & 1) * 2048 + 1024)); }
        if (!has_next) break;
#pragma unroll
        for (int a = 0; a < 2; ++a)
#pragma unroll
            for (int b = 0; b < 2; ++b)
#pragma unroll
                for (int m = 0; m < 4; ++m)
#pragma unroll
                    for (int n = 0; n < 2; ++n) acc[a][b][m][n] = (f32x4){0.f, 0.f, 0.f, 0.f};
        cur = nxt; cB = nB; ++ui;
        PG8_AUX(cur, ui);
        if (GEMM_ALIGN && wr == 1) PG8_BAR;
    }
    PG8_WAIT_V(0);
    if (!GEMM_ALIGN && wr == 0) PG8_BAR;
    PG8_BAR;
#undef PG8_SA
#undef PG8_SB
#undef PG8_STAGEA
#undef PG8_STAGEB
#undef PG8_LDA
#undef PG8_LDB
#undef PG8_MMA
#undef PG8_WAIT_V
#undef PG8_WAIT_L
#undef PG8_BAR
#undef PG8_SCHED
#undef PG8_VAOFF
#undef PG8_AUX
}

struct EpiBf16 {
    static constexpr bool PERM = true;
    bf16* O; int ldc;
    __device__ __forceinline__ bool skip() const { return false; }
    __device__ __forceinline__ AuxSrc aux(int, const Unit&, int) const { return AuxSrc{nullptr, 0u}; }
    __device__ __forceinline__ void operator()(const f32x4 (&acc)[2][2][4][2], const Unit& u, int wr, int wc, int fr, int fq, const LAS float*, const LAS float*) const {
        const int row0 = u.pm * BM + wr * 64 + fr, col0 = u.pn * BM + wc * 32 + 8 * fq;
#pragma unroll
        for (int ai = 0; ai < 2; ++ai)
#pragma unroll
            for (int m = 0; m < 4; ++m) { bf16* rowp = O + (size_t)(row0 + ai * HALF + m * 16) * ldc + col0;
#pragma unroll
                for (int bj = 0; bj < 2; ++bj) { const f32x4 v0 = acc[ai][bj][m][0], v1 = acc[ai][bj][m][1];
                    u32x4 w; w.x = pk2(v0[0], v0[1]); w.y = pk2(v0[2], v0[3]); w.z = pk2(v1[0], v1[1]); w.w = pk2(v1[2], v1[3]);
                    *(u32x4*)(rowp + bj * HALF) = w; } }
    }
};
struct EpiI8 {
    static constexpr bool PERM = true;
    bf16* O; int ldc; const float* hs; const float* ws; bool nost; int nreal  ;
    __device__ __forceinline__ bool skip() const { return PROBE_NOSTORE == 2 && nost; }
    __device__ __forceinline__ AuxSrc aux(int which, const Unit& u, int lane) const { return which == 0 ? AuxSrc{ws + u.pn * BM, (unsigned)lane * 16u} : AuxSrc{hs + u.pm * BM, (unsigned)lane * 16u}; }
    __device__ __forceinline__ void operator()(const f32x4 (&acc)[2][2][4][2], const Unit& u, int wr, int wc, int fr, int fq, const LAS float* a0, const LAS float* a1) const {
        const int row0 = u.pm * BM + wr * 64 + fr, col0 = u.pn * BM + wc * 32 + 8 * fq;
        f32x4 wv[2][2];
#pragma unroll
        for (int bj = 0; bj < 2; ++bj)
#pragma unroll
            for (int n = 0; n < 2; ++n) wv[bj][n] = *(const LAS f32x4*)(a0 + wc * 32 + 8 * fq + bj * HALF + 4 * n);
#pragma unroll
        for (int ai = 0; ai < 2; ++ai)
#pragma unroll
            for (int m = 0; m < 4; ++m) { const int row = row0 + ai * HALF + m * 16; const float hr = a1[wr * 64 + fr + ai * HALF + m * 16]; bf16* rowp = O + (size_t)row * ldc + col0;
#pragma unroll
                for (int bj = 0; bj < 2; ++bj) { const f32x4 v0 = __builtin_convertvector(__builtin_bit_cast(v4i, acc[ai][bj][m][0]), f32x4) * hr * wv[bj][0], v1 = __builtin_convertvector(__builtin_bit_cast(v4i, acc[ai][bj][m][1]), f32x4) * hr * wv[bj][1];
                    u32x4 w; w.x = pk2(v0[0], v0[1]); w.y = pk2(v0[2], v0[3]); w.z = pk2(v1[0], v1[1]); w.w = pk2(v1[2], v1[3]);
                    if (!nost && col0 + bj * HALF < nreal) *(u32x4*)(rowp + bj * HALF) = w; } }
    }
};
struct EpiResid {
    static constexpr bool PERM = true;
    const float* xin_lat; const float* xin_ctx; bf16* xb; const float* mod  ; int chunk; bool skip_ctx, first; float sc;
    __device__ __forceinline__ bool skip() const { return false; }
    __device__ __forceinline__ AuxSrc aux(int which, const Unit& u, int lane) const { const int b = u.pm / 17, j = u.pm - b * 17;
        return which == 0 ? AuxSrc{mod + (size_t)((j == 0 ? 8 : b) * 6 + chunk) * DM + u.pn * BM, (unsigned)lane * 16u} : AuxSrc{nullptr, 0u}; }
    __device__ __forceinline__ void operator()(const f32x4 (&acc)[2][2][4][2], const Unit& u, int wr, int wc, int fr, int fq, const LAS float* a0, const LAS float*) const {
        const int b = u.pm / 17, j = u.pm - b * 17; const bool isctx = (j == 0);
        if (isctx && skip_ctx) return;
        const float* xin = isctx ? xin_ctx + (size_t)b * CTX * DM : xin_lat + ((size_t)b * SEQ + (size_t)(j - 1) * 256) * DM;
        bf16* xt = xb + (size_t)u.pm * BM * DM;
        const int col0 = u.pn * BM + wc * 32 + 8 * fq;
        f32x4 gv[2][2];
#pragma unroll
        for (int bj = 0; bj < 2; ++bj)
#pragma unroll
            for (int n = 0; n < 2; ++n) gv[bj][n] = *(const LAS f32x4*)(a0 + wc * 32 + 8 * fq + bj * HALF + 4 * n) * sc;
#pragma unroll
        for (int ai = 0; ai < 2; ++ai)
#pragma unroll
            for (int m = 0; m < 4; ++m) { const size_t ro = (size_t)(ai * HALF + wr * 64 + m * 16 + fr) * DM;
#pragma unroll
                for (int bj = 0; bj < 2; ++bj) { const int c = col0 + bj * HALF; f32x4 x0, x1;
                    if (first) { x0 = *(const f32x4*)(xin + ro + c); x1 = *(const f32x4*)(xin + ro + c + 4); }
                    else { const u32x4 w = *(const u32x4*)(xt + ro + c); x0 = (f32x4){bflo(w.x), bfhi(w.x), bflo(w.y), bfhi(w.y)}; x1 = (f32x4){bflo(w.z), bfhi(w.z), bflo(w.w), bfhi(w.w)}; }
                    x0 = x0 + gv[bj][0] * acc[ai][bj][m][0]; x1 = x1 + gv[bj][1] * acc[ai][bj][m][1];
                    u32x4 o; o.x = pk2(x0[0], x0[1]); o.y = pk2(x0[2], x0[3]); o.z = pk2(x1[0], x1[1]); o.w = pk2(x1[2], x1[3]);
                    *(u32x4*)(xt + ro + c) = o; } }
    }
};
struct EpiGU {
    static constexpr bool PERM = true;
    void* ACT; const float* bgu  ; bool nost;
    __device__ __forceinline__ bool skip() const { return PROBE_NOSTORE == 2 && nost; }
    __device__ __forceinline__ AuxSrc aux(int which, const Unit& u, int lane) const {
        return which == 0 ? AuxSrc{bgu + (size_t)u.e * 2048 + u.pn * HALF, lane < 32 ? (unsigned)lane * 16u : 4096u + (unsigned)(lane - 32) * 16u} : AuxSrc{nullptr, 0u}; }
    __device__ __forceinline__ void operator()(const f32x4 (&acc)[2][2][4][2], const Unit& u, int wr, int wc, int fr, int fq, const LAS float* a0, const LAS float*) const {
        const int row0 = u.pm * BM + wr * 64 + fr, col0 = u.pn * HALF + wc * 32 + 8 * fq;
        constexpr float SC = MOE_FP8 ? 1.f / 512.f : 1.f;
        f32x4 bgv[2], buv[2];
#pragma unroll
        for (int n = 0; n < 2; ++n) { bgv[n] = *(const LAS f32x4*)(a0 + wc * 32 + 8 * fq + 4 * n); buv[n] = *(const LAS f32x4*)(a0 + HALF + wc * 32 + 8 * fq + 4 * n); }
#pragma unroll
        for (int ai = 0; ai < 2; ++ai)
#pragma unroll
            for (int m = 0; m < 4; ++m) { float o[8];
#pragma unroll
                for (int n = 0; n < 2; ++n)
#pragma unroll
                    for (int i = 0; i < 4; ++i) { float gt = acc[ai][0][m][n][i] * SC + bgv[n][i], up = acc[ai][1][m][n][i] * SC + buv[n][i];
                        gt = fminf(gt, 7.f); up = fminf(fmaxf(up, -7.f), 7.f);
                        o[4 * n + i] = (up + 1.f) * gt * sigm(1.702f * gt); }
                const size_t eo = MOE_FP8 ? (size_t)(u.pm * 8 + u.pn) * 32768 + (size_t)(((((ai * 4 + m) * 2 + wr) * 4 + wc) * 512) + (fr * 4 + fq) * 8)
                                          : (size_t)(row0 + ai * HALF + m * 16) * DM + col0;
                if constexpr (MOE_FP8) { u32x2 w; w.x = pk_fp8x4(4.f * o[0], 4.f * o[1], 4.f * o[2], 4.f * o[3]); w.y = pk_fp8x4(4.f * o[4], 4.f * o[5], 4.f * o[6], 4.f * o[7]);
                    if (!nost) *(u32x2*)((unsigned char*)ACT + eo) = w; }
                else { u32x4 w; w.x = pk2(o[0], o[1]); w.y = pk2(o[2], o[3]); w.z = pk2(o[4], o[5]); w.w = pk2(o[6], o[7]); *(u32x4*)((bf16*)ACT + eo) = w; } }
    }
};
struct EpiDown {
    static constexpr bool PERM = true;
    bf16* YM; const float* bdn  ; const float* gatep; bool nost;
    __device__ __forceinline__ bool skip() const { return PROBE_NOSTORE == 2 && nost; }
    __device__ __forceinline__ AuxSrc aux(int which, const Unit& u, int lane) const {
        return which == 0 ? AuxSrc{bdn + (size_t)u.e * 1024 + u.pn * BM, (unsigned)lane * 16u} : AuxSrc{gatep + (size_t)u.pm * BM, (unsigned)lane * 16u}; }
    __device__ __forceinline__ void operator()(const f32x4 (&acc)[2][2][4][2], const Unit& u, int wr, int wc, int fr, int fq, const LAS float* a0, const LAS float* a1) const {
        const int row0 = u.pm * BM + wr * 64 + fr, col0 = u.pn * BM + wc * 32 + 8 * fq;
        constexpr float SC = MOE_FP8 ? 1.f / 256.f : 1.f;
        f32x4 bv[2][2];
#pragma unroll
        for (int bj = 0; bj < 2; ++bj)
#pragma unroll
            for (int n = 0; n < 2; ++n) bv[bj][n] = *(const LAS f32x4*)(a0 + wc * 32 + 8 * fq + bj * HALF + 4 * n);
#pragma unroll
        for (int ai = 0; ai < 2; ++ai)
#pragma unroll
            for (int m = 0; m < 4; ++m) { const int row = row0 + ai * HALF + m * 16; const float gt = a1[wr * 64 + fr + ai * HALF + m * 16]; bf16* rowp = YM + (size_t)row * DM + col0;
#pragma unroll
                for (int bj = 0; bj < 2; ++bj) { const f32x4 v0 = (acc[ai][bj][m][0] * SC + bv[bj][0]) * gt, v1 = (acc[ai][bj][m][1] * SC + bv[bj][1]) * gt;
                    u32x4 w; w.x = pk2(v0[0], v0[1]); w.y = pk2(v0[2], v0[3]); w.z = pk2(v1[0], v1[1]); w.w = pk2(v1[2], v1[3]);
                    if (!nost) *(u32x4*)(rowp + bj * HALF) = w; } }
    }
};
}

namespace att {
constexpr int D = 128, NW = 8, QBLK = 32, KVBLK = 64;
constexpr float SCALE = 0.088388347648318440f;
constexpr float THR = 8.f;
constexpr int LDQ = PC, LDK = PC, LDO = DM;
constexpr size_t SHM_V = KVBLK * D * 2, SHM_K = KVBLK * D * 2, SHM_ATTN = 2 * SHM_V + 2 * SHM_K + NW * 64 * 4;
#define KSWZ(row, colB) ((row) * 256 + ((colB) ^ (((row) & 15) << 4)))
#define SBAR() __builtin_amdgcn_sched_barrier(0)
__device__ __forceinline__ int crow(int r, int hi) { return (r & 3) + 8 * (r >> 2) + 4 * hi; }
__device__ __forceinline__ unsigned cvtpk(float lo, float hi) { unsigned r; asm volatile("v_cvt_pk_bf16_f32 %0, %1, %2" : "=v"(r) : "v"(lo), "v"(hi)); return r; }
__device__ __forceinline__ bf16x8 ld8(const bf16* p) { return *reinterpret_cast<const bf16x8*>(p); }
__device__ __forceinline__ void finishSM(f32x16& p0, f32x16& p1, float& l_reg, bf16x8& pa0, bf16x8& pa1, bf16x8& pa2, bf16x8& pa3) {
  for (int r = 0; r < 16; ++r) p1[r] = __builtin_amdgcn_exp2f(p1[r]);
  float ps = 0; for (int r = 0; r < 16; ++r) ps += p0[r]; for (int r = 0; r < 16; ++r) ps += p1[r];
  { auto rr = __builtin_amdgcn_permlane32_swap(__float_as_uint(ps), __float_as_uint(ps), false, false);
    ps = __uint_as_float(rr[0]) + __uint_as_float(rr[1]); }
  l_reg += ps;
#define PK4(P, BASE, OUT) do { unsigned a0 = cvtpk(P[BASE + 0], P[BASE + 1]), a1 = cvtpk(P[BASE + 2], P[BASE + 3]);   \
    unsigned b0 = cvtpk(P[BASE + 4], P[BASE + 5]), b1 = cvtpk(P[BASE + 6], P[BASE + 7]);                              \
    auto r0 = __builtin_amdgcn_permlane32_swap(a0, b0, false, false); auto r1 = __builtin_amdgcn_permlane32_swap(a1, b1, false, false); \
    u32x4 w = {r0[0], r1[0], r0[1], r1[1]}; OUT = *reinterpret_cast<bf16x8*>(&w); } while (0)
  PK4(p0, 0, pa0); PK4(p0, 8, pa1); PK4(p1, 0, pa2); PK4(p1, 8, pa3);
#undef PK4
}
__device__ __forceinline__ void qkt(f32x16& p0, f32x16& p1, const LAS char* Ks, const bf16x8* qr, int r32, int hi, float negm) {
#pragma unroll
  for (int r = 0; r < 16; ++r) { p0[r] = negm; p1[r] = negm; }
  for (int d0 = 0; d0 < 8; ++d0) { int cb = (d0 * 16 + hi * 8) * 2;
    bf16x8 b0 = *reinterpret_cast<const LAS bf16x8*>(Ks + KSWZ(r32, cb));
    bf16x8 b1 = *reinterpret_cast<const LAS bf16x8*>(Ks + KSWZ(32 + r32, cb));
    p0 = __builtin_amdgcn_mfma_f32_32x32x16_bf16(b0, qr[d0], p0, 0, 0, 0);
    p1 = __builtin_amdgcn_mfma_f32_32x32x16_bf16(b1, qr[d0], p1, 0, 0, 0); }
}
__device__ __forceinline__ void partialSM_fix(f32x16& p0) { for (int r = 0; r < 16; ++r) p0[r] = __builtin_amdgcn_exp2f(p0[r]); }
__device__ __forceinline__ int v_st(int k, int c) { const int kk = (k & ~0xC) | ((k & 4) << 1) | ((k & 8) >> 1); return ((kk >> 3) * 4 + (c >> 5)) * 512 + ((kk & 7) * 32 + (c & 31)) * 2; }
__device__ __forceinline__ int v_rd_base(int lane) { return ((lane & 3) << 3) | (((lane >> 2) & 3) << 6) | (((lane >> 4) & 1) << 5) | (((lane >> 5) & 1) << 8); }
constexpr int v_rd_off(int d0, int ks, int half) { return d0 * 512 + ks * 4096 + half * 2048; }
template <int OFF> __device__ __forceinline__ s16x4 tr_read(int vb) {
  s16x4 r; asm volatile("ds_read_b64_tr_b16 %0, %1 offset:%2" : "=&v"(r) : "v"(vb), "i"(OFF) : "memory"); return r;
}
template <int D0> __device__ __forceinline__ void pv_one(f32x16& od, int vb, bf16x8 pa0, bf16x8 pa1, bf16x8 pa2, bf16x8 pa3) {
  const s16x4 l0 = tr_read<v_rd_off(D0, 0, 0)>(vb), h0 = tr_read<v_rd_off(D0, 0, 1)>(vb), l1 = tr_read<v_rd_off(D0, 1, 0)>(vb), h1 = tr_read<v_rd_off(D0, 1, 1)>(vb);
  const s16x4 l2 = tr_read<v_rd_off(D0, 2, 0)>(vb), h2 = tr_read<v_rd_off(D0, 2, 1)>(vb), l3 = tr_read<v_rd_off(D0, 3, 0)>(vb), h3 = tr_read<v_rd_off(D0, 3, 1)>(vb);
  asm volatile("s_waitcnt lgkmcnt(0)" ::: "memory"); SBAR();
#define PK(L, H) (bf16x8){L[0], L[1], L[2], L[3], H[0], H[1], H[2], H[3]}
  od = __builtin_amdgcn_mfma_f32_32x32x16_bf16(pa0, PK(l0, h0), od, 0, 0, 0);
  od = __builtin_amdgcn_mfma_f32_32x32x16_bf16(pa1, PK(l1, h1), od, 0, 0, 0);
  od = __builtin_amdgcn_mfma_f32_32x32x16_bf16(pa2, PK(l2, h2), od, 0, 0, 0);
  od = __builtin_amdgcn_mfma_f32_32x32x16_bf16(pa3, PK(l3, h3), od, 0, 0, 0);
#undef PK
}
__device__ __forceinline__ void pv_d0(f32x16* o, int vb, bf16x8 pa0, bf16x8 pa1, bf16x8 pa2, bf16x8 pa3) {
  pv_one<0>(o[0], vb, pa0, pa1, pa2, pa3); pv_one<1>(o[1], vb, pa0, pa1, pa2, pa3); pv_one<2>(o[2], vb, pa0, pa1, pa2, pa3); pv_one<3>(o[3], vb, pa0, pa1, pa2, pa3);
}
__device__ __forceinline__ void attn_dense_body(const bf16* __restrict__ Qb, const bf16* __restrict__ Kh, const bf16* __restrict__ Vh, bf16* __restrict__ Ob, int seq, LAS char* lds,
                                                const float* __restrict__ qg, const float* __restrict__ ropet, int t0, float negm_u, int exactmax) {
  const int tid = otid(), wid = tid >> 6, lane = tid & 63, r32 = lane & 31, hi = lane >> 5;
  LAS char* V_lds = lds; LAS char* K_lds = lds + 2 * SHM_V;
  LAS float* ws = (LAS float*)(lds + 2 * SHM_V + 2 * SHM_K) + wid * 64; LAS float* li_l = ws;
  float l_reg = 0; f32x16 o[4] = {}; bf16x8 qr[8];
  const bf16* Qw = Qb + (long)(wid * QBLK + r32) * LDQ + hi * 8;
#pragma unroll
  for (int d0 = 0; d0 < 8; ++d0) qr[d0] = ld8(Qw + d0 * 16);
  { float x[8][8]; float ss = 0.f;
#pragma unroll
    for (int d0 = 0; d0 < 8; ++d0) { const u32x4 w = __builtin_bit_cast(u32x4, qr[d0]);
#pragma unroll
      for (int p = 0; p < 4; ++p) { x[d0][2 * p] = bflo(w[p]); x[d0][2 * p + 1] = bfhi(w[p]); ss += x[d0][2 * p] * x[d0][2 * p] + x[d0][2 * p + 1] * x[d0][2 * p + 1]; } }
    { auto rr = __builtin_amdgcn_permlane32_swap(__float_as_uint(ss), __float_as_uint(ss), false, false); ss = __uint_as_float(rr[0]) + __uint_as_float(rr[1]); }
    const float rstd = __builtin_amdgcn_rsqf(ss * (1.f / 128.f) + EPS) * (SCALE * 1.4426950408889634f);
#pragma unroll
    for (int d0 = 0; d0 < 8; ++d0) { const f32x4 g0 = *(const f32x4*)(qg + 16 * d0 + 8 * hi), g1 = *(const f32x4*)(qg + 16 * d0 + 8 * hi + 4);
#pragma unroll
      for (int j = 0; j < 4; ++j) { x[d0][j] *= rstd * g0[j]; x[d0][4 + j] *= rstd * g1[j]; } }
    if (t0 >= 0) { const int t = t0 + wid * QBLK + r32;
#pragma unroll
      for (int kind = 0; kind < 2; ++kind) { const int pos = kind == 0 ? (t >> 6) : (t & 63);
#pragma unroll
        for (int e = 0; e < 2; ++e) { const float* cp = ropet + pos * 32 + 16 * e + 8 * hi;
          const f32x4 c0 = *(const f32x4*)cp, c1 = *(const f32x4*)(cp + 4), s0 = *(const f32x4*)(cp + 2048), s1 = *(const f32x4*)(cp + 2048 + 4);
#pragma unroll
          for (int j = 0; j < 8; ++j) { const float cs = j < 4 ? c0[j & 3] : c1[j & 3], sn = j < 4 ? s0[j & 3] : s1[j & 3];
            const float a1 = x[4 * kind + e][j], a2 = x[4 * kind + 2 + e][j]; x[4 * kind + e][j] = a1 * cs - a2 * sn; x[4 * kind + 2 + e][j] = a2 * cs + a1 * sn; } } } }
#pragma unroll
    for (int d0 = 0; d0 < 8; ++d0) { u32x4 w; w.x = pk2(x[d0][0], x[d0][1]); w.y = pk2(x[d0][2], x[d0][3]); w.z = pk2(x[d0][4], x[d0][5]); w.w = pk2(x[d0][6], x[d0][7]); qr[d0] = __builtin_bit_cast(bf16x8, w); } }
  const int sr = tid >> 4, sc = (tid & 15) * 8, vst0 = v_st(sr, sc), vst1 = v_st(32 + sr, sc);
  const int vb0 = (int)(unsigned)(size_t)V_lds + v_rd_base(lane);
  const unsigned goff = (unsigned)(sr * LDK + sc) * 2u;
  const char* Kb0 = (const char*)Kh; const char* Vb0 = (const char*)Vh;
  const int NT = seq / KVBLK;
  float negm = negm_u;
  if (exactmax) {
    float mrow = -3.0e38f; f32x16 p0, p1;
    for (int j = 0; j < NT; ++j) { const size_t to_ = (size_t)j * KVBLK * LDK * 2;
      const bf16x8 k0 = *(const bf16x8*)(Kb0 + to_ + goff), k1 = *(const bf16x8*)(Kb0 + to_ + (size_t)32 * LDK * 2 + goff);
      __syncthreads();
      *(LAS bf16x8*)(K_lds + KSWZ(sr, sc * 2)) = k0; *(LAS bf16x8*)(K_lds + KSWZ(32 + sr, sc * 2)) = k1;
      __syncthreads();
      qkt(p0, p1, K_lds, qr, r32, hi, 0.f);
#pragma unroll
      for (int r = 0; r < 16; ++r) mrow = fmaxf(mrow, fmaxf(p0[r], p1[r])); }
    { auto rr = __builtin_amdgcn_permlane32_swap(__float_as_uint(mrow), __float_as_uint(mrow), false, false); mrow = fmaxf(__uint_as_float(rr[0]), __uint_as_float(rr[1])); }
    negm = -mrow; __syncthreads(); }
  struct { bf16x8 vs0, vs1, ks0, ks1; } sr_[1];
#define SLOAD(i, k0) do { const size_t to_ = (size_t)(k0) * LDK * 2; \
    sr_[i].vs0 = *(const bf16x8*)(Vb0 + to_ + goff); sr_[i].vs1 = *(const bf16x8*)(Vb0 + to_ + (size_t)32 * LDK * 2 + goff); \
    sr_[i].ks0 = *(const bf16x8*)(Kb0 + to_ + goff); sr_[i].ks1 = *(const bf16x8*)(Kb0 + to_ + (size_t)32 * LDK * 2 + goff); } while (0)
#define SWRITE(b, i) do { *(LAS bf16x8*)(V_lds + (b) * SHM_V + vst0) = sr_[i].vs0;          \
    *(LAS bf16x8*)(V_lds + (b) * SHM_V + vst1) = sr_[i].vs1; int kc = sc * 2;               \
    *(LAS bf16x8*)(K_lds + (b) * SHM_K + KSWZ(sr, kc)) = sr_[i].ks0;                       \
    *(LAS bf16x8*)(K_lds + (b) * SHM_K + KSWZ(32 + sr, kc)) = sr_[i].ks1; } while (0)
#define SWAIT() asm volatile("s_waitcnt vmcnt(0)" ::: "memory")
#define PSM(P0) do { for (int r_ = 0; r_ < 16; ++r_) P0[r_] = __builtin_amdgcn_exp2f(P0[r_]); } while (0)
  f32x16 pA0, pA1, pB0, pB1; bf16x8 pa0, pa1, pa2, pa3;
  constexpr int SE = 0, SO = 0;
  SLOAD(SE, 0); asm volatile("s_waitcnt vmcnt(0)" ::: "memory"); SWRITE(0, SE); __syncthreads();
  qkt(pA0, pA1, K_lds, qr, r32, hi, negm); PSM(pA0);
  SLOAD(SO, KVBLK);
  SWAIT(); SWRITE(1, SO); if (2 < NT) SLOAD(SE, 2 * KVBLK); __syncthreads();
  for (int j = 1; j + 1 < NT; j += 2) {
    SBAR(); qkt(pB0, pB1, K_lds + SHM_K, qr, r32, hi, negm);
    finishSM(pA0, pA1, l_reg, pa0, pa1, pa2, pa3); SBAR();
    pv_d0(o, vb0, pa0, pa1, pa2, pa3); PSM(pB0);
    __syncthreads(); SWAIT(); SWRITE(0, SE); SBAR(); SLOAD(SO, (j + 2) * KVBLK); SBAR();
    __syncthreads();
    SBAR(); qkt(pA0, pA1, K_lds, qr, r32, hi, negm);
    finishSM(pB0, pB1, l_reg, pa0, pa1, pa2, pa3); SBAR();
    pv_d0(o, vb0 + (int)SHM_V, pa0, pa1, pa2, pa3); PSM(pA0);
    __syncthreads(); SWAIT(); SWRITE(1, SO); SBAR(); if (j + 3 < NT) SLOAD(SE, (j + 3) * KVBLK); SBAR();
    __syncthreads();
  }
  SBAR(); qkt(pB0, pB1, K_lds + SHM_K, qr, r32, hi, negm);
  finishSM(pA0, pA1, l_reg, pa0, pa1, pa2, pa3); SBAR();
  pv_d0(o, vb0, pa0, pa1, pa2, pa3); PSM(pB0);
  __syncthreads();
  finishSM(pB0, pB1, l_reg, pa0, pa1, pa2, pa3); SBAR();
  pv_d0(o, vb0 + (int)SHM_V, pa0, pa1, pa2, pa3);
#undef PSM
  if (hi == 0) li_l[r32] = l_reg; asm volatile("s_waitcnt lgkmcnt(0)" ::: "memory");
  float rli[16];
#pragma unroll
  for (int r = 0; r < 16; ++r) rli[r] = __builtin_amdgcn_rcpf(li_l[crow(r, hi)]);
  bf16* Ow = Ob + (long)(wid * QBLK) * LDO;
#pragma unroll
  for (int r = 0; r < 16; ++r) { int orow = crow(r, hi);
    for (int d0 = 0; d0 < 4; ++d0) { if (OUTPROJ_FP8) ((unsigned char*)Ob)[(long)(wid * QBLK + orow) * LDO + d0 * 32 + r32] = (unsigned char)fp8_1(16.f * o[d0][r] * rli[r]); else Ow[(long)orow * LDO + d0 * 32 + r32] = (bf16)f2bf(o[d0][r] * rli[r]); } }
#undef SLOAD
#undef SWRITE
#undef SWAIT
}
}

enum { PH_PRO = 0, PH_NORM1 = 1, PH_INPROJ = 2, PH_PREP = 3, PH_SCAN = 4, PH_ATTN = 5, PH_FINISH = 6, PH_OUTPROJ = 7, PH_ROUTER = 8, PH_DISPATCH = 9, PH_GU = 10, PH_DOWN = 11, PH_COMBINE = 12, NPH = 13 };

struct MapIn  { __device__ __forceinline__ int operator()(int n) const { return n < 2320 ? n + 1024 : n - 2320; } };
struct MapId  { __device__ __forceinline__ int operator()(int n) const { return n; } };
struct MapGU  { __device__ __forceinline__ int operator()(int n) const { const int bj = n >> 10, w = n & 1023; return (w >> 7) * 256 + bj * 128 + (w & 127); } };
__device__ __forceinline__ size_t wt_off(int nrow, int kbyte) {
    const int ntile = nrow >> 8, nl = nrow & 255, h = nl >> 7, g = nl & 127, g5 = g & 31;
    const int rho = (g & ~31) + ((g5 >> 2) & 1) * 16 + (g5 >> 3) * 4 + (g5 & 3);
    const int i = rho >> 6, R0 = rho & 63, st = (R0 >> 4) * 2 + ((kbyte >> 6) & 1), swz = (R0 & 15) * 64 + (kbyte & 63), sb = swz ^ (((swz >> 9) & 1) << 5);
    return (size_t)ntile * 262144 + (size_t)(kbyte >> 7) * 32768 + (size_t)(((h * 2 + i) * 8 + st) * 1024 + sb);
}
struct TrItem { const float* W; unsigned char* WT; int N, kind  , kb, nb, m  ; unsigned* cmax; };
__device__ __forceinline__ int tr_map(int kind, int n) {
    if (kind == 0) return n < 2320 ? n + 1024 : n - 2320;
    if (kind == 2) { const int bj = n >> 10, w = n & 1023; return (w >> 7) * 256 + bj * 128 + (w & 127); }
    return n;
}
__device__ __forceinline__ void tr_load(f32x4 (&v)[16], const TrItem& t, int lane) {
    const int nq = (lane & 15) * 4, kr = lane >> 4; const bool okn = 64 * t.nb + nq < t.N;
#pragma unroll
    for (int j = 0; j < 16; ++j) v[j] = okn ? *(const f32x4*)(t.W + (size_t)(64 * t.kb + kr + 4 * j) * t.N + 64 * t.nb + nq) : (f32x4){0.f, 0.f, 0.f, 0.f};
}
__device__ __forceinline__ void tr_store(const f32x4 (&v)[16], const TrItem& t, LAS float* scr, int lane) {
    const int k0 = 64 * t.kb, n0 = 64 * t.nb, nq = (lane & 15) * 4, kr = lane >> 4;
#pragma unroll
    for (int j = 0; j < 16; ++j) { LAS float* s = scr + (kr + 4 * j) * 65 + nq; s[0] = v[j][0]; s[1] = v[j][1]; s[2] = v[j][2]; s[3] = v[j][3]; }
    LDS_WAIT(); asm volatile("" ::: "memory");
    if (INPROJ_I8 && t.kind == 0) {
        const int n = n0 + lane; float mx = 0.f;
#pragma unroll 8
        for (int k = 0; k < 64; ++k) mx = fmaxf(mx, fabsf(scr[k * 65 + lane]));
        if (n < t.N) __hip_atomic_fetch_max(t.cmax + t.m * PC + tr_map(0, n), __float_as_uint(mx), __ATOMIC_RELAXED, __HIP_MEMORY_SCOPE_AGENT);
        LDS_WAIT(); asm volatile("" ::: "memory"); return; }
    if ((MOE_FP8 && t.kind >= 2) || (OUTPROJ_FP8 && t.kind == 1)) { const int c = lane & 3;
#pragma unroll
        for (int j = 0; j < 4; ++j) { const int nl = (lane >> 2) + 16 * j, n = n0 + nl; const LAS float* s = scr + (16 * c) * 65 + nl;
            u32x4 o; o.x = pk_fp8x4(64.f * s[0 * 65], 64.f * s[1 * 65], 64.f * s[2 * 65], 64.f * s[3 * 65]); o.y = pk_fp8x4(64.f * s[4 * 65], 64.f * s[5 * 65], 64.f * s[6 * 65], 64.f * s[7 * 65]);
            o.z = pk_fp8x4(64.f * s[8 * 65], 64.f * s[9 * 65], 64.f * s[10 * 65], 64.f * s[11 * 65]); o.w = pk_fp8x4(64.f * s[12 * 65], 64.f * s[13 * 65], 64.f * s[14 * 65], 64.f * s[15 * 65]);
            if (n < t.N) *(u32x4*)(t.WT + wt_off(tr_map(t.kind, n), k0 + 16 * c)) = o; } }
    else { const int c = lane & 7;
#pragma unroll
        for (int j = 0; j < 8; ++j) { const int nl = (lane >> 3) + 8 * j, n = n0 + nl; const LAS float* s = scr + (8 * c) * 65 + nl;
            u32x4 o; o.x = pk2(s[0 * 65], s[1 * 65]); o.y = pk2(s[2 * 65], s[3 * 65]); o.z = pk2(s[4 * 65], s[5 * 65]); o.w = pk2(s[6 * 65], s[7 * 65]);
            if (n < t.N) *(u32x4*)((bf16*)t.WT + (size_t)tr_map(t.kind, n) * 1024 + k0 + 8 * c) = o; } }
    LDS_WAIT(); asm volatile("" ::: "memory");
}
__device__ __forceinline__ void tr_load_w(f32x4 (&v)[16], const TrItem& t, int lane) {
    const int nq = (lane & 7) * 4, kr = lane >> 3;
#pragma unroll
    for (int j = 0; j < 16; ++j) v[j] = *(const f32x4*)(t.W + (size_t)(128 * t.kb + kr + 8 * j) * t.N + 32 * t.nb + nq);
}
__device__ __forceinline__ void tr_store_w(const f32x4 (&v)[16], const TrItem& t, LAS float* scr, int lane) {
    const int k0 = 128 * t.kb, n0 = 32 * t.nb, nq = (lane & 7) * 4, kr = lane >> 3;
#pragma unroll
    for (int j = 0; j < 16; ++j) { LAS float* s = scr + (kr + 8 * j) * 33 + nq; s[0] = v[j][0]; s[1] = v[j][1]; s[2] = v[j][2]; s[3] = v[j][3]; }
    LDS_WAIT(); asm volatile("" ::: "memory");
    const int c = lane & 7;
#pragma unroll
    for (int j = 0; j < 4; ++j) { const int nl = (lane >> 3) + 8 * j, n = n0 + nl; const LAS float* s = scr + (16 * c) * 33 + nl;
        u32x4 o; o.x = pk_fp8x4(64.f * s[0 * 33], 64.f * s[1 * 33], 64.f * s[2 * 33], 64.f * s[3 * 33]); o.y = pk_fp8x4(64.f * s[4 * 33], 64.f * s[5 * 33], 64.f * s[6 * 33], 64.f * s[7 * 33]);
        o.z = pk_fp8x4(64.f * s[8 * 33], 64.f * s[9 * 33], 64.f * s[10 * 33], 64.f * s[11 * 33]); o.w = pk_fp8x4(64.f * s[12 * 33], 64.f * s[13 * 33], 64.f * s[14 * 33], 64.f * s[15 * 33]);
        *(u32x4*)(t.WT + wt_off(tr_map(t.kind, n), k0 + 16 * c)) = o; }
    LDS_WAIT(); asm volatile("" ::: "memory");
}
__device__ __forceinline__ void p_prologue(const Args& a, LAS unsigned char* lds) {
    const int tid = otid(), lane = tid & 63, wave = tid >> 6, G = ogrid(), bid = obid();
    const int gw = bid * NWAVE + wave, NGW = G * NWAVE;
    const int gt = bid * NTHR + tid, NGT = G * NTHR;
    LAS float* scr = (LAS float*)(lds + wave * 16896);
    constexpr int NNB_IN = (NIN + 63) / 64;
    constexpr int I_IN = 16 * NNB_IN, I_OUT = 16 * 16, I_GU = 16 * 32, I_DN = 16 * 16;
    constexpr int T_IN = DEPTH * I_IN, T_OUT = DEPTH * I_OUT, T_GU = DEPTH * NEXP * I_GU, T_DN = DEPTH * NEXP * I_DN;
    constexpr int NITEMS = T_IN + T_OUT + T_GU + T_DN;
    constexpr size_t WB = MOE_FP8 ? 1 : 2;
    auto decode = [&](int it) { TrItem t; int r = it;
        if (r < T_IN) { const int m = r / I_IN, q = r % I_IN; t.W = a.in[8] + (size_t)m * 1024 * NIN; t.WT = a.ws + WS_WIN + (size_t)m * PC * 1024 * 2; t.N = NIN; t.kind = 0; t.kb = q / NNB_IN; t.nb = q % NNB_IN; t.m = m; t.cmax = (unsigned*)(a.ws + WS_CTL) + CW_CMAX; return t; } r -= T_IN;
        if (r < T_OUT) { const int m = r / I_OUT, q = r % I_OUT; t.W = a.in[9] + (size_t)m * 1024 * 1024; t.WT = a.ws + WS_WOUT + (size_t)m * 1024 * 1024 * (OUTPROJ_FP8 ? 1 : 2); t.N = 1024; t.kind = 1; t.kb = q / 16; t.nb = q % 16; return t; } r -= T_OUT;
        if (r < T_GU) { const int m = r / I_GU, q = r % I_GU; t.W = a.in[18] + (size_t)m * 1024 * 2048; t.WT = a.ws + WS_WGU + (size_t)m * 2048 * 1024 * WB; t.N = 2048; t.kind = 2; if (MOE_FP8) { t.kb = q / 64; t.nb = q % 64; } else { t.kb = q / 32; t.nb = q % 32; } return t; } r -= T_GU;
        { const int m = r / I_DN, q = r % I_DN; t.W = a.in[20] + (size_t)m * 1024 * 1024; t.WT = a.ws + WS_WDN + (size_t)m * 1024 * 1024 * WB; t.N = 1024; t.kind = 3; if (MOE_FP8) { t.kb = q / 32; t.nb = q % 32; } else { t.kb = q / 16; t.nb = q % 16; } return t; } };
    if (gw < NITEMS) {
        TrItem cur = decode(gw); f32x4 vc[16]; if (MOE_FP8 && cur.kind >= 2) tr_load_w(vc, cur, lane); else tr_load(vc, cur, lane);
        for (int it = gw; it < NITEMS; it += NGW) {
            const bool more = it + NGW < NITEMS; TrItem nxt = cur; f32x4 vn[16];
            if (more) { nxt = decode(it + NGW); if (MOE_FP8 && nxt.kind >= 2) tr_load_w(vn, nxt, lane); else tr_load(vn, nxt, lane); }
            if (MOE_FP8 && cur.kind >= 2) tr_store_w(vc, cur, scr, lane); else tr_store(vc, cur, scr, lane);
            if (more) { cur = nxt;
#pragma unroll
                for (int j = 0; j < 16; ++j) vc[j] = vn[j]; }
        }
    }
    if (!INPROJ_I8) for (int i = gt; i < DEPTH * (PC - NIN) * 128; i += NGT) { const int m = i / ((PC - NIN) * 128), q = i % ((PC - NIN) * 128);
        *(u32x4*)((bf16*)(a.ws + WS_WIN) + ((size_t)m * PC + NIN) * 1024 + (size_t)q * 8) = (u32x4){0u, 0u, 0u, 0u}; }
    for (int i = gt; i < DEPTH * 32 * 1024; i += NGT) { const int l = i >> 15, e = (i >> 10) & 31, k = i & 1023;
        const float w = a.in[16][((size_t)l * 1024 + k) * 32 + e]; const unsigned h = f2bf(w); const float lo = w - bf2f(h);
        ((bf16*)(a.ws + WS_WRH))[i] = (bf16)h; ((bf16*)(a.ws + WS_WRL))[i] = (bf16)f2bf(lo); }
    for (int i = gt; i < 64 * 32; i += NGT) { const int pos = i >> 5, fi = i & 31;
        const float inv = powf(10000.f, -(float)(2 * fi) / 64.f); const float ang = (float)pos * inv;
        ((float*)(a.ws + WS_ROPE))[i] = cosf(ang); ((float*)(a.ws + WS_ROPE))[2048 + i] = sinf(ang); }
    __syncthreads();
    {
        LAS float* SL = (LAS float*)lds;
        LAS float* PT = (LAS float*)(lds + 40960);
        bool have = false;
        for (int it = bid; it < DEPTH * 96; it += G) {
            if (!have) { for (int i = tid; i < 9 * 1024; i += NTHR) { const float v = i < 8192 ? a.in[1][i] : a.in[3][i - 8192]; SL[i] = v / (1.f + expf(-v)); } have = true; __syncthreads(); }
            const int l = it / 96, n = (it % 96) * 64 + lane;
            const float* W = a.in[4] + ((size_t)l * 1024 + wave * 128) * 6144 + n;
            float acc[9];
#pragma unroll
            for (int j = 0; j < 9; ++j) acc[j] = 0.f;
            for (int k0 = 0; k0 < 128; k0 += 32) { float wv[32];
#pragma unroll
                for (int i = 0; i < 32; ++i) wv[i] = W[(size_t)(k0 + i) * 6144];
#pragma unroll
                for (int i4 = 0; i4 < 32; i4 += 4)
#pragma unroll
                    for (int j = 0; j < 9; ++j) { const f32x4 sv = *(const LAS f32x4*)(SL + j * 1024 + wave * 128 + k0 + i4);
                        acc[j] += sv[0] * wv[i4] + sv[1] * wv[i4 + 1] + sv[2] * wv[i4 + 2] + sv[3] * wv[i4 + 3]; } }
#pragma unroll
            for (int j = 0; j < 9; ++j) PT[(wave * 9 + j) * 64 + lane] = acc[j];
            __syncthreads();
            for (int i = tid; i < 9 * 64; i += NTHR) { const int j = i >> 6, c = i & 63; float s = 0.f;
#pragma unroll
                for (int w = 0; w < 8; ++w) s += PT[(w * 9 + j) * 64 + c];
                const int nn = (it % 96) * 64 + c;
                ((float*)(a.ws + WS_MOD))[(size_t)(l * 9 + j) * 6144 + nn] = s + a.in[5][(size_t)l * 6144 + nn]; }
            __syncthreads();
        }
    }
}

__device__ __forceinline__ void norm_mod_store(f32x4 (&v)[2][2], const float* gn, const float* sc, const float* sh, bf16* hrow, int lane) {
    float ss = 0.f;
#pragma unroll
    for (int j = 0; j < 2; ++j)
#pragma unroll
        for (int q = 0; q < 2; ++q) ss += (v[j][q][0] * v[j][q][0] + v[j][q][1] * v[j][q][1]) + (v[j][q][2] * v[j][q][2] + v[j][q][3] * v[j][q][3]);
    const float rstd = 1.f / sqrtf(wave_sum(ss) * (1.f / DM) + EPS);
#pragma unroll
    for (int j = 0; j < 2; ++j) { const int c = 8 * lane + 512 * j;
#pragma unroll
        for (int q = 0; q < 2; ++q) { const f32x4 g = *(const f32x4*)(gn + c + 4 * q), s1 = *(const f32x4*)(sc + c + 4 * q), s0 = *(const f32x4*)(sh + c + 4 * q);
            v[j][q] = v[j][q] * rstd * g * (1.f + s1) + s0; }
        if (hrow) { u32x4 w; w.x = pk2(v[j][0][0], v[j][0][1]); w.y = pk2(v[j][0][2], v[j][0][3]); w.z = pk2(v[j][1][0], v[j][1][1]); w.w = pk2(v[j][1][2], v[j][1][3]);
            *(u32x4*)(hrow + c) = w; } }
}
__device__ __forceinline__ void load_row_bf(const bf16* xr, f32x4 (&v)[2][2], int lane) {
#pragma unroll
    for (int j = 0; j < 2; ++j) { const u32x4 w = *(const u32x4*)(xr + 8 * lane + 512 * j);
        v[j][0] = (f32x4){bflo(w.x), bfhi(w.x), bflo(w.y), bfhi(w.y)}; v[j][1] = (f32x4){bflo(w.z), bfhi(w.z), bflo(w.w), bfhi(w.w)}; }
}
__device__ __forceinline__ void load_row(const float* xr, f32x4 (&v)[2][2], int lane) {
#pragma unroll
    for (int j = 0; j < 2; ++j)
#pragma unroll
        for (int q = 0; q < 2; ++q) v[j][q] = *(const f32x4*)(xr + 8 * lane + 512 * j + 4 * q);
}

__device__ __forceinline__ void p_quant_win(const Args& a) {
    const int gt = obid() * NTHR + otid(), NGT = ogrid() * NTHR;
    const unsigned* CM = (const unsigned*)(a.ws + WS_CTL) + CW_CMAX; float* WSC = (float*)(a.ws + WS_WSC); unsigned char* W8 = (unsigned char*)(a.ws + WS_WIN);
    for (int idx = gt; idx < DEPTH * 64 * PC; idx += NGT) { const int l = idx / (64 * PC), rem = idx - l * (64 * PC), kc = rem / PC, j = rem - kc * PC;
        u32x4 o = {0u, 0u, 0u, 0u}; float s = 0.f;
        if (j < NIN) { const int n = j < 1024 ? j + 2320 : j - 1024; const float cm = __uint_as_float(__hip_atomic_load(CM + l * PC + j, __ATOMIC_RELAXED, __HIP_MEMORY_SCOPE_AGENT));
            s = cm * (1.f / 127.f); const float inv = cm > 0.f ? 127.f / cm : 0.f; const float* wp = a.in[8] + ((size_t)l * 1024 + 16 * kc) * NIN + n; float w[16];
#pragma unroll
            for (int i = 0; i < 16; ++i) w[i] = wp[(size_t)i * NIN] * inv;
            o.x = pk_i8x4(w[0], w[1], w[2], w[3]); o.y = pk_i8x4(w[4], w[5], w[6], w[7]); o.z = pk_i8x4(w[8], w[9], w[10], w[11]); o.w = pk_i8x4(w[12], w[13], w[14], w[15]); }
        *(u32x4*)(W8 + (size_t)l * PC * 1024 + wt_off(j, 16 * kc)) = o;
        if (kc == 0) WSC[l * PC + j] = s; }
}
__device__ __forceinline__ void store_row_i8(const f32x4 (&v)[2][2], unsigned char* hrow, float* hs, int lane) {
    float mx = 0.f;
#pragma unroll
    for (int j = 0; j < 2; ++j)
#pragma unroll
        for (int q = 0; q < 2; ++q) mx = fmaxf(fmaxf(mx, fmaxf(fabsf(v[j][q][0]), fabsf(v[j][q][1]))), fmaxf(fabsf(v[j][q][2]), fabsf(v[j][q][3])));
    mx = fmaxf(wave_max_nn(mx), 1e-20f); const float inv = 127.f / mx;
#pragma unroll
    for (int j = 0; j < 2; ++j) { u32x2 w; w.x = pk_i8x4(v[j][0][0] * inv, v[j][0][1] * inv, v[j][0][2] * inv, v[j][0][3] * inv); w.y = pk_i8x4(v[j][1][0] * inv, v[j][1][1] * inv, v[j][1][2] * inv, v[j][1][3] * inv);
        *(u32x2*)(hrow + 8 * lane + 512 * j) = w; }
    if (lane == 0) *hs = mx * (1.f / 127.f);
}
__device__ __forceinline__ void p_norm1(const Args& a, int layer) {
    const int tid = otid(), lane = tid & 63, wave = tid >> 6; const int gw = obid() * NWAVE + wave, NGW = ogrid() * NWAVE;
    bf16* H = (bf16*)(a.ws + WS_H);
    for (int r = gw; r < NR; r += NGW) { f32x4 v[2][2]; load_row(x_rd(a, layer == 0, r), v, lane);
        norm_mod_store(v, a.in[6] + (size_t)layer * DM, modv(a, layer, r, 1), modv(a, layer, r, 0), INPROJ_I8 ? (bf16*)nullptr : H + (size_t)r * DM, lane);
        if (INPROJ_I8) store_row_i8(v, (unsigned char*)(a.ws + WS_H) + (size_t)r * DM, (float*)(a.ws + WS_HSC) + r, lane); }
}

__device__ __forceinline__ void p_prep(const Args& a, int layer, bool dry = false) {
    const int tid = otid(), lane = tid & 63, wave = tid >> 6; const int gw = obid() * NWAVE + wave, NGW = ogrid() * NWAVE;
    bf16* P = (bf16*)(a.ws + WS_P); const float* COS = (const float*)(a.ws + WS_ROPE); const float* SIN = COS + 2048;
    const int half = lane >> 5, fi = lane & 31;
    const float gq1 = a.in[14][layer * 128 + half * 64 + fi], gq2 = a.in[14][layer * 128 + half * 64 + 32 + fi];
    const float gk1 = a.in[15][layer * 128 + half * 64 + fi], gk2 = a.in[15][layer * 128 + half * 64 + 32 + fi];
    for (int r = gw; r < NR; r += NGW) { const int s = r % SB; const bool lat = s >= CTX; const int t = s - CTX;
        float cs = 1.f, sn = 0.f;
        if (lat) { const int pos = half == 0 ? (t >> 6) : (t & 63); cs = COS[pos * 32 + fi]; sn = SIN[pos * 32 + fi]; }
        bf16* pr = P + (size_t)r * PC;
#pragma unroll
        for (int hh = 4; hh < 6; ++hh) { bf16* p1 = pr + hh * 128 + half * 64 + fi;
            const float x1 = bf2f(p1[0]), x2 = bf2f(p1[32]);
            const float rstd = __builtin_amdgcn_rsqf(wave_sum(x1 * x1 + x2 * x2) * (1.f / 128.f) + EPS);
            const float y1 = x1 * rstd * gk1, y2 = x2 * rstd * gk2;
            bf16* po = dry ? (bf16*)(a.ws + WS_ACT) + (size_t)r * 1024 + hh * 128 + half * 64 + fi : p1;
            po[0] = (bf16)f2bf(y1 * cs - y2 * sn); po[32] = (bf16)f2bf(y2 * cs + y1 * sn); }
    }
}

__device__ __forceinline__ int seq_step_s(int dir, int n) { return dir == 0 ? n : (n < CTX ? CTX - 1 - n : SB + CTX - 1 - n); }
__device__ __forceinline__ void hg_seq(const Args& a, int layer, int sid, LAS unsigned char* lds) {
    const int tid = otid(), lane = tid & 63, wave = tid >> 6;
    const int dir = sid & 1, h = (sid >> 1) & 3, b = sid >> 3;
    LAS float* qs = (LAS float*)lds; LAS float* ks = qs + 2048; LAS float* fs = ks + 2048; LAS float* vs = fs + 2048; LAS float* part = vs + 2048;
    const bf16* P = (const bf16*)(a.ws + WS_P);
    float* OH = (float*)(a.ws + WS_OH) + (size_t)dir * NR * 256;
    float lb;
    { const float* lg = a.in[10] + (size_t)dir * DEPTH * 256 + h * 64 + lane;
      const float l0 = lg[0], l1 = lg[256], l2 = lg[512], l3 = lg[768]; const float mx = fmaxf(fmaxf(l0, l1), fmaxf(l2, l3));
      const float e0 = expf(l0 - mx), e1 = expf(l1 - mx), e2 = expf(l2 - mx), e3 = expf(l3 - mx);
      lb = ((layer >= 1 ? e1 : 0.f) + (layer >= 2 ? e2 : 0.f) + (layer >= 3 ? e3 : 0.f)) / (e0 + e1 + e2 + e3); }
    float S[8];
#pragma unroll
    for (int i = 0; i < 8; ++i) S[i] = 0.f;
    for (int n0 = 0; n0 < SB; n0 += 32) {
#pragma unroll
        for (int jj = 0; jj < 4; ++jj) { const int j = wave + 8 * jj; const int s = seq_step_s(dir, n0 + j);
            const bf16* pr = P + (size_t)(b * SB + s) * PC + h * 64 + lane;
            const float q = bf2f(pr[C_HGQ]), z = bf2f(pr[dir ? C_HGZB : C_HGZF]), v = bf2f(pr[C_HGV]);
            const float sg = 1.f / (1.f + expf(-z));
            qs[j * 64 + lane] = q; fs[j * 64 + lane] = lb + (1.f - lb) * sg; ks[j * 64 + lane] = (1.f - lb) * (1.f - sg); vs[j * 64 + lane] = v; }
        __syncthreads();
        for (int j = 0; j < 32; ++j) { const float v = vs[j * 64 + lane]; float p = 0.f;
#pragma unroll
            for (int i = 0; i < 8; ++i) { const int d = wave * 8 + i; S[i] = fs[j * 64 + d] * S[i] + ks[j * 64 + d] * v; p += S[i] * qs[j * 64 + d]; }
            part[(wave * 32 + j) * 64 + lane] = p; }
        __syncthreads();
#pragma unroll
        for (int jj = 0; jj < 4; ++jj) { const int j = wave + 8 * jj; float o = 0.f;
#pragma unroll
            for (int w = 0; w < 8; ++w) o += part[(w * 32 + j) * 64 + lane];
            const int s = seq_step_s(dir, n0 + j); OH[(size_t)(b * SB + s) * 256 + h * 64 + lane] = o; }
        __syncthreads();
    }
}
__device__ __forceinline__ void ml_seq(const Args& a, int layer, int sid, LAS unsigned char* lds) {
    const int tid = otid(), lane = tid & 63, wave = tid >> 6;
    const int dir = sid & 1, h = (sid >> 1) & 3, b = sid >> 3;
    LAS float* qs = (LAS float*)lds; LAS float* ks = qs + 2048; LAS float* vs = ks + 2048; LAS float* part = vs + 2048;
    LAS float* ip = part + 8 * 2048; LAS float* lf = ip + 32; LAS float* dp = lf + 32; LAS float* ms = dp + 8 * 32;
    const bf16* P = (const bf16*)(a.ws + WS_P);
    float* OM = (float*)(a.ws + WS_OM) + (size_t)dir * NR * 256;
    const float bi = a.in[12][layer * 16 + dir * 4 + h], bfg = a.in[12][layer * 16 + 8 + dir * 4 + h];
    float C[8], nn[8], m = 0.f;
#pragma unroll
    for (int i = 0; i < 8; ++i) { C[i] = 0.f; nn[i] = 0.f; }
    for (int n0 = 0; n0 < SB; n0 += 32) {
#pragma unroll
        for (int jj = 0; jj < 4; ++jj) { const int j = wave + 8 * jj; const int s = seq_step_s(dir, n0 + j);
            const bf16* pr = P + (size_t)(b * SB + s) * PC;
            qs[j * 64 + lane] = bf2f(pr[C_MLQ + h * 64 + lane]); ks[j * 64 + lane] = bf2f(pr[C_MLK + h * 64 + lane]) * 0.125f; vs[j * 64 + lane] = bf2f(pr[C_MLV + h * 64 + lane]);
            if (lane == 0) { ip[j] = bf2f(pr[C_MLG + dir * 4 + h]) + bi; const float fp = bf2f(pr[C_MLG + 8 + dir * 4 + h]) + bfg;
                lf[j] = fminf(fp, 0.f) - log1pf(expf(-fabsf(fp))); } }
        __syncthreads();
        for (int j = 0; j < 32; ++j) { const float v = vs[j * 64 + lane]; const float ipj = ip[j], lfj = lf[j];
            const float mn = fmaxf(lfj + m, ipj); const float aa = expf(lfj + m - mn), bb = expf(ipj - mn); m = mn;
            float p = 0.f, dn = 0.f;
#pragma unroll
            for (int i = 0; i < 8; ++i) { const int d = wave * 8 + i; const float kk = ks[j * 64 + d] * bb, qq = qs[j * 64 + d];
                C[i] = aa * C[i] + kk * v; nn[i] = aa * nn[i] + kk; p += C[i] * qq; dn += nn[i] * qq; }
            part[(wave * 32 + j) * 64 + lane] = p; if (lane == 0) { dp[wave * 32 + j] = dn; if (wave == 0) ms[j] = mn; } }
        __syncthreads();
#pragma unroll
        for (int jj = 0; jj < 4; ++jj) { const int j = wave + 8 * jj; float o = 0.f, dn = 0.f;
#pragma unroll
            for (int w = 0; w < 8; ++w) { o += part[(w * 32 + j) * 64 + lane]; dn += dp[w * 32 + j]; }
            const int s = seq_step_s(dir, n0 + j); OM[(size_t)(b * SB + s) * 256 + h * 64 + lane] = o / fmaxf(fabsf(dn), expf(-ms[j])); }
        __syncthreads();
    }
}
__device__ __forceinline__ void p_scan(const Args& a, int layer, LAS unsigned char* lds, int do_hg, int do_ml) {
    for (int u = obid(); u < 128; u += ogrid()) { if (u < 64) { if (do_hg) hg_seq(a, layer, u, lds); } else { if (do_ml) ml_seq(a, layer, u - 64, lds); } }
}


namespace scan {
constexpr int NCH = 68, NTASK = NB * 4 * 2 * NCH;
__device__ __forceinline__ int swz(int row, int unit) { return row * 128 + ((unit ^ ((row >> 1) & 7)) << 4); }
__device__ __forceinline__ bf16x8 frag(const LAS char* arr, int row, int unit) { return *(const LAS bf16x8*)(arr + swz(row, unit)); }
__device__ __forceinline__ void put2(LAS char* arr, int row, int col_even, float lo, float hi) { *(LAS unsigned*)(arr + swz(row, col_even >> 3) + (col_even & 7) * 2) = pk2(lo, hi); }
__device__ __forceinline__ void put1(LAS char* arr, int row, int col, float x) { *(LAS bf16*)(arr + swz(row, col >> 3) + (col & 7) * 2) = (bf16)f2bf(x); }
__device__ __forceinline__ int crow(int r, int hh) { return (r & 3) + 8 * (r >> 2) + 4 * hh; }
__device__ __forceinline__ void mm64(f32x16 (&acc)[2][2], const LAS char* A, const LAS char* B, int r32, int hh, int skip_a, int skip_b) {
#pragma unroll
    for (int st = 0; st < 4; ++st) { bf16x8 af[2], bfr[2];
#pragma unroll
        for (int i = 0; i < 2; ++i) { af[i] = frag(A, 32 * i + r32, 2 * st + hh); bfr[i] = frag(B, 32 * i + r32, 2 * st + hh); }
#pragma unroll
        for (int ai = 0; ai < 2; ++ai)
#pragma unroll
            for (int bi = 0; bi < 2; ++bi) if (!(ai == skip_a && bi == skip_b)) acc[ai][bi] = __builtin_amdgcn_mfma_f32_32x32x16_bf16(af[ai], bfr[bi], acc[ai][bi], 0, 0, 0); }
}
#define SC_PK4(P, BASE, OUT) do { unsigned a0 = pk2(P[BASE + 0], P[BASE + 1]), a1 = pk2(P[BASE + 2], P[BASE + 3]);   \
    unsigned b0 = pk2(P[BASE + 4], P[BASE + 5]), b1 = pk2(P[BASE + 6], P[BASE + 7]);                              \
    auto r0 = __builtin_amdgcn_permlane32_swap(a0, b0, false, false); auto r1 = __builtin_amdgcn_permlane32_swap(a1, b1, false, false); \
    u32x4 w = {r0[0], r1[0], r0[1], r1[1]}; OUT = __builtin_bit_cast(bf16x8, w); } while (0)
__device__ __forceinline__ float hg_lb(const Args& a, int layer, int dir, int h, int lane) {
    const float* lg = a.in[10] + (size_t)dir * DEPTH * 256 + h * 64 + lane;
    const float l0 = lg[0], l1 = lg[256], l2 = lg[512], l3 = lg[768]; const float mx = fmaxf(fmaxf(l0, l1), fmaxf(l2, l3));
    const float e0 = __expf(l0 - mx), e1 = __expf(l1 - mx), e2 = __expf(l2 - mx), e3 = __expf(l3 - mx);
    return ((layer >= 1 ? e1 : 0.f) + (layer >= 2 ? e2 : 0.f) + (layer >= 3 ? e3 : 0.f)) / (e0 + e1 + e2 + e3);
}
__device__ __forceinline__ float scan_add(float x, int lane, int dir) {
#pragma unroll
    for (int o = 1; o < 64; o <<= 1) { const float y = dir ? __shfl_down(x, o) : __shfl_up(x, o); const bool ok = dir ? (lane + o < 64) : (lane >= o); x += ok ? y : 0.f; }
    return x;
}
__device__ __forceinline__ float scan_max(float x, int lane, int dir) {
#pragma unroll
    for (int o = 1; o < 64; o <<= 1) { const float y = dir ? __shfl_down(x, o) : __shfl_up(x, o); const bool ok = dir ? (lane + o < 64) : (lane >= o); x = ok ? fmaxf(x, y) : x; }
    return x;
}
__device__ __forceinline__ float wave_max(float v) {
#pragma unroll
    for (int o = 1; o < 64; o <<= 1) v = fmaxf(v, __shfl_xor(v, o));
    return v;
}
__device__ __forceinline__ float logsig(float x) { return fminf(x, 0.f) - __logf(1.f + __expf(-fabsf(x))); }
__device__ __forceinline__ void store_ut(bf16* UT, const f32x16 (&acc)[2][2], int r32, int hh) {
#pragma unroll
    for (int vi = 0; vi < 2; ++vi)
#pragma unroll
        for (int di = 0; di < 2; ++di)
#pragma unroll
            for (int rg = 0; rg < 16; ++rg) UT[(32 * vi + crow(rg, hh)) * 64 + 32 * di + r32] = (bf16)f2bf(acc[vi][di][rg]);
}
__device__ __forceinline__ void stage_vt(LAS char* X, const bf16* Pr, int vcol, int lane) {
#pragma unroll 8
    for (int p = 0; p < 32; ++p) put2(X, lane, 2 * p, bf2f(Pr[(size_t)(2 * p) * PC + vcol + lane]), bf2f(Pr[(size_t)(2 * p + 1) * PC + vcol + lane]));
}
__device__ __forceinline__ void stage_copy(LAS char* X, const bf16* G, int ldg, int lane) {
#pragma unroll
    for (int j = 0; j < 8; ++j) { const int u = lane + 64 * j, row = u >> 3, unit = u & 7; *(LAS u32x4*)(X + swz(row, unit)) = *(const u32x4*)(G + (size_t)row * ldg + unit * 8); }
}

__device__ __forceinline__ int tile8_row(int lane, int j) { return 2 * (lane >> 3) + (j & 1) + 16 * (j >> 1); }
__device__ __forceinline__ void load_tile8(u32x4 (&vr)[8], const bf16* G, int ldg, int lane) {
#pragma unroll
    for (int j = 0; j < 8; ++j) vr[j] = *(const u32x4*)(G + (size_t)tile8_row(lane, j) * ldg + 8 * (lane & 7));
}
__device__ __forceinline__ void put_tile8_t(LAS char* X, const u32x4 (&vr)[8], int lane) {
#pragma unroll
    for (int j = 0; j < 8; j += 2) { const int t = tile8_row(lane, j);
#pragma unroll
        for (int e = 0; e < 8; ++e) { const int v = 8 * (lane & 7) + e; const unsigned w0 = vr[j][e >> 1], w1 = vr[j + 1][e >> 1];
            const unsigned pk = (e & 1) ? ((w0 >> 16) | (w1 & 0xffff0000u)) : ((w0 & 0xffffu) | (w1 << 16));
            *(LAS unsigned*)(X + swz(v, t >> 3) + (t & 7) * 2) = pk; } }
}
__device__ __forceinline__ void put_tile8(LAS char* X, const u32x4 (&vr)[8], int lane) {
#pragma unroll
    for (int j = 0; j < 8; ++j) *(LAS u32x4*)(X + swz(tile8_row(lane, j), lane & 7)) = vr[j];
}
__device__ __forceinline__ float get1(const LAS char* arr, int row, int col) { return bf2f(*(const LAS bf16*)(arr + swz(row, col >> 3) + (col & 7) * 2)); }

__device__ __forceinline__ void hgA(const Args& a, int layer, int b, int c, int h, int dir, LAS char* X, LAS char* Y, int lane) {
    const bf16* Pr = (const bf16*)(a.ws + WS_P) + (size_t)(b * SB + 64 * c) * PC;
    stage_copy(X, Pr + (dir ? C_HGZB : C_HGZF) + h * 64, PC, lane);
    u32x4 vr[8]; load_tile8(vr, Pr + C_HGV + h * 64, PC, lane);
    const float lb = hg_lb(a, layer, dir, h, lane), omlb = 1.f - lb;
    float R = 1.f;
#pragma unroll 4
    for (int p = 0; p < 32; ++p) { const int t0 = dir ? 2 * p : 63 - 2 * p, t1 = dir ? 2 * p + 1 : 62 - 2 * p;
        const float f0 = lb + omlb * sigm(get1(X, t0, lane)); const float k0 = (1.f - f0) * R; R *= f0;
        const float f1 = lb + omlb * sigm(get1(X, t1, lane)); const float k1 = (1.f - f1) * R; R *= f1;
        put2(Y, lane, dir ? t0 : t1, dir ? k0 : k1, dir ? k1 : k0); }
    put_tile8_t(X, vr, lane);
    const int tk = ((b * 4 + h) * 2 + dir) * NCH + c;
    ((float*)(a.ws + WS_DT))[(size_t)tk * 64 + lane] = R;
    f32x16 acc[2][2] = {};
    mm64(acc, X, Y, lane & 31, lane >> 5, -1, -1);
    store_ut((bf16*)(a.ws + WS_UTH) + (size_t)tk * 4096, acc, lane & 31, lane >> 5);
}
__device__ __forceinline__ void mlA(const Args& a, int layer, int b, int c, int h, int dir, LAS char* X, LAS char* Y, int lane) {
    const bf16* Pr = (const bf16*)(a.ws + WS_P) + (size_t)(b * SB + 64 * c) * PC;
    stage_copy(X, Pr + C_MLK + h * 64, PC, lane);
    u32x4 vr[8]; load_tile8(vr, Pr + C_MLV + h * 64, PC, lane);
    const float ip = bf2f(Pr[(size_t)lane * PC + C_MLG + dir * 4 + h]) + a.in[12][layer * 16 + dir * 4 + h];
    const float lf = logsig(bf2f(Pr[(size_t)lane * PC + C_MLG + 8 + dir * 4 + h]) + a.in[12][layer * 16 + 8 + dir * 4 + h]);
    const float bt = scan_add(lf, lane, dir), g = wave_sum(lf);
    const float at = g - bt + ip, l = wave_max(at), w = __expf(at - l);
    float nu = 0.f;
#pragma unroll
    for (int p = 0; p < 32; ++p) { const float w0 = __builtin_bit_cast(float, __builtin_amdgcn_readlane(__builtin_bit_cast(int, w), 2 * p)), w1 = __builtin_bit_cast(float, __builtin_amdgcn_readlane(__builtin_bit_cast(int, w), 2 * p + 1));
        const float k0 = get1(X, 2 * p, lane) * 0.125f * w0, k1 = get1(X, 2 * p + 1, lane) * 0.125f * w1;
        nu += k0 + k1; put2(Y, lane, 2 * p, k0, k1); }
    put_tile8_t(X, vr, lane);
    const int tk = ((b * 4 + h) * 2 + dir) * NCH + c;
    ((float*)(a.ws + WS_NU))[(size_t)tk * 64 + lane] = nu;
    if (lane == 0) { ((float*)(a.ws + WS_GL))[tk * 2] = g; ((float*)(a.ws + WS_GL))[tk * 2 + 1] = l; }
    f32x16 acc[2][2] = {};
    mm64(acc, X, Y, lane & 31, lane >> 5, -1, -1);
    store_ut((bf16*)(a.ws + WS_UTM) + (size_t)tk * 4096, acc, lane & 31, lane >> 5);
}
__device__ __forceinline__ void p_scanA(const Args& a, int layer, LAS unsigned char* lds, int do_hg, int do_ml) {
    const int tid = otid(), lane = tid & 63, wave = __builtin_amdgcn_readfirstlane(tid >> 6), G = ogrid(), h = wave >> 1, dir = wave & 1;
    LAS char* X = (LAS char*)lds + wave * 16384; LAS char* Y = X + 8192;
    for (int u = obid(); u < 2 * NB * NCH; u += G) { const int mixer = u / (NB * NCH), q = u % (NB * NCH), b = q / NCH, c = q % NCH;
        int ln = lane; asm volatile("" : "+v"(ln));
        if (mixer == 0) { if (do_hg) hgA(a, layer, b, c, h, dir, X, Y, ln); } else { if (do_ml) mlA(a, layer, b, c, h, dir, X, Y, ln); } }
}

__device__ __forceinline__ int chunk_of(int dir, int k) { return dir == 0 ? k : (k < 4 ? 3 - k : NCH + 3 - k); }
__device__ __forceinline__ void p_scanB(const Args& a, int do_hg, int do_ml) {
    constexpr int KB = 17;
    const int tid = otid(), G = ogrid();
    for (int g = obid() * NTHR + tid; g < 128 * 1024; g += G * NTHR) {
        const int seq = __builtin_amdgcn_readfirstlane(g >> 10), mixer = seq >> 6, sq = seq & 63, dir = sq & 1, e4 = g & 1023, d0 = (e4 & 15) * 4;
        if (mixer == 0) { if (!do_hg) continue;
            const bf16* UT = (const bf16*)(a.ws + WS_UTH); bf16* SP = (bf16*)(a.ws + WS_SPH); const float* DT = (const float*)(a.ws + WS_DT);
            f32x4 S = {0.f, 0.f, 0.f, 0.f};
            for (int kb = 0; kb < NCH; kb += KB) {
                u32x2 uu[KB]; f32x4 dv[KB];
#pragma unroll
                for (int i = 0; i < KB; ++i) { const size_t tk = (size_t)sq * NCH + chunk_of(dir, kb + i);
                    uu[i] = *(const u32x2*)(UT + tk * 4096 + e4 * 4); dv[i] = *(const f32x4*)(DT + tk * 64 + d0); }
#pragma unroll
                for (int i = 0; i < KB; ++i) { const size_t tk = (size_t)sq * NCH + chunk_of(dir, kb + i);
                    u32x2 o; o.x = pk2(S[0], S[1]); o.y = pk2(S[2], S[3]); *(u32x2*)(SP + tk * 4096 + e4 * 4) = o;
                    S = S * dv[i] + (f32x4){bflo(uu[i].x), bfhi(uu[i].x), bflo(uu[i].y), bfhi(uu[i].y)}; } }
        } else { if (!do_ml) continue;
            const bf16* UT = (const bf16*)(a.ws + WS_UTM); bf16* SP = (bf16*)(a.ws + WS_SPM); const float* NU = (const float*)(a.ws + WS_NU);
            float* NP = (float*)(a.ws + WS_NP); const float* GL = (const float*)(a.ws + WS_GL); float* MP = (float*)(a.ws + WS_MP);
            f32x4 S = {0.f, 0.f, 0.f, 0.f}, n = {0.f, 0.f, 0.f, 0.f}; float m = 0.f;
            for (int kb = 0; kb < NCH; kb += KB) {
                u32x2 uu[KB]; f32x4 nv[KB]; f32x2 gv[KB];
#pragma unroll
                for (int i = 0; i < KB; ++i) { const size_t tk = (size_t)sq * NCH + chunk_of(dir, kb + i);
                    uu[i] = *(const u32x2*)(UT + tk * 4096 + e4 * 4); nv[i] = *(const f32x4*)(NU + tk * 64 + d0); gv[i] = *(const f32x2*)(GL + tk * 2); }
#pragma unroll
                for (int i = 0; i < KB; ++i) { const size_t tk = (size_t)sq * NCH + chunk_of(dir, kb + i);
                    u32x2 o; o.x = pk2(S[0], S[1]); o.y = pk2(S[2], S[3]); *(u32x2*)(SP + tk * 4096 + e4 * 4) = o;
                    if (e4 < 16) { *(f32x4*)(NP + tk * 64 + d0) = n; if (e4 == 0) MP[tk] = m; }
                    const float mn = fmaxf(gv[i][0] + m, gv[i][1]), aa = __expf(gv[i][0] + m - mn), bb = __expf(gv[i][1] - mn); m = mn;
                    S = S * aa + (f32x4){bflo(uu[i].x), bfhi(uu[i].x), bflo(uu[i].y), bfhi(uu[i].y)} * bb; n = n * aa + nv[i] * bb; } }
        }
    }
}

__device__ __forceinline__ void loadC(const Args& a, int mixer, int b, int c, int h, int dir, u32x4 (&tq)[8], u32x4 (&tz)[8], int lane) {
    const bf16* Pr = (const bf16*)(a.ws + WS_P) + (size_t)(b * SB + 64 * c) * PC + h * 64;
    load_tile8(tq, Pr + (mixer == 0 ? C_HGQ : C_MLQ), PC, lane); load_tile8(tz, Pr + (mixer == 0 ? (dir ? C_HGZB : C_HGZF) : C_MLK), PC, lane);
}
__device__ __forceinline__ void hgC(const Args& a, int layer, int b, int c, int h, int dir, LAS char* X, LAS char* Y, int lane, const u32x4 (&qr_)[8], const u32x4 (&zr_)[8]) {
    const int r32 = lane & 31, hh = lane >> 5;
    const bf16* Pr = (const bf16*)(a.ws + WS_P) + (size_t)(b * SB + 64 * c) * PC;
    const int tk = ((b * 4 + h) * 2 + dir) * NCH + c;
    u32x4 vr[8], sp[8];
    load_tile8(vr, Pr + C_HGV + h * 64, PC, lane); load_tile8(sp, (const bf16*)(a.ws + WS_SPH) + (size_t)tk * 4096, 64, lane);
    put_tile8(X, qr_, lane); put_tile8(Y, zr_, lane);
    const float lb = hg_lb(a, layer, dir, h, lane), omlb = 1.f - lb;
    float Gp = 1.f;
#pragma unroll 4
    for (int i = 32; i < 64; ++i) { const int t = dir ? 63 - i : i; const float f = lb + omlb * sigm(get1(Y, t, lane)); Gp *= f;
        const float q = get1(X, t, lane) * Gp, k = (1.f - f) * __builtin_amdgcn_rcpf(Gp); put1(X, t, lane, q); put1(Y, t, lane, k); }
    float Hp = 1.f;
#pragma unroll 4
    for (int i = 31; i >= 0; --i) { const int t = dir ? 63 - i : i; const float f = lb + omlb * sigm(get1(Y, t, lane));
        const float q = get1(X, t, lane) * __builtin_amdgcn_rcpf(Hp), k = (1.f - f) * Hp; Hp *= f; put1(X, t, lane, q); put1(Y, t, lane, k); }
    f32x16 sc[2][2] = {};
    mm64(sc, Y, X, r32, hh, dir ? 0 : 1, dir ? 1 : 0);
    bf16x8 pa[2][4];
#pragma unroll
    for (int ti = 0; ti < 2; ++ti)
#pragma unroll
        for (int si = 0; si < 2; ++si) { const bool dead = dir ? (si == 0 && ti == 1) : (si == 1 && ti == 0);
            if (dead) { pa[ti][2 * si] = (bf16x8){0, 0, 0, 0, 0, 0, 0, 0}; pa[ti][2 * si + 1] = (bf16x8){0, 0, 0, 0, 0, 0, 0, 0}; }
            else { f32x16 p = sc[si][ti];
                if (si == ti) {
#pragma unroll
                    for (int rg = 0; rg < 16; ++rg) { const int s = crow(rg, hh); const bool ok = dir ? (s >= r32) : (s <= r32); p[rg] = ok ? p[rg] : 0.f; } }
                SC_PK4(p, 0, pa[ti][2 * si]); SC_PK4(p, 8, pa[ti][2 * si + 1]); } }
    { const float eb = Hp;
#pragma unroll 8
      for (int t = 0; t < 64; ++t) put1(Y, t, lane, get1(X, t, lane) * eb); }
    put_tile8_t(X, vr, lane);
    f32x16 o[2][2] = {};
#pragma unroll
    for (int ss = 0; ss < 4; ++ss) { bf16x8 vf[2];
#pragma unroll
        for (int vi = 0; vi < 2; ++vi) vf[vi] = frag(X, 32 * vi + r32, 2 * ss + hh);
#pragma unroll
        for (int ti = 0; ti < 2; ++ti)
#pragma unroll
            for (int vi = 0; vi < 2; ++vi) o[ti][vi] = __builtin_amdgcn_mfma_f32_32x32x16_bf16(pa[ti][ss], vf[vi], o[ti][vi], 0, 0, 0); }
    put_tile8(X, sp, lane);
    mm64(o, Y, X, r32, hh, -1, -1);
    LAS float* O = (LAS float*)X;
#pragma unroll
    for (int ti = 0; ti < 2; ++ti)
#pragma unroll
        for (int vi = 0; vi < 2; ++vi)
#pragma unroll
            for (int rg = 0; rg < 16; ++rg) O[(32 * ti + crow(rg, hh)) * 64 + 32 * vi + r32] = o[ti][vi][rg];
}
__device__ __forceinline__ void mlC(const Args& a, int layer, int b, int c, int h, int dir, LAS char* X, LAS char* Y, LAS float* T, int lane, const u32x4 (&qr_)[8], const u32x4 (&kr_)[8]) {
    const int r32 = lane & 31, hh = lane >> 5;
    const bf16* Pr = (const bf16*)(a.ws + WS_P) + (size_t)(b * SB + 64 * c) * PC;
    const int tk = ((b * 4 + h) * 2 + dir) * NCH + c;
    LAS float* TMU = T; LAS float* TCS = T + 64; LAS float* TEM = T + 128; LAS float* TAP = T + 192;
    u32x4 vr[8], sp[8];
    load_tile8(vr, Pr + C_MLV + h * 64, PC, lane); load_tile8(sp, (const bf16*)(a.ws + WS_SPM) + (size_t)tk * 4096, 64, lane);
    { const float ip = bf2f(Pr[(size_t)lane * PC + C_MLG + dir * 4 + h]) + a.in[12][layer * 16 + dir * 4 + h];
      const float lf = logsig(bf2f(Pr[(size_t)lane * PC + C_MLG + 8 + dir * 4 + h]) + a.in[12][layer * 16 + 8 + dir * 4 + h]);
      const float bt = scan_add(lf, lane, dir), cs = ip - bt, mp = ((const float*)(a.ws + WS_MP))[tk];
      const float mu = fmaxf(mp, scan_max(cs, lane, dir));
      TMU[lane] = mu; TCS[lane] = cs; TEM[lane] = __expf(-bt - mu); TAP[lane] = __expf(mp - mu); }
    put_tile8(X, qr_, lane); put_tile8(Y, kr_, lane);
    f32x16 sc[2][2] = {};
    mm64(sc, Y, X, r32, hh, dir ? 0 : 1, dir ? 1 : 0);
    bf16x8 pa[2][4];
#pragma unroll
    for (int ti = 0; ti < 2; ++ti) { const float mu = TMU[32 * ti + r32];
#pragma unroll
        for (int si = 0; si < 2; ++si) { const bool dead = dir ? (si == 0 && ti == 1) : (si == 1 && ti == 0);
            if (dead) { pa[ti][2 * si] = (bf16x8){0, 0, 0, 0, 0, 0, 0, 0}; pa[ti][2 * si + 1] = (bf16x8){0, 0, 0, 0, 0, 0, 0, 0}; }
            else { f32x16 p = sc[si][ti];
#pragma unroll
                for (int g4 = 0; g4 < 4; ++g4) { const f32x4 cs = *(const LAS f32x4*)(TCS + 32 * si + 8 * g4 + 4 * hh);
#pragma unroll
                    for (int i = 0; i < 4; ++i) { const int rg = 4 * g4 + i, s = crow(rg, hh); const bool ok = (si != ti) || (dir ? (s >= r32) : (s <= r32));
                        const float w = p[rg] * 0.125f * __expf(cs[i] - mu); p[rg] = ok ? w : 0.f; } }
                SC_PK4(p, 0, pa[ti][2 * si]); SC_PK4(p, 8, pa[ti][2 * si + 1]); } } }
#pragma unroll
    for (int j = 0; j < 8; ++j) { const int u = lane + 64 * j, row = u >> 3, unit = u & 7; const float ap = TAP[row];
        const u32x4 qv = *(const LAS u32x4*)(X + swz(row, unit)); u32x4 o;
        o.x = pk2(bflo(qv.x) * ap, bfhi(qv.x) * ap); o.y = pk2(bflo(qv.y) * ap, bfhi(qv.y) * ap); o.z = pk2(bflo(qv.z) * ap, bfhi(qv.z) * ap); o.w = pk2(bflo(qv.w) * ap, bfhi(qv.w) * ap);
        *(LAS u32x4*)(Y + swz(row, unit)) = o; }
    put_tile8_t(X, vr, lane);
    f32x16 o[2][2] = {}; f32x16 dn[2] = {};
    const bf16x8 ones = {0x3f80, 0x3f80, 0x3f80, 0x3f80, 0x3f80, 0x3f80, 0x3f80, 0x3f80};
#pragma unroll
    for (int ss = 0; ss < 4; ++ss) { bf16x8 vf[2];
#pragma unroll
        for (int vi = 0; vi < 2; ++vi) vf[vi] = frag(X, 32 * vi + r32, 2 * ss + hh);
#pragma unroll
        for (int ti = 0; ti < 2; ++ti) { dn[ti] = __builtin_amdgcn_mfma_f32_32x32x16_bf16(pa[ti][ss], ones, dn[ti], 0, 0, 0);
#pragma unroll
            for (int vi = 0; vi < 2; ++vi) o[ti][vi] = __builtin_amdgcn_mfma_f32_32x32x16_bf16(pa[ti][ss], vf[vi], o[ti][vi], 0, 0, 0); } }
    put_tile8(X, sp, lane);
    mm64(o, Y, X, r32, hh, -1, -1);
    { const float* NPg = (const float*)(a.ws + WS_NP) + (size_t)tk * 64;
#pragma unroll
      for (int st = 0; st < 4; ++st) { const f32x4 n0 = *(const f32x4*)(NPg + 16 * st + 8 * hh), n1 = *(const f32x4*)(NPg + 16 * st + 8 * hh + 4);
          u32x4 w; w.x = pk2(n0[0], n0[1]); w.y = pk2(n0[2], n0[3]); w.z = pk2(n1[0], n1[1]); w.w = pk2(n1[2], n1[3]); const bf16x8 nf = __builtin_bit_cast(bf16x8, w);
#pragma unroll
          for (int ti = 0; ti < 2; ++ti) dn[ti] = __builtin_amdgcn_mfma_f32_32x32x16_bf16(frag(Y, 32 * ti + r32, 2 * st + hh), nf, dn[ti], 0, 0, 0); } }
    float em[2][16];
#pragma unroll
    for (int ti = 0; ti < 2; ++ti)
#pragma unroll
        for (int g4 = 0; g4 < 4; ++g4) { const f32x4 e = *(const LAS f32x4*)(TEM + 32 * ti + 8 * g4 + 4 * hh);
#pragma unroll
            for (int i = 0; i < 4; ++i) em[ti][4 * g4 + i] = e[i]; }
    LAS float* O = (LAS float*)X;
#pragma unroll
    for (int ti = 0; ti < 2; ++ti)
#pragma unroll
        for (int rg = 0; rg < 16; ++rg) { const float rd = __builtin_amdgcn_rcpf(fmaxf(fabsf(dn[ti][rg]), em[ti][rg]));
#pragma unroll
            for (int vi = 0; vi < 2; ++vi) O[(32 * ti + crow(rg, hh)) * 64 + 32 * vi + r32] = o[ti][vi][rg] * rd; }
}
__device__ __forceinline__ void p_scanC(const Args& a, int layer, LAS unsigned char* lds, int do_hg, int do_ml) {
    const int tid = otid(), lane = tid & 63, wave = __builtin_amdgcn_readfirstlane(tid >> 6), G = ogrid(), h = wave >> 1, dir = wave & 1;
    LAS char* X = (LAS char*)lds + wave * 16384; LAS char* Y = X + 8192; LAS float* T = (LAS float*)(lds + 131072 + wave * 1024);
    const bf16* P = (const bf16*)(a.ws + WS_P); bf16* Yo = (bf16*)(a.ws + WS_Y);
    const bool lastl = layer == DEPTH - 1;
#define SC_SKIP(u_) ((lastl && ((u_) % (NB * NCH)) % NCH < 4) || (((u_) / (NB * NCH)) == 0 ? !do_hg : !do_ml))
    int u = obid(); while (u < 2 * NB * NCH && SC_SKIP(u)) u += G;
    u32x4 tq[8], tz[8];
    if (u < 2 * NB * NCH) { const int mixer = u / (NB * NCH), q = u % (NB * NCH); loadC(a, mixer, q / NCH, q % NCH, h, dir, tq, tz, lane); }
    while (u < 2 * NB * NCH) { const int mixer = u / (NB * NCH), q = u % (NB * NCH), b = q / NCH, c = q % NCH;
        int ln = lane; asm volatile("" : "+v"(ln));
        if (mixer == 0) hgC(a, layer, b, c, h, dir, X, Y, ln, tq, tz); else mlC(a, layer, b, c, h, dir, X, Y, T, ln, tq, tz);
        asm volatile("" : "+v"(ln));
        __builtin_amdgcn_sched_barrier(0);
        int un = u + G; while (un < 2 * NB * NCH && SC_SKIP(un)) un += G;
        if (un < 2 * NB * NCH) { const int mixer2 = un / (NB * NCH), q2 = un % (NB * NCH); loadC(a, mixer2, q2 / NCH, q2 % NCH, h, dir, tq, tz, ln); }
        __builtin_amdgcn_sched_barrier(0);
        const int fh = ln >> 4, fv = (ln & 15) * 4, fw = __builtin_amdgcn_readfirstlane(otid() >> 6);
        u32x2 gq2[8];
        { const bf16* gp = P + (size_t)(b * SB + 64 * c + 8 * fw) * PC + (mixer == 0 ? C_HGG : C_MLOG) + fh * 64 + fv;
#pragma unroll
          for (int i = 0; i < 8; ++i) gq2[i] = *(const u32x2*)(gp + (size_t)i * PC); }
        const f32x4 gn4 = *(const f32x4*)((mixer == 0 ? a.in[11] : a.in[13]) + layer * 64 + fv);
        __builtin_amdgcn_sched_barrier(0);
        __syncthreads();
        { const LAS float* Of = (const LAS float*)((LAS char*)lds + (2 * fh) * 16384); const LAS float* Ob = (const LAS float*)((LAS char*)lds + (2 * fh + 1) * 16384);
#pragma unroll
          for (int i = 0; i < 8; ++i) { const int t = 8 * fw + i; const size_t r = (size_t)(b * SB + 64 * c + t);
              const f32x4 ov = *(const LAS f32x4*)(Of + t * 64 + fv) + *(const LAS f32x4*)(Ob + t * 64 + fv);
              const float rs = __builtin_amdgcn_rsqf(row16_sum(ov[0] * ov[0] + ov[1] * ov[1] + ov[2] * ov[2] + ov[3] * ov[3]) * (1.f / 64.f) + EPS);
              const float g4[4] = {bflo(gq2[i].x), bfhi(gq2[i].x), bflo(gq2[i].y), bfhi(gq2[i].y)}; float ow[4];
#pragma unroll
              for (int e = 0; e < 4; ++e) { const float y = ov[e] * rs * gn4[e]; ow[e] = mixer == 0 ? y * g4[e] * sigm(g4[e]) : y * sigm(g4[e]); }
              if (OUTPROJ_FP8) *(unsigned*)((unsigned char*)Yo + r * DM + mixer * 256 + fh * 64 + fv) = pk_fp8x4(16.f * ow[0], 16.f * ow[1], 16.f * ow[2], 16.f * ow[3]);
              else { u32x2 w; w.x = pk2(ow[0], ow[1]); w.y = pk2(ow[2], ow[3]); *(u32x2*)(Yo + r * DM + mixer * 256 + fh * 64 + fv) = w; } } }
        __syncthreads();
        u = un;
    }
#undef SC_SKIP
}
#undef SC_PK4
}

__device__ __forceinline__ void p_attn(const Args& a, int layer, LAS char* ldsg) {
    asm volatile("" ::: "memory");
    const bf16* P = (const bf16*)(a.ws + WS_P); bf16* Y = (bf16*)(a.ws + WS_Y); const int G = ogrid();
    const int bid = obid(), lane = otid() & 63;
    const float* qg = a.in[14] + layer * 128; const float* kg = a.in[15] + layer * 128;
    const float mq = wave_max_nn(fmaxf(fabsf(qg[lane]), fabsf(qg[lane + 64]))), mk = wave_max_nn(fmaxf(fabsf(kg[lane]), fabsf(kg[lane + 64])));
    unsigned sbnd; { const float vb = 128.f * mq * mk * (att::SCALE * 1.4426950408889634f) * 1.02f; asm volatile("s_nop 0\n\tv_readfirstlane_b32 %0, %1\n\ts_nop 3" : "=s"(sbnd) : "v"(vb)); }
    const float bound = __builtin_bit_cast(float, sbnd);
    const bool fix = bound <= 60.f;
    const int cu = (layer != DEPTH - 1) ? (G >= 96 ? bid - 64 : bid) : -1; const bool hasc = cu >= 0 && cu < 32;
    const float* ropet = (const float*)(a.ws + WS_ROPE);
#define AT_LAT(u) const int b = (u) & 7, idx = ((u) >> 3) & 31, kvh = (u) >> 8, h = kvh * 2 + (idx >> 4), qb = idx & 15; const size_t r0 = (size_t)b * SB + CTX + (size_t)qb * 256; \
        const bf16* Qp = P + r0 * PC + C_ATQ + h * 128; const bf16* Kp = P + (size_t)b * SB * PC + C_ATK + kvh * 128; const bf16* Vp = P + (size_t)b * SB * PC + C_ATV + kvh * 128; \
        bf16* Op = (bf16*)((unsigned char*)Y + (r0 * DM + 512 + h * 128) * (OUTPROJ_FP8 ? 1 : 2));
#define AT_CTX() const int b = cu & 7, h = cu >> 3, kvh = h >> 1; const size_t r0 = (size_t)b * SB; \
        const bf16* Qp = P + r0 * PC + C_ATQ + h * 128; const bf16* Kp = P + r0 * PC + C_ATK + kvh * 128; const bf16* Vp = P + r0 * PC + C_ATV + kvh * 128; \
        bf16* Op = (bf16*)((unsigned char*)Y + (r0 * DM + 512 + h * 128) * (OUTPROJ_FP8 ? 1 : 2));
    const int ex = fix ? 0 : 1;
    for (int u = bid; u < 512; u += G) { AT_LAT(u) att::attn_dense_body(Qp, Kp, Vp, Op, SB, ldsg, qg, ropet, qb * 256, -bound, ex); __syncthreads(); }
    if (hasc) { AT_CTX() att::attn_dense_body(Qp, Kp, Vp, Op, CTX, ldsg, qg, ropet, -1, -bound, ex); __syncthreads(); }
#undef AT_LAT
#undef AT_CTX
}

__device__ __forceinline__ void p_finish(const Args& a, int layer, int do_hg, int do_ml) {
    const int tid = otid(), lane = tid & 63, wave = tid >> 6; const int gw = obid() * NWAVE + wave, NGW = ogrid() * NWAVE;
    const bf16* P = (const bf16*)(a.ws + WS_P); bf16* Y = (bf16*)(a.ws + WS_Y);
    const float* OH = (const float*)(a.ws + WS_OH); const float* OM = (const float*)(a.ws + WS_OM);
    const float gh = a.in[11][layer * 64 + lane], gm = a.in[13][layer * 64 + lane];
    for (int r = gw; r < NR; r += NGW) { if (layer == DEPTH - 1 && (r % SB) < CTX) continue;
#pragma unroll
        for (int h = 0; h < 4; ++h) {
            if (do_hg) { const float o = OH[(size_t)r * 256 + h * 64 + lane] + OH[(size_t)(NR + r) * 256 + h * 64 + lane];
              const float y = o * (1.f / sqrtf(wave_sum(o * o) * (1.f / 64.f) + EPS)) * gh; const float g = bf2f(P[(size_t)r * PC + C_HGG + h * 64 + lane]);
              Y[(size_t)r * DM + h * 64 + lane] = (bf16)f2bf(y * g * sigm(g)); }
            if (do_ml) { const float o = OM[(size_t)r * 256 + h * 64 + lane] + OM[(size_t)(NR + r) * 256 + h * 64 + lane];
              const float y = o * (1.f / sqrtf(wave_sum(o * o) * (1.f / 64.f) + EPS)) * gm; const float g = bf2f(P[(size_t)r * PC + C_MLOG + h * 64 + lane]);
              Y[(size_t)r * DM + 256 + h * 64 + lane] = (bf16)f2bf(y * sigm(g)); }
        }
    }
}

__device__ __forceinline__ void p_router(const Args& a, int layer, LAS unsigned char* lds) {
    const int tid = otid(), lane = tid & 63, wave = tid >> 6, G = ogrid(), bid = obid();
    constexpr int TP = 2064;
    LAS unsigned char* TH = lds; LAS unsigned char* TL = lds + 32 * TP;
    LAS float* PART = (LAS float*)lds;
    LAS float* LOG = (LAS float*)(lds + 64 * TP);
    LAS int* LCNT = (LAS int*)(lds + 64 * TP + 32 * 33 * 4);
    bf16* H = (bf16*)(a.ws + WS_H);
    int* RE = (int*)(a.ws + WS_RE); int* RS = (int*)(a.ws + WS_RS); float* RG = (float*)(a.ws + WS_RG);
    const bool lastl = layer == DEPTH - 1;
    const int e_l = lane & 31, hh = lane >> 5;
    bf16x8 bh[8], bl[8];
#pragma unroll
    for (int ks = 0; ks < 8; ++ks) { const size_t o = ((size_t)(layer * 32 + e_l)) * 1024 + wave * 128 + ks * 16 + hh * 8;
        bh[ks] = *(const bf16x8*)((const bf16*)(a.ws + WS_WRH) + o); bl[ks] = *(const bf16x8*)((const bf16*)(a.ws + WS_WRL) + o); }
    if (tid < 32) LCNT[tid] = 0;
    __syncthreads();
#define RT_SKIP(t_) (lastl && (((t_) * 32) % SB) < CTX)
    int tile = bid; while (tile < NR / 32 && RT_SKIP(tile)) tile += G;
    u32x4 rw[4][2];
    if (tile < NR / 32) {
#pragma unroll
        for (int q = 0; q < 4; ++q)
#pragma unroll
            for (int j = 0; j < 2; ++j) rw[q][j] = *(const u32x4*)((const bf16*)(a.ws + WS_XB) + (size_t)(tile * 32 + wave * 4 + q) * DM + 8 * lane + 512 * j); }
    while (tile < NR / 32) {
        const int r0 = tile * 32;
#pragma unroll
        for (int q = 0; q < 4; ++q) { const int row = wave * 4 + q, r = r0 + row; f32x4 v[2][2];
#pragma unroll
            for (int j = 0; j < 2; ++j) { const u32x4 w = rw[q][j]; v[j][0] = (f32x4){bflo(w.x), bfhi(w.x), bflo(w.y), bfhi(w.y)}; v[j][1] = (f32x4){bflo(w.z), bfhi(w.z), bflo(w.w), bfhi(w.w)}; }
            norm_mod_store(v, a.in[7] + (size_t)layer * DM, modv(a, layer, r, 4), modv(a, layer, r, 3), MOE_FP8 ? (bf16*)nullptr : H + (size_t)r * DM, lane);
            if (MOE_FP8) {
#pragma unroll
                for (int j = 0; j < 2; ++j) { u32x2 w8; w8.x = pk_fp8x4(8.f * v[j][0][0], 8.f * v[j][0][1], 8.f * v[j][0][2], 8.f * v[j][0][3]); w8.y = pk_fp8x4(8.f * v[j][1][0], 8.f * v[j][1][1], 8.f * v[j][1][2], 8.f * v[j][1][3]);
                    *(u32x2*)((unsigned char*)(a.ws + WS_H8) + (size_t)r * DM + 8 * lane + 512 * j) = w8; } }
#pragma unroll
            for (int j = 0; j < 2; ++j) { unsigned hi[4], lo[4];
#pragma unroll
                for (int p = 0; p < 4; ++p) { const float x0 = v[j][p >> 1][(p & 1) * 2], x1 = v[j][p >> 1][(p & 1) * 2 + 1]; const unsigned w = pk2(x0, x1); hi[p] = w; lo[p] = pk2(x0 - bflo(w), x1 - bfhi(w)); }
                *(LAS u32x4*)(TH + row * TP + (8 * lane + 512 * j) * 2) = (u32x4){hi[0], hi[1], hi[2], hi[3]};
                *(LAS u32x4*)(TL + row * TP + (8 * lane + 512 * j) * 2) = (u32x4){lo[0], lo[1], lo[2], lo[3]}; } }
        __syncthreads();
        int ntile = tile + G; while (ntile < NR / 32 && RT_SKIP(ntile)) ntile += G;
        if (ntile < NR / 32) {
#pragma unroll
            for (int q = 0; q < 4; ++q)
#pragma unroll
                for (int j = 0; j < 2; ++j) rw[q][j] = *(const u32x4*)((const bf16*)(a.ws + WS_XB) + (size_t)(ntile * 32 + wave * 4 + q) * DM + 8 * lane + 512 * j); }
        f32x16 acc = {};
#pragma unroll
        for (int ks = 0; ks < 8; ++ks) { const int off = e_l * TP + (wave * 128 + ks * 16 + hh * 8) * 2;
            const bf16x8 ah = *(const LAS bf16x8*)(TH + off), al = *(const LAS bf16x8*)(TL + off);
            acc = __builtin_amdgcn_mfma_f32_32x32x16_bf16(ah, bh[ks], acc, 0, 0, 0);
            acc = __builtin_amdgcn_mfma_f32_32x32x16_bf16(ah, bl[ks], acc, 0, 0, 0);
            acc = __builtin_amdgcn_mfma_f32_32x32x16_bf16(al, bh[ks], acc, 0, 0, 0); }
        __syncthreads();
#pragma unroll
        for (int rg = 0; rg < 16; ++rg) { const int row = (rg & 3) + 8 * (rg >> 2) + 4 * hh; PART[(wave * 32 + row) * 32 + e_l] = acc[rg]; }
        __syncthreads();
#pragma unroll
        for (int q = 0; q < 2; ++q) { const int idx = tid + 512 * q, row = idx >> 5, e = idx & 31; float s = a.in[17][layer * 32 + e];
#pragma unroll
            for (int w = 0; w < 8; ++w) s += PART[(w * 32 + row) * 32 + e];
            LOG[row * 33 + e] = s; }
        __syncthreads();
        if (tid < 32) { const int r = r0 + tid; float tv[4]; int te[4];
#pragma unroll
            for (int k = 0; k < 4; ++k) { float best = -INFINITY; int bi = 0;
                for (int e = 0; e < 32; ++e) { const float v = LOG[tid * 33 + e]; if (v > best) { best = v; bi = e; } }
                tv[k] = best; te[k] = bi; LOG[tid * 33 + bi] = -INFINITY; }
            float p[4], ps = 0.f;
#pragma unroll
            for (int k = 0; k < 4; ++k) { p[k] = expf(tv[k] - tv[0]); ps += p[k]; }
#pragma unroll
            for (int k = 0; k < 4; ++k) { RE[r * 4 + k] = te[k]; RS[r * 4 + k] = atomicAdd((int*)&LCNT[te[k]], 1); RG[r * 4 + k] = p[k] / ps; } }
        __syncthreads();
        tile = ntile;
    }
#undef RT_SKIP
    if (tid < 32) ((int*)(a.ws + WS_CNT))[bid * 32 + tid] = LCNT[tid];
}

__device__ __forceinline__ void p_dispatch(const Args& a, int layer, LAS unsigned char* lds) {
    const int tid = otid(), G = ogrid(), bid = obid();
    LAS int* tot = (LAS int*)lds; LAS int* base = tot + 32; LAS int* pst = base + 32;
    const int* CNT = (const int*)(a.ws + WS_CNT);
    const int* RE = (const int*)(a.ws + WS_RE); const int* RS = (const int*)(a.ws + WS_RS); const float* RG = (const float*)(a.ws + WS_RG);
    int* POS = (int*)(a.ws + WS_POS); int* TOK = (int*)(a.ws + WS_TOK); float* GATEP = (float*)(a.ws + WS_GATEP); int* TILEE = (int*)(a.ws + WS_TILEE);
    const bool lastl = layer == DEPTH - 1;
    { LAS int* ptot = pst + 64; LAS int* pbase = ptot + 512;
      const int e = tid & 31, part = tid >> 5; int t = 0, bs = 0;
      for (int blk = part; blk < G; blk += 16) { const int c = CNT[blk * 32 + e]; if (blk < bid) bs += c; t += c; }
      ptot[tid] = t; pbase[tid] = bs;
      __syncthreads();
      if (tid < 32) { int tt = 0, bb = 0;
#pragma unroll
          for (int p = 0; p < 16; ++p) { tt += ptot[p * 32 + tid]; bb += pbase[p * 32 + tid]; }
          tot[tid] = tt; base[tid] = bb; } }
    __syncthreads();
    if (tid == 0) { int p = 0; for (int e = 0; e < 32; ++e) { pst[e] = p; p += (tot[e] + 255) & ~255; } pst[32] = p; }
    __syncthreads();
    for (int tile = bid; tile < NR / 32; tile += G) { const int r0 = tile * 32; if (lastl && (r0 % SB) < CTX) continue;
        if (tid < 128) { const int i = r0 * 4 + tid; const int e = RE[i]; const int pos = pst[e] + base[e] + RS[i]; TOK[pos] = r0 + (tid >> 2); GATEP[pos] = RG[i]; POS[i] = pos; } }
    for (int e = bid; e < 32; e += G) {
        for (int p = pst[e] + tot[e] + tid; p < pst[e + 1]; p += NTHR) { TOK[p] = 0; GATEP[p] = 0.f; }
        for (int rt = pst[e] / 256 + tid; rt < pst[e + 1] / 256; rt += NTHR) TILEE[rt] = e; }
    if (bid == 0 && tid == 0) *(int*)(a.ws + WS_NRT) = pst[32] / 256;
}

__device__ __forceinline__ void p_combine(const Args& a, int layer, bool dry = false) {
    const int tid = otid(), lane = tid & 63, wave = tid >> 6; const int gw = obid() * NWAVE + wave, NGW = ogrid() * NWAVE;
    const bf16* YM = (const bf16*)(a.ws + WS_YM); const int* POS = (const int*)(a.ws + WS_POS); bf16* H = (bf16*)(a.ws + WS_H);
    const bool lastl = layer == DEPTH - 1;
    for (int r = gw; r < NR; r += NGW) { if (lastl && (r % SB) < CTX) continue;
        const float* g2 = modv(a, layer, r, 5); bf16* xb = (bf16*)(a.ws + WS_XB) + (size_t)r * DM;
        float* xo = dry ? (float*)(a.ws + WS_ACT) + (size_t)r * DM : a.out + ((size_t)(r / SB) * SEQ + (r % SB) - CTX) * DM;
        bf16* xbo = dry ? (bf16*)(a.ws + WS_ACT) + (size_t)r * DM : xb; bf16* hw = dry ? (bf16*)(a.ws + WS_ACT + 160 * MiB) + (size_t)r * DM : H + (size_t)r * DM;
        int pos[4];
#pragma unroll
        for (int k = 0; k < 4; ++k) pos[k] = POS[r * 4 + k];
        f32x4 v[2][2]; load_row_bf(xb, v, lane);
#pragma unroll
        for (int j = 0; j < 2; ++j) { const int c = 8 * lane + 512 * j; float f[8];
#pragma unroll
            for (int i = 0; i < 8; ++i) f[i] = 0.f;
#pragma unroll
            for (int k = 0; k < 4; ++k) { const u32x4 y = *(const u32x4*)(YM + (size_t)pos[k] * DM + c);
                f[0] += bflo(y.x); f[1] += bfhi(y.x); f[2] += bflo(y.y); f[3] += bfhi(y.y); f[4] += bflo(y.z); f[5] += bfhi(y.z); f[6] += bflo(y.w); f[7] += bfhi(y.w); }
#pragma unroll
            for (int q = 0; q < 2; ++q) { const f32x4 g = *(const f32x4*)(g2 + c + 4 * q);
                v[j][q] = v[j][q] + g * (f32x4){f[4 * q], f[4 * q + 1], f[4 * q + 2], f[4 * q + 3]};
                if (lastl) *(f32x4*)(xo + c + 4 * q) = v[j][q]; }
            if (!lastl) { u32x4 w; w.x = pk2(v[j][0][0], v[j][0][1]); w.y = pk2(v[j][0][2], v[j][0][3]); w.z = pk2(v[j][1][0], v[j][1][1]); w.w = pk2(v[j][1][2], v[j][1][3]); *(u32x4*)(xbo + c) = w; } }
        if (!lastl) { norm_mod_store(v, a.in[6] + (size_t)(layer + 1) * DM, modv(a, layer + 1, r, 1), modv(a, layer + 1, r, 0), INPROJ_I8 ? (bf16*)nullptr : hw, lane);
            if (INPROJ_I8) store_row_i8(v, dry ? (unsigned char*)(a.ws + WS_ACT + 160 * MiB) + (size_t)r * DM : (unsigned char*)(a.ws + WS_H) + (size_t)r * DM, dry ? (float*)(a.ws + WS_ACT + 240 * MiB) + r : (float*)(a.ws + WS_HSC) + r, lane); }
    }
}

template <int PH>
__device__ __forceinline__ void run_phase(int layer, unsigned char* ldsg, int rep = 0) {
    const Args a = fetch_args();
    const bool nost = PROBE_NOSTORE && rep && ogrid() < 100000;
    LAS unsigned char* lds = (LAS unsigned char*)ldsg;
    const int G = ogrid(), bid = obid();
    if constexpr (PH == PH_PRO) p_prologue(a, lds);
    if constexpr (PH == PH_NORM1) { if (INPROJ_I8) p_quant_win(a); p_norm1(a, layer); }
    if constexpr (PH == PH_INPROJ) {
        if constexpr (INPROJ_I8) { pg8::SchedDense S; S.init(NR, PC, G, bid, nullptr); S.Bt = (const char*)(a.ws + WS_WIN) + (size_t)layer * PC * 1024; S.rb = 1024;
            pg8::EpiI8 E{(bf16*)(a.ws + WS_P), PC, (const float*)(a.ws + WS_HSC), (const float*)(a.ws + WS_WSC) + (size_t)layer * PC, nost, NIN}; pg8::gemm_phase<2>(lds, (const void*)(a.ws + WS_H), S, E); }
        else { pg8::SchedDense S; S.init(NR, PC, G, bid, (const bf16*)(a.ws + WS_WIN) + (size_t)layer * PC * 1024);
            pg8::EpiBf16 E{(bf16*)(a.ws + WS_P), PC}; pg8::gemm_phase<0>(lds, (const bf16*)(a.ws + WS_H), S, E); } }
    if constexpr (PH == PH_PREP) { if (PROBE_DOUBLE == 96) p_prep(a, layer, true); p_prep(a, layer); if (NEW_HG || NEW_ML) scan::p_scanA(a, layer, lds, NEW_HG, NEW_ML); if (PROBE_DOUBLE == 20) scan::p_scanA(a, layer, lds, NEW_HG, NEW_ML); }
    if constexpr (PH == PH_SCAN) { if (!NEW_HG || !NEW_ML) p_scan(a, layer, lds, !NEW_HG, !NEW_ML); if (NEW_HG || NEW_ML) scan::p_scanB(a, NEW_HG, NEW_ML); if (PROBE_DOUBLE == 21) scan::p_scanB(a, NEW_HG, NEW_ML); }
    if constexpr (PH == PH_ATTN) { if (NEW_HG || NEW_ML) scan::p_scanC(a, layer, lds, NEW_HG, NEW_ML); if (PROBE_DOUBLE == 22) scan::p_scanC(a, layer, lds, NEW_HG, NEW_ML); p_attn(a, layer, (LAS char*)lds); }
    if constexpr (PH == PH_FINISH) { if (!NEW_HG || !NEW_ML) p_finish(a, layer, !NEW_HG, !NEW_ML); }
    if constexpr (PH == PH_OUTPROJ) { pg8::SchedDense S; S.init(NR, DM, G, bid, nullptr); S.rb = OUTPROJ_FP8 ? 1024 : 2048; S.Bt = (const char*)(a.ws + WS_WOUT) + (size_t)layer * 1024 * S.rb;
        pg8::EpiResid E{a.in[0], a.in[2], (bf16*)(a.ws + WS_XB), (const float*)(a.ws + WS_MOD) + (size_t)layer * 9 * 6144, 2, layer == DEPTH - 1, layer == 0, OUTPROJ_FP8 ? 1.f / 1024.f : 1.f};
        pg8::gemm_phase<OUTPROJ_FP8 ? 1 : 0>(lds, (const void*)(a.ws + WS_Y), S, E); }
    if constexpr (PH == PH_ROUTER) p_router(a, layer, lds);
    if constexpr (PH == PH_DISPATCH) p_dispatch(a, layer, lds);
    if constexpr (PH == PH_GU) { constexpr int RBW = MOE_FP8 ? 1024 : 2048;
        pg8::SchedMoe S{G, bid, 8, 2048, __builtin_amdgcn_readfirstlane(__hip_atomic_load((const int*)(a.ws + WS_NRT), __ATOMIC_RELAXED, __HIP_MEMORY_SCOPE_AGENT)), (const int*)(a.ws + WS_TILEE),
                        (const char*)(a.ws + WS_WGU) + (size_t)layer * 32 * 2048 * RBW, (const int*)(a.ws + WS_TOK), RBW, false, false};
        pg8::EpiGU E{(void*)(a.ws + WS_ACT), a.in[19] + (size_t)layer * 32 * 2048, nost};
        pg8::gemm_phase<MOE_FP8>(lds, MOE_FP8 ? (const void*)(a.ws + WS_H8) : (const void*)(a.ws + WS_H), S, E); }
    if constexpr (PH == PH_DOWN) { constexpr int RBW = MOE_FP8 ? 1024 : 2048;
        pg8::SchedMoe S{G, bid, 4, 1024, __builtin_amdgcn_readfirstlane(__hip_atomic_load((const int*)(a.ws + WS_NRT), __ATOMIC_RELAXED, __HIP_MEMORY_SCOPE_AGENT)), (const int*)(a.ws + WS_TILEE),
                        (const char*)(a.ws + WS_WDN) + (size_t)layer * 32 * 1024 * RBW, nullptr, RBW, MOE_FP8 ? true : false, false};
        if (STAGGER_DOWN > 0 && ((bid >> 5) & 1)) { const unsigned long long t0 = wall_clock64(); while (wall_clock64() - t0 < (unsigned long long)STAGGER_DOWN) __builtin_amdgcn_s_sleep(16); }
        pg8::EpiDown E{(bf16*)(a.ws + WS_YM), a.in[21] + (size_t)layer * 32 * 1024, (const float*)(a.ws + WS_GATEP), nost}; pg8::gemm_phase<MOE_FP8>(lds, (const void*)(a.ws + WS_ACT), S, E); }
    if constexpr (PH == PH_COMBINE) { if (PROBE_DOUBLE == 97) p_combine(a, layer, true); p_combine(a, layer); }
}

template <int PH>
__global__ void __launch_bounds__(NTHR, 2) k_phase(Args a, int layer) {
    extern __shared__ __attribute__((aligned(16))) unsigned char lds[];
    kernel_setup(a);
    run_phase<PH>(layer, lds);
}


__global__ void __launch_bounds__(NTHR, 2) k_mega(Args a) {
    extern __shared__ __attribute__((aligned(16))) unsigned char lds[];
    kernel_setup(a);
    const XcdBarrier bar = xcd_barrier_post((unsigned*)(a.ws + WS_CTL) + CW_BAR, (volatile LAS unsigned*)(MISC_OFF + 32));
#define GRID_BAR() do { for (int rep_ = 0; rep_ < (PROBE_DOUBLE == 99 ? 2 : 1); ++rep_) { const Args b_ = fetch_args(); XcdBarrier bb; bb.bar = (unsigned*)(b_.ws + WS_CTL) + CW_BAR; bb.x = xb_xcc_id(); bb.st = (volatile LAS unsigned*)(MISC_OFF + 32); xcd_barrier(bb); } } while (0)
    run_phase<PH_PRO>(0, lds); GRID_BAR();
    if (PROBE_DOUBLE == PH_PRO) { run_phase<PH_PRO>(0, lds); GRID_BAR(); }
    run_phase<PH_NORM1>(0, lds); GRID_BAR();
#define RUNP(PH, l) do { run_phase<PH>(l, lds); if (PROBE_DOUBLE == PH) { GRID_BAR(); run_phase<PH>(l, lds, 1); } } while (0)
#define LAYER_BODY(l) do { \
        RUNP(PH_INPROJ, l); GRID_BAR(); \
        run_phase<PH_PREP>(l, lds); GRID_BAR(); \
        RUNP(PH_SCAN, l); GRID_BAR(); \
        RUNP(PH_ATTN, l); GRID_BAR(); \
        if (!NEW_HG || !NEW_ML) { RUNP(PH_FINISH, l); GRID_BAR(); } \
        run_phase<PH_OUTPROJ>(l, lds); GRID_BAR(); \
        if (PROBE_DOUBLE == 98 && (l) == 0) { run_phase<PH_OUTPROJ>(l, lds); GRID_BAR(); } \
        RUNP(PH_ROUTER, l); GRID_BAR(); \
        RUNP(PH_DISPATCH, l); GRID_BAR(); \
        RUNP(PH_GU, l); GRID_BAR(); \
        RUNP(PH_DOWN, l); GRID_BAR(); \
        run_phase<PH_COMBINE>(l, lds); \
        if ((l) + 1 < DEPTH) GRID_BAR(); \
    } while (0)
    LAYER_BODY(0); LAYER_BODY(1); LAYER_BODY(2); LAYER_BODY(3);
#undef LAYER_BODY
#undef RUNP
#undef GRID_BAR
}

template <int PH> static void launch_phase(const Args& a, int layer, int grid, hipStream_t stream) {
    static bool attr = false;
    if (!attr) { (void)hipFuncSetAttribute((const void*)k_phase<PH>, hipFuncAttributeMaxDynamicSharedMemorySize, LDS_BYTES); attr = true; }
    hipLaunchKernelGGL(k_phase<PH>, dim3(grid), dim3(NTHR), LDS_BYTES, stream, a, layer);
}

extern "C" void kernel_launch(void* const* d_in, const int* in_sizes, int n_in, void* d_out, int out_size, void* d_ws, size_t ws_size, hipStream_t stream) {
    static int grid = 0;
    if (grid == 0) {
        if (n_in != 22 || out_size != NB * SEQ * DM || ws_size < WS_END) { fprintf(stderr, "kernel_launch: unexpected shapes (n_in %d, out %d, ws %zu < %zu)\n", n_in, out_size, ws_size, (size_t)WS_END); grid = -1; return; }
        int dev = 0, cus = 0;
        if (hipGetDevice(&dev) != hipSuccess || hipDeviceGetAttribute(&cus, hipDeviceAttributeMultiprocessorCount, dev) != hipSuccess) { grid = -1; return; }
        grid = cus;
    }
    if (grid < 0) return;
    (void)hipMemsetAsync((char*)d_ws + WS_CTL, 0, CTL_ZERO_BYTES, stream);
    Args a{};
    for (int i = 0; i < 22; ++i) a.in[i] = (const float*)d_in[i];
    a.out = (float*)d_out; a.ws = (unsigned char*)d_ws; a.ph_lo = 0; a.ph_hi = 0;
#if MK_MULTI
    launch_phase<PH_PRO>(a, 0, grid, stream);
    launch_phase<PH_NORM1>(a, 0, grid, stream);
    for (int l = 0; l < DEPTH; ++l) {
        launch_phase<PH_INPROJ>(a, l, grid, stream);
        launch_phase<PH_PREP>(a, l, grid, stream);
        launch_phase<PH_SCAN>(a, l, grid, stream);
        launch_phase<PH_ATTN>(a, l, grid, stream);
        launch_phase<PH_FINISH>(a, l, grid, stream);
        launch_phase<PH_OUTPROJ>(a, l, grid, stream);
        launch_phase<PH_ROUTER>(a, l, grid, stream);
        launch_phase<PH_DISPATCH>(a, l, grid, stream);
        launch_phase<PH_GU>(a, l, grid, stream);
        launch_phase<PH_DOWN>(a, l, grid, stream);
        launch_phase<PH_COMBINE>(a, l, grid, stream);
    }
#else
    static bool attr = false;
    if (!attr) { (void)hipFuncSetAttribute((const void*)k_mega, hipFuncAttributeMaxDynamicSharedMemorySize, LDS_BYTES); attr = true; }
    hipLaunchKernelGGL(k_mega, dim3(grid), dim3(NTHR), LDS_BYTES, stream, a);
#endif
}
```
